# Optimizing an MI355X kernel written in HIP

```python
import math
import jax, jax.numpy as jnp
from jax import lax
import numpy as np

D_MODEL = 1024
BATCH = 4
SEQ = 4096
DEPTH = 1
DEC_BATCH = 128
DEC_SEQ = 1
PAST_LEN = 2048
PAGE_SIZE = 128

MIX_WIDTH = D_MODEL
SB_WIDTH = MIX_WIDTH // 2
SSM_WIDTH = MIX_WIDTH - SB_WIDTH
SB_HEAD_DIM = 64
SB_HEADS = SB_WIDTH // SB_HEAD_DIM
SB_BIAS_LO = -7.0
SB_BIAS_HI = -4.0
SSM_GROUP = 16
SSM_GROUPS = SSM_WIDTH // SSM_GROUP
SSM_STATE = 64
IN_WIDTH = 3 * SB_WIDTH + SSM_WIDTH
MEM_TOKENS = 256
MEM_HEADS = 4
MEM_HEAD_DIM = D_MODEL // MEM_HEADS
D_FF = ((8 * D_MODEL // 3 + 127) // 128) * 128
CONV_W = 3
BLOCK_Q = 128
EPS = 1e-6
DT_MIN = 1e-3
DT_MAX = 1e-1

kernel_name = "hymba_s5_stickbreaking_memxattn_convffn_step"


def _rmsnorm(x, g):
    xf = x.astype(jnp.float32)
    y = xf * lax.rsqrt(jnp.mean(xf * xf, axis=-1, keepdims=True) + EPS)
    return (y * g.astype(jnp.float32)).astype(x.dtype)


def _sb_block(q_blk, q_pos, k, v, k_pos, sb_bias):
    z = jnp.einsum('bqhd,bkhd->bhqk', q_blk.astype(jnp.float32), k.astype(jnp.float32)) / math.sqrt(SB_HEAD_DIM)
    z = z + sb_bias.astype(jnp.float32)[None, :, None, None]
    causal = k_pos[None, :] < q_pos[:, None]
    log_not_beta = jnp.where(causal, -jax.nn.softplus(z), 0.0)
    after = lax.cumsum(log_not_beta, axis=3, reverse=True) - log_not_beta
    a = jnp.where(causal, jnp.exp(jax.nn.log_sigmoid(z) + after), 0.0)
    return jnp.einsum('bhqk,bkhd->bqhd', a, v.astype(jnp.float32)).astype(v.dtype)


def _stick_breaking(q, k, v, q_pos, k_pos, sb_bias):
    b, n_q, h, dh = q.shape
    if n_q > BLOCK_Q and n_q % BLOCK_Q == 0:
        n_blk = n_q // BLOCK_Q
        qb = q.reshape(b, n_blk, BLOCK_Q, h, dh).transpose(1, 0, 2, 3, 4)
        pb = q_pos.reshape(n_blk, BLOCK_Q)
        out = lax.map(lambda a: _sb_block(a[0], a[1], k, v, k_pos, sb_bias), (qb, pb))
        return out.transpose(1, 0, 2, 3, 4).reshape(b, n_q, h, dh)
    return _sb_block(q, q_pos, k, v, k_pos, sb_bias)


def _s5(u, h0, lam_re, lam_im, log_dt, b_re, b_im, c_re, c_im, d_skip, w_glu, b_glu):
    bsz, t = u.shape[:2]
    ug = u.astype(jnp.float32).reshape(bsz, t, SSM_GROUPS, SSM_GROUP)
    lam = lax.complex(lam_re.astype(jnp.float32), lam_im.astype(jnp.float32))
    dt = jnp.exp(log_dt.astype(jnp.float32))[:, None]
    lam_bar = jnp.exp(lam * dt)
    bmat = lax.complex(b_re.astype(jnp.float32), b_im.astype(jnp.float32))
    cmat = lax.complex(c_re.astype(jnp.float32), c_im.astype(jnp.float32))
    b_bar = ((lam_bar - 1.0) / lam)[..., None] * bmat
    bu = jnp.einsum('gnp,btgp->btgn', b_bar, ug)
    bu = bu.at[:, 0].add(lam_bar * h0)
    decay = jnp.broadcast_to(lam_bar, bu.shape)

    def combine(e1, e2):
        a1, x1 = e1
        a2, x2 = e2
        return a2 * a1, a2 * x1 + x2

    _, hs = lax.associative_scan(combine, (decay, bu), axis=1)
    y = jnp.einsum('gpn,btgn->btgp', cmat, hs).real + d_skip.astype(jnp.float32).reshape(SSM_GROUPS, SSM_GROUP) * ug
    y = jax.nn.gelu(y.reshape(bsz, t, SSM_WIDTH))
    out = y * jax.nn.sigmoid(y @ w_glu.astype(jnp.float32) + b_glu.astype(jnp.float32))
    return out.astype(u.dtype), hs[:, -1]


def _mem_kv(mem, g_mem_kv, w_mk, w_mv):
    b = mem.shape[0]
    m = _rmsnorm(mem, g_mem_kv)
    mk = (m @ w_mk).reshape(b, MEM_TOKENS, MEM_HEADS, MEM_HEAD_DIM)
    mv = (m @ w_mv).reshape(b, MEM_TOKENS, MEM_HEADS, MEM_HEAD_DIM)
    return mk, mv


def _mem_attend(h, mk, mv, w_mq, w_mo):
    b, t, _ = h.shape
    q = (h @ w_mq).reshape(b, t, MEM_HEADS, MEM_HEAD_DIM)
    s = jnp.einsum('bqhd,bkhd->bhqk', q.astype(jnp.float32), mk.astype(jnp.float32)) / math.sqrt(MEM_HEAD_DIM)
    p = jax.nn.softmax(s, axis=-1)
    o = jnp.einsum('bhqk,bkhd->bqhd', p, mv.astype(jnp.float32)).reshape(b, t, D_MODEL)
    return o.astype(h.dtype) @ w_mo


def _conv_ffn(h, prev, w_gate, w_up, conv_w, conv_b, w_down):
    t = h.shape[1]
    gate_in = h @ w_gate
    buf = jnp.concatenate([prev.astype(gate_in.dtype), gate_in], axis=1)
    conv = conv_b
    for j in range(CONV_W):
        conv = conv + conv_w[j] * buf[:, j:j + t]
    out = (jax.nn.gelu(conv) * (h @ w_up)) @ w_down
    return out, buf[:, -(CONV_W - 1):]


def _layer(x, k_past, v_past, past_len, h0, conv_prev, mem_k, mem_v, lp):
    b, t, _ = x.shape
    h = _rmsnorm(x, lp['g_mix'])
    proj = h @ lp['w_in']
    q, k, v, u = jnp.split(proj, [SB_WIDTH, 2 * SB_WIDTH, 3 * SB_WIDTH], axis=-1)
    q = q.reshape(b, t, SB_HEADS, SB_HEAD_DIM)
    k = k.reshape(b, t, SB_HEADS, SB_HEAD_DIM)
    v = v.reshape(b, t, SB_HEADS, SB_HEAD_DIM)
    q_pos = past_len + jnp.arange(t, dtype=jnp.int32)
    if k_past is None:
        k_all, v_all, k_pos = k, v, q_pos
    else:
        k_all = jnp.concatenate([k_past.astype(k.dtype), k], axis=1)
        v_all = jnp.concatenate([v_past.astype(v.dtype), v], axis=1)
        k_pos = jnp.arange(past_len + t, dtype=jnp.int32)
    o_sb = _stick_breaking(q, k_all, v_all, q_pos, k_pos, lp['sb_bias']).reshape(b, t, SB_WIDTH)
    o_ssm, h_last = _s5(u, h0, lp['lam_re'], lp['lam_im'], lp['log_dt'], lp['b_re'], lp['b_im'],
                        lp['c_re'], lp['c_im'], lp['d_skip'], lp['w_glu'], lp['b_glu'])
    mix = jnp.concatenate([_rmsnorm(o_sb, lp['g_sb_out']), _rmsnorm(o_ssm, lp['g_ssm_out'])], axis=-1)
    x = x + mix @ lp['w_out']
    x = x + _mem_attend(_rmsnorm(x, lp['g_mem_q']), mem_k, mem_v, lp['w_mq'], lp['w_mo'])
    f, conv_state = _conv_ffn(_rmsnorm(x, lp['g_ffn']), conv_prev, lp['w_gate'], lp['w_up'],
                              lp['conv_w'], lp['conv_b'], lp['w_down'])
    x = x + f
    return x, k, v, h_last, conv_state


def setup_inputs(seed: int = 0) -> dict:
    key = jax.random.key(seed)
    ks = iter(jax.random.split(key, 48))
    f32 = jnp.float32

    def nrm(shape, scale):
        return jax.random.normal(next(ks), shape, f32) * scale

    def gain(shape):
        return 1.0 + nrm(shape, 0.02)

    n_pages = PAST_LEN // PAGE_SIZE
    n_pool = (DEC_BATCH * n_pages * 5) // 4
    L = DEPTH
    inp = {}
    inp['x_prompt'] = nrm((BATCH, SEQ, D_MODEL), 1.0)
    inp['x_sample'] = nrm((DEC_BATCH, DEC_SEQ, D_MODEL), 1.0)
    inp['cache_sb_k'] = nrm((L, n_pool, PAGE_SIZE, SB_HEADS, SB_HEAD_DIM), 1.0)
    inp['cache_sb_v'] = nrm((L, n_pool, PAGE_SIZE, SB_HEADS, SB_HEAD_DIM), 1.0)
    perm = jax.random.permutation(next(ks), n_pool)[:DEC_BATCH * n_pages]
    inp['page_table'] = perm.reshape(DEC_BATCH, n_pages).astype(jnp.int32)
    inp['state_ssm_re'] = nrm((L, DEC_BATCH, SSM_GROUPS, SSM_STATE), 0.5)
    inp['state_ssm_im'] = nrm((L, DEC_BATCH, SSM_GROUPS, SSM_STATE), 0.5)
    inp['state_conv'] = nrm((L, DEC_BATCH, CONV_W - 1, D_FF), 1.0)
    inp['cache_mem_k'] = nrm((L, DEC_BATCH, MEM_TOKENS, MEM_HEADS, MEM_HEAD_DIM), 1.0)
    inp['cache_mem_v'] = nrm((L, DEC_BATCH, MEM_TOKENS, MEM_HEADS, MEM_HEAD_DIM), 1.0)
    inp['mem_prompt'] = nrm((BATCH, MEM_TOKENS, D_MODEL), 1.0)
    inp['g_mix'] = gain((L, D_MODEL))
    inp['w_in'] = nrm((L, D_MODEL, IN_WIDTH), D_MODEL ** -0.5)
    inp['sb_bias'] = jax.random.uniform(next(ks), (L, SB_HEADS), f32, SB_BIAS_LO, SB_BIAS_HI)
    inp['lam_re'] = -0.5 + nrm((L, SSM_GROUPS, SSM_STATE), 0.01)
    inp['lam_im'] = math.pi * jnp.arange(SSM_STATE, dtype=f32) + nrm((L, SSM_GROUPS, SSM_STATE), 0.01)
    inp['log_dt'] = jax.random.uniform(next(ks), (L, SSM_GROUPS), f32, math.log(DT_MIN), math.log(DT_MAX))
    inp['b_re'] = nrm((L, SSM_GROUPS, SSM_STATE, SSM_GROUP), (2 * SSM_GROUP) ** -0.5)
    inp['b_im'] = nrm((L, SSM_GROUPS, SSM_STATE, SSM_GROUP), (2 * SSM_GROUP) ** -0.5)
    inp['c_re'] = nrm((L, SSM_GROUPS, SSM_GROUP, SSM_STATE), (2 * SSM_STATE) ** -0.5)
    inp['c_im'] = nrm((L, SSM_GROUPS, SSM_GROUP, SSM_STATE), (2 * SSM_STATE) ** -0.5)
    inp['d_skip'] = nrm((L, SSM_WIDTH), 1.0)
    inp['w_glu'] = nrm((L, SSM_WIDTH, SSM_WIDTH), SSM_WIDTH ** -0.5)
    inp['b_glu'] = nrm((L, SSM_WIDTH), 0.01)
    inp['g_sb_out'] = gain((L, SB_WIDTH))
    inp['g_ssm_out'] = gain((L, SSM_WIDTH))
    inp['w_out'] = nrm((L, MIX_WIDTH, D_MODEL), MIX_WIDTH ** -0.5)
    inp['g_mem_q'] = gain((L, D_MODEL))
    inp['g_mem_kv'] = gain((L, D_MODEL))
    inp['w_mq'] = nrm((L, D_MODEL, D_MODEL), D_MODEL ** -0.5)
    inp['w_mk'] = nrm((L, D_MODEL, D_MODEL), D_MODEL ** -0.5)
    inp['w_mv'] = nrm((L, D_MODEL, D_MODEL), D_MODEL ** -0.5)
    inp['w_mo'] = nrm((L, D_MODEL, D_MODEL), D_MODEL ** -0.5)
    inp['g_ffn'] = gain((L, D_MODEL))
    inp['w_gate'] = nrm((L, D_MODEL, D_FF), D_MODEL ** -0.5)
    inp['w_up'] = nrm((L, D_MODEL, D_FF), D_MODEL ** -0.5)
    inp['conv_w'] = nrm((L, CONV_W, D_FF), CONV_W ** -0.5)
    inp['conv_b'] = nrm((L, D_FF), 0.01)
    inp['w_down'] = nrm((L, D_FF, D_MODEL), D_FF ** -0.5)
    inp['g_final'] = gain((D_MODEL,))
    return inp


def reference(x_prompt, x_sample, cache_sb_k, cache_sb_v, page_table, state_ssm_re, state_ssm_im,
              state_conv, cache_mem_k, cache_mem_v, mem_prompt,
              g_mix, w_in, sb_bias, lam_re, lam_im, log_dt, b_re, b_im, c_re, c_im, d_skip, w_glu, b_glu,
              g_sb_out, g_ssm_out, w_out, g_mem_q, g_mem_kv, w_mq, w_mk, w_mv, w_mo,
              g_ffn, w_gate, w_up, conv_w, conv_b, w_down, g_final):
    n_p = x_prompt.shape[0]
    n_s = x_sample.shape[0]
    past_len = page_table.shape[1] * cache_sb_k.shape[2]
    yp, ys = x_prompt, x_sample
    pk, pv, pre, pim, pconv, pmk, pmv = [], [], [], [], [], [], []
    sk, sv, sre, sim, sconv = [], [], [], [], []
    for l in range(DEPTH):
        lp = dict(g_mix=g_mix[l], w_in=w_in[l], sb_bias=sb_bias[l], lam_re=lam_re[l], lam_im=lam_im[l],
                  log_dt=log_dt[l], b_re=b_re[l], b_im=b_im[l], c_re=c_re[l], c_im=c_im[l], d_skip=d_skip[l],
                  w_glu=w_glu[l], b_glu=b_glu[l], g_sb_out=g_sb_out[l], g_ssm_out=g_ssm_out[l],
                  w_out=w_out[l], g_mem_q=g_mem_q[l], w_mq=w_mq[l], w_mo=w_mo[l], g_ffn=g_ffn[l],
                  w_gate=w_gate[l], w_up=w_up[l], conv_w=conv_w[l], conv_b=conv_b[l], w_down=w_down[l])
        mk_p, mv_p = _mem_kv(mem_prompt, g_mem_kv[l], w_mk[l], w_mv[l])
        h0_p = jnp.zeros((n_p, SSM_GROUPS, SSM_STATE), jnp.complex64)
        conv0 = jnp.zeros((n_p, CONV_W - 1, D_FF), yp.dtype)
        yp, kp, vp, hp, cp = _layer(yp, None, None, 0, h0_p, conv0, mk_p, mv_p, lp)
        pk.append(kp); pv.append(vp); pconv.append(cp); pmk.append(mk_p); pmv.append(mv_p)
        pre.append(hp.real); pim.append(hp.imag)
        k_past = cache_sb_k[l][page_table].reshape(n_s, past_len, SB_HEADS, SB_HEAD_DIM)
        v_past = cache_sb_v[l][page_table].reshape(n_s, past_len, SB_HEADS, SB_HEAD_DIM)
        h0_s = lax.complex(state_ssm_re[l].astype(jnp.float32), state_ssm_im[l].astype(jnp.float32))
        ys, ks_, vs_, hs_, cs_ = _layer(ys, k_past, v_past, past_len, h0_s, state_conv[l],
                                        cache_mem_k[l], cache_mem_v[l], lp)
        sk.append(ks_); sv.append(vs_); sconv.append(cs_)
        sre.append(hs_.real); sim.append(hs_.imag)
    y_prompt = _rmsnorm(yp, g_final)
    y_sample = _rmsnorm(ys, g_final)
    return (y_prompt, y_sample,
            jnp.stack(pk), jnp.stack(pv), jnp.stack(pre), jnp.stack(pim), jnp.stack(pconv),
            jnp.stack(pmk), jnp.stack(pmv),
            jnp.stack(sk), jnp.stack(sv), jnp.stack(sre), jnp.stack(sim), jnp.stack(sconv))
```

```cpp
#include <hip/hip_runtime.h>
#include <cstdio>
#include <cstdint>
namespace nv {
constexpr int D = 1024, NB = 4, T = 4096, MPR = NB * T, MS = 128, M = MPR + MS;
constexpr int SBW = 512, NH = 8, HD = 64, NG = 32, GP = 16, NST = 64, INW = 2048;
constexpr int MT = 256, MH = 4, MHD = 256, FF = 2816, PAST = 2048, PAGE = 128, NPG = 16;
constexpr float EPS = 1e-6f;

__device__ __forceinline__ float gelu_tanh(float x) {
    const float u = 0.7978845608028654f * (x + 0.044715f * x * x * x);
    return 0.5f * x * (1.f + tanhf(u));
}
__device__ __forceinline__ float softplus(float z) { return fmaxf(z, 0.f) + log1pf(expf(-fabsf(z))); }

__global__ void k_rmsnorm(const float* in, int ldi, const float* g, float* out, int ldo, int n) {
    __shared__ float red[256];
    const float* x = in + (size_t)blockIdx.x * ldi; float* o = out + (size_t)blockIdx.x * ldo;
    float s = 0.f; for (int i = threadIdx.x; i < n; i += 256) { float v = x[i]; s += v * v; }
    red[threadIdx.x] = s; __syncthreads();
    for (int k = 128; k > 0; k >>= 1) { if ((int)threadIdx.x < k) red[threadIdx.x] += red[threadIdx.x + k]; __syncthreads(); }
    const float r = rsqrtf(red[0] / (float)n + EPS);
    for (int i = threadIdx.x; i < n; i += 256) o[i] = x[i] * r * g[i];
}
struct GemmP { const float* A; const float* B; const float* R; float* C; int lda, ldb, ldr, ldc, M, N, K, tb; float alpha; long sA1, sB1, sC1, sA2, sB2, sC2; int nb2; };
__global__ void __launch_bounds__(256) k_gemm(GemmP p) {
    __shared__ float As[16][65], Bs[16][65];
    const int z = blockIdx.z, z1 = z / p.nb2, z2 = z % p.nb2;
    const float* A = p.A + z1 * p.sA1 + z2 * p.sA2; const float* B = p.B + z1 * p.sB1 + z2 * p.sB2; float* C = p.C + z1 * p.sC1 + z2 * p.sC2;
    const float* R = p.R ? p.R + z1 * p.sC1 + z2 * p.sC2 : nullptr;
    const int m0 = blockIdx.y * 64, n0 = blockIdx.x * 64, tx = threadIdx.x & 15, ty = threadIdx.x >> 4;
    float acc[4][4] = {};
    for (int k0 = 0; k0 < p.K; k0 += 16) {
        for (int i = threadIdx.x; i < 1024; i += 256) {
            { const int kk = i & 15, mm = i >> 4; const int m = m0 + mm; As[kk][mm] = (m < p.M) ? A[(size_t)m * p.lda + k0 + kk] : 0.f; }
            if (p.tb) { const int kk = i & 15, nn = i >> 4; const int n = n0 + nn; Bs[kk][nn] = (n < p.N) ? B[(size_t)n * p.ldb + k0 + kk] : 0.f; }
            else { const int nn = i & 63, kk = i >> 6; const int n = n0 + nn; Bs[kk][nn] = (n < p.N) ? B[(size_t)(k0 + kk) * p.ldb + n] : 0.f; }
        }
        __syncthreads();
#pragma unroll
        for (int kk = 0; kk < 16; ++kk) {
            float a[4], b[4];
#pragma unroll
            for (int i = 0; i < 4; ++i) { a[i] = As[kk][ty * 4 + i]; b[i] = Bs[kk][tx * 4 + i]; }
#pragma unroll
            for (int i = 0; i < 4; ++i)
#pragma unroll
                for (int j = 0; j < 4; ++j) acc[i][j] += a[i] * b[j];
        }
        __syncthreads();
    }
#pragma unroll
    for (int i = 0; i < 4; ++i) { const int m = m0 + ty * 4 + i; if (m >= p.M) continue;
#pragma unroll
        for (int j = 0; j < 4; ++j) { const int n = n0 + tx * 4 + j; if (n >= p.N) continue;
            float v = p.alpha * acc[i][j]; if (R) v += R[(size_t)m * p.ldr + n]; C[(size_t)m * p.ldc + n] = v; } }
}
__global__ void k_copy_cols(const float* src, int lds_, int r0, int c0, int rows, int w, float* dst) {
    const long i = (long)blockIdx.x * 256 + threadIdx.x; if (i >= (long)rows * w) return;
    const int r = (int)(i / w), c = (int)(i % w); dst[i] = src[(size_t)(r0 + r) * lds_ + c0 + c];
}
__global__ void __launch_bounds__(64) k_sb_prompt(const float* proj, const float* sb_bias, float* osb) {
    __shared__ float Ks[64][64], Vs[64][64];
    const int qt = blockIdx.x, h = blockIdx.y, b = blockIdx.z, lane = threadIdx.x;
    const int t = qt * 64 + lane; const size_t row = (size_t)b * T + t;
    float q[64], o[64];
#pragma unroll
    for (int d = 0; d < 64; ++d) { q[d] = proj[row * INW + h * 64 + d]; o[d] = 0.f; }
    const float bias = sb_bias[h]; float run = 0.f;
    for (int kt = qt; kt >= 0; --kt) {
        for (int i = lane; i < 64 * 64; i += 64) { const int s = i >> 6, d = i & 63; const size_t kr = (size_t)b * T + kt * 64 + s;
            Ks[s][d] = proj[kr * INW + 512 + h * 64 + d]; Vs[s][d] = proj[kr * INW + 1024 + h * 64 + d]; }
        __syncthreads();
        for (int s = 63; s >= 0; --s) {
            const int kpos = kt * 64 + s;
            float z = 0.f;
#pragma unroll
            for (int d = 0; d < 64; ++d) z += q[d] * Ks[s][d];
            z = z * 0.125f + bias;
            if (kpos < t) {
                const float sp = softplus(z);
                const float a = expf(z - sp + run);
                run -= sp;
#pragma unroll
                for (int d = 0; d < 64; ++d) o[d] += a * Vs[s][d];
            }
        }
        __syncthreads();
    }
#pragma unroll
    for (int d = 0; d < 64; ++d) osb[row * SBW + h * 64 + d] = o[d];
}
__global__ void __launch_bounds__(256) k_sb_sample(const float* proj, const float* ck, const float* cv, const int* pt, const float* sb_bias, float* osb) {
    __shared__ float z[PAST], a[PAST], qs[64], part[4][64];
    const int h = blockIdx.x, b = blockIdx.y, tid = threadIdx.x; const size_t row = (size_t)MPR + b;
    if (tid < 64) qs[tid] = proj[row * INW + h * 64 + tid];
    __syncthreads();
    const float bias = sb_bias[h];
    for (int s = tid; s < PAST; s += 256) { const int pg = pt[b * NPG + s / PAGE]; const float* kr = ck + (((size_t)pg * PAGE + s % PAGE) * NH + h) * HD;
        float acc = 0.f; for (int d = 0; d < 64; ++d) acc += qs[d] * kr[d]; z[s] = acc * 0.125f + bias; }
    __syncthreads();
    if (tid == 0) { float run = 0.f; for (int s = PAST - 1; s >= 0; --s) { const float sp = softplus(z[s]); a[s] = expf(z[s] - sp + run); run -= sp; } }
    __syncthreads();
    { const int d = tid & 63, q4 = tid >> 6; float acc = 0.f;
      for (int s = q4; s < PAST; s += 4) { const int pg = pt[b * NPG + s / PAGE]; acc += a[s] * cv[(((size_t)pg * PAGE + s % PAGE) * NH + h) * HD + d]; }
      part[q4][d] = acc; }
    __syncthreads();
    if (tid < 64) osb[row * SBW + h * 64 + tid] = part[0][tid] + part[1][tid] + part[2][tid] + part[3][tid];
}
__global__ void __launch_bounds__(64) k_s5_scan(const float* proj, const float* st_re, const float* st_im, const float* lam_re, const float* lam_im, const float* log_dt,
                                                const float* b_re, const float* b_im, float* hs, float* out_re_p, float* out_im_p, float* out_re_s, float* out_im_s) {
    const int g = blockIdx.x, ba = blockIdx.y, n = threadIdx.x;
    const float lr = lam_re[g * NST + n], li = lam_im[g * NST + n], dt = expf(log_dt[g]);
    const float mag = expf(lr * dt), lbr = mag * cosf(li * dt), lbi = mag * sinf(li * dt);
    const float nr = lbr - 1.f, ni = lbi, den = lr * lr + li * li; const float cr = (nr * lr + ni * li) / den, ci = (ni * lr - nr * li) / den;
    float bbr[16], bbi[16];
#pragma unroll
    for (int p = 0; p < 16; ++p) { const float br = b_re[(g * NST + n) * GP + p], bi = b_im[(g * NST + n) * GP + p]; bbr[p] = cr * br - ci * bi; bbi[p] = cr * bi + ci * br; }
    float hr = 0.f, hi = 0.f; int steps = T; size_t row0 = (size_t)ba * T;
    if (ba >= NB) { const int b = ba - NB; hr = st_re[(b * NG + g) * NST + n]; hi = st_im[(b * NG + g) * NST + n]; steps = 1; row0 = (size_t)MPR + b; }
    for (int t = 0; t < steps; ++t) {
        const float* u = proj + (row0 + t) * INW + 1536 + g * GP;
        float br = 0.f, bi = 0.f;
#pragma unroll
        for (int p = 0; p < 16; ++p) { const float uv = u[p]; br += bbr[p] * uv; bi += bbi[p] * uv; }
        const float nhr = lbr * hr - lbi * hi + br, nhi = lbr * hi + lbi * hr + bi; hr = nhr; hi = nhi;
        float* o = hs + (((row0 + t) * NG + g) * NST + n) * 2; o[0] = hr; o[1] = hi;
    }
    if (ba < NB) { out_re_p[(ba * NG + g) * NST + n] = hr; out_im_p[(ba * NG + g) * NST + n] = hi; }
    else { const int b = ba - NB; out_re_s[(b * NG + g) * NST + n] = hr; out_im_s[(b * NG + g) * NST + n] = hi; }
}
__global__ void k_s5_out(const float* proj, const float* hs, const float* c_re, const float* c_im, const float* d_skip, float* yg) {
    const long i = (long)blockIdx.x * 256 + threadIdx.x; if (i >= (long)M * SBW) return;
    const int row = (int)(i / SBW), ch = (int)(i % SBW), g = ch / GP, p = ch % GP;
    const float* h = hs + ((size_t)row * NG + g) * NST * 2; float acc = 0.f;
    for (int n = 0; n < NST; ++n) acc += c_re[(g * GP + p) * NST + n] * h[2 * n] - c_im[(g * GP + p) * NST + n] * h[2 * n + 1];
    acc += d_skip[ch] * proj[(size_t)row * INW + 1536 + ch];
    yg[i] = gelu_tanh(acc);
}
__global__ void k_glu(const float* yg, const float* zl, const float* b_glu, float* ossm) {
    const long i = (long)blockIdx.x * 256 + threadIdx.x; if (i >= (long)M * SBW) return;
    const int ch = (int)(i % SBW); const float z = zl[i] + b_glu[ch]; ossm[i] = yg[i] / (1.f + expf(-z));
}
__global__ void k_softmax256(float* s, float alpha) {
    __shared__ float red[256];
    float* x = s + (size_t)blockIdx.x * 256; const float v = x[threadIdx.x] * alpha;
    red[threadIdx.x] = v; __syncthreads();
    for (int k = 128; k > 0; k >>= 1) { if ((int)threadIdx.x < k) red[threadIdx.x] = fmaxf(red[threadIdx.x], red[threadIdx.x + k]); __syncthreads(); }
    const float mx = red[0]; __syncthreads();
    const float e = expf(v - mx); red[threadIdx.x] = e; __syncthreads();
    for (int k = 128; k > 0; k >>= 1) { if ((int)threadIdx.x < k) red[threadIdx.x] += red[threadIdx.x + k]; __syncthreads(); }
    x[threadIdx.x] = e / red[0];
}
__global__ void __launch_bounds__(256) k_xattn_sample(const float* Q, const float* ck, const float* cv, float* om) {
    __shared__ float qs[256], p[256], red[256];
    const int h = blockIdx.x, b = blockIdx.y, tid = threadIdx.x; const size_t row = (size_t)MPR + b;
    qs[tid] = Q[row * D + h * MHD + tid]; __syncthreads();
    { const float* kr = ck + (((size_t)b * MT + tid) * MH + h) * MHD; float acc = 0.f; for (int d = 0; d < MHD; ++d) acc += qs[d] * kr[d]; p[tid] = acc * 0.0625f; }
    red[tid] = p[tid]; __syncthreads();
    for (int k = 128; k > 0; k >>= 1) { if (tid < k) red[tid] = fmaxf(red[tid], red[tid + k]); __syncthreads(); }
    const float mx = red[0]; __syncthreads();
    const float e = expf(p[tid] - mx); red[tid] = e; __syncthreads();
    for (int k = 128; k > 0; k >>= 1) { if (tid < k) red[tid] += red[tid + k]; __syncthreads(); }
    const float inv = 1.f / red[0]; __syncthreads();
    p[tid] = e * inv; __syncthreads();
    float acc = 0.f; for (int t = 0; t < MT; ++t) acc += p[t] * cv[(((size_t)b * MT + t) * MH + h) * MHD + tid];
    om[row * D + h * MHD + tid] = acc;
}
__global__ void k_conv_act(const float* G, const float* U, const float* conv_w, const float* conv_b, const float* state_conv, float* act) {
    const long i = (long)blockIdx.x * 256 + threadIdx.x; if (i >= (long)M * FF) return;
    const int row = (int)(i / FF), j = (int)(i % FF);
    float g2, g1; const float g0 = G[i];
    if (row < MPR) { const int t = row % T; g1 = t >= 1 ? G[i - FF] : 0.f; g2 = t >= 2 ? G[i - 2 * FF] : 0.f; }
    else { const int b = row - MPR; g2 = state_conv[((size_t)b * 2 + 0) * FF + j]; g1 = state_conv[((size_t)b * 2 + 1) * FF + j]; }
    const float c = conv_b[j] + conv_w[j] * g2 + conv_w[FF + j] * g1 + conv_w[2 * FF + j] * g0;
    act[i] = gelu_tanh(c) * U[i];
}
__global__ void k_conv_out(const float* G, const float* state_conv, float* conv_p, float* conv_s) {
    const long i = (long)blockIdx.x * 256 + threadIdx.x;
    if (i < (long)NB * 2 * FF) { const int b = (int)(i / (2 * FF)), r = (int)((i / FF) % 2), j = (int)(i % FF); conv_p[i] = G[((size_t)b * T + T - 2 + r) * FF + j]; }
    if (i < (long)MS * 2 * FF) { const int b = (int)(i / (2 * FF)), r = (int)((i / FF) % 2), j = (int)(i % FF);
        conv_s[i] = r == 0 ? state_conv[((size_t)b * 2 + 1) * FF + j] : G[((size_t)MPR + b) * FF + j]; }
}

inline void gemm(hipStream_t st, const float* A, int lda, const float* B, int ldb, float* C, int ldc, int M_, int N_, int K_, const float* R = nullptr, int ldr = 0, float alpha = 1.f,
                 int tb = 0, int nb1 = 1, int nb2 = 1, long sA1 = 0, long sB1 = 0, long sC1 = 0, long sA2 = 0, long sB2 = 0, long sC2 = 0) {
    GemmP p{}; p.A = A; p.B = B; p.R = R; p.C = C; p.lda = lda; p.ldb = ldb; p.ldr = ldr; p.ldc = ldc; p.M = M_; p.N = N_; p.K = K_; p.tb = tb; p.alpha = alpha;
    p.sA1 = sA1; p.sB1 = sB1; p.sC1 = sC1; p.sA2 = sA2; p.sB2 = sB2; p.sC2 = sC2; p.nb2 = nb2;
    hipLaunchKernelGGL(k_gemm, dim3((N_ + 63) / 64, (M_ + 63) / 64, nb1 * nb2), dim3(256), 0, st, p);
}

constexpr size_t O_YP = 0, O_YS = O_YP + (size_t)MPR * D, O_KP = O_YS + (size_t)MS * D, O_VP = O_KP + (size_t)MPR * SBW, O_REP = O_VP + (size_t)MPR * SBW,
    O_IMP = O_REP + NB * NG * NST, O_CVP = O_IMP + NB * NG * NST, O_MKP = O_CVP + (size_t)NB * 2 * FF, O_MVP = O_MKP + (size_t)NB * MT * D, O_KS = O_MVP + (size_t)NB * MT * D,
    O_VS = O_KS + (size_t)MS * SBW, O_RES = O_VS + (size_t)MS * SBW, O_IMS = O_RES + (size_t)MS * NG * NST, O_CVS = O_IMS + (size_t)MS * NG * NST, O_END = O_CVS + (size_t)MS * 2 * FF;

struct Bufs { float *XA, *H, *PROJ, *OSB, *HS, *YG, *ZL, *OSSM, *MIX, *X1, *MN, *Q, *S, *OM, *X2, *G, *U, *ACT, *X3; };
inline Bufs carve(float* ws) {
    Bufs b; size_t o = 0; auto take = [&](size_t n) { float* p = ws + o; o += (n + 63) & ~(size_t)63; return p; };
    b.XA = take((size_t)M * D); b.H = take((size_t)M * D); b.PROJ = take((size_t)M * INW); b.OSB = take((size_t)M * SBW); b.HS = take((size_t)M * NG * NST * 2);
    b.YG = take((size_t)M * SBW); b.ZL = take((size_t)M * SBW); b.OSSM = take((size_t)M * SBW); b.MIX = take((size_t)M * D); b.X1 = take((size_t)M * D); b.MN = take((size_t)NB * MT * D);
    b.Q = take((size_t)M * D); b.S = take((size_t)MPR * MH * MT); b.OM = take((size_t)M * D); b.X2 = take((size_t)M * D); b.G = take((size_t)M * FF); b.U = take((size_t)M * FF);
    b.ACT = take((size_t)M * FF); b.X3 = take((size_t)M * D);
    return b;
}
constexpr size_t WS_FLOATS = (size_t)M * (D * 9 + INW + SBW * 4 + NG * NST * 2 + FF * 3) + (size_t)NB * MT * D + (size_t)MPR * MH * MT + 64 * 32;

inline void forward(void* const* d_in, float* out, float* ws, hipStream_t st) {
    const float* x_prompt = (const float*)d_in[0]; const float* x_sample = (const float*)d_in[1]; const float* cache_k = (const float*)d_in[2]; const float* cache_v = (const float*)d_in[3];
    const int* page_table = (const int*)d_in[4]; const float* st_re = (const float*)d_in[5]; const float* st_im = (const float*)d_in[6]; const float* state_conv = (const float*)d_in[7];
    const float* cmk = (const float*)d_in[8]; const float* cmv = (const float*)d_in[9]; const float* mem_prompt = (const float*)d_in[10];
    const float* g_mix = (const float*)d_in[11]; const float* w_in = (const float*)d_in[12]; const float* sb_bias = (const float*)d_in[13]; const float* lam_re = (const float*)d_in[14];
    const float* lam_im = (const float*)d_in[15]; const float* log_dt = (const float*)d_in[16]; const float* b_re = (const float*)d_in[17]; const float* b_im = (const float*)d_in[18];
    const float* c_re = (const float*)d_in[19]; const float* c_im = (const float*)d_in[20]; const float* d_skip = (const float*)d_in[21]; const float* w_glu = (const float*)d_in[22];
    const float* b_glu = (const float*)d_in[23]; const float* g_sb_out = (const float*)d_in[24]; const float* g_ssm_out = (const float*)d_in[25]; const float* w_out = (const float*)d_in[26];
    const float* g_mem_q = (const float*)d_in[27]; const float* g_mem_kv = (const float*)d_in[28]; const float* w_mq = (const float*)d_in[29]; const float* w_mk = (const float*)d_in[30];
    const float* w_mv = (const float*)d_in[31]; const float* w_mo = (const float*)d_in[32]; const float* g_ffn = (const float*)d_in[33]; const float* w_gate = (const float*)d_in[34];
    const float* w_up = (const float*)d_in[35]; const float* conv_w = (const float*)d_in[36]; const float* conv_b = (const float*)d_in[37]; const float* w_down = (const float*)d_in[38];
    const float* g_final = (const float*)d_in[39];
    Bufs B = carve(ws);
    hipMemcpyAsync(B.XA, x_prompt, (size_t)MPR * D * 4, hipMemcpyDeviceToDevice, st);
    hipMemcpyAsync(B.XA + (size_t)MPR * D, x_sample, (size_t)MS * D * 4, hipMemcpyDeviceToDevice, st);
    hipLaunchKernelGGL(k_rmsnorm, dim3(M), dim3(256), 0, st, B.XA, D, g_mix, B.H, D, D);
    gemm(st, B.H, D, w_in, INW, B.PROJ, INW, M, INW, D);
    hipLaunchKernelGGL(k_copy_cols, dim3((MPR * SBW + 255) / 256), dim3(256), 0, st, B.PROJ, INW, 0, 512, MPR, SBW, out + O_KP);
    hipLaunchKernelGGL(k_copy_cols, dim3((MPR * SBW + 255) / 256), dim3(256), 0, st, B.PROJ, INW, 0, 1024, MPR, SBW, out + O_VP);
    hipLaunchKernelGGL(k_copy_cols, dim3((MS * SBW + 255) / 256), dim3(256), 0, st, B.PROJ, INW, MPR, 512, MS, SBW, out + O_KS);
    hipLaunchKernelGGL(k_copy_cols, dim3((MS * SBW + 255) / 256), dim3(256), 0, st, B.PROJ, INW, MPR, 1024, MS, SBW, out + O_VS);
    hipLaunchKernelGGL(k_sb_prompt, dim3(T / 64, NH, NB), dim3(64), 0, st, B.PROJ, sb_bias, B.OSB);
    hipLaunchKernelGGL(k_sb_sample, dim3(NH, MS), dim3(256), 0, st, B.PROJ, cache_k, cache_v, page_table, sb_bias, B.OSB);
    hipLaunchKernelGGL(k_s5_scan, dim3(NG, NB + MS), dim3(64), 0, st, B.PROJ, st_re, st_im, lam_re, lam_im, log_dt, b_re, b_im, B.HS, out + O_REP, out + O_IMP, out + O_RES, out + O_IMS);
    hipLaunchKernelGGL(k_s5_out, dim3((int)(((long)M * SBW + 255) / 256)), dim3(256), 0, st, B.PROJ, B.HS, c_re, c_im, d_skip, B.YG);
    gemm(st, B.YG, SBW, w_glu, SBW, B.ZL, SBW, M, SBW, SBW);
    hipLaunchKernelGGL(k_glu, dim3((int)(((long)M * SBW + 255) / 256)), dim3(256), 0, st, B.YG, B.ZL, b_glu, B.OSSM);
    hipLaunchKernelGGL(k_rmsnorm, dim3(M), dim3(256), 0, st, B.OSB, SBW, g_sb_out, B.MIX, D, SBW);
    hipLaunchKernelGGL(k_rmsnorm, dim3(M), dim3(256), 0, st, B.OSSM, SBW, g_ssm_out, B.MIX + SBW, D, SBW);
    gemm(st, B.MIX, D, w_out, D, B.X1, D, M, D, D, B.XA, D);
    hipLaunchKernelGGL(k_rmsnorm, dim3(NB * MT), dim3(256), 0, st, mem_prompt, D, g_mem_kv, B.MN, D, D);
    gemm(st, B.MN, D, w_mk, D, out + O_MKP, D, NB * MT, D, D);
    gemm(st, B.MN, D, w_mv, D, out + O_MVP, D, NB * MT, D, D);
    hipLaunchKernelGGL(k_rmsnorm, dim3(M), dim3(256), 0, st, B.X1, D, g_mem_q, B.H, D, D);
    gemm(st, B.H, D, w_mq, D, B.Q, D, M, D, D);
    gemm(st, B.Q, D, out + O_MKP, D, B.S, MT, T, MT, MHD, nullptr, 0, 1.f, 1, NB, MH, (long)T * D, (long)MT * D, (long)MH * T * MT, MHD, MHD, (long)T * MT);
    hipLaunchKernelGGL(k_softmax256, dim3(MPR * MH), dim3(256), 0, st, B.S, 0.0625f);
    gemm(st, B.S, MT, out + O_MVP, D, B.OM, D, T, MHD, MT, nullptr, 0, 1.f, 0, NB, MH, (long)MH * T * MT, (long)MT * D, (long)T * D, (long)T * MT, MHD, MHD);
    hipLaunchKernelGGL(k_xattn_sample, dim3(MH, MS), dim3(256), 0, st, B.Q, cmk, cmv, B.OM);
    gemm(st, B.OM, D, w_mo, D, B.X2, D, M, D, D, B.X1, D);
    hipLaunchKernelGGL(k_rmsnorm, dim3(M), dim3(256), 0, st, B.X2, D, g_ffn, B.H, D, D);
    gemm(st, B.H, D, w_gate, FF, B.G, FF, M, FF, D);
    gemm(st, B.H, D, w_up, FF, B.U, FF, M, FF, D);
    hipLaunchKernelGGL(k_conv_out, dim3((MS * 2 * FF + 255) / 256), dim3(256), 0, st, B.G, state_conv, out + O_CVP, out + O_CVS);
    hipLaunchKernelGGL(k_conv_act, dim3((int)(((long)M * FF + 255) / 256)), dim3(256), 0, st, B.G, B.U, conv_w, conv_b, state_conv, B.ACT);
    gemm(st, B.ACT, FF, w_down, D, B.X3, D, M, D, FF, B.X2, D);
    hipLaunchKernelGGL(k_rmsnorm, dim3(MPR), dim3(256), 0, st, B.X3, D, g_final, out + O_YP, D, D);
    hipLaunchKernelGGL(k_rmsnorm, dim3(MS), dim3(256), 0, st, B.X3 + (size_t)MPR * D, D, g_final, out + O_YS, D, D);
}
}
extern "C" void kernel_launch(void* const* d_in, const int* in_sizes, int n_in, void* d_out, int out_size, void* d_ws, size_t ws_size, hipStream_t stream) {
    if (n_in != 40 || (size_t)out_size != nv::O_END || ws_size < nv::WS_FLOATS * 4) { fprintf(stderr, "kernel_launch: unexpected shapes n_in %d out %d ws %zu\n", n_in, out_size, ws_size); return; }
    nv::forward(d_in, (float*)d_out, (float*)d_ws, stream);
}
```

```cpp
#define MK_DEBUG 0
#define MK_ONE_LAUNCH 1
#include <hip/hip_runtime.h>
#include <cstdio>
#include <cstdint>
#include <cmath>
namespace pg8 {
#define PG8_LAS __attribute__((address_space(3)))
typedef unsigned short bf16_t;
typedef short bf16x8 __attribute__((ext_vector_type(8)));
typedef float f32x4 __attribute__((ext_vector_type(4)));
typedef unsigned u32x4 __attribute__((ext_vector_type(4)));
constexpr int BM = 256, BK = 64, HALF = 128, HTB = HALF * BK * 2  , STAGE_BYTES = 8 * HTB, NXCD = 8, WGM = 8;

__host__ __device__ __forceinline__ int lds_byte(int r, int c) { const int st = (r >> 4) * 2 + (c >> 5), rr = r & 15, cc = c & 31, ob = rr * 64 + cc * 2; return st * 1024 + (ob ^ (((ob >> 9) & 1) << 5)); }
__host__ __device__ __forceinline__ void stage_rc(int b, int& R, int& C) { const int st = b / 1024, sb = b % 1024, swz = sb ^ (((sb >> 9) & 1) << 5); R = (st >> 1) * 16 + swz / 64; C = (st & 1) * 32 + (swz % 64) / 2; }
__host__ __device__ __forceinline__ int perm32(int rho) { const int n = rho >> 4, i = rho & 15; return 8 * (i >> 2) + 4 * n + (i & 3); }

struct Unit { int pm, pn; };
struct Gemm { const bf16_t* A; const bf16_t* Bt; int lda, ldb, K; };

struct GridOrder {
    int nM, nN, nwg, G, c; size_t astep, bstep;
    __device__ void init(int nM_, int nN_, int G_, int c_, int shift, int lda, int ldb) { nM = nM_; nN = nN_; nwg = nM * nN; G = G_; c = (c_ + G_ - (shift % G_)) % G_; astep = (size_t)BM * lda * 2; bstep = (size_t)BM * ldb * 2; }
    __device__ bool next(int i, Unit& u) const {
        const long L = (long)i * G + c; if (L >= nwg) return false;
        int wgid = (int)L; { const int q = nwg / NXCD, r = nwg % NXCD, xcd = wgid % NXCD, off = wgid / NXCD; wgid = (xcd < r ? xcd * (q + 1) : r * (q + 1) + (xcd - r) * q) + off; }
        const int nig = WGM * nN, gid = wgid / nig, fm = gid * WGM, gsz = (nM - fm) < WGM ? (nM - fm) : WGM;
        u.pm = fm + ((wgid % nig) % gsz); u.pn = (wgid % nig) / gsz; return true;
    }
    __device__ __forceinline__ size_t aoff(const Unit& u) const { return (size_t)u.pm * astep; }
    __device__ __forceinline__ size_t boff(const Unit& u) const { return (size_t)u.pn * bstep; }
};

__device__ __forceinline__ unsigned cvt_pk_bf16(float lo, float hi) { unsigned r; asm volatile("v_cvt_pk_bf16_f32 %0, %1, %2" : "=v"(r) : "v"(lo), "v"(hi)); return r; }

template <class Epi, class Sched, bool ALIGN_EPI = true, bool SP2 = true>
__device__ __forceinline__ void gemm_phase(PG8_LAS unsigned char* lds, const Gemm g, const Sched& S, const Epi& E) {
    const int tid = threadIdx.x, wid = __builtin_amdgcn_readfirstlane(tid >> 6), lane = tid & 63, wr = wid >> 2, wc = wid & 3, fr = lane & 15, fq = lane >> 4;
    const int K = g.K, nt = K / BK;
    unsigned voffA[2], voffB[2];
#pragma unroll
    for (int i = 0; i < 2; ++i) { int R, C; stage_rc(tid * 16 + i * 8192, R, C); const int Rb = (R & ~31) + perm32(R & 31);
        voffA[i] = (unsigned)(R * g.lda + C) * 2u; voffB[i] = (unsigned)(Rb * g.ldb + C) * 2u; }
    const size_t kstep = (size_t)(BK * 2);
    const size_t hstepA = (size_t)HALF * g.lda * 2, hstepB = (size_t)HALF * g.ldb * 2;
    const unsigned ldsw = (unsigned)wid * 1024u;
    const int aoff = lds_byte(wr * 64 + fr, fq * 8), boff = lds_byte(wc * 32 + fr, fq * 8);
#define PG8_SA(b, h) (((b) * 2 + (h)) * HTB)
#define PG8_SB(b, h) ((4 + (b) * 2 + (h)) * HTB)
#define PG8_STAGE(bufoff, gbase, voff) do { _Pragma("unroll") for (int _i = 0; _i < 2; ++_i) \
        __builtin_amdgcn_global_load_lds((const unsigned*)((const char*)(gbase) + (voff)[_i]), (PG8_LAS unsigned*)(lds + (bufoff) + ldsw + _i * 8192), 16, 0, 0); } while (0)
#define PG8_LDA(dst, b, h) do { _Pragma("unroll") for (int m = 0; m < 4; ++m) _Pragma("unroll") for (int k = 0; k < 2; ++k) dst[m][k] = *(const PG8_LAS bf16x8*)(lds + PG8_SA(b, h) + aoff + m * 2048 + k * 1024); } while (0)
#define PG8_LDB(dst, b, h) do { _Pragma("unroll") for (int n = 0; n < 2; ++n) _Pragma("unroll") for (int k = 0; k < 2; ++k) dst[n][k] = *(const PG8_LAS bf16x8*)(lds + PG8_SB(b, h) + boff + n * 2048 + k * 1024); } while (0)
#define PG8_MMA(ai, bj, At, Bt) do { __builtin_amdgcn_s_setprio(1); _Pragma("unroll") for (int m = 0; m < 4; ++m) _Pragma("unroll") for (int n = 0; n < 2; ++n) _Pragma("unroll") for (int k = 0; k < 2; ++k) \
        acc[ai][bj][m][n] = __builtin_amdgcn_mfma_f32_16x16x32_bf16(Bt[n][k], At[m][k], acc[ai][bj][m][n], 0, 0, 0); __builtin_amdgcn_s_setprio(0); } while (0)
#define PG8_WAIT_V(n) asm volatile("s_waitcnt vmcnt(" #n ")" ::: "memory")
#define PG8_WAIT_L(n) asm volatile("s_waitcnt lgkmcnt(" #n ")" ::: "memory")
#define PG8_BAR __builtin_amdgcn_s_barrier()
#define PG8_SCHED __builtin_amdgcn_sched_barrier(0)
    Unit cur, nxt; int ui = 0;
    if (!S.next(0, cur)) return;
    f32x4 acc[2][2][4][2];
#pragma unroll
    for (int a = 0; a < 2; ++a)
#pragma unroll
        for (int b = 0; b < 2; ++b)
#pragma unroll
            for (int m = 0; m < 4; ++m)
#pragma unroll
                for (int n = 0; n < 2; ++n) acc[a][b][m][n] = (f32x4){0.f, 0.f, 0.f, 0.f};
    bf16x8 At[4][2], B0[2][2], B1[2][2];
    const char* cA = (const char*)g.A + S.aoff(cur); const char* cB = (const char*)g.Bt + S.boff(cur);
    static_assert(SP2, "only the SP2 loop is kept in this file");
    PG8_STAGE(PG8_SB(0, 0), cB, voffB); PG8_STAGE(PG8_SB(0, 1), cB + hstepB, voffB); PG8_STAGE(PG8_SA(0, 0), cA, voffA); PG8_STAGE(PG8_SA(0, 1), cA + hstepA, voffA);
    if (wr == 1) PG8_BAR;
    PG8_WAIT_V(2); PG8_BAR;
    PG8_STAGE(PG8_SB(1, 0), cB + kstep, voffB); PG8_STAGE(PG8_SA(1, 0), cA + kstep, voffA); PG8_STAGE(PG8_SB(1, 1), cB + hstepB + kstep, voffB);
    PG8_WAIT_V(6); PG8_BAR;
    for (;;) {
        const bool has_next = S.next(ui + 1, nxt);
        const char* nA = has_next ? (const char*)g.A + S.aoff(nxt) : cA; const char* nB = has_next ? (const char*)g.Bt + S.boff(nxt) : cB;
        for (int t = 0; t < nt; t += 2) {
            const bool last = (t == nt - 2);
            const char* a1 = cA + (size_t)(t + 1) * kstep;
            const char* a2 = last ? nA : cA + (size_t)(t + 2) * kstep; const char* b2 = last ? nB : cB + (size_t)(t + 2) * kstep;
            const char* a3 = a2 + kstep; const char* b3 = b2 + kstep;
            PG8_LDB(B0, 0, 0); PG8_LDB(B1, 0, 1); PG8_SCHED; PG8_LDA(At, 0, 0); PG8_STAGE(PG8_SA(1, 1), a1 + hstepA, voffA);
            PG8_WAIT_V(8); PG8_WAIT_L(0); PG8_BAR; PG8_MMA(0, 0, At, B0); PG8_MMA(0, 1, At, B1); PG8_BAR; PG8_SCHED;
            PG8_LDA(At, 0, 1); PG8_STAGE(PG8_SB(0, 0), b2, voffB); PG8_STAGE(PG8_SB(0, 1), b2 + hstepB, voffB); PG8_STAGE(PG8_SA(0, 0), a2, voffA);
            PG8_WAIT_V(8); PG8_WAIT_L(0); PG8_BAR; PG8_MMA(1, 0, At, B0); PG8_MMA(1, 1, At, B1); PG8_BAR; PG8_SCHED;
            PG8_LDB(B0, 1, 0); PG8_LDB(B1, 1, 1); PG8_SCHED; PG8_LDA(At, 1, 0); PG8_STAGE(PG8_SA(0, 1), a2 + hstepA, voffA);
            PG8_WAIT_V(8); PG8_WAIT_L(0); PG8_BAR; PG8_MMA(0, 0, At, B0); PG8_MMA(0, 1, At, B1); PG8_BAR; PG8_SCHED;
            PG8_LDA(At, 1, 1); PG8_STAGE(PG8_SB(1, 0), b3, voffB); PG8_STAGE(PG8_SB(1, 1), b3 + hstepB, voffB); PG8_STAGE(PG8_SA(1, 0), a3, voffA);
            PG8_WAIT_V(8); PG8_WAIT_L(0); PG8_BAR; PG8_MMA(1, 0, At, B0); PG8_MMA(1, 1, At, B1); PG8_BAR; PG8_SCHED;
        }
        if constexpr (ALIGN_EPI) { if (wr == 0) PG8_BAR; }
        E(acc, cur, wr, wc, fr, fq);
        if (!has_next) break;
#pragma unroll
        for (int a = 0; a < 2; ++a)
#pragma unroll
            for (int b = 0; b < 2; ++b)
#pragma unroll
                for (int m = 0; m < 4; ++m)
#pragma unroll
                    for (int n = 0; n < 2; ++n) acc[a][b][m][n] = (f32x4){0.f, 0.f, 0.f, 0.f};
        cur = nxt; cA = nA; cB = nB; ++ui;
        if constexpr (ALIGN_EPI) { if (wr == 1) PG8_BAR; }
    }
    PG8_WAIT_V(0);
    if constexpr (!ALIGN_EPI) { if (wr == 0) PG8_BAR; }
    PG8_BAR;
#undef PG8_SA
#undef PG8_SB
#undef PG8_STAGE
#undef PG8_LDA
#undef PG8_LDB
#undef PG8_MMA
#undef PG8_WAIT_V
#undef PG8_WAIT_L
#undef PG8_BAR
#undef PG8_SCHED
}
}
constexpr int NWAVES = 8, NTHR = 512;
constexpr int D = 1024, NB = 4, T = 4096, MPR = NB * T, MS = 128, MALL = MPR + MS, MPAD = 16640;
constexpr int SBW = 512, NH = 8, HD = 64, NG = 32, GP = 16, NST = 64, INW = 2048, FF = 2816, NFF2 = 2 * FF;
constexpr int MT = 256, MH = 4, MHD = 256, PAST = 2048, PAGE = 128, NPG = 16;
constexpr int LC = 16, NCH = T / LC, XHP = 384;
constexpr float EPS = 1e-6f, LOG2E = 1.4426950408889634f;
constexpr float C2 = 0.125f * LOG2E;
constexpr float CM = 0.0625f * LOG2E;

constexpr size_t O_YP = 0, O_YS = O_YP + (size_t)MPR * D, O_KP = O_YS + (size_t)MS * D, O_VP = O_KP + (size_t)MPR * SBW, O_REP = O_VP + (size_t)MPR * SBW,
    O_IMP = O_REP + NB * NG * NST, O_CVP = O_IMP + NB * NG * NST, O_MKP = O_CVP + (size_t)NB * 2 * FF, O_MVP = O_MKP + (size_t)NB * MT * D, O_KS = O_MVP + (size_t)NB * MT * D,
    O_VS = O_KS + (size_t)MS * SBW, O_RES = O_VS + (size_t)MS * SBW, O_IMS = O_RES + (size_t)MS * NG * NST, O_CVS = O_IMS + (size_t)MS * NG * NST, O_END = O_CVS + (size_t)MS * 2 * FF;

constexpr size_t MiB = 1u << 20;
constexpr size_t al(size_t x) { return (x + 4095) & ~(size_t)4095; }
constexpr size_t WS_CTL = 0, CTL_ZERO_BYTES = 1 * MiB;
constexpr size_t WS_WIN = 1 * MiB;
constexpr size_t WS_WMKV = WS_WIN + al((size_t)INW * D * 2);
constexpr size_t WS_WGLU = WS_WMKV + al((size_t)2048 * D * 2);
constexpr size_t WS_WOUT = WS_WGLU + al((size_t)SBW * SBW * 2);
constexpr size_t WS_WMQ = WS_WOUT + al((size_t)D * D * 2);
constexpr size_t WS_WMO = WS_WMQ + al((size_t)D * D * 2);
constexpr size_t WS_WGU = WS_WMO + al((size_t)D * D * 2);
constexpr size_t WS_WDN = WS_WGU + al((size_t)NFF2 * D * 2);
constexpr size_t WS_W1 = WS_WDN + al((size_t)D * FF * 2);
constexpr size_t WS_BTC = WS_W1 + al((size_t)33 * 128 * 256 * 2);
constexpr size_t WS_XB = WS_BTC + al((size_t)NG * 256 * XHP * 2);
constexpr size_t WS_RSTD0 = WS_XB + al((size_t)MPAD * D * 2);
constexpr size_t WS_MB = WS_RSTD0 + al((size_t)MPAD * 4);
constexpr size_t WS_RSTDM = WS_MB + al((size_t)1024 * D * 2);
constexpr size_t WS_QB = WS_RSTDM + al(4096);
constexpr size_t WS_KB = WS_QB + al((size_t)MPAD * SBW * 2);
constexpr size_t WS_VB = WS_KB + al((size_t)MPAD * SBW * 2);
constexpr size_t WS_QS = WS_VB + al((size_t)MPAD * SBW * 2);
constexpr size_t WS_US = WS_QS + al((size_t)MS * SBW * 4);
constexpr size_t WS_XH = WS_US + al((size_t)MS * SBW * 4);
constexpr size_t WS_SST = WS_XH + al((size_t)1024 * NG * XHP * 2 + 65536);
constexpr size_t WS_YG = WS_SST + al((size_t)1024 * NG * 128 * 4);
constexpr size_t WS_OSB = WS_YG + al((size_t)MPAD * SBW * 2);
constexpr size_t WS_OSSM = WS_OSB + al((size_t)MPAD * SBW * 2);
constexpr size_t WS_SBPO = WS_OSSM + al((size_t)MPAD * SBW * 2);
constexpr size_t WS_SBPL = WS_SBPO + al((size_t)MS * NPG * NH * HD * 4);
constexpr size_t WS_MIX = WS_SBPL + al((size_t)MS * NPG * NH * 4);
constexpr size_t WS_X1 = WS_MIX + al((size_t)MPAD * D * 2);
constexpr size_t WS_X1B = WS_X1 + al((size_t)MPAD * D * 4);
constexpr size_t WS_MKB = WS_X1B + al((size_t)MPAD * D * 2);
constexpr size_t WS_MVB = WS_MKB + al((size_t)1024 * D * 2);
constexpr size_t WS_QM = WS_MVB + al((size_t)1024 * D * 2);
constexpr size_t WS_OMEM = WS_QM + al((size_t)MPAD * D * 2);
constexpr size_t WS_X2 = WS_OMEM + al((size_t)MPAD * D * 2);
constexpr size_t WS_X2B = WS_X2 + al((size_t)MPAD * D * 4);
constexpr size_t WS_GB = WS_X2B + al((size_t)MPAD * D * 2);
constexpr size_t WS_UB = WS_GB + al((size_t)MPAD * FF * 2);
constexpr size_t WS_FAST_END = WS_UB + al((size_t)MPAD * FF * 2);
constexpr int CW_TMO = 0, CW_CODE = 1, CW_BAR = 4096;
constexpr int CW_SSQ1 = 16384, CW_SSQ2 = CW_SSQ1 + MPAD, CW_SSQ3 = CW_SSQ2 + MPAD;
static_assert((CW_SSQ3 + MPAD) * 4 <= (int)CTL_ZERO_BYTES, "CTL words inside the memset region");

constexpr int RING_OFF = 0, RING_BYTES = 131072;
constexpr int LDSCTL_OFF = RING_BYTES, MISC_OFF = LDSCTL_OFF + 320;
constexpr int LDS_BYTES = 147456;
static_assert(MISC_OFF + 128 <= LDS_BYTES, "LDS map");

#define GAS __attribute__((address_space(1)))
#define LAS __attribute__((address_space(3)))
typedef unsigned short bf16;
typedef unsigned v4u __attribute__((ext_vector_type(4)));
typedef unsigned v2u __attribute__((ext_vector_type(2)));
typedef float f32x4 __attribute__((ext_vector_type(4)));
typedef float f32x2 __attribute__((ext_vector_type(2)));
typedef float f32x16 __attribute__((ext_vector_type(16)));
typedef short bf16x8 __attribute__((ext_vector_type(8)));
typedef short s16x4 __attribute__((ext_vector_type(4)));
typedef GAS unsigned gu32;
#define RLX_AGENT __ATOMIC_RELAXED, __HIP_MEMORY_SCOPE_AGENT
#define LDS_WAIT() asm volatile("s_waitcnt lgkmcnt(0)" ::: "memory")
#define VM_WAIT() asm volatile("s_waitcnt vmcnt(0)" ::: "memory")
__device__ __forceinline__ unsigned f2bf(float f) { unsigned u = __builtin_bit_cast(unsigned, f); return (u + 0x7fffu + ((u >> 16) & 1u)) >> 16; }
__device__ __forceinline__ unsigned pk2(float lo, float hi) { return f2bf(lo) | (f2bf(hi) << 16); }
__device__ __forceinline__ float bf2f(unsigned short h) { return __builtin_bit_cast(float, (unsigned)h << 16); }
__device__ __forceinline__ float bflo(unsigned w) { return __builtin_bit_cast(float, w << 16); }
__device__ __forceinline__ float bfhi(unsigned w) { return __builtin_bit_cast(float, w & 0xffff0000u); }
__device__ __forceinline__ unsigned cvtpk(float lo, float hi) { return pg8::cvt_pk_bf16(lo, hi); }
__device__ __forceinline__ float gelu_tanh_f(float x) {
    const float u2 = 2.f * 0.7978845608028654f * (x + 0.044715f * x * x * x);
    return x * __builtin_amdgcn_rcpf(1.f + __builtin_amdgcn_exp2f(-u2 * LOG2E));
}
__device__ __forceinline__ float wave_sum(float v) {
#pragma unroll
    for (int o = 1; o < 64; o <<= 1) v += __shfl_xor(v, o);
    return v;
}

#define XB_TMO      128
#define XB_XCNT(j)  (256  + 64 * (j))
#define XB_XSUB(j)  (1280 + 64 * (j))
#define XB_XGEN(j)  (2304 + 64 * (j))
#define XB_TOP      3328
#define XB_TOPGEN   3392
#define XCD_BAR_WORDS 3456
#define XB_SPIN_CAP (1u << 18)
__device__ __forceinline__ unsigned xb_ld(unsigned* p)              { return __hip_atomic_load(p, __ATOMIC_RELAXED, __HIP_MEMORY_SCOPE_AGENT); }
__device__ __forceinline__ unsigned xb_add(unsigned* p, unsigned v) { return __hip_atomic_fetch_add(p, v, __ATOMIC_RELAXED, __HIP_MEMORY_SCOPE_AGENT); }
__device__ __forceinline__ unsigned xb_xcc_id() { return (unsigned)__builtin_amdgcn_s_getreg((3 << 11) | 20) & 0xFu; }
#define XB_SPIN(cond, bar) do { unsigned _sp = 0; while (cond) { __builtin_amdgcn_s_sleep(1); \
    if ((++_sp & 255u) == 0u) { if (xb_ld(&(bar)[XB_TMO])) break; if (_sp > XB_SPIN_CAP) { atomicAdd(&(bar)[XB_TMO], 1u); break; } } } } while (0)
struct XcdBarrier { unsigned* bar; unsigned x; volatile LAS unsigned* st; };
__device__ __forceinline__ XcdBarrier xcd_barrier_post(unsigned* bar, volatile LAS unsigned* st) {
    XcdBarrier b; b.bar = bar; b.x = xb_xcc_id(); b.st = st;
    if (threadIdx.x == 0) (void)xb_add(&bar[XB_XCNT(b.x)], 1u);
    return b;
}
__device__ __forceinline__ void xcd_barrier_complete(unsigned* bar, unsigned x, unsigned& nloc, unsigned& nx) {
    const unsigned G = gridDim.x * gridDim.y * gridDim.z;
    unsigned sum, cnt, mine, sp = 0u;
    for (;;) {
        sum = 0u; cnt = 0u; mine = 0u;
#pragma unroll
        for (unsigned j = 0; j < 16; ++j) { const unsigned c = xb_ld(&bar[XB_XCNT(j)]); sum += c; cnt += (c > 0u) ? 1u : 0u; mine = (j == x) ? c : mine; }
        if (sum == G) break;
        __builtin_amdgcn_s_sleep(1);
        if ((++sp & 255u) == 0u) { if (xb_ld(&bar[XB_TMO])) break; if (sp > XB_SPIN_CAP) { atomicAdd(&bar[XB_TMO], 1u); break; } }
    }
    nloc = mine > 0u ? mine : 1u; nx = cnt > 0u ? cnt : 1u;
}
__device__ __forceinline__ void xcd_barrier(const XcdBarrier& b) {
    asm volatile("s_waitcnt vmcnt(0)" ::: "memory");
    __syncthreads();
    if (threadIdx.x == 0) {
        unsigned* bar = b.bar;
        __builtin_amdgcn_s_waitcnt(0);
        unsigned nloc = b.st[0], nx = b.st[1];
        if (nloc == 0u) { xcd_barrier_complete(bar, b.x, nloc, nx); b.st[0] = nloc; b.st[1] = nx; }
        const unsigned old = xb_add(&bar[XB_XSUB(b.x)], 1u);
        const unsigned gen = old / nloc;
        if (old + 1u == (gen + 1u) * nloc) {
            __builtin_amdgcn_fence(__ATOMIC_RELEASE, "agent");
            asm volatile("s_waitcnt vmcnt(0)" ::: "memory");
            const unsigned og = xb_add(&bar[XB_TOP], 1u);
            const unsigned tg = og / nx;
            if (og + 1u == (tg + 1u) * nx) xb_add(&bar[XB_TOPGEN], 1u);
            else XB_SPIN(xb_ld(&bar[XB_TOPGEN]) == tg, bar);
            __builtin_amdgcn_fence(__ATOMIC_ACQUIRE, "agent");
            xb_add(&bar[XB_XGEN(b.x)], 1u);
            asm volatile("s_waitcnt vmcnt(0)" ::: "memory");
        } else {
            XB_SPIN(xb_ld(&bar[XB_XGEN(b.x)]) == gen, bar);
            __builtin_amdgcn_fence(__ATOMIC_ACQUIRE, "agent");
            asm volatile("s_waitcnt vmcnt(0)" ::: "memory");
        }
    }
    __syncthreads();
}

struct Args { const void* in[40]; float* out; unsigned char* ws; int ph_lo, ph_hi, use_bar, pad; };
struct Frame {
    LAS unsigned char* lds; volatile LAS unsigned* MISC; unsigned* ctl;
    int tid, lane, wave, vcu, G;
    unsigned char* ws; float* out; const void* const* in;
};
#define INF(i) ((const float*)F.in[i])
#define WSP(T_, off) ((T_*)(F.ws + (off)))
__device__ __forceinline__ void p0_transpose_item(const float* W, int K, int N, bf16* WT, int row_off, const float* gain, LAS float* scr, int item, int lane) {
    const int nblk = N / 32, kb = item / nblk, nb = item % nblk, k0 = 64 * kb, n0 = 32 * nb;
#pragma unroll 8
    for (int i = 0; i < 32; ++i) { const int kk = 2 * i + (lane >> 5); const float gv = gain ? gain[k0 + kk] : 1.f; scr[kk * 33 + (lane & 31)] = W[(size_t)(k0 + kk) * N + n0 + (lane & 31)] * gv; }
    LDS_WAIT(); asm volatile("" ::: "memory");
    const int c = lane & 7;
#pragma unroll
    for (int j = 0; j < 4; ++j) { const int n = (lane >> 3) + 8 * j; const LAS float* s = scr + (8 * c) * 33 + n;
        v4u o; o.x = pk2(s[0 * 33], s[1 * 33]); o.y = pk2(s[2 * 33], s[3 * 33]); o.z = pk2(s[4 * 33], s[5 * 33]); o.w = pk2(s[6 * 33], s[7 * 33]);
        *(GAS v4u*)(WT + (size_t)(row_off + n0 + n) * K + k0 + 8 * c) = o; }
    LDS_WAIT(); asm volatile("" ::: "memory");
}
__device__ __forceinline__ void row_to_bf16_rstd(const float* xrow, bf16* orow, float* rstd, int lane) {
    const GAS f32x4* xr = (const GAS f32x4*)xrow + lane;
    f32x4 v[4]; float s = 0.f;
#pragma unroll
    for (int j = 0; j < 4; ++j) { v[j] = xr[64 * j]; s += (v[j].x * v[j].x + v[j].y * v[j].y) + (v[j].z * v[j].z + v[j].w * v[j].w); }
    s = wave_sum(s);
    GAS v2u* o8 = (GAS v2u*)orow + lane;
#pragma unroll
    for (int j = 0; j < 4; ++j) { v2u w; w.x = pk2(v[j].x, v[j].y); w.y = pk2(v[j].z, v[j].w); o8[64 * j] = w; }
    if (lane == 0) *rstd = 1.f / sqrtf(s * (1.f / D) + EPS);
}
__device__ __forceinline__ void lam_pow(float lr, float li, float logdt, int tau, float& pr, float& pi) {
    const double dt = exp((double)logdt);
    const double ang = (double)li * dt * (double)tau;
    const double k = rint(ang * 0.15915494309189535);
    double r = fma(-k, 6.283185307179586, ang); r = fma(-k, 2.4492935982947064e-16, r);
    const float rf = (float)r, mag = (float)exp((double)lr * dt * (double)tau);
    pr = mag * cosf(rf); pi = mag * sinf(rf);
}
__device__ __forceinline__ void lam_coef(float lr, float li, float logdt, float& cr, float& ci) {
    const double dt = exp((double)logdt);
    const double ang = (double)li * dt;
    const double k = rint(ang * 0.15915494309189535);
    double r = fma(-k, 6.283185307179586, ang); r = fma(-k, 2.4492935982947064e-16, r);
    const float th = (float)r, a = (float)((double)lr * dt);
    const float sh = sinf(0.5f * th);
    const float nr = expm1f(a) * cosf(th) - 2.f * sh * sh, ni = expf(a) * sinf(th);
    const float den = lr * lr + li * li;
    cr = (nr * lr + ni * li) / den; ci = (ni * lr - nr * li) / den;
}
__device__ __forceinline__ void ssm_table_unit(Frame& F, int g, int tau) {
    LAS float* Mr = (LAS float*)(F.lds + RING_OFF); LAS float* Mi = Mr + 1024; LAS float* Pr = Mi + 1024; LAS float* Pi = Pr + 64; LAS float* Kt = Pi + 64;
    const float* lam_re = INF(14); const float* lam_im = INF(15); const float* log_dt = INF(16); const float* b_re = INF(17); const float* b_im = INF(18);
    const float* c_re = INF(19); const float* c_im = INF(20); const float* d_skip = INF(21);
    bf16* W1 = WSP(bf16, WS_W1); bf16* BTC = WSP(bf16, WS_BTC);
    const int tid = F.tid; const float ldt = log_dt[g];
    __syncthreads();
    if (tid < 64) { float pr, pi; lam_pow(lam_re[g * NST + tid], lam_im[g * NST + tid], ldt, tau, pr, pi); Pr[tid] = pr; Pi[tid] = pi; }
    __syncthreads();
    for (int i = tid; i < 1024; i += NTHR) { const int n = i >> 4, q = i & 15; float cr, ci; lam_coef(lam_re[g * NST + n], lam_im[g * NST + n], ldt, cr, ci);
        const float br = b_re[(g * NST + n) * GP + q], bi = b_im[(g * NST + n) * GP + q]; const float bbr = cr * br - ci * bi, bbi = cr * bi + ci * br;
        const float pr = Pr[n], pi = Pi[n]; Mr[i] = pr * bbr - pi * bbi; Mi[i] = pr * bbi + pi * bbr; }
    __syncthreads();
    if (tau <= 15) {
        const int s = 15 - tau;
        for (int i = tid; i < 2048; i += NTHR) { const int n = i >> 5, ri = (i >> 4) & 1, q = i & 15; const float v = ri ? Mi[n * 16 + q] : Mr[n * 16 + q];
            W1[((size_t)g * 128 + 2 * n + ri) * 256 + s * 16 + q] = (bf16)f2bf(v); }
        if (tid < 256) { const int p = tid >> 4, q = tid & 15; float acc = 0.f;
            for (int n = 0; n < NST; ++n) acc += c_re[(g * GP + p) * NST + n] * Mr[n * 16 + q] - c_im[(g * GP + p) * NST + n] * Mi[n * 16 + q];
            if (tau == 0 && p == q) acc += d_skip[g * GP + p];
            Kt[tid] = acc; }
        __syncthreads();
        for (int idx = tid; idx < (16 - tau) * 256; idx += NTHR) { const int blk = idx >> 8, e = idx & 255, p = e >> 4, q = e & 15; const int s2 = blk, t2 = s2 + tau;
            BTC[((size_t)g * 256 + t2 * 16 + p) * XHP + s2 * 16 + q] = (bf16)f2bf(Kt[e]);
            if (tau >= 1) BTC[((size_t)g * 256 + s2 * 16 + p) * XHP + t2 * 16 + q] = (bf16)0; }
    }
    if (tau >= 1) {
        const int t2 = tau - 1;
        for (int idx = tid; idx < 1024; idx += NTHR) { const int p = idx >> 6, n = idx & 63; const float cr = c_re[(g * GP + p) * NST + n], ci = c_im[(g * GP + p) * NST + n], pr = Pr[n], pi = Pi[n];
            v2u dummy; (void)dummy;
            const unsigned w = pk2(cr * pr - ci * pi, -(cr * pi + ci * pr));
            *(GAS unsigned*)(BTC + ((size_t)g * 256 + t2 * 16 + p) * XHP + 256 + 2 * n) = w; }
    }
    __syncthreads();
}
__device__ __forceinline__ void p0_prologue(Frame& F) {
    LAS float* scr = (LAS float*)(F.lds + RING_OFF + F.wave * 16384);
    const int gw = F.vcu * NWAVES + F.wave, NGW = F.G * NWAVES;
    constexpr int I_IN = 16 * 64, I_MK = 16 * 32, I_GLU = 8 * 16, I_SQ = 16 * 32, I_G = 16 * 88, I_DN = 44 * 32;
    constexpr int NITEMS = I_IN + 2 * I_MK + I_GLU + 3 * I_SQ + 2 * I_G + I_DN;
    for (int it = gw; it < NITEMS; it += NGW) {
        int r = it;
        if (r < I_IN) { p0_transpose_item(INF(12), D, INW, WSP(bf16, WS_WIN), 0, INF(11), scr, r, F.lane); continue; } r -= I_IN;
        if (r < I_MK) { p0_transpose_item(INF(30), D, D, WSP(bf16, WS_WMKV), 0, INF(28), scr, r, F.lane); continue; } r -= I_MK;
        if (r < I_MK) { p0_transpose_item(INF(31), D, D, WSP(bf16, WS_WMKV), D, INF(28), scr, r, F.lane); continue; } r -= I_MK;
        if (r < I_GLU) { p0_transpose_item(INF(22), SBW, SBW, WSP(bf16, WS_WGLU), 0, nullptr, scr, r, F.lane); continue; } r -= I_GLU;
        if (r < I_SQ) { const int kb = r / (D / 32); const float* gn = (kb < 8) ? INF(24) : INF(25) - SBW; p0_transpose_item(INF(26), D, D, WSP(bf16, WS_WOUT), 0, gn, scr, r, F.lane); continue; } r -= I_SQ;
        if (r < I_SQ) { p0_transpose_item(INF(29), D, D, WSP(bf16, WS_WMQ), 0, INF(27), scr, r, F.lane); continue; } r -= I_SQ;
        if (r < I_SQ) { p0_transpose_item(INF(32), D, D, WSP(bf16, WS_WMO), 0, nullptr, scr, r, F.lane); continue; } r -= I_SQ;
        if (r < I_G) { p0_transpose_item(INF(34), D, FF, WSP(bf16, WS_WGU), 0, INF(33), scr, r, F.lane); continue; } r -= I_G;
        if (r < I_G) { p0_transpose_item(INF(35), D, FF, WSP(bf16, WS_WGU), FF, INF(33), scr, r, F.lane); continue; } r -= I_G;
        p0_transpose_item(INF(38), FF, D, WSP(bf16, WS_WDN), 0, nullptr, scr, r, F.lane);
    }
    for (int m = gw; m < MALL; m += NGW) { const float* xr = (m < MPR) ? INF(0) + (size_t)m * D : INF(1) + (size_t)(m - MPR) * D;
        row_to_bf16_rstd(xr, WSP(bf16, WS_XB) + (size_t)m * D, WSP(float, WS_RSTD0) + m, F.lane); }
    for (int m = gw; m < NB * MT; m += NGW) row_to_bf16_rstd(INF(10) + (size_t)m * D, WSP(bf16, WS_MB) + (size_t)m * D, WSP(float, WS_RSTDM) + m, F.lane);
    for (int u = F.vcu; u < NG * 17; u += F.G) ssm_table_unit(F, u / 17, u % 17);
    { bf16* W1 = WSP(bf16, WS_W1); for (int i = gw * 64 + F.lane; i < 128 * 256 / 8; i += NGW * 64) *(GAS v4u*)(W1 + (size_t)32 * 128 * 256 + (size_t)i * 8) = (v4u){0u, 0u, 0u, 0u}; }
}

#define EPI_LOOP_BEGIN \
    _Pragma("unroll") for (int ai = 0; ai < 2; ++ai) _Pragma("unroll") for (int m = 0; m < 4; ++m) { const int row = u.pm * 256 + ai * 128 + wr * 64 + m * 16 + fr; \
    _Pragma("unroll") for (int bj = 0; bj < 2; ++bj) { const int col = u.pn * 256 + bj * 128 + wc * 32 + 8 * fq; f32x4 v0 = acc[ai][bj][m][0], v1 = acc[ai][bj][m][1];
#define EPI_LOOP_END } }
__device__ __forceinline__ v4u pack8(f32x4 a, f32x4 b) { v4u w; w.x = cvtpk(a[0], a[1]); w.y = cvtpk(a[2], a[3]); w.z = cvtpk(b[0], b[1]); w.w = cvtpk(b[2], b[3]); return w; }

struct EpiInProj {
    const float* rstd; bf16 *QBp, *KBp, *VBp, *XHp; float *QSp, *USp, *out;
    __device__ __forceinline__ void operator()(const f32x4 (&acc)[2][2][4][2], const pg8::Unit& u, int wr, int wc, int fr_, int fq_) const { int fr = fr_, fq = fq_; asm volatile("" : "+v"(fr), "+v"(fq));
        const int sect = u.pn >> 1;
        EPI_LOOP_BEGIN
            if (row < MALL) {
                const float rs = rstd[row]; v0 = v0 * rs; v1 = v1 * rs;
                const int c = col - sect * SBW;
                if (sect == 0) { v0 = v0 * C2; v1 = v1 * C2; *(v4u*)(QBp + (size_t)row * SBW + c) = pack8(v0, v1);
                    if (row >= MPR) { float* q = QSp + (size_t)(row - MPR) * SBW + c; *(f32x4*)q = v0; *(f32x4*)(q + 4) = v1; } }
                else if (sect == 1 || sect == 2) { bf16* B = (sect == 1) ? KBp : VBp; *(v4u*)(B + (size_t)row * SBW + c) = pack8(v0, v1);
                    float* o = (row < MPR) ? out + (sect == 1 ? O_KP : O_VP) + (size_t)row * SBW + c : out + (sect == 1 ? O_KS : O_VS) + (size_t)(row - MPR) * SBW + c;
                    *(f32x4*)o = v0; *(f32x4*)(o + 4) = v1; }
                else { if (row < MPR) { const int b = row >> 12, t = row & 4095, ch = t >> 4, s = t & 15, g = c >> 4, q0 = c & 15;
                        *(v4u*)(XHp + ((size_t)(b * NCH + ch) * NG + g) * XHP + s * 16 + q0) = pack8(v0, v1); }
                    else { float* q = USp + (size_t)(row - MPR) * SBW + c; *(f32x4*)q = v0; *(f32x4*)(q + 4) = v1; } }
            }
        EPI_LOOP_END
    }
};
struct EpiMemKV {
    const float* rstd; bf16 *MKBp, *MVBp; float* out;
    __device__ __forceinline__ void operator()(const f32x4 (&acc)[2][2][4][2], const pg8::Unit& u, int wr, int wc, int fr_, int fq_) const { int fr = fr_, fq = fq_; asm volatile("" : "+v"(fr), "+v"(fq));
        const int sect = u.pn >> 2;
        EPI_LOOP_BEGIN
            const float rs = rstd[row]; v0 = v0 * rs; v1 = v1 * rs; const int c = col - sect * D;
            bf16* B = sect ? MVBp : MKBp; *(v4u*)(B + (size_t)row * D + c) = pack8(v0, v1);
            float* o = out + (sect ? O_MVP : O_MKP) + (size_t)row * D + c; *(f32x4*)o = v0; *(f32x4*)(o + 4) = v1;
        EPI_LOOP_END
    }
};
struct EpiSsmA {
    float* SST;
    __device__ __forceinline__ void operator()(const f32x4 (&acc)[2][2][4][2], const pg8::Unit& u, int wr, int wc, int fr_, int fq_) const { int fr = fr_, fq = fq_; asm volatile("" : "+v"(fr), "+v"(fq));
        _Pragma("unroll") for (int ai = 0; ai < 2; ++ai) _Pragma("unroll") for (int m = 0; m < 4; ++m) { const int row = u.pm * 256 + ai * 128 + wr * 64 + m * 16 + fr;
            const int col = wc * 32 + 8 * fq; float* o = SST + ((size_t)row * NG + u.pn) * 128 + col; *(f32x4*)o = acc[ai][0][m][0]; *(f32x4*)(o + 4) = acc[ai][0][m][1]; }
    }
};
struct EpiSsmC {
    bf16* YG;
    __device__ __forceinline__ void operator()(const f32x4 (&acc)[2][2][4][2], const pg8::Unit& u, int wr, int wc, int fr_, int fq_) const { int fr = fr_, fq = fq_; asm volatile("" : "+v"(fr), "+v"(fq));
        _Pragma("unroll") for (int ai = 0; ai < 2; ++ai) _Pragma("unroll") for (int m = 0; m < 4; ++m) { const int ch = ai * 128 + wr * 64 + m * 16 + fr;
            _Pragma("unroll") for (int bj = 0; bj < 2; ++bj) { const int col = bj * 128 + wc * 32 + 8 * fq, t = col >> 4, p0 = col & 15; f32x4 v0 = acc[ai][bj][m][0], v1 = acc[ai][bj][m][1];
                _Pragma("unroll") for (int e = 0; e < 4; ++e) { v0[e] = gelu_tanh_f(v0[e]); v1[e] = gelu_tanh_f(v1[e]); }
                *(v4u*)(YG + ((size_t)u.pm * T + ch * LC + t) * SBW + u.pn * GP + p0) = pack8(v0, v1); } }
    }
};
struct EpiGlu {
    const bf16* YG; const float* bglu; bf16* OSSM;
    __device__ __forceinline__ void operator()(const f32x4 (&acc)[2][2][4][2], const pg8::Unit& u, int wr, int wc, int fr_, int fq_) const { int fr = fr_, fq = fq_; asm volatile("" : "+v"(fr), "+v"(fq));
        EPI_LOOP_BEGIN
            if (row < MALL) {
                const v4u yw = *(const v4u*)(YG + (size_t)row * SBW + col); const f32x4 b0 = *(const f32x4*)(bglu + col), b1 = *(const f32x4*)(bglu + col + 4);
                const float y[8] = {bflo(yw.x), bfhi(yw.x), bflo(yw.y), bfhi(yw.y), bflo(yw.z), bfhi(yw.z), bflo(yw.w), bfhi(yw.w)};
                _Pragma("unroll") for (int e = 0; e < 4; ++e) { v0[e] = y[e] * __builtin_amdgcn_rcpf(1.f + __builtin_amdgcn_exp2f(-(v0[e] + b0[e]) * LOG2E));
                                                                 v1[e] = y[4 + e] * __builtin_amdgcn_rcpf(1.f + __builtin_amdgcn_exp2f(-(v1[e] + b1[e]) * LOG2E)); }
                *(v4u*)(OSSM + (size_t)row * SBW + col) = pack8(v0, v1);
            }
        EPI_LOOP_END
    }
};
struct EpiResid {
    const float* base0; const float* base1; float* xo; bf16* xb; float* ssq;
    __device__ __forceinline__ void operator()(const f32x4 (&acc)[2][2][4][2], const pg8::Unit& u, int wr, int wc, int fr_, int fq_) const { int fr = fr_, fq = fq_; asm volatile("" : "+v"(fr), "+v"(fq));
        _Pragma("unroll") for (int ai = 0; ai < 2; ++ai) _Pragma("unroll") for (int m = 0; m < 4; ++m) { const int row = u.pm * 256 + ai * 128 + wr * 64 + m * 16 + fr; float sq = 0.f;
            const bool ok = row < MALL; const float* bp = (row < MPR) ? base0 + (size_t)row * D : base1 + (size_t)(row - MPR) * D;
            _Pragma("unroll") for (int bj = 0; bj < 2; ++bj) { const int col = u.pn * 256 + bj * 128 + wc * 32 + 8 * fq; f32x4 v0 = acc[ai][bj][m][0], v1 = acc[ai][bj][m][1];
                if (ok) { v0 = v0 + *(const f32x4*)(bp + col); v1 = v1 + *(const f32x4*)(bp + col + 4);
                    float* o = xo + (size_t)row * D + col; *(f32x4*)o = v0; *(f32x4*)(o + 4) = v1;
                    if (xb) *(v4u*)(xb + (size_t)row * D + col) = pack8(v0, v1);
                    sq += (v0[0] * v0[0] + v0[1] * v0[1]) + (v0[2] * v0[2] + v0[3] * v0[3]) + (v1[0] * v1[0] + v1[1] * v1[1]) + (v1[2] * v1[2] + v1[3] * v1[3]); } }
            sq += __shfl_xor(sq, 16); sq += __shfl_xor(sq, 32);
            if (ok && fq == 0) atomicAdd(ssq + row, sq); }
    }
};
struct EpiScaleBf16 {
    const float* ssq; float scale; bf16* O;
    __device__ __forceinline__ void operator()(const f32x4 (&acc)[2][2][4][2], const pg8::Unit& u, int wr, int wc, int fr_, int fq_) const { int fr = fr_, fq = fq_; asm volatile("" : "+v"(fr), "+v"(fq));
        EPI_LOOP_BEGIN
            if (row < MALL) { const float rs = scale / sqrtf(ssq[row] * (1.f / D) + EPS); v0 = v0 * rs; v1 = v1 * rs; *(v4u*)(O + (size_t)row * D + col) = pack8(v0, v1); }
        EPI_LOOP_END
    }
};
struct EpiGateUp {
    const float* ssq; bf16 *GBp, *UBp; float* out;
    __device__ __forceinline__ void operator()(const f32x4 (&acc)[2][2][4][2], const pg8::Unit& u, int wr, int wc, int fr_, int fq_) const { int fr = fr_, fq = fq_; asm volatile("" : "+v"(fr), "+v"(fq));
        const bool up = u.pn >= 11;
        EPI_LOOP_BEGIN
            if (row < MALL) { const float rs = 1.f / sqrtf(ssq[row] * (1.f / D) + EPS); v0 = v0 * rs; v1 = v1 * rs;
                if (up) *(v4u*)(UBp + (size_t)row * FF + (col - FF)) = pack8(v0, v1);
                else { *(v4u*)(GBp + (size_t)row * FF + col) = pack8(v0, v1);
                    if (row >= MPR) { float* o = out + O_CVS + ((size_t)(row - MPR) * 2 + 1) * FF + col; *(f32x4*)o = v0; *(f32x4*)(o + 4) = v1; }
                    else { const int t = row & 4095; if (t >= T - 2) { float* o = out + O_CVP + ((size_t)(row >> 12) * 2 + (t - (T - 2))) * FF + col; *(f32x4*)o = v0; *(f32x4*)(o + 4) = v1; } } } }
        EPI_LOOP_END
    }
};
struct SsmOrder {
    int G, c; size_t bstride;
    __device__ bool next(int i, pg8::Unit& u) const { const int L = i * G + c; if (L >= NG * NB) return false; u.pn = L >> 2; u.pm = L & 3; return true; }
    __device__ __forceinline__ size_t aoff(const pg8::Unit& u) const { return ((size_t)u.pm * NCH * NG * XHP + (size_t)u.pn * XHP) * 2; }
    __device__ __forceinline__ size_t boff(const pg8::Unit& u) const { return (size_t)u.pn * bstride; }
};
__device__ __forceinline__ int crow(int r, int hi) { return (r & 3) + 8 * (r >> 2) + 4 * hi; }
__device__ __forceinline__ void glds16(const void* gsrc, unsigned lds_dst) { unsigned keep;
    asm volatile("s_mov_b32 %0, m0\n\ts_mov_b32 m0, %2\n\ts_nop 0\n\tglobal_load_lds_dwordx4 %1, off\n\ts_mov_b32 m0, %0" : "=&s"(keep) : "v"(gsrc), "s"(lds_dst) : "memory"); }
#define WAIT_BAR(N) asm volatile("s_waitcnt vmcnt(" #N ") lgkmcnt(0)\n\ts_barrier" ::: "memory")
typedef LAS const char* lds_cptr;
typedef short v4i16_t __attribute__((ext_vector_type(4)));
__device__ __forceinline__ s16x4 vtr(lds_cptr p) { return __builtin_bit_cast(s16x4, __builtin_amdgcn_ds_read_tr16_b64_v4i16((LAS v4i16_t*)p)); }
__device__ __forceinline__ bf16x8 ldsq(lds_cptr p) { return *(const LAS bf16x8*)p; }
#define MFMA32(a, b, c) __builtin_amdgcn_mfma_f32_32x32x16_bf16((a), (b), (c), 0, 0, 0)
__device__ __forceinline__ bf16x8 pack_bf8(const f32x16& p, int base) {
    v4u w; w.x = cvtpk(p[base], p[base + 1]); w.y = cvtpk(p[base + 2], p[base + 3]); w.z = cvtpk(p[base + 4], p[base + 5]); w.w = cvtpk(p[base + 6], p[base + 7]); return __builtin_bit_cast(bf16x8, w);
}
__device__ __forceinline__ float swap_half(float v) { auto rr = __builtin_amdgcn_permlane32_swap(__float_as_uint(v), __float_as_uint(v), false, false); return __uint_as_float((threadIdx.x & 32) ? rr[0] : rr[1]); }

constexpr int SBA_K = 0, SBA_V = 16384, SBA_OST = 32768;
__device__ __forceinline__ void sb_attn_unit(Frame& F, int b, int h, int qb, float b2) {
    const int lane = F.lane, r32 = lane & 31, hi = lane >> 5, wid = F.wave;
    const bf16* QBp = WSP(bf16, WS_QB); const bf16* KBp = WSP(bf16, WS_KB); const bf16* VBp = WSP(bf16, WS_VB); bf16* OSB = WSP(bf16, WS_OSB);
    const long rowbase = (long)b * T; const int q0 = qb * 256;
    const bf16* Qw = QBp + (rowbase + q0 + wid * 32) * SBW + h * HD;
    const bf16* Kh = KBp + rowbase * SBW + h * HD; const bf16* Vh = VBp + rowbase * SBW + h * HD;
    const unsigned lds0 = (unsigned)(uintptr_t)(F.lds + RING_OFF);
    const bf16* ksrc = Kh + (long)lane * SBW + wid * 8;
    const bf16* vsrc = Vh + (long)(16 * (wid & 3) + (lane >> 2)) * SBW + (wid >> 2) * 32 + (lane & 3) * 8;
    const unsigned kdst = lds0 + SBA_K + wid * 1024, vdst = lds0 + SBA_V + wid * 1024;
    const lds_cptr base3 = (lds_cptr)(F.lds + RING_OFF);
    const lds_cptr kp0 = base3 + SBA_K + hi * 1024 + r32 * 16;
    const lds_cptr vp0 = base3 + SBA_V + ((lane >> 4) & 1) * 32 + (lane & 3) * 8 + (4 * hi + ((lane & 15) >> 2)) * 64;
    const int NT = (q0 + 256) / 64;
#define DMA_KV(t, slot) do { glds16(ksrc + (long)(t) * 64 * SBW, (unsigned)__builtin_amdgcn_readfirstlane(kdst + (slot) * 8192)); glds16(vsrc + (long)(t) * 64 * SBW, (unsigned)__builtin_amdgcn_readfirstlane(vdst + (slot) * 8192)); } while (0)
    DMA_KV(NT - 1, 0);
    bf16x8 qr[4];
#pragma unroll
    for (int d0 = 0; d0 < 4; ++d0) qr[d0] = *reinterpret_cast<const bf16x8*>(&Qw[(long)r32 * SBW + d0 * 16 + hi * 8]);
    bf16x8 A0, A1, AN;
#pragma unroll
    for (int j = 0; j < 8; ++j) { const int kv = crow(j, hi); A0[j] = (short)((kv > r32) ? 0xBF80 : 0); A1[j] = (short)((kv + 16 > r32) ? 0xBF80 : 0); AN[j] = (short)0xBF80; }
    f32x16 o0 = {}, o1 = {}, racc = {}, bt;
#pragma unroll
    for (int r = 0; r < 16; ++r) bt[r] = b2;
    const int qrel = wid * 32 + r32;
    for (int it = 0; it < NT; ++it) {
        const int t = NT - 1 - it, cur = it & 1;
        if (it + 1 < NT) { DMA_KV(t - 1, cur ^ 1); WAIT_BAR(2); } else { WAIT_BAR(0); }
        const int jb = t - (NT - 4);
        if (jb <= (wid >> 1)) {
            const lds_cptr kp = kp0 + cur * 8192; const lds_cptr vp = vp0 + cur * 8192;
            f32x16 p0 = bt, p1 = bt;
#pragma unroll
            for (int d0 = 0; d0 < 4; ++d0) { const bf16x8 k0 = ldsq(kp + d0 * 2048), k1 = ldsq(kp + d0 * 2048 + 512); p0 = MFMA32(k0, qr[d0], p0); p1 = MFMA32(k1, qr[d0], p1); }
            if (jb == (wid >> 1)) {
                const float NEG = -INFINITY; const int kb = 64 * jb + 4 * hi;
#pragma unroll
                for (int r = 0; r < 16; ++r) { const int kv = kb + (r & 3) + 8 * (r >> 2); if (kv >= qrel) p0[r] = NEG; if (kv + 32 >= qrel) p1[r] = NEG; }
            }
            f32x16 s0, s1;
#pragma unroll
            for (int r = 0; r < 16; ++r) { s0[r] = __builtin_amdgcn_logf(1.f + __builtin_amdgcn_exp2f(p0[r])); s1[r] = __builtin_amdgcn_logf(1.f + __builtin_amdgcn_exp2f(p1[r])); }
            const bf16x8 sb0 = pack_bf8(s0, 0), sb1 = pack_bf8(s0, 8), sb2 = pack_bf8(s1, 0), sb3 = pack_bf8(s1, 8);
            f32x16 d1 = MFMA32(A0, sb2, racc); d1 = MFMA32(A1, sb3, d1);
            f32x16 d0 = MFMA32(A0, sb0, racc); d0 = MFMA32(A1, sb1, d0); d0 = MFMA32(AN, sb2, d0); d0 = MFMA32(AN, sb3, d0);
            racc = MFMA32(AN, sb0, racc); racc = MFMA32(AN, sb1, racc); racc = MFMA32(AN, sb2, racc); racc = MFMA32(AN, sb3, racc);
#pragma unroll
            for (int r = 0; r < 16; ++r) { p0[r] = __builtin_amdgcn_exp2f((p0[r] - s0[r]) + d0[r]); p1[r] = __builtin_amdgcn_exp2f((p1[r] - s1[r]) + d1[r]); }
            const bf16x8 pa0 = pack_bf8(p0, 0), pa1 = pack_bf8(p0, 8), pa2 = pack_bf8(p1, 0), pa3 = pack_bf8(p1, 8);
#pragma unroll
            for (int dh = 0; dh < 2; ++dh) {
                f32x16& o = dh ? o1 : o0;
#pragma unroll
                for (int rg = 0; rg < 4; ++rg) { const s16x4 lo = vtr(vp + dh * 4096 + rg * 1024), hh = vtr(vp + dh * 4096 + rg * 1024 + 512);
                    const bf16x8 vf = (bf16x8){lo[0], lo[1], lo[2], lo[3], hh[0], hh[1], hh[2], hh[3]};
                    o = MFMA32(rg == 0 ? pa0 : rg == 1 ? pa1 : rg == 2 ? pa2 : pa3, vf, o); }
            }
        }
        WAIT_BAR(0);
    }
#undef DMA_KV
    { int l2 = lane; asm volatile("" : "+v"(l2)); const int e32 = l2 & 31, ehi = l2 >> 5;
      LAS bf16* stg = (LAS bf16*)(F.lds + RING_OFF + SBA_OST) + wid * 2048; LAS bf16* sb = stg + (4 * ehi) * 64 + e32;
#pragma unroll
      for (int r = 0; r < 16; ++r) { sb[((r & 3) + 8 * (r >> 2)) * 64] = (bf16)f2bf(o0[r]); sb[((r & 3) + 8 * (r >> 2)) * 64 + 32] = (bf16)f2bf(o1[r]); }
      LDS_WAIT();
      bf16* Ow = OSB + (rowbase + q0 + wid * 32 + (l2 >> 3)) * SBW + h * HD + (l2 & 7) * 8; const LAS bf16* sr = stg + (l2 >> 3) * 64 + (l2 & 7) * 8;
#pragma unroll
      for (int i = 0; i < 4; ++i) { const v4u v = *(const LAS v4u*)(sr + i * 512); *(v4u*)(Ow + (long)i * 8 * SBW) = v; } }
    asm volatile("s_waitcnt vmcnt(0) lgkmcnt(0)\n\ts_barrier" ::: "memory");
}

__device__ __forceinline__ void sb_sample_unit(Frame& F, int b, int pg) {
    const int lane = F.lane, h = F.wave, ts = lane >> 4, d4 = lane & 15;
    const float* QS = WSP(float, WS_QS); const float* ck = INF(2); const float* cv = INF(3); const int* pt = (const int*)F.in[4];
    const float b2 = INF(13)[h] * LOG2E;
    const f32x4 q4 = *(const f32x4*)(QS + (size_t)b * SBW + h * HD + 4 * d4);
    const int page = pt[b * NPG + pg];
    const float* kb = ck + ((size_t)page * PAGE + ts) * (NH * HD) + h * HD + 4 * d4;
    const float* vb = cv + ((size_t)page * PAGE + ts) * (NH * HD) + h * HD + 4 * d4;
    float z[32];
#pragma unroll
    for (int i0 = 0; i0 < 32; i0 += 8) {
        f32x4 kk[8];
#pragma unroll
        for (int i = 0; i < 8; ++i) kk[i] = __builtin_nontemporal_load((const f32x4*)(kb + (size_t)(i0 + i) * 4 * NH * HD));
#pragma unroll
        for (int i = 0; i < 8; ++i) { float p = (q4[0] * kk[i][0] + q4[1] * kk[i][1]) + (q4[2] * kk[i][2] + q4[3] * kk[i][3]);
            p += __shfl_xor(p, 1); p += __shfl_xor(p, 2); p += __shfl_xor(p, 4); p += __shfl_xor(p, 8); z[i0 + i] = p + b2; }
    }
    float run = 0.f;
    float a[32];
#pragma unroll
    for (int i = 31; i >= 0; --i) {
        const float sp = __builtin_amdgcn_logf(1.f + __builtin_amdgcn_exp2f(z[i]));
        const float nb = __shfl_xor(sp, 16), v1 = sp + nb, po = __shfl_xor(v1, 32);
        const float aft = ((ts & 1) ? 0.f : nb) + ((ts & 2) ? 0.f : po);
        a[i] = __builtin_amdgcn_exp2f(z[i] - sp - (run + aft));
        run += v1 + po;
    }
    f32x4 acc = {0.f, 0.f, 0.f, 0.f};
#pragma unroll
    for (int i0 = 0; i0 < 32; i0 += 8) {
        f32x4 vv[8];
#pragma unroll
        for (int i = 0; i < 8; ++i) vv[i] = __builtin_nontemporal_load((const f32x4*)(vb + (size_t)(i0 + i) * 4 * NH * HD));
#pragma unroll
        for (int i = 0; i < 8; ++i) acc = acc + vv[i] * a[i0 + i];
    }
#pragma unroll
    for (int e = 0; e < 4; ++e) { acc[e] += __shfl_xor(acc[e], 16); acc[e] += __shfl_xor(acc[e], 32); }
    if (ts == 0) *(f32x4*)(WSP(float, WS_SBPO) + (((size_t)b * NPG + pg) * NH + h) * HD + 4 * d4) = acc;
    if (lane == 0) WSP(float, WS_SBPL)[((size_t)b * NPG + pg) * NH + h] = -run;
}
__device__ __forceinline__ void sb_sample_combine(Frame& F, int b, int h) {
    const float* PO = WSP(float, WS_SBPO); const float* PL = WSP(float, WS_SBPL); float o = 0.f, run = 0.f;
#pragma unroll
    for (int pg = NPG - 1; pg >= 0; --pg) { o += __builtin_amdgcn_exp2f(run) * PO[(((size_t)b * NPG + pg) * NH + h) * HD + F.lane]; run += PL[((size_t)b * NPG + pg) * NH + h]; }
    WSP(bf16, WS_OSB)[(size_t)(MPR + b) * SBW + h * HD + F.lane] = (bf16)f2bf(o);
}
__device__ __forceinline__ void ssm_sample_unit(Frame& F, int b, int g) {
    const int n = F.lane;
    const float lr = INF(14)[g * NST + n], li = INF(15)[g * NST + n], ldt = INF(16)[g];
    float lbr, lbi, cr, ci; lam_pow(lr, li, ldt, 1, lbr, lbi); lam_coef(lr, li, ldt, cr, ci);
    const float* u = WSP(float, WS_US) + (size_t)b * SBW + g * GP;
    float br = 0.f, bi = 0.f;
#pragma unroll
    for (int p = 0; p < 16; ++p) { const float bre = INF(17)[(g * NST + n) * GP + p], bim = INF(18)[(g * NST + n) * GP + p]; const float uv = u[p]; br += (cr * bre - ci * bim) * uv; bi += (cr * bim + ci * bre) * uv; }
    const float h0r = INF(5)[(b * NG + g) * NST + n], h0i = INF(6)[(b * NG + g) * NST + n];
    const float hr = lbr * h0r - lbi * h0i + br, hi = lbr * h0i + lbi * h0r + bi;
    F.out[O_RES + (size_t)(b * NG + g) * NST + n] = hr; F.out[O_IMS + (size_t)(b * NG + g) * NST + n] = hi;
    float y = 0.f;
#pragma unroll
    for (int p = 0; p < 16; ++p) { const float v = wave_sum(INF(19)[(g * GP + p) * NST + n] * hr - INF(20)[(g * GP + p) * NST + n] * hi); if (n == p) y = v; }
    if (n < 16) { y += INF(21)[g * GP + n] * u[n]; WSP(bf16, WS_YG)[(size_t)(MPR + b) * SBW + g * GP + n] = (bf16)f2bf(gelu_tanh_f(y)); }
}
__device__ __forceinline__ void ssm_scan_unit(Frame& F, int unit) {
    const int b = unit >> 6, g = (unit >> 1) & 31, nh = unit & 1, nl = F.tid & 31, seg = F.tid >> 5, n = nh * 32 + nl;
    LAS float* tot = (LAS float*)(F.lds + RING_OFF);
    const float lr = INF(14)[g * NST + n], li = INF(15)[g * NST + n], ldt = INF(16)[g];
    float Lr, Li, Sr, Si; lam_pow(lr, li, ldt, LC, Lr, Li); lam_pow(lr, li, ldt, LC * 16, Sr, Si);
    const float* SST = WSP(float, WS_SST); bf16* XH = WSP(bf16, WS_XH);
    f32x2 s[16];
#pragma unroll
    for (int k = 0; k < 16; ++k) s[k] = *(const f32x2*)(SST + ((size_t)(b * NCH + seg * 16 + k) * NG + g) * 128 + 2 * n);
    float pr = 0.f, pi = 0.f;
#pragma unroll
    for (int k = 0; k < 16; ++k) { const float nr = Lr * pr - Li * pi + s[k].x, ni = Lr * pi + Li * pr + s[k].y; pr = nr; pi = ni; s[k].x = pr; s[k].y = pi; }
    __syncthreads();
    tot[(seg * 32 + nl) * 2] = pr; tot[(seg * 32 + nl) * 2 + 1] = pi;
    __syncthreads();
    float cr = 0.f, ci = 0.f;
    for (int s2 = 0; s2 < seg; ++s2) { const float tr = tot[(s2 * 32 + nl) * 2], ti = tot[(s2 * 32 + nl) * 2 + 1]; const float nr = Sr * cr - Si * ci + tr, ni = Sr * ci + Si * cr + ti; cr = nr; ci = ni; }
    if (seg == 0) *(GAS unsigned*)(XH + ((size_t)(b * NCH) * NG + g) * XHP + 256 + 2 * n) = 0u;
    float wr_ = Lr, wi_ = Li;
#pragma unroll
    for (int k = 0; k < 16; ++k) {
        const float hr = wr_ * cr - wi_ * ci + s[k].x, hi = wr_ * ci + wi_ * cr + s[k].y;
        const int c = seg * 16 + k;
        if (c + 1 < NCH) *(GAS unsigned*)(XH + ((size_t)(b * NCH + c + 1) * NG + g) * XHP + 256 + 2 * n) = pk2(hr, hi);
        else { F.out[O_REP + (size_t)(b * NG + g) * NST + n] = hr; F.out[O_IMP + (size_t)(b * NG + g) * NST + n] = hi; }
        const float nr = wr_ * Lr - wi_ * Li, ni = wr_ * Li + wi_ * Lr; wr_ = nr; wi_ = ni;
    }
}
__device__ __forceinline__ void xattn_prompt_unit(Frame& F, int b, int h, int qb) {
    const int lane = F.lane, r32 = lane & 31, hi = lane >> 5, wid = F.wave;
    const bf16* QM = WSP(bf16, WS_QM); const bf16* MKB = WSP(bf16, WS_MKB); const bf16* MVB = WSP(bf16, WS_MVB); bf16* OM = WSP(bf16, WS_OMEM);
    const unsigned lds0 = (unsigned)(uintptr_t)(F.lds + RING_OFF); const lds_cptr base3 = (lds_cptr)(F.lds + RING_OFF);
    const long qrow0 = (long)b * T + qb * 256 + wid * 32;
#pragma unroll
    for (int t = 0; t < 4; ++t)
#pragma unroll
        for (int j = 0; j < 4; ++j) { const int c = wid + 8 * j;
            glds16(MKB + ((long)b * MT + t * 64 + lane) * D + h * MHD + c * 8, (unsigned)__builtin_amdgcn_readfirstlane(lds0 + t * 32768 + c * 1024)); }
    bf16x8 qr[16];
#pragma unroll
    for (int ks = 0; ks < 16; ++ks) qr[ks] = *reinterpret_cast<const bf16x8*>(QM + (qrow0 + r32) * D + h * MHD + ks * 16 + hi * 8);
    WAIT_BAR(0);
    f32x16 S[8];
#pragma unroll
    for (int t = 0; t < 4; ++t)
#pragma unroll
        for (int blk = 0; blk < 2; ++blk) { f32x16 p = {};
#pragma unroll
            for (int ks = 0; ks < 16; ++ks) p = MFMA32(ldsq(base3 + t * 32768 + (2 * ks + hi) * 1024 + (32 * blk + r32) * 16), qr[ks], p);
            S[t * 2 + blk] = p; }
    WAIT_BAR(0);
#pragma unroll
    for (int t = 0; t < 4; ++t)
#pragma unroll
        for (int j = 0; j < 4; ++j) { const int p = wid + 8 * j, dblk = p >> 2, rg = p & 3;
            glds16(MVB + ((long)b * MT + t * 64 + 16 * rg + (lane >> 2)) * D + h * MHD + dblk * 32 + (lane & 3) * 8, (unsigned)__builtin_amdgcn_readfirstlane(lds0 + t * 32768 + p * 1024)); }
    float mx = -INFINITY;
#pragma unroll
    for (int i = 0; i < 8; ++i)
#pragma unroll
        for (int r = 0; r < 16; ++r) mx = fmaxf(mx, S[i][r]);
    mx = fmaxf(mx, swap_half(mx));
    float l = 0.f;
#pragma unroll
    for (int i = 0; i < 8; ++i)
#pragma unroll
        for (int r = 0; r < 16; ++r) { S[i][r] = __builtin_amdgcn_exp2f(S[i][r] - mx); l += S[i][r]; }
    l += swap_half(l);
    bf16x8 pa[16];
#pragma unroll
    for (int i = 0; i < 8; ++i) { pa[2 * i] = pack_bf8(S[i], 0); pa[2 * i + 1] = pack_bf8(S[i], 8); }
    WAIT_BAR(0);
    f32x16 o[8];
#pragma unroll
    for (int dblk = 0; dblk < 8; ++dblk) o[dblk] = (f32x16){};
    const lds_cptr vp0 = base3 + ((lane >> 4) & 1) * 32 + (lane & 3) * 8 + (4 * hi + ((lane & 15) >> 2)) * 64;
#pragma unroll
    for (int t = 0; t < 4; ++t)
#pragma unroll
        for (int dblk = 0; dblk < 8; ++dblk)
#pragma unroll
            for (int rg = 0; rg < 4; ++rg) { const s16x4 lo = vtr(vp0 + t * 32768 + dblk * 4096 + rg * 1024), hh = vtr(vp0 + t * 32768 + dblk * 4096 + rg * 1024 + 512);
                const bf16x8 vf = (bf16x8){lo[0], lo[1], lo[2], lo[3], hh[0], hh[1], hh[2], hh[3]};
                o[dblk] = MFMA32(pa[t * 4 + rg], vf, o[dblk]); }
    WAIT_BAR(0);
    int l2 = lane; asm volatile("" : "+v"(l2));
    const int e32 = l2 & 31, ehi = l2 >> 5;
    LAS bf16* stg = (LAS bf16*)(F.lds + RING_OFF) + wid * 8192;
    LAS float* lsw = (LAS float*)stg;
    if (ehi == 0) lsw[e32] = l;
    LDS_WAIT();
    float rli[16];
    { const LAS float* lb = lsw + 4 * ehi;
#pragma unroll
      for (int r = 0; r < 16; ++r) rli[r] = __builtin_amdgcn_rcpf(lb[(r & 3) + 8 * (r >> 2)]); }
    LDS_WAIT(); asm volatile("" ::: "memory");
    { LAS bf16* sb = stg + (4 * ehi) * 256 + e32;
#pragma unroll
      for (int dblk = 0; dblk < 8; ++dblk)
#pragma unroll
        for (int r = 0; r < 16; ++r) sb[((r & 3) + 8 * (r >> 2)) * 256 + dblk * 32] = (bf16)f2bf(o[dblk][r] * rli[r]); }
    LDS_WAIT();
    { bf16* Ow = OM + (qrow0 + (l2 >> 5)) * D + h * MHD + (l2 & 31) * 8; const LAS bf16* sr = stg + (l2 >> 5) * 256 + (l2 & 31) * 8;
#pragma unroll
      for (int i = 0; i < 16; ++i) { const v4u v = *(const LAS v4u*)(sr + i * 512); *(v4u*)(Ow + (long)i * 2 * D) = v; } }
    asm volatile("s_waitcnt vmcnt(0) lgkmcnt(0)\n\ts_barrier" ::: "memory");
}
__device__ __forceinline__ void xattn_sample_unit(Frame& F, int b, int h) {
    const int lane = F.lane, wid = F.wave;
    const bf16* QM = WSP(bf16, WS_QM); const float* ck = INF(8); const float* cv = INF(9);
    LAS float* xm = (LAS float*)(F.lds + RING_OFF);
    const v2u qw = *(const v2u*)(QM + (size_t)(MPR + b) * D + h * MHD + 4 * lane);
    const f32x4 q4 = {bflo(qw.x), bfhi(qw.x), bflo(qw.y), bfhi(qw.y)};
    const float* kb = ck + (((size_t)b * MT + wid * 32) * MH + h) * MHD + 4 * lane;
    const float* vb = cv + (((size_t)b * MT + wid * 32) * MH + h) * MHD + 4 * lane;
    float s[32];
#pragma unroll
    for (int i0 = 0; i0 < 32; i0 += 8) {
        f32x4 kk[8];
#pragma unroll
        for (int i = 0; i < 8; ++i) kk[i] = __builtin_nontemporal_load((const f32x4*)(kb + (size_t)(i0 + i) * MH * MHD));
#pragma unroll
        for (int i = 0; i < 8; ++i) s[i0 + i] = wave_sum((q4[0] * kk[i][0] + q4[1] * kk[i][1]) + (q4[2] * kk[i][2] + q4[3] * kk[i][3]));
    }
    float mx = s[0];
#pragma unroll
    for (int i = 1; i < 32; ++i) mx = fmaxf(mx, s[i]);
    __syncthreads();
    if (lane == 0) xm[wid] = mx;
    __syncthreads();
    float gm = xm[0];
#pragma unroll
    for (int w = 1; w < 8; ++w) gm = fmaxf(gm, xm[w]);
    float l = 0.f;
#pragma unroll
    for (int i = 0; i < 32; ++i) { s[i] = __builtin_amdgcn_exp2f(s[i] - gm); l += s[i]; }
    f32x4 acc = {0.f, 0.f, 0.f, 0.f};
#pragma unroll
    for (int i0 = 0; i0 < 32; i0 += 8) {
        f32x4 vv[8];
#pragma unroll
        for (int i = 0; i < 8; ++i) vv[i] = __builtin_nontemporal_load((const f32x4*)(vb + (size_t)(i0 + i) * MH * MHD));
#pragma unroll
        for (int i = 0; i < 8; ++i) acc = acc + vv[i] * s[i0 + i];
    }
    if (lane == 0) xm[8 + wid] = l;
    *(LAS f32x4*)(xm + 64 + wid * 256 + 4 * lane) = acc;
    __syncthreads();
    if (F.tid < 256) { float lt = 0.f, ov = 0.f;
#pragma unroll
        for (int w = 0; w < 8; ++w) { lt += xm[8 + w]; ov += xm[64 + w * 256 + F.tid]; }
        WSP(bf16, WS_OMEM)[(size_t)(MPR + b) * D + h * MHD + F.tid] = (bf16)f2bf(ov / lt); }
}
__device__ __forceinline__ void mix_row(Frame& F, int row) {
    const int lane = F.lane;
#pragma unroll
    for (int half = 0; half < 2; ++half) {
        const bf16* src = (half ? WSP(bf16, WS_OSSM) : WSP(bf16, WS_OSB)) + (size_t)row * SBW + 8 * lane;
        const v4u w = *(const v4u*)src; float v[8] = {bflo(w.x), bfhi(w.x), bflo(w.y), bfhi(w.y), bflo(w.z), bfhi(w.z), bflo(w.w), bfhi(w.w)};
        float s = 0.f;
#pragma unroll
        for (int e = 0; e < 8; ++e) s += v[e] * v[e];
        s = wave_sum(s); const float rs = 1.f / sqrtf(s * (1.f / SBW) + EPS);
        v4u o; o.x = pk2(v[0] * rs, v[1] * rs); o.y = pk2(v[2] * rs, v[3] * rs); o.z = pk2(v[4] * rs, v[5] * rs); o.w = pk2(v[6] * rs, v[7] * rs);
        *(v4u*)(WSP(bf16, WS_MIX) + (size_t)row * D + half * SBW + 8 * lane) = o;
    }
}
__device__ __forceinline__ void conv_act_item(Frame& F, long item) {
    const int row = (int)(item / (FF / 8)), j = (int)(item % (FF / 8)) * 8;
    const bf16* GB = WSP(bf16, WS_GB); bf16* UB = WSP(bf16, WS_UB);
    const float* cw = INF(36); const float* cb = INF(37); const float* sc = INF(7);
    float g0[8], g1[8], g2[8], uu[8];
    { const v4u w = *(const v4u*)(GB + (size_t)row * FF + j); g0[0] = bflo(w.x); g0[1] = bfhi(w.x); g0[2] = bflo(w.y); g0[3] = bfhi(w.y); g0[4] = bflo(w.z); g0[5] = bfhi(w.z); g0[6] = bflo(w.w); g0[7] = bfhi(w.w); }
    { const v4u w = *(const v4u*)(UB + (size_t)row * FF + j); uu[0] = bflo(w.x); uu[1] = bfhi(w.x); uu[2] = bflo(w.y); uu[3] = bfhi(w.y); uu[4] = bflo(w.z); uu[5] = bfhi(w.z); uu[6] = bflo(w.w); uu[7] = bfhi(w.w); }
    if (row < MPR) { const int t = row & 4095;
        if (t >= 1) { const v4u w = *(const v4u*)(GB + (size_t)(row - 1) * FF + j); g1[0] = bflo(w.x); g1[1] = bfhi(w.x); g1[2] = bflo(w.y); g1[3] = bfhi(w.y); g1[4] = bflo(w.z); g1[5] = bfhi(w.z); g1[6] = bflo(w.w); g1[7] = bfhi(w.w); }
        else { _Pragma("unroll") for (int e = 0; e < 8; ++e) g1[e] = 0.f; }
        if (t >= 2) { const v4u w = *(const v4u*)(GB + (size_t)(row - 2) * FF + j); g2[0] = bflo(w.x); g2[1] = bfhi(w.x); g2[2] = bflo(w.y); g2[3] = bfhi(w.y); g2[4] = bflo(w.z); g2[5] = bfhi(w.z); g2[6] = bflo(w.w); g2[7] = bfhi(w.w); }
        else { _Pragma("unroll") for (int e = 0; e < 8; ++e) g2[e] = 0.f; }
    } else { const int b = row - MPR;
        _Pragma("unroll") for (int e = 0; e < 8; ++e) { g2[e] = sc[((size_t)b * 2 + 0) * FF + j + e]; g1[e] = sc[((size_t)b * 2 + 1) * FF + j + e]; F.out[O_CVS + ((size_t)b * 2 + 0) * FF + j + e] = g1[e]; } }
    float r[8];
#pragma unroll
    for (int e = 0; e < 8; ++e) { const float c = cb[j + e] + cw[j + e] * g2[e] + cw[FF + j + e] * g1[e] + cw[2 * FF + j + e] * g0[e]; r[e] = gelu_tanh_f(c) * uu[e]; }
    v4u o; o.x = pk2(r[0], r[1]); o.y = pk2(r[2], r[3]); o.z = pk2(r[4], r[5]); o.w = pk2(r[6], r[7]);
    *(v4u*)(UB + (size_t)row * FF + j) = o;
}
__device__ __forceinline__ void final_norm_row(Frame& F, int row) {
    const float rs = 1.f / sqrtf(((const float*)(F.ctl + CW_SSQ3))[row] * (1.f / D) + EPS);
    float* y = F.out + O_YP + (size_t)row * D; const float* g = INF(39);
#pragma unroll
    for (int j = 0; j < 4; ++j) { const int c = 4 * F.lane + 256 * j; f32x4 v = *(const f32x4*)(y + c); const f32x4 gv = *(const f32x4*)(g + c); v = v * rs * gv; *(f32x4*)(y + c) = v; }
}
constexpr int N_PHASES = 15;
__global__ void __launch_bounds__(NTHR, 2) mk_fwd(Args args) {
    extern __shared__ __attribute__((aligned(16))) unsigned char lds[];
    Frame F;
    F.lds = (LAS unsigned char*)lds; F.MISC = (volatile LAS unsigned*)(F.lds + MISC_OFF);
    F.tid = threadIdx.x; F.lane = F.tid & 63; F.wave = __builtin_amdgcn_readfirstlane(F.tid >> 6);
    F.G = gridDim.x; { const int bx = blockIdx.x; F.vcu = (F.G % 8 == 0) ? (bx % 8) * (F.G / 8) + bx / 8 : bx; }
    F.ws = args.ws; F.out = args.out; F.in = args.in; F.ctl = (unsigned*)(args.ws + WS_CTL);
    for (int u = F.tid; u < (LDS_BYTES - LDSCTL_OFF) / 4; u += NTHR) ((LAS unsigned*)(F.lds + LDSCTL_OFF))[u] = 0u;
    __syncthreads();
    XcdBarrier bar; bar.bar = F.ctl + CW_BAR; bar.x = 0; bar.st = nullptr;
    if (args.use_bar) bar = xcd_barrier_post(F.ctl + CW_BAR, F.MISC + 8);
    const int lo = args.ph_lo, hi = args.ph_hi;
#define IN(k) (lo <= (k) && (k) < hi)
#define SEAM(k) do { if (IN(k) && IN((k) + 1)) xcd_barrier(bar); } while (0)
    const int gw = F.vcu * NWAVES + F.wave, NGW = F.G * NWAVES;
    LAS unsigned char* ring = F.lds + RING_OFF;

    if (IN(0)) { p0_prologue(F); } SEAM(0);
    if (IN(1)) {
        { pg8::Gemm g{WSP(bf16, WS_XB), WSP(bf16, WS_WIN), D, D, D}; pg8::GridOrder S; S.init(MPAD / 256, INW / 256, F.G, (int)blockIdx.x, 0, D, D);
          EpiInProj E{WSP(float, WS_RSTD0), WSP(bf16, WS_QB), WSP(bf16, WS_KB), WSP(bf16, WS_VB), WSP(bf16, WS_XH), WSP(float, WS_QS), WSP(float, WS_US), F.out};
          pg8::gemm_phase<EpiInProj, pg8::GridOrder>(ring, g, S, E); }
        { pg8::Gemm g{WSP(bf16, WS_MB), WSP(bf16, WS_WMKV), D, D, D}; pg8::GridOrder S; S.init(4, 8, F.G, (int)blockIdx.x, 8, D, D);
          EpiMemKV E{WSP(float, WS_RSTDM), WSP(bf16, WS_MKB), WSP(bf16, WS_MVB), F.out};
          pg8::gemm_phase<EpiMemKV, pg8::GridOrder>(ring, g, S, E); }
    } SEAM(1);
    if (IN(2)) {
        { const int bh = F.vcu >> 3, s = F.vcu & 7; const float b2 = INF(13)[bh & 7] * LOG2E;
          if (F.G == 256) { sb_attn_unit(F, bh >> 3, bh & 7, s, b2); sb_attn_unit(F, bh >> 3, bh & 7, 15 - s, b2); }
          else { for (int u = F.vcu; u < 512; u += F.G) { const int bh2 = u >> 4; sb_attn_unit(F, bh2 >> 3, bh2 & 7, u & 15, INF(13)[bh2 & 7] * LOG2E); } } }
        { pg8::Gemm g{WSP(bf16, WS_XH), WSP(bf16, WS_W1), NG * XHP, 256, 256}; SsmOrder S{F.G, (int)blockIdx.x, (size_t)128 * 256 * 2};
          EpiSsmA E{WSP(float, WS_SST)};
          pg8::gemm_phase<EpiSsmA, SsmOrder>(ring, g, S, E); }
        for (int u = F.vcu; u < MS * NPG; u += F.G) sb_sample_unit(F, u >> 4, u & 15);
        for (int u = gw; u < MS * NG; u += NGW) ssm_sample_unit(F, u >> 5, u & 31);
    } SEAM(2);
    if (IN(3)) {
        for (int u = F.vcu; u < 256; u += F.G) ssm_scan_unit(F, u);
        for (int u = gw; u < MS * NH; u += NGW) sb_sample_combine(F, u >> 3, u & 7);
    } SEAM(3);
    if (IN(4)) {
        pg8::Gemm g{WSP(bf16, WS_XH), WSP(bf16, WS_BTC), NG * XHP, XHP, XHP}; SsmOrder S{F.G, (int)blockIdx.x, (size_t)256 * XHP * 2};
        EpiSsmC E{WSP(bf16, WS_YG)};
        pg8::gemm_phase<EpiSsmC, SsmOrder>(ring, g, S, E);
    } SEAM(4);
    if (IN(5)) {
        pg8::Gemm g{WSP(bf16, WS_YG), WSP(bf16, WS_WGLU), SBW, SBW, SBW}; pg8::GridOrder S; S.init(MPAD / 256, 2, F.G, (int)blockIdx.x, 0, SBW, SBW);
        EpiGlu E{WSP(bf16, WS_YG), INF(23), WSP(bf16, WS_OSSM)};
        pg8::gemm_phase<EpiGlu, pg8::GridOrder>(ring, g, S, E);
    } SEAM(5);
    if (IN(6)) { for (int m = gw; m < MALL; m += NGW) mix_row(F, m); } SEAM(6);
    if (IN(7)) {
        pg8::Gemm g{WSP(bf16, WS_MIX), WSP(bf16, WS_WOUT), D, D, D}; pg8::GridOrder S; S.init(MPAD / 256, 4, F.G, (int)blockIdx.x, 0, D, D);
        EpiResid E{INF(0), INF(1), WSP(float, WS_X1), WSP(bf16, WS_X1B), (float*)(F.ctl + CW_SSQ1)};
        pg8::gemm_phase<EpiResid, pg8::GridOrder>(ring, g, S, E);
    } SEAM(7);
    if (IN(8)) {
        pg8::Gemm g{WSP(bf16, WS_X1B), WSP(bf16, WS_WMQ), D, D, D}; pg8::GridOrder S; S.init(MPAD / 256, 4, F.G, (int)blockIdx.x, 0, D, D);
        EpiScaleBf16 E{(const float*)(F.ctl + CW_SSQ1), CM, WSP(bf16, WS_QM)};
        pg8::gemm_phase<EpiScaleBf16, pg8::GridOrder>(ring, g, S, E);
    } SEAM(8);
    if (IN(9)) {
        for (int u = F.vcu; u < 256; u += F.G) xattn_prompt_unit(F, u >> 6, (u >> 4) & 3, u & 15);
        for (int u = F.vcu; u < MS * MH; u += F.G) xattn_sample_unit(F, u >> 2, u & 3);
    } SEAM(9);
    if (IN(10)) {
        pg8::Gemm g{WSP(bf16, WS_OMEM), WSP(bf16, WS_WMO), D, D, D}; pg8::GridOrder S; S.init(MPAD / 256, 4, F.G, (int)blockIdx.x, 0, D, D);
        EpiResid E{WSP(float, WS_X1), WSP(float, WS_X1) + (size_t)MPR * D, WSP(float, WS_X2), WSP(bf16, WS_X2B), (float*)(F.ctl + CW_SSQ2)};
        pg8::gemm_phase<EpiResid, pg8::GridOrder>(ring, g, S, E);
    } SEAM(10);
    if (IN(11)) {
        pg8::Gemm g{WSP(bf16, WS_X2B), WSP(bf16, WS_WGU), D, D, D}; pg8::GridOrder S; S.init(MPAD / 256, NFF2 / 256, F.G, (int)blockIdx.x, 0, D, D);
        EpiGateUp E{(const float*)(F.ctl + CW_SSQ2), WSP(bf16, WS_GB), WSP(bf16, WS_UB), F.out};
        pg8::gemm_phase<EpiGateUp, pg8::GridOrder>(ring, g, S, E);
    } SEAM(11);
    if (IN(12)) { const long NIT = (long)MALL * (FF / 8); for (long it = (long)F.vcu * NTHR + F.tid; it < NIT; it += (long)F.G * NTHR) conv_act_item(F, it); } SEAM(12);
    if (IN(13)) {
        pg8::Gemm g{WSP(bf16, WS_UB), WSP(bf16, WS_WDN), FF, FF, FF}; pg8::GridOrder S; S.init(MPAD / 256, 4, F.G, (int)blockIdx.x, 0, FF, FF);
        EpiResid E{WSP(float, WS_X2), WSP(float, WS_X2) + (size_t)MPR * D, F.out + O_YP, nullptr, (float*)(F.ctl + CW_SSQ3)};
        pg8::gemm_phase<EpiResid, pg8::GridOrder>(ring, g, S, E);
    } SEAM(13);
    if (IN(14)) { for (int m = gw; m < MALL; m += NGW) final_norm_row(F, m); }
#undef IN
#undef SEAM
}
#ifndef MK_DEBUG
#define MK_DEBUG 0
#endif
#ifndef MK_ONE_LAUNCH
#define MK_ONE_LAUNCH 1
#endif
#if MK_DEBUG
struct Chk { const void* fast; const float* ref; int isbf; long rows, cols, ldf, ldr; float scale; };
__global__ void k_compare(Chk c, double* acc) {
    __shared__ double se[256], sr[256];
    double e = 0.0, r = 0.0; const long n = c.rows * c.cols;
    for (long i = (long)blockIdx.x * 256 + threadIdx.x; i < n; i += (long)gridDim.x * 256) { const long rr = i / c.cols, cc = i % c.cols;
        const float f = (c.isbf ? bf2f(((const unsigned short*)c.fast)[rr * c.ldf + cc]) : ((const float*)c.fast)[rr * c.ldf + cc]) * c.scale; const float g = c.ref[rr * c.ldr + cc];
        const double d = (double)f - (double)g; e += d * d; r += (double)g * (double)g; }
    se[threadIdx.x] = e; sr[threadIdx.x] = r; __syncthreads();
    for (int k = 128; k > 0; k >>= 1) { if ((int)threadIdx.x < k) { se[threadIdx.x] += se[threadIdx.x + k]; sr[threadIdx.x] += sr[threadIdx.x + k]; } __syncthreads(); }
    if (threadIdx.x == 0) { atomicAdd(acc, se[0]); atomicAdd(acc + 1, sr[0]); }
}
__global__ void k_compare_xh(const unsigned short* XH, const float* proj, const float* hs, int part, double* acc) {
    __shared__ double se[256], sr[256];
    double e = 0.0, r = 0.0; const int w = part ? 128 : 256; const long n = (long)1024 * NG * w;
    for (long i = (long)blockIdx.x * 256 + threadIdx.x; i < n; i += (long)gridDim.x * 256) { const int j = (int)(i % w); const long bcg = i / w; const int g = (int)(bcg % NG); const long bc = bcg / NG; const int b = (int)(bc / NCH), c = (int)(bc % NCH);
        const float f = bf2f(XH[bcg * XHP + (part ? 256 : 0) + j]); float gref;
        if (!part) { const int s = j >> 4, q = j & 15; gref = proj[((size_t)b * T + c * LC + s) * INW + 1536 + g * GP + q]; }
        else { const int nn = j >> 1, ri = j & 1; gref = (c == 0) ? 0.f : hs[((((size_t)b * T + c * LC - 1) * NG + g) * NST + nn) * 2 + ri]; }
        const double d = (double)f - (double)gref; e += d * d; r += (double)gref * (double)gref; }
    se[threadIdx.x] = e; sr[threadIdx.x] = r; __syncthreads();
    for (int k = 128; k > 0; k >>= 1) { if ((int)threadIdx.x < k) { se[threadIdx.x] += se[threadIdx.x + k]; sr[threadIdx.x] += sr[threadIdx.x + k]; } __syncthreads(); }
    if (threadIdx.x == 0) { atomicAdd(acc, se[0]); atomicAdd(acc + 1, sr[0]); }
}
__global__ void k_judge(const double* acc, int n, float tol, float* out) {
    if (threadIdx.x != 0 || blockIdx.x != 0) return;
    for (int k = 0; k < n; ++k) { const double rv = acc[2 * k] / acc[2 * k + 1];
        if (!(rv < (double)tol)) { int m = 5; if (rv != rv) m = 0; else if (rv >= 1.0) m = 9; else if (rv >= 0.1) m = 8; else if (rv >= 0.01) m = 7; else if (rv >= 0.001) m = 6;
            const int grp = k / 9, kk = k % 9 + 1; float code = (float)(10 * kk + m) * 100.f; for (int i = 0; i < grp; ++i) code *= 100.f; out[0] = code; return; } }
}
#endif

extern "C" void kernel_launch(void* const* d_in, const int* in_sizes, int n_in, void* d_out, int out_size, void* d_ws, size_t ws_size, hipStream_t stream) {
    static int grid = 0;
    if (grid == 0) {
        if (n_in != 40 || (size_t)out_size != O_END || ws_size < WS_FAST_END) { fprintf(stderr, "kernel_launch: unexpected shapes: n_in %d out %d ws %zu\n", n_in, out_size, ws_size); grid = -1; return; }
        int dev = 0, cus = 0, per_cu = 0;
        if (hipGetDevice(&dev) != hipSuccess || hipDeviceGetAttribute(&cus, hipDeviceAttributeMultiprocessorCount, dev) != hipSuccess) { grid = -1; return; }
        if (hipFuncSetAttribute((const void*)mk_fwd, hipFuncAttributeMaxDynamicSharedMemorySize, LDS_BYTES) != hipSuccess) { fprintf(stderr, "kernel_launch: hipFuncSetAttribute failed\n"); grid = -1; return; }
        if (hipOccupancyMaxActiveBlocksPerMultiprocessor(&per_cu, (const void*)mk_fwd, NTHR, LDS_BYTES) != hipSuccess || per_cu < 1) { fprintf(stderr, "kernel_launch: occupancy query says %d\n", per_cu); }
        (void)hipGetLastError();
        grid = cus;
    }
    if (grid < 0) return;
    (void)hipMemsetAsync((char*)d_ws + WS_CTL, 0, CTL_ZERO_BYTES, stream);
    Args a{};
    for (int i = 0; i < 40; ++i) a.in[i] = d_in[i];
    a.out = (float*)d_out; a.ws = (unsigned char*)d_ws;
#if MK_DEBUG
    const size_t fo_off = (WS_FAST_END + 4095) & ~(size_t)4095, nv_off = fo_off + (((size_t)O_END * 4 + 4095) & ~(size_t)4095), chk_off = nv_off + (((size_t)nv::WS_FLOATS * 4 + 4095) & ~(size_t)4095);
    if (ws_size < chk_off + 4096) { fprintf(stderr, "debug build: workspace too small (%zu < %zu)\n", ws_size, chk_off + 4096); return; }
    float* fast_out = (float*)((char*)d_ws + fo_off); float* nvws = (float*)((char*)d_ws + nv_off); double* chk = (double*)((char*)d_ws + chk_off);
    nv::forward(d_in, (float*)d_out, nvws, stream);
    a.out = fast_out;
    (void)hipMemsetAsync(chk, 0, 4096, stream);
#endif
#if MK_ONE_LAUNCH
    a.ph_lo = 0; a.ph_hi = N_PHASES; a.use_bar = 1;
    hipLaunchKernelGGL(mk_fwd, dim3(grid), dim3(NTHR), LDS_BYTES, stream, a);
#else
    for (int p = 0; p < N_PHASES; ++p) { a.ph_lo = p; a.ph_hi = p + 1; a.use_bar = 0; hipLaunchKernelGGL(mk_fwd, dim3(grid), dim3(NTHR), LDS_BYTES, stream, a); }
#endif
#if MK_DEBUG
    {
        const nv::Bufs B = nv::carve(nvws); unsigned char* ws = (unsigned char*)d_ws; int k = 0; const float* no = (const float*)d_out;
        auto cmp = [&](const void* fast, int isbf, long ldf, const float* ref, long ldr, long rows, long cols, float scale) {
            Chk c{fast, ref, isbf, rows, cols, ldf, ldr, scale}; hipLaunchKernelGGL(k_compare, dim3(1024), dim3(256), 0, stream, c, chk + 2 * k); ++k; };
        cmp(ws + WS_KB, 1, SBW, B.PROJ + 512, INW, MALL, SBW, 1.f);
        cmp(ws + WS_VB, 1, SBW, B.PROJ + 1024, INW, MALL, SBW, 1.f);
        cmp(ws + WS_QB, 1, SBW, B.PROJ, INW, MALL, SBW, 1.f / C2);
        hipLaunchKernelGGL(k_compare_xh, dim3(1024), dim3(256), 0, stream, (const unsigned short*)(ws + WS_XH), B.PROJ, B.HS, 0, chk + 2 * k); ++k;
        cmp(ws + WS_MKB, 1, D, no + O_MKP, D, NB * MT, D, 1.f);
        cmp(ws + WS_MVB, 1, D, no + O_MVP, D, NB * MT, D, 1.f);
        cmp(ws + WS_OSB, 1, SBW, B.OSB, SBW, MPR, SBW, 1.f);
        cmp(ws + WS_OSB + (size_t)MPR * SBW * 2, 1, SBW, B.OSB + (size_t)MPR * SBW, SBW, MS, SBW, 1.f);
        hipLaunchKernelGGL(k_compare_xh, dim3(1024), dim3(256), 0, stream, (const unsigned short*)(ws + WS_XH), B.PROJ, B.HS, 1, chk + 2 * k); ++k;
        cmp(ws + WS_YG, 1, SBW, B.YG, SBW, MPR, SBW, 1.f);
        cmp(ws + WS_YG + (size_t)MPR * SBW * 2, 1, SBW, B.YG + (size_t)MPR * SBW, SBW, MS, SBW, 1.f);
        cmp(ws + WS_OSSM, 1, SBW, B.OSSM, SBW, MALL, SBW, 1.f);
        cmp(ws + WS_X1, 0, D, B.X1, D, MALL, D, 1.f);
        cmp(ws + WS_QM, 1, D, B.Q, D, MALL, D, 1.f / CM);
        cmp(ws + WS_OMEM, 1, D, B.OM, D, MPR, D, 1.f);
        cmp(ws + WS_OMEM + (size_t)MPR * D * 2, 1, D, B.OM + (size_t)MPR * D, D, MS, D, 1.f);
        cmp(ws + WS_X2, 0, D, B.X2, D, MALL, D, 1.f);
        cmp(ws + WS_GB, 1, FF, B.G, FF, MALL, FF, 1.f);
        cmp(ws + WS_UB, 1, FF, B.ACT, FF, MALL, FF, 1.f);
        const size_t offs[15] = {O_YP, O_YS, O_KP, O_VP, O_REP, O_IMP, O_CVP, O_MKP, O_MVP, O_KS, O_VS, O_RES, O_IMS, O_CVS, O_END};
        for (int i = 0; i < 14; ++i) cmp(fast_out + offs[i], 0, 1, no + offs[i], 1, (long)(offs[i + 1] - offs[i]), 1, 1.f);
        hipLaunchKernelGGL(k_judge, dim3(1), dim3(64), 0, stream, (const double*)chk, k, 2e-3f, (float*)d_out);
    }
#endif
}
```

```cpp
#define MK_DEBUG 0
#define MK_ONE_LAUNCH 1
#define MK_PROBE 0
#include <hip/hip_runtime.h>
#include <cstdio>
#include <cstdint>
#include <cmath>
namespace pg8 {
#define PG8_LAS __attribute__((address_space(3)))
typedef unsigned short bf16_t;
typedef short bf16x8 __attribute__((ext_vector_type(8)));
typedef float f32x4 __attribute__((ext_vector_type(4)));
typedef unsigned u32x4 __attribute__((ext_vector_type(4)));
constexpr int BM = 256, BK = 64, HALF = 128, HTB = HALF * BK * 2  , STAGE_BYTES = 8 * HTB, NXCD = 8, WGM = 8;

__host__ __device__ __forceinline__ int lds_byte(int r, int c) { const int st = (r >> 4) * 2 + (c >> 5), rr = r & 15, cc = c & 31, ob = rr * 64 + cc * 2; return st * 1024 + (ob ^ (((ob >> 9) & 1) << 5)); }
__host__ __device__ __forceinline__ void stage_rc(int b, int& R, int& C) { const int st = b / 1024, sb = b % 1024, swz = sb ^ (((sb >> 9) & 1) << 5); R = (st >> 1) * 16 + swz / 64; C = (st & 1) * 32 + (swz % 64) / 2; }
__host__ __device__ __forceinline__ int perm32(int rho) { const int n = rho >> 4, i = rho & 15; return 8 * (i >> 2) + 4 * n + (i & 3); }

struct Unit { int pm, pn; };
struct Gemm { const bf16_t* A; const bf16_t* Bt; int lda, ldb, K; };

struct GridOrder {
    int nM, nN, nwg, G, c; size_t astep, bstep;
    __device__ void init(int nM_, int nN_, int G_, int c_, int shift, int lda, int ldb) { nM = nM_; nN = nN_; nwg = nM * nN; G = G_; c = (c_ + G_ - (shift % G_)) % G_; astep = (size_t)BM * lda * 2; bstep = (size_t)BM * ldb * 2; }
    __device__ bool next(int i, Unit& u) const {
        const long L = (long)i * G + c; if (L >= nwg) return false;
        int wgid = (int)L; { const int q = nwg / NXCD, r = nwg % NXCD, xcd = wgid % NXCD, off = wgid / NXCD; wgid = (xcd < r ? xcd * (q + 1) : r * (q + 1) + (xcd - r) * q) + off; }
        const int nig = WGM * nN, gid = wgid / nig, fm = gid * WGM, gsz = (nM - fm) < WGM ? (nM - fm) : WGM;
        u.pm = fm + ((wgid % nig) % gsz); u.pn = (wgid % nig) / gsz; return true;
    }
    __device__ __forceinline__ size_t aoff(const Unit& u) const { return (size_t)u.pm * astep; }
    __device__ __forceinline__ size_t boff(const Unit& u) const { return (size_t)u.pn * bstep; }
};

__device__ __forceinline__ unsigned cvt_pk_bf16(float lo, float hi) { unsigned r; asm volatile("v_cvt_pk_bf16_f32 %0, %1, %2" : "=v"(r) : "v"(lo), "v"(hi)); return r; }

template <class Epi, class Sched, bool ALIGN_EPI = true, bool SP2 = true>
__device__ __forceinline__ void gemm_phase(PG8_LAS unsigned char* lds, const Gemm g, const Sched& S, const Epi& E) {
    const int tid = threadIdx.x, wid = __builtin_amdgcn_readfirstlane(tid >> 6), lane = tid & 63, wr = wid >> 2, wc = wid & 3, fr = lane & 15, fq = lane >> 4;
    const int K = g.K, nt = K / BK;
    unsigned voffA[2], voffB[2];
#pragma unroll
    for (int i = 0; i < 2; ++i) { int R, C; stage_rc(tid * 16 + i * 8192, R, C); const int Rb = (R & ~31) + perm32(R & 31);
        voffA[i] = (unsigned)(R * g.lda + C) * 2u; voffB[i] = (unsigned)(Rb * g.ldb + C) * 2u; }
    const size_t kstep = (size_t)(BK * 2);
    const size_t hstepA = (size_t)HALF * g.lda * 2, hstepB = (size_t)HALF * g.ldb * 2;
    const unsigned ldsw = (unsigned)wid * 1024u;
    const int aoff = lds_byte(wr * 64 + fr, fq * 8), boff = lds_byte(wc * 32 + fr, fq * 8);
#define PG8_SA(b, h) (((b) * 2 + (h)) * HTB)
#define PG8_SB(b, h) ((4 + (b) * 2 + (h)) * HTB)
#define PG8_STAGE(bufoff, gbase, voff) do { _Pragma("unroll") for (int _i = 0; _i < 2; ++_i) \
        __builtin_amdgcn_global_load_lds((const unsigned*)((const char*)(gbase) + (voff)[_i]), (PG8_LAS unsigned*)(lds + (bufoff) + ldsw + _i * 8192), 16, 0, 0); } while (0)
#define PG8_LDA(dst, b, h) do { _Pragma("unroll") for (int m = 0; m < 4; ++m) _Pragma("unroll") for (int k = 0; k < 2; ++k) dst[m][k] = *(const PG8_LAS bf16x8*)(lds + PG8_SA(b, h) + aoff + m * 2048 + k * 1024); } while (0)
#define PG8_LDB(dst, b, h) do { _Pragma("unroll") for (int n = 0; n < 2; ++n) _Pragma("unroll") for (int k = 0; k < 2; ++k) dst[n][k] = *(const PG8_LAS bf16x8*)(lds + PG8_SB(b, h) + boff + n * 2048 + k * 1024); } while (0)
#define PG8_MMA(ai, bj, At, Bt) do { __builtin_amdgcn_s_setprio(1); _Pragma("unroll") for (int m = 0; m < 4; ++m) _Pragma("unroll") for (int n = 0; n < 2; ++n) _Pragma("unroll") for (int k = 0; k < 2; ++k) \
        acc[ai][bj][m][n] = __builtin_amdgcn_mfma_f32_16x16x32_bf16(Bt[n][k], At[m][k], acc[ai][bj][m][n], 0, 0, 0); __builtin_amdgcn_s_setprio(0); } while (0)
#define PG8_WAIT_V(n) asm volatile("s_waitcnt vmcnt(" #n ")" ::: "memory")
#define PG8_WAIT_L(n) asm volatile("s_waitcnt lgkmcnt(" #n ")" ::: "memory")
#define PG8_BAR __builtin_amdgcn_s_barrier()
#define PG8_SCHED __builtin_amdgcn_sched_barrier(0)
    Unit cur, nxt; int ui = 0;
    if (!S.next(0, cur)) return;
    f32x4 acc[2][2][4][2];
#pragma unroll
    for (int a = 0; a < 2; ++a)
#pragma unroll
        for (int b = 0; b < 2; ++b)
#pragma unroll
            for (int m = 0; m < 4; ++m)
#pragma unroll
                for (int n = 0; n < 2; ++n) acc[a][b][m][n] = (f32x4){0.f, 0.f, 0.f, 0.f};
    bf16x8 At[4][2], B0[2][2], B1[2][2];
    const char* cA = (const char*)g.A + S.aoff(cur); const char* cB = (const char*)g.Bt + S.boff(cur);
    static_assert(SP2, "only the SP2 loop is kept in this file");
    PG8_STAGE(PG8_SB(0, 0), cB, voffB); PG8_STAGE(PG8_SB(0, 1), cB + hstepB, voffB); PG8_STAGE(PG8_SA(0, 0), cA, voffA); PG8_STAGE(PG8_SA(0, 1), cA + hstepA, voffA);
    if (wr == 1) PG8_BAR;
    PG8_WAIT_V(2); PG8_BAR;
    PG8_STAGE(PG8_SB(1, 0), cB + kstep, voffB); PG8_STAGE(PG8_SA(1, 0), cA + kstep, voffA); PG8_STAGE(PG8_SB(1, 1), cB + hstepB + kstep, voffB);
    PG8_WAIT_V(6); PG8_BAR;
    for (;;) {
        const bool has_next = S.next(ui + 1, nxt);
        const char* nA = has_next ? (const char*)g.A + S.aoff(nxt) : cA; const char* nB = has_next ? (const char*)g.Bt + S.boff(nxt) : cB;
        for (int t = 0; t < nt; t += 2) {
            const bool last = (t == nt - 2);
            const char* a1 = cA + (size_t)(t + 1) * kstep;
            const char* a2 = last ? nA : cA + (size_t)(t + 2) * kstep; const char* b2 = last ? nB : cB + (size_t)(t + 2) * kstep;
            const char* a3 = a2 + kstep; const char* b3 = b2 + kstep;
            PG8_LDB(B0, 0, 0); PG8_LDB(B1, 0, 1); PG8_SCHED; PG8_LDA(At, 0, 0); PG8_STAGE(PG8_SA(1, 1), a1 + hstepA, voffA);
            PG8_WAIT_V(8); PG8_WAIT_L(0); PG8_BAR; PG8_MMA(0, 0, At, B0); PG8_MMA(0, 1, At, B1); PG8_BAR; PG8_SCHED;
            PG8_LDA(At, 0, 1); PG8_STAGE(PG8_SB(0, 0), b2, voffB); PG8_STAGE(PG8_SB(0, 1), b2 + hstepB, voffB); PG8_STAGE(PG8_SA(0, 0), a2, voffA);
            PG8_WAIT_V(8); PG8_WAIT_L(0); PG8_BAR; PG8_MMA(1, 0, At, B0); PG8_MMA(1, 1, At, B1); PG8_BAR; PG8_SCHED;
            PG8_LDB(B0, 1, 0); PG8_LDB(B1, 1, 1); PG8_SCHED; PG8_LDA(At, 1, 0); PG8_STAGE(PG8_SA(0, 1), a2 + hstepA, voffA);
            PG8_WAIT_V(8); PG8_WAIT_L(0); PG8_BAR; PG8_MMA(0, 0, At, B0); PG8_MMA(0, 1, At, B1); PG8_BAR; PG8_SCHED;
            PG8_LDA(At, 1, 1); PG8_STAGE(PG8_SB(1, 0), b3, voffB); PG8_STAGE(PG8_SB(1, 1), b3 + hstepB, voffB); PG8_STAGE(PG8_SA(1, 0), a3, voffA);
            PG8_WAIT_V(8); PG8_WAIT_L(0); PG8_BAR; PG8_MMA(1, 0, At, B0); PG8_MMA(1, 1, At, B1); PG8_BAR; PG8_SCHED;
        }
        if constexpr (ALIGN_EPI) { if (wr == 0) PG8_BAR; }
        E(acc, cur, wr, wc, fr, fq);
        if (!has_next) break;
#pragma unroll
        for (int a = 0; a < 2; ++a)
#pragma unroll
            for (int b = 0; b < 2; ++b)
#pragma unroll
                for (int m = 0; m < 4; ++m)
#pragma unroll
                    for (int n = 0; n < 2; ++n) acc[a][b][m][n] = (f32x4){0.f, 0.f, 0.f, 0.f};
        cur = nxt; cA = nA; cB = nB; ++ui;
        if constexpr (ALIGN_EPI) { if (wr == 1) PG8_BAR; }
    }
    PG8_WAIT_V(0);
    if constexpr (!ALIGN_EPI) { if (wr == 0) PG8_BAR; }
    PG8_BAR;
#undef PG8_SA
#undef PG8_SB
#undef PG8_STAGE
#undef PG8_LDA
#undef PG8_LDB
#undef PG8_MMA
#undef PG8_WAIT_V
#undef PG8_WAIT_L
#undef PG8_BAR
#undef PG8_SCHED
}
}
constexpr int NWAVES = 8, NTHR = 512;
constexpr int D = 1024, NB = 4, T = 4096, MPR = NB * T, MS = 128, MALL = MPR + MS, MPAD = 16640;
constexpr int SBW = 512, NH = 8, HD = 64, NG = 32, GP = 16, NST = 64, INW = 2048, FF = 2816, NFF2 = 2 * FF;
constexpr int MT = 256, MH = 4, MHD = 256, PAST = 2048, PAGE = 128, NPG = 16;
constexpr int LC = 16, NCH = T / LC, XHP = 384;
constexpr float EPS = 1e-6f, LOG2E = 1.4426950408889634f;
constexpr float C2 = 0.125f * LOG2E;
constexpr float CM = 0.0625f * LOG2E;

constexpr size_t O_YP = 0, O_YS = O_YP + (size_t)MPR * D, O_KP = O_YS + (size_t)MS * D, O_VP = O_KP + (size_t)MPR * SBW, O_REP = O_VP + (size_t)MPR * SBW,
    O_IMP = O_REP + NB * NG * NST, O_CVP = O_IMP + NB * NG * NST, O_MKP = O_CVP + (size_t)NB * 2 * FF, O_MVP = O_MKP + (size_t)NB * MT * D, O_KS = O_MVP + (size_t)NB * MT * D,
    O_VS = O_KS + (size_t)MS * SBW, O_RES = O_VS + (size_t)MS * SBW, O_IMS = O_RES + (size_t)MS * NG * NST, O_CVS = O_IMS + (size_t)MS * NG * NST, O_END = O_CVS + (size_t)MS * 2 * FF;

constexpr size_t MiB = 1u << 20;
constexpr size_t al(size_t x) { return (x + 4095) & ~(size_t)4095; }
constexpr size_t WS_CTL = 0, CTL_ZERO_BYTES = 1 * MiB;
constexpr size_t WS_WIN = 1 * MiB;
constexpr size_t WS_WMKV = WS_WIN + al((size_t)INW * D * 2);
constexpr size_t WS_WGLU = WS_WMKV + al((size_t)2048 * D * 2);
constexpr size_t WS_WOUT = WS_WGLU + al((size_t)SBW * SBW * 2);
constexpr size_t WS_WMQ = WS_WOUT + al((size_t)D * D * 2);
constexpr size_t WS_WMO = WS_WMQ + al((size_t)D * D * 2);
constexpr size_t WS_WGU = WS_WMO + al((size_t)D * D * 2);
constexpr size_t WS_WDN = WS_WGU + al((size_t)NFF2 * D * 2);
constexpr size_t WS_W1 = WS_WDN + al((size_t)D * FF * 2);
constexpr size_t WS_BTC = WS_W1 + al((size_t)33 * 128 * 256 * 2);
constexpr size_t WS_XB = WS_BTC + al((size_t)NG * 256 * XHP * 2);
constexpr size_t WS_RSTD0 = WS_XB + al((size_t)MPAD * D * 2);
constexpr size_t WS_MB = WS_RSTD0 + al((size_t)MPAD * 4);
constexpr size_t WS_RSTDM = WS_MB + al((size_t)1024 * D * 2);
constexpr size_t WS_QB = WS_RSTDM + al(4096);
constexpr size_t WS_KB = WS_QB + al((size_t)MPAD * SBW * 2);
constexpr size_t WS_VB = WS_KB + al((size_t)MPAD * SBW * 2);
constexpr size_t WS_QS = WS_VB + al((size_t)MPAD * SBW * 2);
constexpr size_t WS_US = WS_QS + al((size_t)MS * SBW * 4);
constexpr size_t WS_XH = WS_US + al((size_t)MS * SBW * 4);
constexpr size_t WS_SST = WS_XH + al((size_t)1024 * NG * XHP * 2 + 65536);
constexpr size_t WS_YG = WS_SST + al((size_t)1024 * NG * 128 * 4);
constexpr size_t WS_OSB = WS_YG + al((size_t)MPAD * SBW * 2);
constexpr size_t WS_OSSM = WS_OSB + al((size_t)MPAD * SBW * 2);
constexpr size_t WS_SBPO = WS_OSSM + al((size_t)MPAD * SBW * 2);
constexpr size_t WS_SBPL = WS_SBPO + al((size_t)MS * NPG * NH * HD * 4);
constexpr size_t WS_MIX = WS_SBPL + al((size_t)MS * NPG * NH * 4);
constexpr size_t WS_X1 = WS_MIX + al((size_t)MPAD * D * 2);
constexpr size_t WS_X1B = WS_X1 + al((size_t)MPAD * D * 4);
constexpr size_t WS_MKB = WS_X1B + al((size_t)MPAD * D * 2);
constexpr size_t WS_MVB = WS_MKB + al((size_t)1024 * D * 2);
constexpr size_t WS_QM = WS_MVB + al((size_t)1024 * D * 2);
constexpr size_t WS_OMEM = WS_QM + al((size_t)MPAD * D * 2);
constexpr size_t WS_X2 = WS_OMEM + al((size_t)MPAD * D * 2);
constexpr size_t WS_X2B = WS_X2 + al((size_t)MPAD * D * 4);
constexpr size_t WS_GB = WS_X2B + al((size_t)MPAD * D * 2);
constexpr size_t WS_UB = WS_GB + al((size_t)MPAD * FF * 2);
constexpr size_t WS_FAST_END = WS_UB + al((size_t)MPAD * FF * 2);
constexpr int CW_TMO = 0, CW_CODE = 1, CW_QA = 2048, CW_QM = 2112, CW_BAR = 4096;
constexpr int CW_SSQ1 = 16384, CW_SSQ2 = CW_SSQ1 + MPAD, CW_SSQ3 = CW_SSQ2 + MPAD;
static_assert((CW_SSQ3 + MPAD) * 4 <= (int)CTL_ZERO_BYTES, "CTL words inside the memset region");

constexpr int RING_OFF = 0, RING_BYTES = 131072;
constexpr int LDSCTL_OFF = RING_BYTES, MISC_OFF = LDSCTL_OFF + 320;
constexpr int LDS_BYTES = 147456;
static_assert(MISC_OFF + 128 <= LDS_BYTES, "LDS map");

#define GAS __attribute__((address_space(1)))
#define LAS __attribute__((address_space(3)))
typedef unsigned short bf16;
typedef unsigned v4u __attribute__((ext_vector_type(4)));
typedef unsigned v2u __attribute__((ext_vector_type(2)));
typedef float f32x4 __attribute__((ext_vector_type(4)));
typedef float f32x2 __attribute__((ext_vector_type(2)));
typedef float f32x16 __attribute__((ext_vector_type(16)));
typedef short bf16x8 __attribute__((ext_vector_type(8)));
typedef short s16x4 __attribute__((ext_vector_type(4)));
typedef GAS unsigned gu32;
#define RLX_AGENT __ATOMIC_RELAXED, __HIP_MEMORY_SCOPE_AGENT
#define LDS_WAIT() asm volatile("s_waitcnt lgkmcnt(0)" ::: "memory")
#define VM_WAIT() asm volatile("s_waitcnt vmcnt(0)" ::: "memory")
__device__ __forceinline__ unsigned f2bf(float f) { unsigned u = __builtin_bit_cast(unsigned, f); return (u + 0x7fffu + ((u >> 16) & 1u)) >> 16; }
__device__ __forceinline__ unsigned pk2(float lo, float hi) { return f2bf(lo) | (f2bf(hi) << 16); }
__device__ __forceinline__ float bf2f(unsigned short h) { return __builtin_bit_cast(float, (unsigned)h << 16); }
__device__ __forceinline__ float bflo(unsigned w) { return __builtin_bit_cast(float, w << 16); }
__device__ __forceinline__ float bfhi(unsigned w) { return __builtin_bit_cast(float, w & 0xffff0000u); }
__device__ __forceinline__ unsigned cvtpk(float lo, float hi) { return pg8::cvt_pk_bf16(lo, hi); }
__device__ __forceinline__ float gelu_tanh_f(float x) {
    const float u2 = 2.f * 0.7978845608028654f * (x + 0.044715f * x * x * x);
    return x * __builtin_amdgcn_rcpf(1.f + __builtin_amdgcn_exp2f(-u2 * LOG2E));
}
__device__ __forceinline__ float wave_sum(float v) {
#pragma unroll
    for (int o = 1; o < 64; o <<= 1) v += __shfl_xor(v, o);
    return v;
}

#define XB_TMO      128
#define XB_XCNT(j)  (256  + 64 * (j))
#define XB_XSUB(j)  (1280 + 64 * (j))
#define XB_XGEN(j)  (2304 + 64 * (j))
#define XB_TOP      3328
#define XB_TOPGEN   3392
#define XCD_BAR_WORDS 3456
#define XB_SPIN_CAP (1u << 18)
__device__ __forceinline__ unsigned xb_ld(unsigned* p)              { return __hip_atomic_load(p, __ATOMIC_RELAXED, __HIP_MEMORY_SCOPE_AGENT); }
__device__ __forceinline__ unsigned xb_add(unsigned* p, unsigned v) { return __hip_atomic_fetch_add(p, v, __ATOMIC_RELAXED, __HIP_MEMORY_SCOPE_AGENT); }
__device__ __forceinline__ unsigned xb_xcc_id() { return (unsigned)__builtin_amdgcn_s_getreg((3 << 11) | 20) & 0xFu; }
#define XB_SPIN(cond, bar) do { unsigned _sp = 0; while (cond) { __builtin_amdgcn_s_sleep(1); \
    if ((++_sp & 255u) == 0u) { if (xb_ld(&(bar)[XB_TMO])) break; if (_sp > XB_SPIN_CAP) { atomicAdd(&(bar)[XB_TMO], 1u); break; } } } } while (0)
struct XcdBarrier { unsigned* bar; unsigned x; volatile LAS unsigned* st; };
__device__ __forceinline__ XcdBarrier xcd_barrier_post(unsigned* bar, volatile LAS unsigned* st) {
    XcdBarrier b; b.bar = bar; b.x = xb_xcc_id(); b.st = st;
    if (threadIdx.x == 0) (void)xb_add(&bar[XB_XCNT(b.x)], 1u);
    return b;
}
__device__ __forceinline__ void xcd_barrier_complete(unsigned* bar, unsigned x, unsigned& nloc, unsigned& nx) {
    const unsigned G = gridDim.x * gridDim.y * gridDim.z;
    unsigned sum, cnt, mine, sp = 0u;
    for (;;) {
        sum = 0u; cnt = 0u; mine = 0u;
#pragma unroll
        for (unsigned j = 0; j < 16; ++j) { const unsigned c = xb_ld(&bar[XB_XCNT(j)]); sum += c; cnt += (c > 0u) ? 1u : 0u; mine = (j == x) ? c : mine; }
        if (sum == G) break;
        __builtin_amdgcn_s_sleep(1);
        if ((++sp & 255u) == 0u) { if (xb_ld(&bar[XB_TMO])) break; if (sp > XB_SPIN_CAP) { atomicAdd(&bar[XB_TMO], 1u); break; } }
    }
    nloc = mine > 0u ? mine : 1u; nx = cnt > 0u ? cnt : 1u;
}
__device__ __forceinline__ void xcd_barrier(const XcdBarrier& b) {
    asm volatile("s_waitcnt vmcnt(0)" ::: "memory");
    __syncthreads();
    if (threadIdx.x == 0) {
        unsigned* bar = b.bar;
        __builtin_amdgcn_s_waitcnt(0);
        unsigned nloc = b.st[0], nx = b.st[1];
        if (nloc == 0u) { xcd_barrier_complete(bar, b.x, nloc, nx); b.st[0] = nloc; b.st[1] = nx; }
        const unsigned old = xb_add(&bar[XB_XSUB(b.x)], 1u);
        const unsigned gen = old / nloc;
        if (old + 1u == (gen + 1u) * nloc) {
            __builtin_amdgcn_fence(__ATOMIC_RELEASE, "agent");
            asm volatile("s_waitcnt vmcnt(0)" ::: "memory");
            const unsigned og = xb_add(&bar[XB_TOP], 1u);
            const unsigned tg = og / nx;
            if (og + 1u == (tg + 1u) * nx) xb_add(&bar[XB_TOPGEN], 1u);
            else XB_SPIN(xb_ld(&bar[XB_TOPGEN]) == tg, bar);
            __builtin_amdgcn_fence(__ATOMIC_ACQUIRE, "agent");
            xb_add(&bar[XB_XGEN(b.x)], 1u);
            asm volatile("s_waitcnt vmcnt(0)" ::: "memory");
        } else {
            XB_SPIN(xb_ld(&bar[XB_XGEN(b.x)]) == gen, bar);
            __builtin_amdgcn_fence(__ATOMIC_ACQUIRE, "agent");
            asm volatile("s_waitcnt vmcnt(0)" ::: "memory");
        }
    }
    __syncthreads();
}

struct Args { const void* in[40]; float* out; unsigned char* ws; int ph_lo, ph_hi, use_bar, pad; };
struct Frame {
    LAS unsigned char* lds; volatile LAS unsigned* MISC; unsigned* ctl;
    int tid, lane, wave, vcu, G;
    unsigned char* ws; float* out; const void* const* in;
};
#define INF(i) ((const float*)F.in[i])
#define WSP(T_, off) ((T_*)(F.ws + (off)))
__device__ __forceinline__ void p0_transpose_item(const float* W, int K, int N, bf16* WT, int row_off, const float* gain, LAS float* scr, int item, int lane) {
    const int nblk = N / 32, kb = item / nblk, nb = item % nblk, k0 = 64 * kb, n0 = 32 * nb;
#pragma unroll 8
    for (int i = 0; i < 32; ++i) { const int kk = 2 * i + (lane >> 5); const float gv = gain ? gain[k0 + kk] : 1.f; scr[kk * 33 + (lane & 31)] = W[(size_t)(k0 + kk) * N + n0 + (lane & 31)] * gv; }
    LDS_WAIT(); asm volatile("" ::: "memory");
    const int c = lane & 7;
#pragma unroll
    for (int j = 0; j < 4; ++j) { const int n = (lane >> 3) + 8 * j; const LAS float* s = scr + (8 * c) * 33 + n;
        v4u o; o.x = pk2(s[0 * 33], s[1 * 33]); o.y = pk2(s[2 * 33], s[3 * 33]); o.z = pk2(s[4 * 33], s[5 * 33]); o.w = pk2(s[6 * 33], s[7 * 33]);
        *(GAS v4u*)(WT + (size_t)(row_off + n0 + n) * K + k0 + 8 * c) = o; }
    LDS_WAIT(); asm volatile("" ::: "memory");
}
__device__ __forceinline__ void row_to_bf16_rstd(const float* xrow, bf16* orow, float* rstd, int lane) {
    const GAS f32x4* xr = (const GAS f32x4*)xrow + lane;
    f32x4 v[4]; float s = 0.f;
#pragma unroll
    for (int j = 0; j < 4; ++j) { v[j] = xr[64 * j]; s += (v[j].x * v[j].x + v[j].y * v[j].y) + (v[j].z * v[j].z + v[j].w * v[j].w); }
    s = wave_sum(s);
    GAS v2u* o8 = (GAS v2u*)orow + lane;
#pragma unroll
    for (int j = 0; j < 4; ++j) { v2u w; w.x = pk2(v[j].x, v[j].y); w.y = pk2(v[j].z, v[j].w); o8[64 * j] = w; }
    if (lane == 0) *rstd = 1.f / sqrtf(s * (1.f / D) + EPS);
}
__device__ __forceinline__ void lam_pow(float lr, float li, float logdt, int tau, float& pr, float& pi) {
    const double dt = exp((double)logdt);
    const double ang = (double)li * dt * (double)tau;
    const double k = rint(ang * 0.15915494309189535);
    double r = fma(-k, 6.283185307179586, ang); r = fma(-k, 2.4492935982947064e-16, r);
    const float rf = (float)r, mag = (float)exp((double)lr * dt * (double)tau);
    pr = mag * cosf(rf); pi = mag * sinf(rf);
}
__device__ __forceinline__ void lam_coef(float lr, float li, float logdt, float& cr, float& ci) {
    const double dt = exp((double)logdt);
    const double ang = (double)li * dt;
    const double k = rint(ang * 0.15915494309189535);
    double r = fma(-k, 6.283185307179586, ang); r = fma(-k, 2.4492935982947064e-16, r);
    const float th = (float)r, a = (float)((double)lr * dt);
    const float sh = sinf(0.5f * th);
    const float nr = expm1f(a) * cosf(th) - 2.f * sh * sh, ni = expf(a) * sinf(th);
    const float den = lr * lr + li * li;
    cr = (nr * lr + ni * li) / den; ci = (ni * lr - nr * li) / den;
}
__device__ __forceinline__ void ssm_table_unit(Frame& F, int g, int tau) {
    LAS float* Mr = (LAS float*)(F.lds + RING_OFF); LAS float* Mi = Mr + 1024; LAS float* Pr = Mi + 1024; LAS float* Pi = Pr + 64; LAS float* Kt = Pi + 64;
    const float* lam_re = INF(14); const float* lam_im = INF(15); const float* log_dt = INF(16); const float* b_re = INF(17); const float* b_im = INF(18);
    const float* c_re = INF(19); const float* c_im = INF(20); const float* d_skip = INF(21);
    bf16* W1 = WSP(bf16, WS_W1); bf16* BTC = WSP(bf16, WS_BTC);
    const int tid = F.tid; const float ldt = log_dt[g];
    __syncthreads();
    if (tid < 64) { float pr, pi; lam_pow(lam_re[g * NST + tid], lam_im[g * NST + tid], ldt, tau, pr, pi); Pr[tid] = pr; Pi[tid] = pi; }
    __syncthreads();
    for (int i = tid; i < 1024; i += NTHR) { const int n = i >> 4, q = i & 15; float cr, ci; lam_coef(lam_re[g * NST + n], lam_im[g * NST + n], ldt, cr, ci);
        const float br = b_re[(g * NST + n) * GP + q], bi = b_im[(g * NST + n) * GP + q]; const float bbr = cr * br - ci * bi, bbi = cr * bi + ci * br;
        const float pr = Pr[n], pi = Pi[n]; Mr[i] = pr * bbr - pi * bbi; Mi[i] = pr * bbi + pi * bbr; }
    __syncthreads();
    if (tau <= 15) {
        const int s = 15 - tau;
        for (int i = tid; i < 2048; i += NTHR) { const int n = i >> 5, ri = (i >> 4) & 1, q = i & 15; const float v = ri ? Mi[n * 16 + q] : Mr[n * 16 + q];
            W1[((size_t)g * 128 + 2 * n + ri) * 256 + s * 16 + q] = (bf16)f2bf(v); }
        if (tid < 256) { const int p = tid >> 4, q = tid & 15; float acc = 0.f;
            for (int n = 0; n < NST; ++n) acc += c_re[(g * GP + p) * NST + n] * Mr[n * 16 + q] - c_im[(g * GP + p) * NST + n] * Mi[n * 16 + q];
            if (tau == 0 && p == q) acc += d_skip[g * GP + p];
            Kt[tid] = acc; }
        __syncthreads();
        for (int idx = tid; idx < (16 - tau) * 256; idx += NTHR) { const int blk = idx >> 8, e = idx & 255, p = e >> 4, q = e & 15; const int s2 = blk, t2 = s2 + tau;
            BTC[((size_t)g * 256 + t2 * 16 + p) * XHP + s2 * 16 + q] = (bf16)f2bf(Kt[e]);
            if (tau >= 1) BTC[((size_t)g * 256 + s2 * 16 + p) * XHP + t2 * 16 + q] = (bf16)0; }
    }
    if (tau >= 1) {
        const int t2 = tau - 1;
        for (int idx = tid; idx < 1024; idx += NTHR) { const int p = idx >> 6, n = idx & 63; const float cr = c_re[(g * GP + p) * NST + n], ci = c_im[(g * GP + p) * NST + n], pr = Pr[n], pi = Pi[n];
            v2u dummy; (void)dummy;
            const unsigned w = pk2(cr * pr - ci * pi, -(cr * pi + ci * pr));
            *(GAS unsigned*)(BTC + ((size_t)g * 256 + t2 * 16 + p) * XHP + 256 + 2 * n) = w; }
    }
    __syncthreads();
}
__device__ __forceinline__ void p0_prologue(Frame& F) {
    LAS float* scr = (LAS float*)(F.lds + RING_OFF + F.wave * 16384);
    const int gw = F.vcu * NWAVES + F.wave, NGW = F.G * NWAVES;
    constexpr int I_IN = 16 * 64, I_MK = 16 * 32, I_GLU = 8 * 16, I_SQ = 16 * 32, I_G = 16 * 88, I_DN = 44 * 32;
    constexpr int NITEMS = I_IN + 2 * I_MK + I_GLU + 3 * I_SQ + 2 * I_G + I_DN;
    for (int it = gw; it < NITEMS; it += NGW) {
        int r = it;
        if (r < I_IN) { p0_transpose_item(INF(12), D, INW, WSP(bf16, WS_WIN), 0, INF(11), scr, r, F.lane); continue; } r -= I_IN;
        if (r < I_MK) { p0_transpose_item(INF(30), D, D, WSP(bf16, WS_WMKV), 0, INF(28), scr, r, F.lane); continue; } r -= I_MK;
        if (r < I_MK) { p0_transpose_item(INF(31), D, D, WSP(bf16, WS_WMKV), D, INF(28), scr, r, F.lane); continue; } r -= I_MK;
        if (r < I_GLU) { p0_transpose_item(INF(22), SBW, SBW, WSP(bf16, WS_WGLU), 0, nullptr, scr, r, F.lane); continue; } r -= I_GLU;
        if (r < I_SQ) { const int kb = r / (D / 32); const float* gn = (kb < 8) ? INF(24) : INF(25) - SBW; p0_transpose_item(INF(26), D, D, WSP(bf16, WS_WOUT), 0, gn, scr, r, F.lane); continue; } r -= I_SQ;
        if (r < I_SQ) { p0_transpose_item(INF(29), D, D, WSP(bf16, WS_WMQ), 0, INF(27), scr, r, F.lane); continue; } r -= I_SQ;
        if (r < I_SQ) { p0_transpose_item(INF(32), D, D, WSP(bf16, WS_WMO), 0, nullptr, scr, r, F.lane); continue; } r -= I_SQ;
        if (r < I_G) { p0_transpose_item(INF(34), D, FF, WSP(bf16, WS_WGU), 0, INF(33), scr, r, F.lane); continue; } r -= I_G;
        if (r < I_G) { p0_transpose_item(INF(35), D, FF, WSP(bf16, WS_WGU), FF, INF(33), scr, r, F.lane); continue; } r -= I_G;
        p0_transpose_item(INF(38), FF, D, WSP(bf16, WS_WDN), 0, nullptr, scr, r, F.lane);
    }
    for (int m = gw; m < MALL; m += NGW) { const float* xr = (m < MPR) ? INF(0) + (size_t)m * D : INF(1) + (size_t)(m - MPR) * D;
        row_to_bf16_rstd(xr, WSP(bf16, WS_XB) + (size_t)m * D, WSP(float, WS_RSTD0) + m, F.lane); }
    for (int m = gw; m < NB * MT; m += NGW) row_to_bf16_rstd(INF(10) + (size_t)m * D, WSP(bf16, WS_MB) + (size_t)m * D, WSP(float, WS_RSTDM) + m, F.lane);
    for (int u = F.vcu; u < NG * 17; u += F.G) ssm_table_unit(F, u / 17, u % 17);
    { bf16* W1 = WSP(bf16, WS_W1); for (int i = gw * 64 + F.lane; i < 128 * 256 / 8; i += NGW * 64) *(GAS v4u*)(W1 + (size_t)32 * 128 * 256 + (size_t)i * 8) = (v4u){0u, 0u, 0u, 0u}; }
}

#define EPI_LOOP_BEGIN \
    _Pragma("unroll") for (int ai = 0; ai < 2; ++ai) _Pragma("unroll") for (int m = 0; m < 4; ++m) { const int row = u.pm * 256 + ai * 128 + wr * 64 + m * 16 + fr; \
    _Pragma("unroll") for (int bj = 0; bj < 2; ++bj) { const int col = u.pn * 256 + bj * 128 + wc * 32 + 8 * fq; f32x4 v0 = acc[ai][bj][m][0], v1 = acc[ai][bj][m][1];
#define EPI_LOOP_END } }
__device__ __forceinline__ v4u pack8(f32x4 a, f32x4 b) { v4u w; w.x = cvtpk(a[0], a[1]); w.y = cvtpk(a[2], a[3]); w.z = cvtpk(b[0], b[1]); w.w = cvtpk(b[2], b[3]); return w; }

struct EpiInProj {
    const float* rstd; bf16 *QBp, *KBp, *VBp, *XHp; float *QSp, *USp, *out;
    __device__ __forceinline__ void operator()(const f32x4 (&acc)[2][2][4][2], const pg8::Unit& u, int wr, int wc, int fr_, int fq_) const { int fr = fr_, fq = fq_; asm volatile("" : "+v"(fr), "+v"(fq));
        const int sect = u.pn >> 1;
        EPI_LOOP_BEGIN
            if (row < MALL) {
                const float rs = rstd[row]; v0 = v0 * rs; v1 = v1 * rs;
                const int c = col - sect * SBW;
                if (sect == 0) { v0 = v0 * C2; v1 = v1 * C2; *(v4u*)(QBp + (size_t)row * SBW + c) = pack8(v0, v1);
                    if (row >= MPR) { float* q = QSp + (size_t)(row - MPR) * SBW + c; *(f32x4*)q = v0; *(f32x4*)(q + 4) = v1; } }
                else if (sect == 1 || sect == 2) { bf16* B = (sect == 1) ? KBp : VBp; *(v4u*)(B + (size_t)row * SBW + c) = pack8(v0, v1);
                    float* o = (row < MPR) ? out + (sect == 1 ? O_KP : O_VP) + (size_t)row * SBW + c : out + (sect == 1 ? O_KS : O_VS) + (size_t)(row - MPR) * SBW + c;
                    *(f32x4*)o = v0; *(f32x4*)(o + 4) = v1; }
                else { if (row < MPR) { const int b = row >> 12, t = row & 4095, ch = t >> 4, s = t & 15, g = c >> 4, q0 = c & 15;
                        *(v4u*)(XHp + ((size_t)(b * NCH + ch) * NG + g) * XHP + s * 16 + q0) = pack8(v0, v1); }
                    else { float* q = USp + (size_t)(row - MPR) * SBW + c; *(f32x4*)q = v0; *(f32x4*)(q + 4) = v1; } }
            }
        EPI_LOOP_END
    }
};
struct EpiMemKV {
    const float* rstd; bf16 *MKBp, *MVBp; float* out;
    __device__ __forceinline__ void operator()(const f32x4 (&acc)[2][2][4][2], const pg8::Unit& u, int wr, int wc, int fr_, int fq_) const { int fr = fr_, fq = fq_; asm volatile("" : "+v"(fr), "+v"(fq));
        const int sect = u.pn >> 2;
        EPI_LOOP_BEGIN
            const float rs = rstd[row]; v0 = v0 * rs; v1 = v1 * rs; const int c = col - sect * D;
            bf16* B = sect ? MVBp : MKBp; *(v4u*)(B + (size_t)row * D + c) = pack8(v0, v1);
            float* o = out + (sect ? O_MVP : O_MKP) + (size_t)row * D + c; *(f32x4*)o = v0; *(f32x4*)(o + 4) = v1;
        EPI_LOOP_END
    }
};
struct EpiSsmA {
    float* SST;
    __device__ __forceinline__ void operator()(const f32x4 (&acc)[2][2][4][2], const pg8::Unit& u, int wr, int wc, int fr_, int fq_) const { int fr = fr_, fq = fq_; asm volatile("" : "+v"(fr), "+v"(fq));
        _Pragma("unroll") for (int ai = 0; ai < 2; ++ai) _Pragma("unroll") for (int m = 0; m < 4; ++m) { const int row = u.pm * 256 + ai * 128 + wr * 64 + m * 16 + fr;
            const int col = wc * 32 + 8 * fq; float* o = SST + ((size_t)row * NG + u.pn) * 128 + col; *(f32x4*)o = acc[ai][0][m][0]; *(f32x4*)(o + 4) = acc[ai][0][m][1]; }
    }
};
struct EpiSsmC {
    bf16* YG;
    __device__ __forceinline__ void operator()(const f32x4 (&acc)[2][2][4][2], const pg8::Unit& u, int wr, int wc, int fr_, int fq_) const { int fr = fr_, fq = fq_; asm volatile("" : "+v"(fr), "+v"(fq));
        _Pragma("unroll") for (int ai = 0; ai < 2; ++ai) _Pragma("unroll") for (int m = 0; m < 4; ++m) { const int ch = ai * 128 + wr * 64 + m * 16 + fr;
            _Pragma("unroll") for (int bj = 0; bj < 2; ++bj) { const int col = bj * 128 + wc * 32 + 8 * fq, t = col >> 4, p0 = col & 15; f32x4 v0 = acc[ai][bj][m][0], v1 = acc[ai][bj][m][1];
                _Pragma("unroll") for (int e = 0; e < 4; ++e) { v0[e] = gelu_tanh_f(v0[e]); v1[e] = gelu_tanh_f(v1[e]); }
                *(v4u*)(YG + ((size_t)u.pm * T + ch * LC + t) * SBW + u.pn * GP + p0) = pack8(v0, v1); } }
    }
};
struct EpiGlu {
    const bf16* YG; const float* bglu; bf16* OSSM;
    __device__ __forceinline__ void operator()(const f32x4 (&acc)[2][2][4][2], const pg8::Unit& u, int wr, int wc, int fr_, int fq_) const { int fr = fr_, fq = fq_; asm volatile("" : "+v"(fr), "+v"(fq));
        EPI_LOOP_BEGIN
            if (row < MALL) {
                const v4u yw = *(const v4u*)(YG + (size_t)row * SBW + col); const f32x4 b0 = *(const f32x4*)(bglu + col), b1 = *(const f32x4*)(bglu + col + 4);
                const float y[8] = {bflo(yw.x), bfhi(yw.x), bflo(yw.y), bfhi(yw.y), bflo(yw.z), bfhi(yw.z), bflo(yw.w), bfhi(yw.w)};
                _Pragma("unroll") for (int e = 0; e < 4; ++e) { v0[e] = y[e] * __builtin_amdgcn_rcpf(1.f + __builtin_amdgcn_exp2f(-(v0[e] + b0[e]) * LOG2E));
                                                                 v1[e] = y[4 + e] * __builtin_amdgcn_rcpf(1.f + __builtin_amdgcn_exp2f(-(v1[e] + b1[e]) * LOG2E)); }
                *(v4u*)(OSSM + (size_t)row * SBW + col) = pack8(v0, v1);
            }
        EPI_LOOP_END
    }
};
struct EpiResid {
    const float* base0; const float* base1; float* xo; bf16* xb; float* ssq;
    __device__ __forceinline__ void operator()(const f32x4 (&acc)[2][2][4][2], const pg8::Unit& u, int wr, int wc, int fr_, int fq_) const { int fr = fr_, fq = fq_; asm volatile("" : "+v"(fr), "+v"(fq));
        _Pragma("unroll") for (int ai = 0; ai < 2; ++ai) _Pragma("unroll") for (int m = 0; m < 4; ++m) { const int row = u.pm * 256 + ai * 128 + wr * 64 + m * 16 + fr; float sq = 0.f;
            const bool ok = row < MALL; const float* bp = (row < MPR) ? base0 + (size_t)row * D : base1 + (size_t)(row - MPR) * D;
            _Pragma("unroll") for (int bj = 0; bj < 2; ++bj) { const int col = u.pn * 256 + bj * 128 + wc * 32 + 8 * fq; f32x4 v0 = acc[ai][bj][m][0], v1 = acc[ai][bj][m][1];
                if (ok) { v0 = v0 + *(const f32x4*)(bp + col); v1 = v1 + *(const f32x4*)(bp + col + 4);
                    float* o = xo + (size_t)row * D + col; *(f32x4*)o = v0; *(f32x4*)(o + 4) = v1;
                    if (xb) *(v4u*)(xb + (size_t)row * D + col) = pack8(v0, v1);
                    sq += (v0[0] * v0[0] + v0[1] * v0[1]) + (v0[2] * v0[2] + v0[3] * v0[3]) + (v1[0] * v1[0] + v1[1] * v1[1]) + (v1[2] * v1[2] + v1[3] * v1[3]); } }
            sq += __shfl_xor(sq, 16); sq += __shfl_xor(sq, 32);
            if (ok && fq == 0) atomicAdd(ssq + row, sq); }
    }
};
struct EpiScaleBf16 {
    const float* ssq; float scale; bf16* O;
    __device__ __forceinline__ void operator()(const f32x4 (&acc)[2][2][4][2], const pg8::Unit& u, int wr, int wc, int fr_, int fq_) const { int fr = fr_, fq = fq_; asm volatile("" : "+v"(fr), "+v"(fq));
        EPI_LOOP_BEGIN
            if (row < MALL) { const float rs = scale / sqrtf(ssq[row] * (1.f / D) + EPS); v0 = v0 * rs; v1 = v1 * rs; *(v4u*)(O + (size_t)row * D + col) = pack8(v0, v1); }
        EPI_LOOP_END
    }
};
struct EpiGateUp {
    const float* ssq; bf16 *GBp, *UBp; float* out;
    __device__ __forceinline__ void operator()(const f32x4 (&acc)[2][2][4][2], const pg8::Unit& u, int wr, int wc, int fr_, int fq_) const { int fr = fr_, fq = fq_; asm volatile("" : "+v"(fr), "+v"(fq));
        const bool up = u.pn >= 11;
        EPI_LOOP_BEGIN
            if (row < MALL) { const float rs = 1.f / sqrtf(ssq[row] * (1.f / D) + EPS); v0 = v0 * rs; v1 = v1 * rs;
                if (up) *(v4u*)(UBp + (size_t)row * FF + (col - FF)) = pack8(v0, v1);
                else { *(v4u*)(GBp + (size_t)row * FF + col) = pack8(v0, v1);
                    if (row >= MPR) { float* o = out + O_CVS + ((size_t)(row - MPR) * 2 + 1) * FF + col; *(f32x4*)o = v0; *(f32x4*)(o + 4) = v1; }
                    else { const int t = row & 4095; if (t >= T - 2) { float* o = out + O_CVP + ((size_t)(row >> 12) * 2 + (t - (T - 2))) * FF + col; *(f32x4*)o = v0; *(f32x4*)(o + 4) = v1; } } } }
        EPI_LOOP_END
    }
};
struct SsmOrder {
    int G, c; size_t bstride;
    __device__ bool next(int i, pg8::Unit& u) const { const int L = i * G + c; if (L >= NG * NB) return false; u.pn = L >> 2; u.pm = L & 3; return true; }
    __device__ __forceinline__ size_t aoff(const pg8::Unit& u) const { return ((size_t)u.pm * NCH * NG * XHP + (size_t)u.pn * XHP) * 2; }
    __device__ __forceinline__ size_t boff(const pg8::Unit& u) const { return (size_t)u.pn * bstride; }
};
template <class Epi>
__device__ __forceinline__ void skinny_gemm(Frame& F, const bf16* A, int lda, const bf16* Bt, int ldb, int N, int K, const Epi& E, int u0, int ustride) {
    const int lane = F.lane, wid = F.wave; const int kw = K >> 3, nks = kw >> 5;
    LAS float* red = (LAS float*)(F.lds + RING_OFF);
    for (int u = u0; u < (N >> 5); u += ustride) {
        f32x4 acc[2][8];
#pragma unroll
        for (int nb = 0; nb < 2; ++nb)
#pragma unroll
            for (int mb = 0; mb < 8; ++mb) acc[nb][mb] = (f32x4){0.f, 0.f, 0.f, 0.f};
        const bf16* wp = Bt + (size_t)(u * 32 + (lane & 15)) * ldb + wid * kw + 8 * (lane >> 4);
        const bf16* ap = A + (size_t)(lane & 15) * lda + wid * kw + 8 * (lane >> 4);
        for (int ks = 0; ks < nks; ++ks) {
            bf16x8 wf[2], af[8];
            wf[0] = *(const bf16x8*)(wp + ks * 32); wf[1] = *(const bf16x8*)(wp + (size_t)16 * ldb + ks * 32);
#pragma unroll
            for (int mb = 0; mb < 8; ++mb) af[mb] = *(const bf16x8*)(ap + (size_t)mb * 16 * lda + ks * 32);
#pragma unroll
            for (int nb = 0; nb < 2; ++nb)
#pragma unroll
                for (int mb = 0; mb < 8; ++mb) acc[nb][mb] = __builtin_amdgcn_mfma_f32_16x16x32_bf16(wf[nb], af[mb], acc[nb][mb], 0, 0, 0);
        }
        __syncthreads();
#pragma unroll
        for (int nb = 0; nb < 2; ++nb)
#pragma unroll
            for (int mb = 0; mb < 8; ++mb) *(LAS f32x4*)(red + ((wid * 16 + nb * 8 + mb) * 64 + lane) * 4) = acc[nb][mb];
        __syncthreads();
#pragma unroll
        for (int j = 0; j < 2; ++j) { const int idx = F.tid + NTHR * j, blk = idx >> 6, l = idx & 63;
            f32x4 s = {0.f, 0.f, 0.f, 0.f};
#pragma unroll
            for (int w = 0; w < 8; ++w) s = s + *(const LAS f32x4*)(red + ((w * 16 + blk) * 64 + l) * 4);
            E(16 * (blk & 7) + (l & 15), u * 32 + 16 * (blk >> 3) + 4 * (l >> 4), s); }
    }
    __syncthreads();
}
__device__ __forceinline__ v2u pack4(f32x4 a) { v2u w; w.x = cvtpk(a[0], a[1]); w.y = cvtpk(a[2], a[3]); return w; }
struct SkInProj {
    const float* rstd; bf16* QBp; float *QSp, *USp, *out;
    __device__ __forceinline__ void operator()(int m, int n, f32x4 v) const {
        v = v * rstd[MPR + m]; const int sect = n >> 9, c = n & 511;
        if (sect == 0) { v = v * C2; *(f32x4*)(QSp + (size_t)m * SBW + c) = v; }
        else if (sect == 1) *(f32x4*)(out + O_KS + (size_t)m * SBW + c) = v;
        else if (sect == 2) *(f32x4*)(out + O_VS + (size_t)m * SBW + c) = v;
        else *(f32x4*)(USp + (size_t)m * SBW + c) = v;
    }
};
struct SkGlu {
    const bf16* YG; const float* bglu; bf16* OSSM;
    __device__ __forceinline__ void operator()(int m, int n, f32x4 v) const {
        const size_t o = (size_t)(MPR + m) * SBW + n; const v2u yw = *(const v2u*)(YG + o); const f32x4 b = *(const f32x4*)(bglu + n);
        const float y[4] = {bflo(yw.x), bfhi(yw.x), bflo(yw.y), bfhi(yw.y)};
#pragma unroll
        for (int e = 0; e < 4; ++e) v[e] = y[e] * __builtin_amdgcn_rcpf(1.f + __builtin_amdgcn_exp2f(-(v[e] + b[e]) * LOG2E));
        *(v2u*)(OSSM + o) = pack4(v);
    }
};
struct SkResid {
    const float* base; float* xo; bf16* xb; float* ssq;
    __device__ __forceinline__ void operator()(int m, int n, f32x4 v) const {
        v = v + *(const f32x4*)(base + (size_t)m * D + n); const size_t o = (size_t)(MPR + m) * D + n;
        *(f32x4*)(xo + o) = v; if (xb) *(v2u*)(xb + o) = pack4(v);
        atomicAdd(ssq + MPR + m, (v[0] * v[0] + v[1] * v[1]) + (v[2] * v[2] + v[3] * v[3]));
    }
};
struct SkScale {
    const float* ssq; float scale; bf16* O;
    __device__ __forceinline__ void operator()(int m, int n, f32x4 v) const {
        const float rs = scale / sqrtf(ssq[MPR + m] * (1.f / D) + EPS); v = v * rs; *(v2u*)(O + (size_t)(MPR + m) * D + n) = pack4(v);
    }
};
struct SkGateUp {
    const float* ssq; bf16 *GBp, *UBp; float* out;
    __device__ __forceinline__ void operator()(int m, int n, f32x4 v) const {
        const float rs = 1.f / sqrtf(ssq[MPR + m] * (1.f / D) + EPS); v = v * rs;
        if (n >= FF) *(v2u*)(UBp + (size_t)(MPR + m) * FF + (n - FF)) = pack4(v);
        else { *(v2u*)(GBp + (size_t)(MPR + m) * FF + n) = pack4(v); *(f32x4*)(out + O_CVS + ((size_t)m * 2 + 1) * FF + n) = v; }
    }
};
__device__ __forceinline__ int crow(int r, int hi) { return (r & 3) + 8 * (r >> 2) + 4 * hi; }
__device__ __forceinline__ void glds16(const void* gsrc, unsigned lds_dst) { unsigned keep;
    asm volatile("s_mov_b32 %0, m0\n\ts_mov_b32 m0, %2\n\ts_nop 0\n\tglobal_load_lds_dwordx4 %1, off\n\ts_mov_b32 m0, %0" : "=&s"(keep) : "v"(gsrc), "s"(lds_dst) : "memory"); }
#define WAIT_BAR(N) asm volatile("s_waitcnt vmcnt(" #N ") lgkmcnt(0)\n\ts_barrier" ::: "memory")
typedef LAS const char* lds_cptr;
typedef short v4i16_t __attribute__((ext_vector_type(4)));
__device__ __forceinline__ s16x4 vtr(lds_cptr p) { return __builtin_bit_cast(s16x4, __builtin_amdgcn_ds_read_tr16_b64_v4i16((LAS v4i16_t*)p)); }
__device__ __forceinline__ bf16x8 ldsq(lds_cptr p) { return *(const LAS bf16x8*)p; }
#define MFMA32(a, b, c) __builtin_amdgcn_mfma_f32_32x32x16_bf16((a), (b), (c), 0, 0, 0)
__device__ __forceinline__ bf16x8 pack_bf8(const f32x16& p, int base) {
    v4u w; w.x = cvtpk(p[base], p[base + 1]); w.y = cvtpk(p[base + 2], p[base + 3]); w.z = cvtpk(p[base + 4], p[base + 5]); w.w = cvtpk(p[base + 6], p[base + 7]); return __builtin_bit_cast(bf16x8, w);
}
__device__ __forceinline__ float swap_half(float v) { auto rr = __builtin_amdgcn_permlane32_swap(__float_as_uint(v), __float_as_uint(v), false, false); return __uint_as_float((threadIdx.x & 32) ? rr[0] : rr[1]); }

constexpr int SBA_K = 0, SBA_V = 16384, SBA_OST = 32768;
__device__ __forceinline__ void sb_attn_unit(Frame& F, int b, int h, int qb, float b2) {
    const int lane = F.lane, r32 = lane & 31, hi = lane >> 5, wid = F.wave;
    const bf16* QBp = WSP(bf16, WS_QB); const bf16* KBp = WSP(bf16, WS_KB); const bf16* VBp = WSP(bf16, WS_VB); bf16* OSB = WSP(bf16, WS_OSB);
    const long rowbase = (long)b * T; const int q0 = qb * 256;
    const bf16* Qw = QBp + (rowbase + q0 + wid * 32) * SBW + h * HD;
    const bf16* Kh = KBp + rowbase * SBW + h * HD; const bf16* Vh = VBp + rowbase * SBW + h * HD;
    const unsigned lds0 = (unsigned)(uintptr_t)(F.lds + RING_OFF);
    const bf16* ksrc = Kh + (long)lane * SBW + wid * 8;
    const bf16* vsrc = Vh + (long)(16 * (wid & 3) + (lane >> 2)) * SBW + (wid >> 2) * 32 + (lane & 3) * 8;
    const unsigned kdst = lds0 + SBA_K + wid * 1024, vdst = lds0 + SBA_V + wid * 1024;
    const lds_cptr base3 = (lds_cptr)(F.lds + RING_OFF);
    const lds_cptr kp0 = base3 + SBA_K + hi * 1024 + r32 * 16;
    const lds_cptr vp0 = base3 + SBA_V + ((lane >> 4) & 1) * 32 + (lane & 3) * 8 + (4 * hi + ((lane & 15) >> 2)) * 64;
    const int NT = (q0 + 256) / 64;
#define DMA_KV(t, slot) do { glds16(ksrc + (long)(t) * 64 * SBW, (unsigned)__builtin_amdgcn_readfirstlane(kdst + (slot) * 8192)); glds16(vsrc + (long)(t) * 64 * SBW, (unsigned)__builtin_amdgcn_readfirstlane(vdst + (slot) * 8192)); } while (0)
    DMA_KV(NT - 1, 0);
    bf16x8 qr[4];
#pragma unroll
    for (int d0 = 0; d0 < 4; ++d0) qr[d0] = *reinterpret_cast<const bf16x8*>(&Qw[(long)r32 * SBW + d0 * 16 + hi * 8]);
    bf16x8 A0, A1, AN;
#pragma unroll
    for (int j = 0; j < 8; ++j) { const int kv = crow(j, hi); A0[j] = (short)((kv > r32) ? 0xBF80 : 0); A1[j] = (short)((kv + 16 > r32) ? 0xBF80 : 0); AN[j] = (short)0xBF80; }
    f32x16 o0 = {}, o1 = {}, racc = {}, bt;
#pragma unroll
    for (int r = 0; r < 16; ++r) bt[r] = b2;
    const int qrel = wid * 32 + r32;
    for (int it = 0; it < NT; ++it) {
        const int t = NT - 1 - it, cur = it & 1;
        if (it + 1 < NT) { DMA_KV(t - 1, cur ^ 1); WAIT_BAR(2); } else { WAIT_BAR(0); }
        const int jb = t - (NT - 4);
        if (jb <= (wid >> 1)) {
            const lds_cptr kp = kp0 + cur * 8192; const lds_cptr vp = vp0 + cur * 8192;
            f32x16 p0 = bt, p1 = bt;
#pragma unroll
            for (int d0 = 0; d0 < 4; ++d0) { const bf16x8 k0 = ldsq(kp + d0 * 2048), k1 = ldsq(kp + d0 * 2048 + 512); p0 = MFMA32(k0, qr[d0], p0); p1 = MFMA32(k1, qr[d0], p1); }
            if (jb == (wid >> 1)) {
                const float NEG = -INFINITY; const int kb = 64 * jb + 4 * hi;
#pragma unroll
                for (int r = 0; r < 16; ++r) { const int kv = kb + (r & 3) + 8 * (r >> 2); if (kv >= qrel) p0[r] = NEG; if (kv + 32 >= qrel) p1[r] = NEG; }
            }
            f32x16 s0, s1;
#pragma unroll
            for (int r = 0; r < 16; ++r) { s0[r] = __builtin_amdgcn_logf(1.f + __builtin_amdgcn_exp2f(p0[r])); s1[r] = __builtin_amdgcn_logf(1.f + __builtin_amdgcn_exp2f(p1[r])); }
            const bf16x8 sb0 = pack_bf8(s0, 0), sb1 = pack_bf8(s0, 8), sb2 = pack_bf8(s1, 0), sb3 = pack_bf8(s1, 8);
            f32x16 d1 = MFMA32(A0, sb2, racc); d1 = MFMA32(A1, sb3, d1);
            f32x16 d0 = MFMA32(A0, sb0, racc); d0 = MFMA32(A1, sb1, d0); d0 = MFMA32(AN, sb2, d0); d0 = MFMA32(AN, sb3, d0);
            racc = MFMA32(AN, sb0, racc); racc = MFMA32(AN, sb1, racc); racc = MFMA32(AN, sb2, racc); racc = MFMA32(AN, sb3, racc);
#pragma unroll
            for (int r = 0; r < 16; ++r) { p0[r] = __builtin_amdgcn_exp2f((p0[r] - s0[r]) + d0[r]); p1[r] = __builtin_amdgcn_exp2f((p1[r] - s1[r]) + d1[r]); }
            const bf16x8 pa0 = pack_bf8(p0, 0), pa1 = pack_bf8(p0, 8), pa2 = pack_bf8(p1, 0), pa3 = pack_bf8(p1, 8);
#pragma unroll
            for (int dh = 0; dh < 2; ++dh) {
                f32x16& o = dh ? o1 : o0;
#pragma unroll
                for (int rg = 0; rg < 4; ++rg) { const s16x4 lo = vtr(vp + dh * 4096 + rg * 1024), hh = vtr(vp + dh * 4096 + rg * 1024 + 512);
                    const bf16x8 vf = (bf16x8){lo[0], lo[1], lo[2], lo[3], hh[0], hh[1], hh[2], hh[3]};
                    o = MFMA32(rg == 0 ? pa0 : rg == 1 ? pa1 : rg == 2 ? pa2 : pa3, vf, o); }
            }
        }
        WAIT_BAR(0);
    }
#undef DMA_KV
    { int l2 = lane; asm volatile("" : "+v"(l2)); const int e32 = l2 & 31, ehi = l2 >> 5;
      LAS bf16* stg = (LAS bf16*)(F.lds + RING_OFF + SBA_OST) + wid * 2048; LAS bf16* sb = stg + (4 * ehi) * 64 + e32;
#pragma unroll
      for (int r = 0; r < 16; ++r) { sb[((r & 3) + 8 * (r >> 2)) * 64] = (bf16)f2bf(o0[r]); sb[((r & 3) + 8 * (r >> 2)) * 64 + 32] = (bf16)f2bf(o1[r]); }
      LDS_WAIT();
      bf16* Ow = OSB + (rowbase + q0 + wid * 32 + (l2 >> 3)) * SBW + h * HD + (l2 & 7) * 8; const LAS bf16* sr = stg + (l2 >> 3) * 64 + (l2 & 7) * 8;
#pragma unroll
      for (int i = 0; i < 4; ++i) { const v4u v = *(const LAS v4u*)(sr + i * 512); *(v4u*)(Ow + (long)i * 8 * SBW) = v; } }
    asm volatile("s_waitcnt vmcnt(0) lgkmcnt(0)\n\ts_barrier" ::: "memory");
}

__device__ __forceinline__ float dpp_sum16(float x) {
    x += __builtin_bit_cast(float, __builtin_amdgcn_update_dpp(0, __builtin_bit_cast(int, x), 0xB1, 0xf, 0xf, true));
    x += __builtin_bit_cast(float, __builtin_amdgcn_update_dpp(0, __builtin_bit_cast(int, x), 0x4E, 0xf, 0xf, true));
    x += __builtin_bit_cast(float, __builtin_amdgcn_update_dpp(0, __builtin_bit_cast(int, x), 0x141, 0xf, 0xf, true));
    x += __builtin_bit_cast(float, __builtin_amdgcn_update_dpp(0, __builtin_bit_cast(int, x), 0x140, 0xf, 0xf, true));
    return x;
}
__device__ __forceinline__ float wave_sum_fast(float x) { x = dpp_sum16(x); x += __shfl_xor(x, 16); x += swap_half(x); return x; }
__device__ __forceinline__ void sb_sample_unit(Frame& F, int b, int pg) {
    const int lane = F.lane, h = F.wave, ts = lane >> 4, d4 = lane & 15;
    const float* QS = WSP(float, WS_QS); const float* ck = INF(2); const float* cv = INF(3); const int* pt = (const int*)F.in[4];
    const float b2 = INF(13)[h] * LOG2E;
    const f32x4 q4 = *(const f32x4*)(QS + (size_t)b * SBW + h * HD + 4 * d4);
    const int page = pt[b * NPG + pg];
    const float* kb = ck + ((size_t)page * PAGE + ts) * (NH * HD) + h * HD + 4 * d4;
    const float* vb = cv + ((size_t)page * PAGE + ts) * (NH * HD) + h * HD + 4 * d4;
    float z[32];
    { f32x4 kk[32];
#pragma unroll
      for (int i = 0; i < 32; ++i) kk[i] = __builtin_nontemporal_load((const f32x4*)(kb + (size_t)i * 4 * NH * HD));
#pragma unroll
      for (int i = 0; i < 32; ++i) z[i] = dpp_sum16((q4[0] * kk[i][0] + q4[1] * kk[i][1]) + (q4[2] * kk[i][2] + q4[3] * kk[i][3])) + b2; }
    f32x4 vv[32];
#pragma unroll
    for (int i = 0; i < 32; ++i) vv[i] = __builtin_nontemporal_load((const f32x4*)(vb + (size_t)i * 4 * NH * HD));
    float run = 0.f;
#pragma unroll
    for (int i = 31; i >= 0; --i) {
        const float sp = __builtin_amdgcn_logf(1.f + __builtin_amdgcn_exp2f(z[i]));
        const float nb = __shfl_xor(sp, 16), v1 = sp + nb, po = swap_half(v1);
        const float aft = ((ts & 1) ? 0.f : nb) + ((ts & 2) ? 0.f : po);
        z[i] = __builtin_amdgcn_exp2f(z[i] - sp - (run + aft));
        run += v1 + po;
    }
    f32x4 acc = {0.f, 0.f, 0.f, 0.f};
#pragma unroll
    for (int i = 0; i < 32; ++i) acc = acc + vv[i] * z[i];
#pragma unroll
    for (int e = 0; e < 4; ++e) { acc[e] += __shfl_xor(acc[e], 16); acc[e] += swap_half(acc[e]); }
    if (ts == 0) *(f32x4*)(WSP(float, WS_SBPO) + (((size_t)b * NPG + pg) * NH + h) * HD + 4 * d4) = acc;
    if (lane == 0) WSP(float, WS_SBPL)[((size_t)b * NPG + pg) * NH + h] = -run;
}
__device__ __forceinline__ void sb_sample_combine(Frame& F, int b, int h) {
    const float* PO = WSP(float, WS_SBPO); const float* PL = WSP(float, WS_SBPL); float o = 0.f, run = 0.f;
#pragma unroll
    for (int pg = NPG - 1; pg >= 0; --pg) { o += __builtin_amdgcn_exp2f(run) * PO[(((size_t)b * NPG + pg) * NH + h) * HD + F.lane]; run += PL[((size_t)b * NPG + pg) * NH + h]; }
    WSP(bf16, WS_OSB)[(size_t)(MPR + b) * SBW + h * HD + F.lane] = (bf16)f2bf(o);
}
__device__ __forceinline__ void ssm_sample_unit(Frame& F, int b, int g) {
    const int n = F.lane;
    const float lr = INF(14)[g * NST + n], li = INF(15)[g * NST + n], ldt = INF(16)[g];
    float lbr, lbi, cr, ci; lam_pow(lr, li, ldt, 1, lbr, lbi); lam_coef(lr, li, ldt, cr, ci);
    const float* u = WSP(float, WS_US) + (size_t)b * SBW + g * GP;
    float br = 0.f, bi = 0.f;
#pragma unroll
    for (int p = 0; p < 16; ++p) { const float bre = INF(17)[(g * NST + n) * GP + p], bim = INF(18)[(g * NST + n) * GP + p]; const float uv = u[p]; br += (cr * bre - ci * bim) * uv; bi += (cr * bim + ci * bre) * uv; }
    const float h0r = INF(5)[(b * NG + g) * NST + n], h0i = INF(6)[(b * NG + g) * NST + n];
    const float hr = lbr * h0r - lbi * h0i + br, hi = lbr * h0i + lbi * h0r + bi;
    F.out[O_RES + (size_t)(b * NG + g) * NST + n] = hr; F.out[O_IMS + (size_t)(b * NG + g) * NST + n] = hi;
    float y = 0.f;
#pragma unroll
    for (int p = 0; p < 16; ++p) { const float v = wave_sum(INF(19)[(g * GP + p) * NST + n] * hr - INF(20)[(g * GP + p) * NST + n] * hi); if (n == p) y = v; }
    if (n < 16) { y += INF(21)[g * GP + n] * u[n]; WSP(bf16, WS_YG)[(size_t)(MPR + b) * SBW + g * GP + n] = (bf16)f2bf(gelu_tanh_f(y)); }
}
__device__ __forceinline__ void ssm_scan_unit(Frame& F, int unit) {
    const int b = unit >> 6, g = (unit >> 1) & 31, nh = unit & 1, nl = F.tid & 31, seg = F.tid >> 5, n = nh * 32 + nl;
    LAS float* tot = (LAS float*)(F.lds + RING_OFF);
    const float lr = INF(14)[g * NST + n], li = INF(15)[g * NST + n], ldt = INF(16)[g];
    float Lr, Li, Sr, Si; lam_pow(lr, li, ldt, LC, Lr, Li); lam_pow(lr, li, ldt, LC * 16, Sr, Si);
    const float* SST = WSP(float, WS_SST); bf16* XH = WSP(bf16, WS_XH);
    f32x2 s[16];
#pragma unroll
    for (int k = 0; k < 16; ++k) s[k] = *(const f32x2*)(SST + ((size_t)(b * NCH + seg * 16 + k) * NG + g) * 128 + 2 * n);
    float pr = 0.f, pi = 0.f;
#pragma unroll
    for (int k = 0; k < 16; ++k) { const float nr = Lr * pr - Li * pi + s[k].x, ni = Lr * pi + Li * pr + s[k].y; pr = nr; pi = ni; s[k].x = pr; s[k].y = pi; }
    __syncthreads();
    tot[(seg * 32 + nl) * 2] = pr; tot[(seg * 32 + nl) * 2 + 1] = pi;
    __syncthreads();
    float cr = 0.f, ci = 0.f;
    for (int s2 = 0; s2 < seg; ++s2) { const float tr = tot[(s2 * 32 + nl) * 2], ti = tot[(s2 * 32 + nl) * 2 + 1]; const float nr = Sr * cr - Si * ci + tr, ni = Sr * ci + Si * cr + ti; cr = nr; ci = ni; }
    if (seg == 0) *(GAS unsigned*)(XH + ((size_t)(b * NCH) * NG + g) * XHP + 256 + 2 * n) = 0u;
    float wr_ = Lr, wi_ = Li;
#pragma unroll
    for (int k = 0; k < 16; ++k) {
        const float hr = wr_ * cr - wi_ * ci + s[k].x, hi = wr_ * ci + wi_ * cr + s[k].y;
        const int c = seg * 16 + k;
        if (c + 1 < NCH) *(GAS unsigned*)(XH + ((size_t)(b * NCH + c + 1) * NG + g) * XHP + 256 + 2 * n) = pk2(hr, hi);
        else { F.out[O_REP + (size_t)(b * NG + g) * NST + n] = hr; F.out[O_IMP + (size_t)(b * NG + g) * NST + n] = hi; }
        const float nr = wr_ * Lr - wi_ * Li, ni = wr_ * Li + wi_ * Lr; wr_ = nr; wi_ = ni;
    }
}
__device__ __forceinline__ void xattn_prompt_unit(Frame& F, int b, int h, int qb) {
    const int lane = F.lane, r32 = lane & 31, hi = lane >> 5, wid = F.wave;
    const bf16* QM = WSP(bf16, WS_QM); const bf16* MKB = WSP(bf16, WS_MKB); const bf16* MVB = WSP(bf16, WS_MVB); bf16* OM = WSP(bf16, WS_OMEM);
    const unsigned lds0 = (unsigned)(uintptr_t)(F.lds + RING_OFF); const lds_cptr base3 = (lds_cptr)(F.lds + RING_OFF);
    const long qrow0 = (long)b * T + qb * 256 + wid * 32;
#pragma unroll
    for (int t = 0; t < 4; ++t)
#pragma unroll
        for (int j = 0; j < 4; ++j) { const int c = wid + 8 * j;
            glds16(MKB + ((long)b * MT + t * 64 + lane) * D + h * MHD + c * 8, (unsigned)__builtin_amdgcn_readfirstlane(lds0 + t * 32768 + c * 1024)); }
    bf16x8 qr[16];
#pragma unroll
    for (int ks = 0; ks < 16; ++ks) qr[ks] = *reinterpret_cast<const bf16x8*>(QM + (qrow0 + r32) * D + h * MHD + ks * 16 + hi * 8);
    WAIT_BAR(0);
    f32x16 S[8];
#pragma unroll
    for (int t = 0; t < 4; ++t)
#pragma unroll
        for (int blk = 0; blk < 2; ++blk) { f32x16 p = {};
#pragma unroll
            for (int ks = 0; ks < 16; ++ks) p = MFMA32(ldsq(base3 + t * 32768 + (2 * ks + hi) * 1024 + (32 * blk + r32) * 16), qr[ks], p);
            S[t * 2 + blk] = p; }
    WAIT_BAR(0);
#pragma unroll
    for (int t = 0; t < 4; ++t)
#pragma unroll
        for (int j = 0; j < 4; ++j) { const int p = wid + 8 * j, dblk = p >> 2, rg = p & 3;
            glds16(MVB + ((long)b * MT + t * 64 + 16 * rg + (lane >> 2)) * D + h * MHD + dblk * 32 + (lane & 3) * 8, (unsigned)__builtin_amdgcn_readfirstlane(lds0 + t * 32768 + p * 1024)); }
    float mx = -INFINITY;
#pragma unroll
    for (int i = 0; i < 8; ++i)
#pragma unroll
        for (int r = 0; r < 16; ++r) mx = fmaxf(mx, S[i][r]);
    mx = fmaxf(mx, swap_half(mx));
    float l = 0.f;
#pragma unroll
    for (int i = 0; i < 8; ++i)
#pragma unroll
        for (int r = 0; r < 16; ++r) { S[i][r] = __builtin_amdgcn_exp2f(S[i][r] - mx); l += S[i][r]; }
    l += swap_half(l);
    bf16x8 pa[16];
#pragma unroll
    for (int i = 0; i < 8; ++i) { pa[2 * i] = pack_bf8(S[i], 0); pa[2 * i + 1] = pack_bf8(S[i], 8); }
    WAIT_BAR(0);
    f32x16 o[8];
#pragma unroll
    for (int dblk = 0; dblk < 8; ++dblk) o[dblk] = (f32x16){};
    const lds_cptr vp0 = base3 + ((lane >> 4) & 1) * 32 + (lane & 3) * 8 + (4 * hi + ((lane & 15) >> 2)) * 64;
#pragma unroll
    for (int t = 0; t < 4; ++t)
#pragma unroll
        for (int dblk = 0; dblk < 8; ++dblk)
#pragma unroll
            for (int rg = 0; rg < 4; ++rg) { const s16x4 lo = vtr(vp0 + t * 32768 + dblk * 4096 + rg * 1024), hh = vtr(vp0 + t * 32768 + dblk * 4096 + rg * 1024 + 512);
                const bf16x8 vf = (bf16x8){lo[0], lo[1], lo[2], lo[3], hh[0], hh[1], hh[2], hh[3]};
                o[dblk] = MFMA32(pa[t * 4 + rg], vf, o[dblk]); }
    WAIT_BAR(0);
    int l2 = lane; asm volatile("" : "+v"(l2));
    const int e32 = l2 & 31, ehi = l2 >> 5;
    LAS bf16* stg = (LAS bf16*)(F.lds + RING_OFF) + wid * 8192;
    LAS float* lsw = (LAS float*)stg;
    if (ehi == 0) lsw[e32] = l;
    LDS_WAIT();
    float rli[16];
    { const LAS float* lb = lsw + 4 * ehi;
#pragma unroll
      for (int r = 0; r < 16; ++r) rli[r] = __builtin_amdgcn_rcpf(lb[(r & 3) + 8 * (r >> 2)]); }
    LDS_WAIT(); asm volatile("" ::: "memory");
    { LAS bf16* sb = stg + (4 * ehi) * 256 + e32;
#pragma unroll
      for (int dblk = 0; dblk < 8; ++dblk)
#pragma unroll
        for (int r = 0; r < 16; ++r) sb[((r & 3) + 8 * (r >> 2)) * 256 + dblk * 32] = (bf16)f2bf(o[dblk][r] * rli[r]); }
    LDS_WAIT();
    { bf16* Ow = OM + (qrow0 + (l2 >> 5)) * D + h * MHD + (l2 & 31) * 8; const LAS bf16* sr = stg + (l2 >> 5) * 256 + (l2 & 31) * 8;
#pragma unroll
      for (int i = 0; i < 16; ++i) { const v4u v = *(const LAS v4u*)(sr + i * 512); *(v4u*)(Ow + (long)i * 2 * D) = v; } }
    asm volatile("s_waitcnt vmcnt(0) lgkmcnt(0)\n\ts_barrier" ::: "memory");
}
__device__ __forceinline__ void xattn_sample_unit(Frame& F, int b, int h) {
    const int lane = F.lane, wid = F.wave;
    const bf16* QM = WSP(bf16, WS_QM); const float* ck = INF(8); const float* cv = INF(9);
    LAS float* xm = (LAS float*)(F.lds + RING_OFF);
    const v2u qw = *(const v2u*)(QM + (size_t)(MPR + b) * D + h * MHD + 4 * lane);
    const f32x4 q4 = {bflo(qw.x), bfhi(qw.x), bflo(qw.y), bfhi(qw.y)};
    const float* kb = ck + (((size_t)b * MT + wid * 32) * MH + h) * MHD + 4 * lane;
    const float* vb = cv + (((size_t)b * MT + wid * 32) * MH + h) * MHD + 4 * lane;
    float s[32];
#pragma unroll
    for (int i0 = 0; i0 < 32; i0 += 8) {
        f32x4 kk[8];
#pragma unroll
        for (int i = 0; i < 8; ++i) kk[i] = __builtin_nontemporal_load((const f32x4*)(kb + (size_t)(i0 + i) * MH * MHD));
#pragma unroll
        for (int i = 0; i < 8; ++i) s[i0 + i] = wave_sum((q4[0] * kk[i][0] + q4[1] * kk[i][1]) + (q4[2] * kk[i][2] + q4[3] * kk[i][3]));
    }
    float mx = s[0];
#pragma unroll
    for (int i = 1; i < 32; ++i) mx = fmaxf(mx, s[i]);
    __syncthreads();
    if (lane == 0) xm[wid] = mx;
    __syncthreads();
    float gm = xm[0];
#pragma unroll
    for (int w = 1; w < 8; ++w) gm = fmaxf(gm, xm[w]);
    float l = 0.f;
#pragma unroll
    for (int i = 0; i < 32; ++i) { s[i] = __builtin_amdgcn_exp2f(s[i] - gm); l += s[i]; }
    f32x4 acc = {0.f, 0.f, 0.f, 0.f};
#pragma unroll
    for (int i0 = 0; i0 < 32; i0 += 8) {
        f32x4 vv[8];
#pragma unroll
        for (int i = 0; i < 8; ++i) vv[i] = __builtin_nontemporal_load((const f32x4*)(vb + (size_t)(i0 + i) * MH * MHD));
#pragma unroll
        for (int i = 0; i < 8; ++i) acc = acc + vv[i] * s[i0 + i];
    }
    if (lane == 0) xm[8 + wid] = l;
    *(LAS f32x4*)(xm + 64 + wid * 256 + 4 * lane) = acc;
    __syncthreads();
    if (F.tid < 256) { float lt = 0.f, ov = 0.f;
#pragma unroll
        for (int w = 0; w < 8; ++w) { lt += xm[8 + w]; ov += xm[64 + w * 256 + F.tid]; }
        WSP(bf16, WS_OMEM)[(size_t)(MPR + b) * D + h * MHD + F.tid] = (bf16)f2bf(ov / lt); }
}
__device__ __forceinline__ void mix_row(Frame& F, int row) {
    const int lane = F.lane;
#pragma unroll
    for (int half = 0; half < 2; ++half) {
        const bf16* src = (half ? WSP(bf16, WS_OSSM) : WSP(bf16, WS_OSB)) + (size_t)row * SBW + 8 * lane;
        const v4u w = *(const v4u*)src; float v[8] = {bflo(w.x), bfhi(w.x), bflo(w.y), bfhi(w.y), bflo(w.z), bfhi(w.z), bflo(w.w), bfhi(w.w)};
        float s = 0.f;
#pragma unroll
        for (int e = 0; e < 8; ++e) s += v[e] * v[e];
        s = wave_sum(s); const float rs = 1.f / sqrtf(s * (1.f / SBW) + EPS);
        v4u o; o.x = pk2(v[0] * rs, v[1] * rs); o.y = pk2(v[2] * rs, v[3] * rs); o.z = pk2(v[4] * rs, v[5] * rs); o.w = pk2(v[6] * rs, v[7] * rs);
        *(v4u*)(WSP(bf16, WS_MIX) + (size_t)row * D + half * SBW + 8 * lane) = o;
    }
}
__device__ __forceinline__ void conv_act_item(Frame& F, long item) {
    const int row = (int)(item / (FF / 8)), j = (int)(item % (FF / 8)) * 8;
    const bf16* GB = WSP(bf16, WS_GB); bf16* UB = WSP(bf16, WS_UB);
    const float* cw = INF(36); const float* cb = INF(37); const float* sc = INF(7);
    float g0[8], g1[8], g2[8], uu[8];
    { const v4u w = *(const v4u*)(GB + (size_t)row * FF + j); g0[0] = bflo(w.x); g0[1] = bfhi(w.x); g0[2] = bflo(w.y); g0[3] = bfhi(w.y); g0[4] = bflo(w.z); g0[5] = bfhi(w.z); g0[6] = bflo(w.w); g0[7] = bfhi(w.w); }
    { const v4u w = *(const v4u*)(UB + (size_t)row * FF + j); uu[0] = bflo(w.x); uu[1] = bfhi(w.x); uu[2] = bflo(w.y); uu[3] = bfhi(w.y); uu[4] = bflo(w.z); uu[5] = bfhi(w.z); uu[6] = bflo(w.w); uu[7] = bfhi(w.w); }
    if (row < MPR) { const int t = row & 4095;
        if (t >= 1) { const v4u w = *(const v4u*)(GB + (size_t)(row - 1) * FF + j); g1[0] = bflo(w.x); g1[1] = bfhi(w.x); g1[2] = bflo(w.y); g1[3] = bfhi(w.y); g1[4] = bflo(w.z); g1[5] = bfhi(w.z); g1[6] = bflo(w.w); g1[7] = bfhi(w.w); }
        else { _Pragma("unroll") for (int e = 0; e < 8; ++e) g1[e] = 0.f; }
        if (t >= 2) { const v4u w = *(const v4u*)(GB + (size_t)(row - 2) * FF + j); g2[0] = bflo(w.x); g2[1] = bfhi(w.x); g2[2] = bflo(w.y); g2[3] = bfhi(w.y); g2[4] = bflo(w.z); g2[5] = bfhi(w.z); g2[6] = bflo(w.w); g2[7] = bfhi(w.w); }
        else { _Pragma("unroll") for (int e = 0; e < 8; ++e) g2[e] = 0.f; }
    } else { const int b = row - MPR;
        _Pragma("unroll") for (int e = 0; e < 8; ++e) { g2[e] = sc[((size_t)b * 2 + 0) * FF + j + e]; g1[e] = sc[((size_t)b * 2 + 1) * FF + j + e]; F.out[O_CVS + ((size_t)b * 2 + 0) * FF + j + e] = g1[e]; } }
    float r[8];
#pragma unroll
    for (int e = 0; e < 8; ++e) { const float c = cb[j + e] + cw[j + e] * g2[e] + cw[FF + j + e] * g1[e] + cw[2 * FF + j + e] * g0[e]; r[e] = gelu_tanh_f(c) * uu[e]; }
    v4u o; o.x = pk2(r[0], r[1]); o.y = pk2(r[2], r[3]); o.z = pk2(r[4], r[5]); o.w = pk2(r[6], r[7]);
    *(v4u*)(UB + (size_t)row * FF + j) = o;
}
__device__ __forceinline__ void final_norm_row(Frame& F, int row) {
    const float rs = 1.f / sqrtf(((const float*)(F.ctl + CW_SSQ3))[row] * (1.f / D) + EPS);
    float* y = F.out + O_YP + (size_t)row * D; const float* g = INF(39);
#pragma unroll
    for (int j = 0; j < 4; ++j) { const int c = 4 * F.lane + 256 * j; f32x4 v = *(const f32x4*)(y + c); const f32x4 gv = *(const f32x4*)(g + c); v = v * rs * gv; *(f32x4*)(y + c) = v; }
}
constexpr int N_PHASES = 15;
__global__ void __launch_bounds__(NTHR, 2) mk_fwd(Args args) {
    extern __shared__ __attribute__((aligned(16))) unsigned char lds[];
    Frame F;
    F.lds = (LAS unsigned char*)lds; F.MISC = (volatile LAS unsigned*)(F.lds + MISC_OFF);
    F.tid = threadIdx.x; F.lane = F.tid & 63; F.wave = __builtin_amdgcn_readfirstlane(F.tid >> 6);
    F.G = gridDim.x; { const int bx = blockIdx.x; F.vcu = (F.G % 8 == 0) ? (bx % 8) * (F.G / 8) + bx / 8 : bx; }
    F.ws = args.ws; F.out = args.out; F.in = args.in; F.ctl = (unsigned*)(args.ws + WS_CTL);
    for (int u = F.tid; u < (LDS_BYTES - LDSCTL_OFF) / 4; u += NTHR) ((LAS unsigned*)(F.lds + LDSCTL_OFF))[u] = 0u;
    __syncthreads();
    XcdBarrier bar; bar.bar = F.ctl + CW_BAR; bar.x = 0; bar.st = nullptr;
    if (args.use_bar) bar = xcd_barrier_post(F.ctl + CW_BAR, F.MISC + 8);
    const int lo = args.ph_lo, hi = args.ph_hi;
#define IN(k) (lo <= (k) && (k) < hi)
#define SEAM(k) do { if (IN(k) && IN((k) + 1)) xcd_barrier(bar); } while (0)
    const int gw = F.vcu * NWAVES + F.wave, NGW = F.G * NWAVES;
    LAS unsigned char* ring = F.lds + RING_OFF;

    if (IN(0)) { p0_prologue(F);
#if MK_PROBE == 100
        __syncthreads(); p0_prologue(F);
#endif
    } SEAM(0);
    if (IN(1)) {
        { pg8::Gemm g{WSP(bf16, WS_XB), WSP(bf16, WS_WIN), D, D, D}; pg8::GridOrder S; S.init(MPR / 256, INW / 256, F.G, (int)blockIdx.x, 0, D, D);
          EpiInProj E{WSP(float, WS_RSTD0), WSP(bf16, WS_QB), WSP(bf16, WS_KB), WSP(bf16, WS_VB), WSP(bf16, WS_XH), WSP(float, WS_QS), WSP(float, WS_US), F.out};
          pg8::gemm_phase<EpiInProj, pg8::GridOrder>(ring, g, S, E); }
        { SkInProj E{WSP(float, WS_RSTD0), WSP(bf16, WS_QB), WSP(float, WS_QS), WSP(float, WS_US), F.out};
          skinny_gemm(F, WSP(bf16, WS_XB) + (size_t)MPR * D, D, WSP(bf16, WS_WIN), D, INW, D, E, (int)blockIdx.x, F.G); }
    } SEAM(1);
    if (IN(2)) {
        { pg8::Gemm g{WSP(bf16, WS_XH), WSP(bf16, WS_W1), NG * XHP, 256, 256}; SsmOrder S{F.G, (int)blockIdx.x, (size_t)128 * 256 * 2};
          EpiSsmA E{WSP(float, WS_SST)};
          pg8::gemm_phase<EpiSsmA, SsmOrder>(ring, g, S, E); }
        { pg8::Gemm g{WSP(bf16, WS_MB), WSP(bf16, WS_WMKV), D, D, D}; pg8::GridOrder S; S.init(4, 8, F.G, (int)blockIdx.x, 128, D, D);
          EpiMemKV E{WSP(float, WS_RSTDM), WSP(bf16, WS_MKB), WSP(bf16, WS_MVB), F.out};
          pg8::gemm_phase<EpiMemKV, pg8::GridOrder>(ring, g, S, E); }
        for (int u = gw; u < MS * NG; u += NGW) ssm_sample_unit(F, u >> 5, u & 31);
        { int mode = (F.vcu % 3 == 2) ? 1 : 0; bool adone = false, mdone = false;
          while (!(adone && mdone)) {
              if (mode == 0 && adone) mode = 1; else if (mode == 1 && mdone) mode = 0;
              __syncthreads();
              if (F.tid == 0) F.MISC[16] = __hip_atomic_fetch_add(F.ctl + (mode ? CW_QM : CW_QA), 1u, __ATOMIC_RELAXED, __HIP_MEMORY_SCOPE_AGENT);
              __syncthreads();
              const int idx = (int)F.MISC[16];
              if (mode == 0) { if (idx >= 512) { adone = true; continue; }
                  const int qb = 15 - (idx >> 5), bh = idx & 31; sb_attn_unit(F, bh >> 3, bh & 7, qb, INF(13)[bh & 7] * LOG2E); }
              else { if (idx >= (MS * NPG) / 4) { mdone = true; continue; }
#pragma unroll 1
                  for (int j = 0; j < 4; ++j) { const int u = idx * 4 + j; sb_sample_unit(F, u >> 4, u & 15); } }
          } }
    } SEAM(2);
    if (IN(3)) {
        for (int u = F.vcu; u < 256; u += F.G) ssm_scan_unit(F, u);
        for (int u = gw; u < MS * NH; u += NGW) sb_sample_combine(F, u >> 3, u & 7);
    } SEAM(3);
    if (IN(4)) {
        pg8::Gemm g{WSP(bf16, WS_XH), WSP(bf16, WS_BTC), NG * XHP, XHP, XHP}; SsmOrder S{F.G, (int)blockIdx.x, (size_t)256 * XHP * 2};
        EpiSsmC E{WSP(bf16, WS_YG)};
        pg8::gemm_phase<EpiSsmC, SsmOrder>(ring, g, S, E);
    } SEAM(4);
    if (IN(5)) {
        pg8::Gemm g{WSP(bf16, WS_YG), WSP(bf16, WS_WGLU), SBW, SBW, SBW}; pg8::GridOrder S; S.init(MPR / 256, 2, F.G, (int)blockIdx.x, 0, SBW, SBW);
        EpiGlu E{WSP(bf16, WS_YG), INF(23), WSP(bf16, WS_OSSM)};
        pg8::gemm_phase<EpiGlu, pg8::GridOrder>(ring, g, S, E);
        SkGlu E2{WSP(bf16, WS_YG), INF(23), WSP(bf16, WS_OSSM)};
        skinny_gemm(F, WSP(bf16, WS_YG) + (size_t)MPR * SBW, SBW, WSP(bf16, WS_WGLU), SBW, SBW, SBW, E2, ((int)blockIdx.x + F.G - 128) % F.G, F.G);
    } SEAM(5);
    if (IN(6)) { for (int m = gw; m < MALL; m += NGW) mix_row(F, m);
#if MK_PROBE == 6
        for (int m = gw; m < MALL; m += NGW) mix_row(F, m);
#endif
    } SEAM(6);
    if (IN(7)) {
        pg8::Gemm g{WSP(bf16, WS_MIX), WSP(bf16, WS_WOUT), D, D, D}; pg8::GridOrder S; S.init(MPR / 256, 4, F.G, (int)blockIdx.x, 0, D, D);
        EpiResid E{INF(0), INF(1), WSP(float, WS_X1), WSP(bf16, WS_X1B), (float*)(F.ctl + CW_SSQ1)};
        pg8::gemm_phase<EpiResid, pg8::GridOrder>(ring, g, S, E);
        SkResid E2{INF(1), WSP(float, WS_X1), WSP(bf16, WS_X1B), (float*)(F.ctl + CW_SSQ1)};
        skinny_gemm(F, WSP(bf16, WS_MIX) + (size_t)MPR * D, D, WSP(bf16, WS_WOUT), D, D, D, E2, (int)blockIdx.x, F.G);
    } SEAM(7);
    if (IN(8)) {
        pg8::Gemm g{WSP(bf16, WS_X1B), WSP(bf16, WS_WMQ), D, D, D}; pg8::GridOrder S; S.init(MPR / 256, 4, F.G, (int)blockIdx.x, 0, D, D);
        EpiScaleBf16 E{(const float*)(F.ctl + CW_SSQ1), CM, WSP(bf16, WS_QM)};
        pg8::gemm_phase<EpiScaleBf16, pg8::GridOrder>(ring, g, S, E);
#if MK_PROBE == 8
        pg8::gemm_phase<EpiScaleBf16, pg8::GridOrder>(ring, g, S, E);
#endif
        SkScale E2{(const float*)(F.ctl + CW_SSQ1), CM, WSP(bf16, WS_QM)};
        skinny_gemm(F, WSP(bf16, WS_X1B) + (size_t)MPR * D, D, WSP(bf16, WS_WMQ), D, D, D, E2, (int)blockIdx.x, F.G);
    } SEAM(8);
    if (IN(9)) {
        for (int u = F.vcu; u < 256; u += F.G) xattn_prompt_unit(F, u >> 6, (u >> 4) & 3, u & 15);
#if MK_PROBE == 9
        for (int u = F.vcu; u < 256; u += F.G) xattn_prompt_unit(F, u >> 6, (u >> 4) & 3, u & 15);
#endif
        for (int u = F.vcu; u < MS * MH; u += F.G) xattn_sample_unit(F, u >> 2, u & 3);
#if MK_PROBE == 91
        for (int u = F.vcu; u < MS * MH; u += F.G) xattn_sample_unit(F, u >> 2, u & 3);
#endif
    } SEAM(9);
    if (IN(10)) {
        pg8::Gemm g{WSP(bf16, WS_OMEM), WSP(bf16, WS_WMO), D, D, D}; pg8::GridOrder S; S.init(MPR / 256, 4, F.G, (int)blockIdx.x, 0, D, D);
        EpiResid E{WSP(float, WS_X1), WSP(float, WS_X1) + (size_t)MPR * D, WSP(float, WS_X2), WSP(bf16, WS_X2B), (float*)(F.ctl + CW_SSQ2)};
        pg8::gemm_phase<EpiResid, pg8::GridOrder>(ring, g, S, E);
        SkResid E2{WSP(float, WS_X1) + (size_t)MPR * D, WSP(float, WS_X2), WSP(bf16, WS_X2B), (float*)(F.ctl + CW_SSQ2)};
        skinny_gemm(F, WSP(bf16, WS_OMEM) + (size_t)MPR * D, D, WSP(bf16, WS_WMO), D, D, D, E2, (int)blockIdx.x, F.G);
    } SEAM(10);
    if (IN(11)) {
        pg8::Gemm g{WSP(bf16, WS_X2B), WSP(bf16, WS_WGU), D, D, D}; pg8::GridOrder S; S.init(MPR / 256, NFF2 / 256, F.G, (int)blockIdx.x, 0, D, D);
        EpiGateUp E{(const float*)(F.ctl + CW_SSQ2), WSP(bf16, WS_GB), WSP(bf16, WS_UB), F.out};
        pg8::gemm_phase<EpiGateUp, pg8::GridOrder>(ring, g, S, E);
#if MK_PROBE == 11
        pg8::gemm_phase<EpiGateUp, pg8::GridOrder>(ring, g, S, E);
#endif
        SkGateUp E2{(const float*)(F.ctl + CW_SSQ2), WSP(bf16, WS_GB), WSP(bf16, WS_UB), F.out};
        skinny_gemm(F, WSP(bf16, WS_X2B) + (size_t)MPR * D, D, WSP(bf16, WS_WGU), D, NFF2, D, E2, ((int)blockIdx.x + F.G - 128) % F.G, F.G);
    } SEAM(11);
    if (IN(12)) { const long NIT = (long)MALL * (FF / 8); for (long it = (long)F.vcu * NTHR + F.tid; it < NIT; it += (long)F.G * NTHR) conv_act_item(F, it); } SEAM(12);
    if (IN(13)) {
        pg8::Gemm g{WSP(bf16, WS_UB), WSP(bf16, WS_WDN), FF, FF, FF}; pg8::GridOrder S; S.init(MPR / 256, 4, F.G, (int)blockIdx.x, 0, FF, FF);
        EpiResid E{WSP(float, WS_X2), WSP(float, WS_X2) + (size_t)MPR * D, F.out + O_YP, nullptr, (float*)(F.ctl + CW_SSQ3)};
        pg8::gemm_phase<EpiResid, pg8::GridOrder>(ring, g, S, E);
        SkResid E2{WSP(float, WS_X2) + (size_t)MPR * D, F.out + O_YP, nullptr, (float*)(F.ctl + CW_SSQ3)};
        skinny_gemm(F, WSP(bf16, WS_UB) + (size_t)MPR * FF, FF, WSP(bf16, WS_WDN), FF, D, FF, E2, (int)blockIdx.x, F.G);
    } SEAM(13);
    if (IN(14)) { for (int m = gw; m < MALL; m += NGW) final_norm_row(F, m); }
#undef IN
#undef SEAM
}
#ifndef MK_DEBUG
#define MK_DEBUG 0
#endif
#ifndef MK_ONE_LAUNCH
#define MK_ONE_LAUNCH 1
#endif
#if MK_DEBUG
struct Chk { const void* fast; const float* ref; int isbf; long rows, cols, ldf, ldr; float scale; };
__global__ void k_compare(Chk c, double* acc) {
    __shared__ double se[256], sr[256];
    double e = 0.0, r = 0.0; const long n = c.rows * c.cols;
    for (long i = (long)blockIdx.x * 256 + threadIdx.x; i < n; i += (long)gridDim.x * 256) { const long rr = i / c.cols, cc = i % c.cols;
        const float f = (c.isbf ? bf2f(((const unsigned short*)c.fast)[rr * c.ldf + cc]) : ((const float*)c.fast)[rr * c.ldf + cc]) * c.scale; const float g = c.ref[rr * c.ldr + cc];
        const double d = (double)f - (double)g; e += d * d; r += (double)g * (double)g; }
    se[threadIdx.x] = e; sr[threadIdx.x] = r; __syncthreads();
    for (int k = 128; k > 0; k >>= 1) { if ((int)threadIdx.x < k) { se[threadIdx.x] += se[threadIdx.x + k]; sr[threadIdx.x] += sr[threadIdx.x + k]; } __syncthreads(); }
    if (threadIdx.x == 0) { atomicAdd(acc, se[0]); atomicAdd(acc + 1, sr[0]); }
}
__global__ void k_compare_xh(const unsigned short* XH, const float* proj, const float* hs, int part, double* acc) {
    __shared__ double se[256], sr[256];
    double e = 0.0, r = 0.0; const int w = part ? 128 : 256; const long n = (long)1024 * NG * w;
    for (long i = (long)blockIdx.x * 256 + threadIdx.x; i < n; i += (long)gridDim.x * 256) { const int j = (int)(i % w); const long bcg = i / w; const int g = (int)(bcg % NG); const long bc = bcg / NG; const int b = (int)(bc / NCH), c = (int)(bc % NCH);
        const float f = bf2f(XH[bcg * XHP + (part ? 256 : 0) + j]); float gref;
        if (!part) { const int s = j >> 4, q = j & 15; gref = proj[((size_t)b * T + c * LC + s) * INW + 1536 + g * GP + q]; }
        else { const int nn = j >> 1, ri = j & 1; gref = (c == 0) ? 0.f : hs[((((size_t)b * T + c * LC - 1) * NG + g) * NST + nn) * 2 + ri]; }
        const double d = (double)f - (double)gref; e += d * d; r += (double)gref * (double)gref; }
    se[threadIdx.x] = e; sr[threadIdx.x] = r; __syncthreads();
    for (int k = 128; k > 0; k >>= 1) { if ((int)threadIdx.x < k) { se[threadIdx.x] += se[threadIdx.x + k]; sr[threadIdx.x] += sr[threadIdx.x + k]; } __syncthreads(); }
    if (threadIdx.x == 0) { atomicAdd(acc, se[0]); atomicAdd(acc + 1, sr[0]); }
}
__global__ void k_judge(const double* acc, int n, float tol, float* out) {
    if (threadIdx.x != 0 || blockIdx.x != 0) return;
    for (int k = 0; k < n; ++k) { const double rv = acc[2 * k] / acc[2 * k + 1];
        if (!(rv < (double)tol)) { int m = 5; if (rv != rv) m = 0; else if (rv >= 1.0) m = 9; else if (rv >= 0.1) m = 8; else if (rv >= 0.01) m = 7; else if (rv >= 0.001) m = 6;
            const int grp = k / 9, kk = k % 9 + 1; float code = (float)(10 * kk + m) * 100.f; for (int i = 0; i < grp; ++i) code *= 100.f; out[0] = code; return; } }
}
#endif

extern "C" void kernel_launch(void* const* d_in, const int* in_sizes, int n_in, void* d_out, int out_size, void* d_ws, size_t ws_size, hipStream_t stream) {
    static int grid = 0;
    if (grid == 0) {
        if (n_in != 40 || (size_t)out_size != O_END || ws_size < WS_FAST_END) { fprintf(stderr, "kernel_launch: unexpected shapes: n_in %d out %d ws %zu\n", n_in, out_size, ws_size); grid = -1; return; }
        int dev = 0, cus = 0, per_cu = 0;
        if (hipGetDevice(&dev) != hipSuccess || hipDeviceGetAttribute(&cus, hipDeviceAttributeMultiprocessorCount, dev) != hipSuccess) { grid = -1; return; }
        if (hipFuncSetAttribute((const void*)mk_fwd, hipFuncAttributeMaxDynamicSharedMemorySize, LDS_BYTES) != hipSuccess) { fprintf(stderr, "kernel_launch: hipFuncSetAttribute failed\n"); grid = -1; return; }
        if (hipOccupancyMaxActiveBlocksPerMultiprocessor(&per_cu, (const void*)mk_fwd, NTHR, LDS_BYTES) != hipSuccess || per_cu < 1) { fprintf(stderr, "kernel_launch: occupancy query says %d\n", per_cu); }
        (void)hipGetLastError();
        grid = cus;
    }
    if (grid < 0) return;
    (void)hipMemsetAsync((char*)d_ws + WS_CTL, 0, CTL_ZERO_BYTES, stream);
    Args a{};
    for (int i = 0; i < 40; ++i) a.in[i] = d_in[i];
    a.out = (float*)d_out; a.ws = (unsigned char*)d_ws;
#if MK_DEBUG
    const size_t fo_off = (WS_FAST_END + 4095) & ~(size_t)4095, nv_off = fo_off + (((size_t)O_END * 4 + 4095) & ~(size_t)4095), chk_off = nv_off + (((size_t)nv::WS_FLOATS * 4 + 4095) & ~(size_t)4095);
    if (ws_size < chk_off + 4096) { fprintf(stderr, "debug build: workspace too small (%zu < %zu)\n", ws_size, chk_off + 4096); return; }
    float* fast_out = (float*)((char*)d_ws + fo_off); float* nvws = (float*)((char*)d_ws + nv_off); double* chk = (double*)((char*)d_ws + chk_off);
    nv::forward(d_in, (float*)d_out, nvws, stream);
    a.out = fast_out;
    (void)hipMemsetAsync(chk, 0, 4096, stream);
#endif
#if MK_ONE_LAUNCH
    a.ph_lo = 0; a.ph_hi = N_PHASES; a.use_bar = 1;
    hipLaunchKernelGGL(mk_fwd, dim3(grid), dim3(NTHR), LDS_BYTES, stream, a);
#else
    for (int p = 0; p < N_PHASES; ++p) { a.ph_lo = p; a.ph_hi = p + 1; a.use_bar = 0; hipLaunchKernelGGL(mk_fwd, dim3(grid), dim3(NTHR), LDS_BYTES, stream, a); }
#endif
#if MK_DEBUG
    {
        const nv::Bufs B = nv::carve(nvws); unsigned char* ws = (unsigned char*)d_ws; int k = 0; const float* no = (const float*)d_out;
        auto cmp = [&](const void* fast, int isbf, long ldf, const float* ref, long ldr, long rows, long cols, float scale) {
            Chk c{fast, ref, isbf, rows, cols, ldf, ldr, scale}; hipLaunchKernelGGL(k_compare, dim3(1024), dim3(256), 0, stream, c, chk + 2 * k); ++k; };
        cmp(ws + WS_KB, 1, SBW, B.PROJ + 512, INW, MPR, SBW, 1.f);
        cmp(ws + WS_VB, 1, SBW, B.PROJ + 1024, INW, MPR, SBW, 1.f);
        cmp(ws + WS_QB, 1, SBW, B.PROJ, INW, MPR, SBW, 1.f / C2);
        hipLaunchKernelGGL(k_compare_xh, dim3(1024), dim3(256), 0, stream, (const unsigned short*)(ws + WS_XH), B.PROJ, B.HS, 0, chk + 2 * k); ++k;
        cmp(ws + WS_MKB, 1, D, no + O_MKP, D, NB * MT, D, 1.f);
        cmp(ws + WS_MVB, 1, D, no + O_MVP, D, NB * MT, D, 1.f);
        cmp(ws + WS_OSB, 1, SBW, B.OSB, SBW, MPR, SBW, 1.f);
        cmp(ws + WS_OSB + (size_t)MPR * SBW * 2, 1, SBW, B.OSB + (size_t)MPR * SBW, SBW, MS, SBW, 1.f);
        hipLaunchKernelGGL(k_compare_xh, dim3(1024), dim3(256), 0, stream, (const unsigned short*)(ws + WS_XH), B.PROJ, B.HS, 1, chk + 2 * k); ++k;
        cmp(ws + WS_YG, 1, SBW, B.YG, SBW, MPR, SBW, 1.f);
        cmp(ws + WS_YG + (size_t)MPR * SBW * 2, 1, SBW, B.YG + (size_t)MPR * SBW, SBW, MS, SBW, 1.f);
        cmp(ws + WS_OSSM, 1, SBW, B.OSSM, SBW, MALL, SBW, 1.f);
        cmp(ws + WS_X1, 0, D, B.X1, D, MALL, D, 1.f);
        cmp(ws + WS_QM, 1, D, B.Q, D, MALL, D, 1.f / CM);
        cmp(ws + WS_OMEM, 1, D, B.OM, D, MPR, D, 1.f);
        cmp(ws + WS_OMEM + (size_t)MPR * D * 2, 1, D, B.OM + (size_t)MPR * D, D, MS, D, 1.f);
        cmp(ws + WS_X2, 0, D, B.X2, D, MALL, D, 1.f);
        cmp(ws + WS_GB, 1, FF, B.G, FF, MALL, FF, 1.f);
        cmp(ws + WS_UB, 1, FF, B.ACT, FF, MALL, FF, 1.f);
        const size_t offs[15] = {O_YP, O_YS, O_KP, O_VP, O_REP, O_IMP, O_CVP, O_MKP, O_MVP, O_KS, O_VS, O_RES, O_IMS, O_CVS, O_END};
        for (int i = 0; i < 14; ++i) cmp(fast_out + offs[i], 0, 1, no + offs[i], 1, (long)(offs[i + 1] - offs[i]), 1, 1.f);
        hipLaunchKernelGGL(k_judge, dim3(1), dim3(64), 0, stream, (const double*)chk, k, 2e-3f, (float*)d_out);
    }
#endif
}
```

```cpp
#define MK_DEBUG 0
#define MK_ONE_LAUNCH 1
#define MK_PROBE 0
#include <hip/hip_runtime.h>
#include <cstdio>
#include <cstdint>
#include <cmath>
namespace pg8 {
#define PG8_LAS __attribute__((address_space(3)))
typedef unsigned short bf16_t;
typedef short bf16x8 __attribute__((ext_vector_type(8)));
typedef float f32x4 __attribute__((ext_vector_type(4)));
typedef unsigned u32x4 __attribute__((ext_vector_type(4)));
constexpr int BM = 256, BK = 64, HALF = 128, HTB = HALF * BK * 2  , STAGE_BYTES = 8 * HTB, NXCD = 8, WGM = 8;

__host__ __device__ __forceinline__ int lds_byte(int r, int c) { const int st = (r >> 4) * 2 + (c >> 5), rr = r & 15, cc = c & 31, ob = rr * 64 + cc * 2; return st * 1024 + (ob ^ (((ob >> 9) & 1) << 5)); }
__host__ __device__ __forceinline__ void stage_rc(int b, int& R, int& C) { const int st = b / 1024, sb = b % 1024, swz = sb ^ (((sb >> 9) & 1) << 5); R = (st >> 1) * 16 + swz / 64; C = (st & 1) * 32 + (swz % 64) / 2; }
__host__ __device__ __forceinline__ int perm32(int rho) { const int n = rho >> 4, i = rho & 15; return 8 * (i >> 2) + 4 * n + (i & 3); }

struct Unit { int pm, pn; };
struct Gemm { const bf16_t* A; const bf16_t* Bt; int lda, ldb, K; int bhalf = HALF; };

struct GridOrder {
    int nM, nN, nwg, G, c; size_t astep, bstep;
    __device__ void init(int nM_, int nN_, int G_, int c_, int shift, int lda, int ldb) { nM = nM_; nN = nN_; nwg = nM * nN; G = G_; c = (c_ + G_ - (shift % G_)) % G_; astep = (size_t)BM * lda * 2; bstep = (size_t)BM * ldb * 2; }
    __device__ bool next(int i, Unit& u) const {
        const long L = (long)i * G + c; if (L >= nwg) return false;
        int wgid = (int)L; { const int q = nwg / NXCD, r = nwg % NXCD, xcd = wgid % NXCD, off = wgid / NXCD; wgid = (xcd < r ? xcd * (q + 1) : r * (q + 1) + (xcd - r) * q) + off; }
        const int nig = WGM * nN, gid = wgid / nig, fm = gid * WGM, gsz = (nM - fm) < WGM ? (nM - fm) : WGM;
        u.pm = fm + ((wgid % nig) % gsz); u.pn = (wgid % nig) / gsz; return true;
    }
    __device__ __forceinline__ size_t aoff(const Unit& u) const { return (size_t)u.pm * astep; }
    __device__ __forceinline__ size_t boff(const Unit& u) const { return (size_t)u.pn * bstep; }
};

__device__ __forceinline__ unsigned cvt_pk_bf16(float lo, float hi) { unsigned r; asm volatile("v_cvt_pk_bf16_f32 %0, %1, %2" : "=v"(r) : "v"(lo), "v"(hi)); return r; }

template <class Epi, class Sched, bool ALIGN_EPI = true, bool SP2 = true>
__device__ __forceinline__ void gemm_phase(PG8_LAS unsigned char* lds, const Gemm g, const Sched& S, const Epi& E) {
    const int tid = threadIdx.x, wid = __builtin_amdgcn_readfirstlane(tid >> 6), lane = tid & 63, wr = wid >> 2, wc = wid & 3, fr = lane & 15, fq = lane >> 4;
    const int K = g.K, nt = K / BK;
    unsigned voffA[2], voffB[2];
#pragma unroll
    for (int i = 0; i < 2; ++i) { int R, C; stage_rc(tid * 16 + i * 8192, R, C); const int Rb = (R & ~31) + perm32(R & 31);
        voffA[i] = (unsigned)(R * g.lda + C) * 2u; voffB[i] = (unsigned)(Rb * g.ldb + C) * 2u; }
    const size_t kstep = (size_t)(BK * 2);
    const size_t hstepA = (size_t)HALF * g.lda * 2, hstepB = (size_t)g.bhalf * g.ldb * 2;
    const unsigned ldsw = (unsigned)wid * 1024u;
    const int aoff = lds_byte(wr * 64 + fr, fq * 8), boff = lds_byte(wc * 32 + fr, fq * 8);
#define PG8_SA(b, h) (((b) * 2 + (h)) * HTB)
#define PG8_SB(b, h) ((4 + (b) * 2 + (h)) * HTB)
#define PG8_STAGE(bufoff, gbase, voff) do { _Pragma("unroll") for (int _i = 0; _i < 2; ++_i) \
        __builtin_amdgcn_global_load_lds((const unsigned*)((const char*)(gbase) + (voff)[_i]), (PG8_LAS unsigned*)(lds + (bufoff) + ldsw + _i * 8192), 16, 0, 0); } while (0)
#define PG8_LDA(dst, b, h) do { _Pragma("unroll") for (int m = 0; m < 4; ++m) _Pragma("unroll") for (int k = 0; k < 2; ++k) dst[m][k] = *(const PG8_LAS bf16x8*)(lds + PG8_SA(b, h) + aoff + m * 2048 + k * 1024); } while (0)
#define PG8_LDB(dst, b, h) do { _Pragma("unroll") for (int n = 0; n < 2; ++n) _Pragma("unroll") for (int k = 0; k < 2; ++k) dst[n][k] = *(const PG8_LAS bf16x8*)(lds + PG8_SB(b, h) + boff + n * 2048 + k * 1024); } while (0)
#define PG8_MMA(ai, bj, At, Bt) do { __builtin_amdgcn_s_setprio(1); _Pragma("unroll") for (int m = 0; m < 4; ++m) _Pragma("unroll") for (int n = 0; n < 2; ++n) _Pragma("unroll") for (int k = 0; k < 2; ++k) \
        acc[ai][bj][m][n] = __builtin_amdgcn_mfma_f32_16x16x32_bf16(Bt[n][k], At[m][k], acc[ai][bj][m][n], 0, 0, 0); __builtin_amdgcn_s_setprio(0); } while (0)
#define PG8_WAIT_V(n) asm volatile("s_waitcnt vmcnt(" #n ")" ::: "memory")
#define PG8_WAIT_L(n) asm volatile("s_waitcnt lgkmcnt(" #n ")" ::: "memory")
#define PG8_BAR __builtin_amdgcn_s_barrier()
#define PG8_SCHED __builtin_amdgcn_sched_barrier(0)
    Unit cur, nxt; int ui = 0;
    if (!S.next(0, cur)) return;
    f32x4 acc[2][2][4][2];
#pragma unroll
    for (int a = 0; a < 2; ++a)
#pragma unroll
        for (int b = 0; b < 2; ++b)
#pragma unroll
            for (int m = 0; m < 4; ++m)
#pragma unroll
                for (int n = 0; n < 2; ++n) acc[a][b][m][n] = (f32x4){0.f, 0.f, 0.f, 0.f};
    bf16x8 At[4][2], B0[2][2], B1[2][2];
    const char* cA = (const char*)g.A + S.aoff(cur); const char* cB = (const char*)g.Bt + S.boff(cur);
    static_assert(SP2, "only the SP2 loop is kept in this file");
    PG8_STAGE(PG8_SB(0, 0), cB, voffB); PG8_STAGE(PG8_SB(0, 1), cB + hstepB, voffB); PG8_STAGE(PG8_SA(0, 0), cA, voffA); PG8_STAGE(PG8_SA(0, 1), cA + hstepA, voffA);
    if (wr == 1) PG8_BAR;
    PG8_WAIT_V(2); PG8_BAR;
    PG8_STAGE(PG8_SB(1, 0), cB + kstep, voffB); PG8_STAGE(PG8_SA(1, 0), cA + kstep, voffA); PG8_STAGE(PG8_SB(1, 1), cB + hstepB + kstep, voffB);
    PG8_WAIT_V(6); PG8_BAR;
    for (;;) {
        const bool has_next = S.next(ui + 1, nxt);
        const char* nA = has_next ? (const char*)g.A + S.aoff(nxt) : cA; const char* nB = has_next ? (const char*)g.Bt + S.boff(nxt) : cB;
        for (int t = 0; t < nt; t += 2) {
            const bool last = (t == nt - 2);
            const char* a1 = cA + (size_t)(t + 1) * kstep;
            const char* a2 = last ? nA : cA + (size_t)(t + 2) * kstep; const char* b2 = last ? nB : cB + (size_t)(t + 2) * kstep;
            const char* a3 = a2 + kstep; const char* b3 = b2 + kstep;
            PG8_LDB(B0, 0, 0); PG8_LDB(B1, 0, 1); PG8_SCHED; PG8_LDA(At, 0, 0); PG8_STAGE(PG8_SA(1, 1), a1 + hstepA, voffA);
            PG8_WAIT_V(8); PG8_WAIT_L(0); PG8_BAR; PG8_MMA(0, 0, At, B0); PG8_MMA(0, 1, At, B1); PG8_BAR; PG8_SCHED;
            PG8_LDA(At, 0, 1); PG8_STAGE(PG8_SB(0, 0), b2, voffB); PG8_STAGE(PG8_SB(0, 1), b2 + hstepB, voffB); PG8_STAGE(PG8_SA(0, 0), a2, voffA);
            PG8_WAIT_V(8); PG8_WAIT_L(0); PG8_BAR; PG8_MMA(1, 0, At, B0); PG8_MMA(1, 1, At, B1); PG8_BAR; PG8_SCHED;
            PG8_LDB(B0, 1, 0); PG8_LDB(B1, 1, 1); PG8_SCHED; PG8_LDA(At, 1, 0); PG8_STAGE(PG8_SA(0, 1), a2 + hstepA, voffA);
            PG8_WAIT_V(8); PG8_WAIT_L(0); PG8_BAR; PG8_MMA(0, 0, At, B0); PG8_MMA(0, 1, At, B1); PG8_BAR; PG8_SCHED;
            PG8_LDA(At, 1, 1); PG8_STAGE(PG8_SB(1, 0), b3, voffB); PG8_STAGE(PG8_SB(1, 1), b3 + hstepB, voffB); PG8_STAGE(PG8_SA(1, 0), a3, voffA);
            PG8_WAIT_V(8); PG8_WAIT_L(0); PG8_BAR; PG8_MMA(1, 0, At, B0); PG8_MMA(1, 1, At, B1); PG8_BAR; PG8_SCHED;
        }
        if constexpr (ALIGN_EPI) { if (wr == 0) PG8_BAR; }
        E(acc, cur, wr, wc, fr, fq);
        if (!has_next) break;
#pragma unroll
        for (int a = 0; a < 2; ++a)
#pragma unroll
            for (int b = 0; b < 2; ++b)
#pragma unroll
                for (int m = 0; m < 4; ++m)
#pragma unroll
                    for (int n = 0; n < 2; ++n) acc[a][b][m][n] = (f32x4){0.f, 0.f, 0.f, 0.f};
        cur = nxt; cA = nA; cB = nB; ++ui;
        if constexpr (ALIGN_EPI) { if (wr == 1) PG8_BAR; }
    }
    PG8_WAIT_V(0);
    if constexpr (!ALIGN_EPI) { if (wr == 0) PG8_BAR; }
    PG8_BAR;
#undef PG8_SA
#undef PG8_SB
#undef PG8_STAGE
#undef PG8_LDA
#undef PG8_LDB
#undef PG8_MMA
#undef PG8_WAIT_V
#undef PG8_WAIT_L
#undef PG8_BAR
#undef PG8_SCHED
}
}
constexpr int NWAVES = 8, NTHR = 512;
constexpr int D = 1024, NB = 4, T = 4096, MPR = NB * T, MS = 128, MALL = MPR + MS, MPAD = 16640;
constexpr int SBW = 512, NH = 8, HD = 64, NG = 32, GP = 16, NST = 64, INW = 2048, FF = 2816, NFF2 = 2 * FF;
constexpr int MT = 256, MH = 4, MHD = 256, PAST = 2048, PAGE = 128, NPG = 16;
constexpr int LC = 16, NCH = T / LC, XHP = 384;
constexpr float EPS = 1e-6f, LOG2E = 1.4426950408889634f;
constexpr float C2 = 0.125f * LOG2E;
constexpr float CM = 0.0625f * LOG2E;

constexpr size_t O_YP = 0, O_YS = O_YP + (size_t)MPR * D, O_KP = O_YS + (size_t)MS * D, O_VP = O_KP + (size_t)MPR * SBW, O_REP = O_VP + (size_t)MPR * SBW,
    O_IMP = O_REP + NB * NG * NST, O_CVP = O_IMP + NB * NG * NST, O_MKP = O_CVP + (size_t)NB * 2 * FF, O_MVP = O_MKP + (size_t)NB * MT * D, O_KS = O_MVP + (size_t)NB * MT * D,
    O_VS = O_KS + (size_t)MS * SBW, O_RES = O_VS + (size_t)MS * SBW, O_IMS = O_RES + (size_t)MS * NG * NST, O_CVS = O_IMS + (size_t)MS * NG * NST, O_END = O_CVS + (size_t)MS * 2 * FF;

constexpr size_t MiB = 1u << 20;
constexpr size_t al(size_t x) { return (x + 4095) & ~(size_t)4095; }
constexpr size_t WS_CTL = 0, CTL_ZERO_BYTES = 1 * MiB;
constexpr size_t WS_WIN = 1 * MiB;
constexpr size_t WS_WMKV = WS_WIN + al((size_t)INW * D * 2);
constexpr size_t WS_WGLU = WS_WMKV + al((size_t)2048 * D * 2);
constexpr size_t WS_WOUT = WS_WGLU + al((size_t)SBW * SBW * 2);
constexpr size_t WS_WMQ = WS_WOUT + al((size_t)D * D * 2);
constexpr size_t WS_WMO = WS_WMQ + al((size_t)D * D * 2);
constexpr size_t WS_WGU = WS_WMO + al((size_t)D * D * 2);
constexpr size_t WS_WDN = WS_WGU + al((size_t)NFF2 * D * 2);
constexpr size_t WS_W1 = WS_WDN + al((size_t)D * FF * 2);
constexpr size_t WS_BTC = WS_W1 + al((size_t)33 * 128 * 256 * 2);
constexpr size_t WS_XB = WS_BTC + al((size_t)NG * 256 * XHP * 2);
constexpr size_t WS_RSTD0 = WS_XB + al((size_t)MPAD * D * 2);
constexpr size_t WS_MB = WS_RSTD0 + al((size_t)MPAD * 4);
constexpr size_t WS_RSTDM = WS_MB + al((size_t)1024 * D * 2);
constexpr size_t WS_QB = WS_RSTDM + al(4096);
constexpr size_t WS_KB = WS_QB + al((size_t)MPAD * SBW * 2);
constexpr size_t WS_VB = WS_KB + al((size_t)MPAD * SBW * 2);
constexpr size_t WS_QS = WS_VB + al((size_t)MPAD * SBW * 2);
constexpr size_t WS_US = WS_QS + al((size_t)MS * SBW * 4);
constexpr size_t WS_XH = WS_US + al((size_t)MS * SBW * 4);
constexpr size_t WS_SST = WS_XH + al((size_t)1024 * NG * XHP * 2 + 65536);
constexpr size_t WS_YG = WS_SST + al((size_t)1024 * NG * 128 * 4);
constexpr size_t WS_OSB = WS_YG + al((size_t)MPAD * SBW * 2);
constexpr size_t WS_OSSM = WS_OSB + al((size_t)MPAD * SBW * 2);
constexpr size_t WS_SBPO = WS_OSSM + al((size_t)MPAD * SBW * 2);
constexpr size_t WS_SBPL = WS_SBPO + al((size_t)MS * NPG * NH * HD * 4);
constexpr size_t WS_MIX = WS_SBPL + al((size_t)MS * NPG * NH * 4);
constexpr size_t WS_X1 = WS_MIX + al((size_t)MPAD * D * 2);
constexpr size_t WS_X1B = WS_X1 + al((size_t)MPAD * D * 4);
constexpr size_t WS_MKB = WS_X1B + al((size_t)MPAD * D * 2);
constexpr size_t WS_MVB = WS_MKB + al((size_t)1024 * D * 2);
constexpr size_t WS_QM = WS_MVB + al((size_t)1024 * D * 2);
constexpr size_t WS_OMEM = WS_QM + al((size_t)MPAD * D * 2);
constexpr size_t WS_X2 = WS_OMEM + al((size_t)MPAD * D * 2);
constexpr size_t WS_X2B = WS_X2 + al((size_t)MPAD * D * 4);
constexpr size_t WS_GB = WS_X2B + al((size_t)MPAD * D * 2);
constexpr size_t WS_UB = WS_GB + al((size_t)MPAD * FF * 2);
constexpr size_t WS_FAST_END = WS_UB + al((size_t)MPAD * FF * 2);
constexpr int CW_TMO = 0, CW_CODE = 1, CW_QA = 2048, CW_QM = 2112, CW_BAR = 4096;
constexpr int CW_SSQ1 = 16384, CW_SSQ2 = CW_SSQ1 + MPAD, CW_SSQ3 = CW_SSQ2 + MPAD;
static_assert((CW_SSQ3 + MPAD) * 4 <= (int)CTL_ZERO_BYTES, "CTL words inside the memset region");

constexpr int RING_OFF = 0, RING_BYTES = 131072;
constexpr int LDSCTL_OFF = RING_BYTES, MISC_OFF = LDSCTL_OFF + 320;
constexpr int LDS_BYTES = 147456;
static_assert(MISC_OFF + 128 <= LDS_BYTES, "LDS map");

#define GAS __attribute__((address_space(1)))
#define LAS __attribute__((address_space(3)))
typedef unsigned short bf16;
typedef unsigned v4u __attribute__((ext_vector_type(4)));
typedef unsigned v2u __attribute__((ext_vector_type(2)));
typedef float f32x4 __attribute__((ext_vector_type(4)));
typedef float f32x2 __attribute__((ext_vector_type(2)));
typedef float f32x16 __attribute__((ext_vector_type(16)));
typedef short bf16x8 __attribute__((ext_vector_type(8)));
typedef short s16x4 __attribute__((ext_vector_type(4)));
typedef GAS unsigned gu32;
#define RLX_AGENT __ATOMIC_RELAXED, __HIP_MEMORY_SCOPE_AGENT
#define LDS_WAIT() asm volatile("s_waitcnt lgkmcnt(0)" ::: "memory")
#define VM_WAIT() asm volatile("s_waitcnt vmcnt(0)" ::: "memory")
__device__ __forceinline__ unsigned f2bf(float f) { unsigned u = __builtin_bit_cast(unsigned, f); return (u + 0x7fffu + ((u >> 16) & 1u)) >> 16; }
__device__ __forceinline__ unsigned pk2(float lo, float hi) { return f2bf(lo) | (f2bf(hi) << 16); }
__device__ __forceinline__ float bf2f(unsigned short h) { return __builtin_bit_cast(float, (unsigned)h << 16); }
__device__ __forceinline__ float bflo(unsigned w) { return __builtin_bit_cast(float, w << 16); }
__device__ __forceinline__ float bfhi(unsigned w) { return __builtin_bit_cast(float, w & 0xffff0000u); }
__device__ __forceinline__ unsigned cvtpk(float lo, float hi) { return pg8::cvt_pk_bf16(lo, hi); }
__device__ __forceinline__ float gelu_tanh_f(float x) {
    const float u2 = 2.f * 0.7978845608028654f * (x + 0.044715f * x * x * x);
    return x * __builtin_amdgcn_rcpf(1.f + __builtin_amdgcn_exp2f(-u2 * LOG2E));
}
__device__ __forceinline__ float wave_sum(float v) {
#pragma unroll
    for (int o = 1; o < 64; o <<= 1) v += __shfl_xor(v, o);
    return v;
}

#define XB_TMO      128
#define XB_XCNT(j)  (256  + 64 * (j))
#define XB_XSUB(j)  (1280 + 64 * (j))
#define XB_XGEN(j)  (2304 + 64 * (j))
#define XB_TOP      3328
#define XB_TOPGEN   3392
#define XCD_BAR_WORDS 3456
#define XB_SPIN_CAP (1u << 18)
__device__ __forceinline__ unsigned xb_ld(unsigned* p)              { return __hip_atomic_load(p, __ATOMIC_RELAXED, __HIP_MEMORY_SCOPE_AGENT); }
__device__ __forceinline__ unsigned xb_add(unsigned* p, unsigned v) { return __hip_atomic_fetch_add(p, v, __ATOMIC_RELAXED, __HIP_MEMORY_SCOPE_AGENT); }
__device__ __forceinline__ unsigned xb_xcc_id() { return (unsigned)__builtin_amdgcn_s_getreg((3 << 11) | 20) & 0xFu; }
#define XB_SPIN(cond, bar) do { unsigned _sp = 0; while (cond) { __builtin_amdgcn_s_sleep(1); \
    if ((++_sp & 255u) == 0u) { if (xb_ld(&(bar)[XB_TMO])) break; if (_sp > XB_SPIN_CAP) { atomicAdd(&(bar)[XB_TMO], 1u); break; } } } } while (0)
struct XcdBarrier { unsigned* bar; unsigned x; volatile LAS unsigned* st; };
__device__ __forceinline__ XcdBarrier xcd_barrier_post(unsigned* bar, volatile LAS unsigned* st) {
    XcdBarrier b; b.bar = bar; b.x = xb_xcc_id(); b.st = st;
    if (threadIdx.x == 0) (void)xb_add(&bar[XB_XCNT(b.x)], 1u);
    return b;
}
__device__ __forceinline__ void xcd_barrier_complete(unsigned* bar, unsigned x, unsigned& nloc, unsigned& nx) {
    const unsigned G = gridDim.x * gridDim.y * gridDim.z;
    unsigned sum, cnt, mine, sp = 0u;
    for (;;) {
        sum = 0u; cnt = 0u; mine = 0u;
#pragma unroll
        for (unsigned j = 0; j < 16; ++j) { const unsigned c = xb_ld(&bar[XB_XCNT(j)]); sum += c; cnt += (c > 0u) ? 1u : 0u; mine = (j == x) ? c : mine; }
        if (sum == G) break;
        __builtin_amdgcn_s_sleep(1);
        if ((++sp & 255u) == 0u) { if (xb_ld(&bar[XB_TMO])) break; if (sp > XB_SPIN_CAP) { atomicAdd(&bar[XB_TMO], 1u); break; } }
    }
    nloc = mine > 0u ? mine : 1u; nx = cnt > 0u ? cnt : 1u;
}
__device__ __forceinline__ void xcd_barrier(const XcdBarrier& b) {
    asm volatile("s_waitcnt vmcnt(0)" ::: "memory");
    __syncthreads();
    if (threadIdx.x == 0) {
        unsigned* bar = b.bar;
        __builtin_amdgcn_s_waitcnt(0);
        unsigned nloc = b.st[0], nx = b.st[1];
        if (nloc == 0u) { xcd_barrier_complete(bar, b.x, nloc, nx); b.st[0] = nloc; b.st[1] = nx; }
        const unsigned old = xb_add(&bar[XB_XSUB(b.x)], 1u);
        const unsigned gen = old / nloc;
        if (old + 1u == (gen + 1u) * nloc) {
            __builtin_amdgcn_fence(__ATOMIC_RELEASE, "agent");
            asm volatile("s_waitcnt vmcnt(0)" ::: "memory");
            const unsigned og = xb_add(&bar[XB_TOP], 1u);
            const unsigned tg = og / nx;
            if (og + 1u == (tg + 1u) * nx) xb_add(&bar[XB_TOPGEN], 1u);
            else XB_SPIN(xb_ld(&bar[XB_TOPGEN]) == tg, bar);
            __builtin_amdgcn_fence(__ATOMIC_ACQUIRE, "agent");
            xb_add(&bar[XB_XGEN(b.x)], 1u);
            asm volatile("s_waitcnt vmcnt(0)" ::: "memory");
        } else {
            XB_SPIN(xb_ld(&bar[XB_XGEN(b.x)]) == gen, bar);
            __builtin_amdgcn_fence(__ATOMIC_ACQUIRE, "agent");
            asm volatile("s_waitcnt vmcnt(0)" ::: "memory");
        }
    }
    __syncthreads();
}

struct Args { const void* in[40]; float* out; unsigned char* ws; int ph_lo, ph_hi, use_bar, pad; };
struct Frame {
    LAS unsigned char* lds; volatile LAS unsigned* MISC; unsigned* ctl;
    int tid, lane, wave, vcu, G;
    unsigned char* ws; float* out; const void* const* in;
};
#define INF(i) ((const float*)F.in[i])
#define WSP(T_, off) ((T_*)(F.ws + (off)))
__device__ __forceinline__ void p0_transpose_item(const float* W, int K, int N, bf16* WT, int row_off, const float* gain, LAS float* scr, int item, int lane) {
    const int nblk = N / 32, kb = item / nblk, nb = item % nblk, k0 = 64 * kb, n0 = 32 * nb;
#pragma unroll 8
    for (int i = 0; i < 32; ++i) { const int kk = 2 * i + (lane >> 5); const float gv = gain ? gain[k0 + kk] : 1.f; scr[kk * 33 + (lane & 31)] = W[(size_t)(k0 + kk) * N + n0 + (lane & 31)] * gv; }
    LDS_WAIT(); asm volatile("" ::: "memory");
    const int c = lane & 7;
#pragma unroll
    for (int j = 0; j < 4; ++j) { const int n = (lane >> 3) + 8 * j; const LAS float* s = scr + (8 * c) * 33 + n;
        v4u o; o.x = pk2(s[0 * 33], s[1 * 33]); o.y = pk2(s[2 * 33], s[3 * 33]); o.z = pk2(s[4 * 33], s[5 * 33]); o.w = pk2(s[6 * 33], s[7 * 33]);
        *(GAS v4u*)(WT + (size_t)(row_off + n0 + n) * K + k0 + 8 * c) = o; }
    LDS_WAIT(); asm volatile("" ::: "memory");
}
__device__ __forceinline__ void row_to_bf16_rstd(const float* xrow, bf16* orow, float* rstd, int lane) {
    const GAS f32x4* xr = (const GAS f32x4*)xrow + lane;
    f32x4 v[4]; float s = 0.f;
#pragma unroll
    for (int j = 0; j < 4; ++j) { v[j] = xr[64 * j]; s += (v[j].x * v[j].x + v[j].y * v[j].y) + (v[j].z * v[j].z + v[j].w * v[j].w); }
    s = wave_sum(s);
    GAS v2u* o8 = (GAS v2u*)orow + lane;
#pragma unroll
    for (int j = 0; j < 4; ++j) { v2u w; w.x = pk2(v[j].x, v[j].y); w.y = pk2(v[j].z, v[j].w); o8[64 * j] = w; }
    if (lane == 0) *rstd = 1.f / sqrtf(s * (1.f / D) + EPS);
}
__device__ __forceinline__ void lam_pow(float lr, float li, float logdt, int tau, float& pr, float& pi) {
    const double dt = exp((double)logdt);
    const double ang = (double)li * dt * (double)tau;
    const double k = rint(ang * 0.15915494309189535);
    double r = fma(-k, 6.283185307179586, ang); r = fma(-k, 2.4492935982947064e-16, r);
    const float rf = (float)r, mag = (float)exp((double)lr * dt * (double)tau);
    pr = mag * cosf(rf); pi = mag * sinf(rf);
}
__device__ __forceinline__ void lam_coef(float lr, float li, float logdt, float& cr, float& ci) {
    const double dt = exp((double)logdt);
    const double ang = (double)li * dt;
    const double k = rint(ang * 0.15915494309189535);
    double r = fma(-k, 6.283185307179586, ang); r = fma(-k, 2.4492935982947064e-16, r);
    const float th = (float)r, a = (float)((double)lr * dt);
    const float sh = sinf(0.5f * th);
    const float nr = expm1f(a) * cosf(th) - 2.f * sh * sh, ni = expf(a) * sinf(th);
    const float den = lr * lr + li * li;
    cr = (nr * lr + ni * li) / den; ci = (ni * lr - nr * li) / den;
}
__device__ __forceinline__ void ssm_table_unit(Frame& F, int g, int tau) {
    LAS float* Mr = (LAS float*)(F.lds + RING_OFF); LAS float* Mi = Mr + 1024; LAS float* Pr = Mi + 1024; LAS float* Pi = Pr + 64; LAS float* Kt = Pi + 64;
    const float* lam_re = INF(14); const float* lam_im = INF(15); const float* log_dt = INF(16); const float* b_re = INF(17); const float* b_im = INF(18);
    const float* c_re = INF(19); const float* c_im = INF(20); const float* d_skip = INF(21);
    bf16* W1 = WSP(bf16, WS_W1); bf16* BTC = WSP(bf16, WS_BTC);
    const int tid = F.tid; const float ldt = log_dt[g];
    __syncthreads();
    if (tid < 64) { float pr, pi; lam_pow(lam_re[g * NST + tid], lam_im[g * NST + tid], ldt, tau, pr, pi); Pr[tid] = pr; Pi[tid] = pi; }
    __syncthreads();
    for (int i = tid; i < 1024; i += NTHR) { const int n = i >> 4, q = i & 15; float cr, ci; lam_coef(lam_re[g * NST + n], lam_im[g * NST + n], ldt, cr, ci);
        const float br = b_re[(g * NST + n) * GP + q], bi = b_im[(g * NST + n) * GP + q]; const float bbr = cr * br - ci * bi, bbi = cr * bi + ci * br;
        const float pr = Pr[n], pi = Pi[n]; Mr[i] = pr * bbr - pi * bbi; Mi[i] = pr * bbi + pi * bbr; }
    __syncthreads();
    if (tau <= 15) {
        const int s = 15 - tau;
        for (int i = tid; i < 2048; i += NTHR) { const int n = i >> 5, ri = (i >> 4) & 1, q = i & 15; const float v = ri ? Mi[n * 16 + q] : Mr[n * 16 + q];
            W1[((size_t)g * 128 + 2 * n + ri) * 256 + s * 16 + q] = (bf16)f2bf(v); }
        if (tid < 256) { const int p = tid >> 4, q = tid & 15; float acc = 0.f;
            for (int n = 0; n < NST; ++n) acc += c_re[(g * GP + p) * NST + n] * Mr[n * 16 + q] - c_im[(g * GP + p) * NST + n] * Mi[n * 16 + q];
            if (tau == 0 && p == q) acc += d_skip[g * GP + p];
            Kt[tid] = acc; }
        __syncthreads();
        for (int idx = tid; idx < (16 - tau) * 256; idx += NTHR) { const int blk = idx >> 8, e = idx & 255, p = e >> 4, q = e & 15; const int s2 = blk, t2 = s2 + tau;
            BTC[((size_t)g * 256 + t2 * 16 + p) * XHP + s2 * 16 + q] = (bf16)f2bf(Kt[e]);
            if (tau >= 1) BTC[((size_t)g * 256 + s2 * 16 + p) * XHP + t2 * 16 + q] = (bf16)0; }
    }
    if (tau >= 1) {
        const int t2 = tau - 1;
        for (int idx = tid; idx < 1024; idx += NTHR) { const int p = idx >> 6, n = idx & 63; const float cr = c_re[(g * GP + p) * NST + n], ci = c_im[(g * GP + p) * NST + n], pr = Pr[n], pi = Pi[n];
            v2u dummy; (void)dummy;
            const unsigned w = pk2(cr * pr - ci * pi, -(cr * pi + ci * pr));
            *(GAS unsigned*)(BTC + ((size_t)g * 256 + t2 * 16 + p) * XHP + 256 + 2 * n) = w; }
    }
    __syncthreads();
}
__device__ __forceinline__ void p0_prologue(Frame& F) {
    LAS float* scr = (LAS float*)(F.lds + RING_OFF + F.wave * 16384);
    const int gw = F.vcu * NWAVES + F.wave, NGW = F.G * NWAVES;
    constexpr int I_IN = 16 * 64, I_MK = 16 * 32, I_GLU = 8 * 16, I_SQ = 16 * 32, I_G = 16 * 88, I_DN = 44 * 32;
    constexpr int NITEMS = I_IN + 2 * I_MK + I_GLU + 3 * I_SQ + 2 * I_G + I_DN;
    for (int it = gw; it < NITEMS; it += NGW) {
        int r = it;
        if (r < I_IN) { p0_transpose_item(INF(12), D, INW, WSP(bf16, WS_WIN), 0, INF(11), scr, r, F.lane); continue; } r -= I_IN;
        if (r < I_MK) { p0_transpose_item(INF(30), D, D, WSP(bf16, WS_WMKV), 0, INF(28), scr, r, F.lane); continue; } r -= I_MK;
        if (r < I_MK) { p0_transpose_item(INF(31), D, D, WSP(bf16, WS_WMKV), D, INF(28), scr, r, F.lane); continue; } r -= I_MK;
        if (r < I_GLU) { p0_transpose_item(INF(22), SBW, SBW, WSP(bf16, WS_WGLU), 0, nullptr, scr, r, F.lane); continue; } r -= I_GLU;
        if (r < I_SQ) { const int kb = r / (D / 32); const float* gn = (kb < 8) ? INF(24) : INF(25) - SBW; p0_transpose_item(INF(26), D, D, WSP(bf16, WS_WOUT), 0, gn, scr, r, F.lane); continue; } r -= I_SQ;
        if (r < I_SQ) { p0_transpose_item(INF(29), D, D, WSP(bf16, WS_WMQ), 0, INF(27), scr, r, F.lane); continue; } r -= I_SQ;
        if (r < I_SQ) { p0_transpose_item(INF(32), D, D, WSP(bf16, WS_WMO), 0, nullptr, scr, r, F.lane); continue; } r -= I_SQ;
        if (r < I_G) { p0_transpose_item(INF(34), D, FF, WSP(bf16, WS_WGU), 0, INF(33), scr, r, F.lane); continue; } r -= I_G;
        if (r < I_G) { p0_transpose_item(INF(35), D, FF, WSP(bf16, WS_WGU), FF, INF(33), scr, r, F.lane); continue; } r -= I_G;
        p0_transpose_item(INF(38), FF, D, WSP(bf16, WS_WDN), 0, nullptr, scr, r, F.lane);
    }
    for (int m = gw; m < MALL; m += NGW) { const float* xr = (m < MPR) ? INF(0) + (size_t)m * D : INF(1) + (size_t)(m - MPR) * D;
        row_to_bf16_rstd(xr, WSP(bf16, WS_XB) + (size_t)m * D, WSP(float, WS_RSTD0) + m, F.lane); }
    for (int m = gw; m < NB * MT; m += NGW) row_to_bf16_rstd(INF(10) + (size_t)m * D, WSP(bf16, WS_MB) + (size_t)m * D, WSP(float, WS_RSTDM) + m, F.lane);
    for (int u = F.vcu; u < NG * 17; u += F.G) ssm_table_unit(F, u / 17, u % 17);
    { bf16* W1 = WSP(bf16, WS_W1); for (int i = gw * 64 + F.lane; i < 128 * 256 / 8; i += NGW * 64) *(GAS v4u*)(W1 + (size_t)32 * 128 * 256 + (size_t)i * 8) = (v4u){0u, 0u, 0u, 0u}; }
}

#define EPI_LOOP_BEGIN \
    _Pragma("unroll") for (int ai = 0; ai < 2; ++ai) _Pragma("unroll") for (int m = 0; m < 4; ++m) { const int row = u.pm * 256 + ai * 128 + wr * 64 + m * 16 + fr; \
    _Pragma("unroll") for (int bj = 0; bj < 2; ++bj) { const int col = u.pn * 256 + bj * 128 + wc * 32 + 8 * fq; f32x4 v0 = acc[ai][bj][m][0], v1 = acc[ai][bj][m][1];
#define EPI_LOOP_END } }
__device__ __forceinline__ v4u pack8(f32x4 a, f32x4 b) { v4u w; w.x = cvtpk(a[0], a[1]); w.y = cvtpk(a[2], a[3]); w.z = cvtpk(b[0], b[1]); w.w = cvtpk(b[2], b[3]); return w; }

struct EpiInProj {
    const float* rstd; bf16 *QBp, *KBp, *VBp, *XHp; float *QSp, *USp, *out;
    __device__ __forceinline__ void operator()(const f32x4 (&acc)[2][2][4][2], const pg8::Unit& u, int wr, int wc, int fr_, int fq_) const { int fr = fr_, fq = fq_; asm volatile("" : "+v"(fr), "+v"(fq));
        const int sect = u.pn >> 1;
        EPI_LOOP_BEGIN
            if (row < MALL) {
                const float rs = rstd[row]; v0 = v0 * rs; v1 = v1 * rs;
                const int c = col - sect * SBW;
                if (sect == 0) { v0 = v0 * C2; v1 = v1 * C2; *(v4u*)(QBp + (size_t)row * SBW + c) = pack8(v0, v1);
                    if (row >= MPR) { float* q = QSp + (size_t)(row - MPR) * SBW + c; *(f32x4*)q = v0; *(f32x4*)(q + 4) = v1; } }
                else if (sect == 1 || sect == 2) { bf16* B = (sect == 1) ? KBp : VBp; *(v4u*)(B + (size_t)row * SBW + c) = pack8(v0, v1);
                    float* o = (row < MPR) ? out + (sect == 1 ? O_KP : O_VP) + (size_t)row * SBW + c : out + (sect == 1 ? O_KS : O_VS) + (size_t)(row - MPR) * SBW + c;
                    *(f32x4*)o = v0; *(f32x4*)(o + 4) = v1; }
                else { if (row < MPR) { const int b = row >> 12, t = row & 4095, ch = t >> 4, s = t & 15, g = c >> 4, q0 = c & 15;
                        *(v4u*)(XHp + ((size_t)(b * NCH + ch) * NG + g) * XHP + s * 16 + q0) = pack8(v0, v1); }
                    else { float* q = USp + (size_t)(row - MPR) * SBW + c; *(f32x4*)q = v0; *(f32x4*)(q + 4) = v1; } }
            }
        EPI_LOOP_END
    }
};
struct EpiMemKV {
    const float* rstd; bf16 *MKBp, *MVBp; float* out;
    __device__ __forceinline__ void operator()(const f32x4 (&acc)[2][2][4][2], const pg8::Unit& u, int wr, int wc, int fr_, int fq_) const { int fr = fr_, fq = fq_; asm volatile("" : "+v"(fr), "+v"(fq));
        const int sect = u.pn >> 2;
        EPI_LOOP_BEGIN
            const float rs = rstd[row]; v0 = v0 * rs; v1 = v1 * rs; const int c = col - sect * D;
            bf16* B = sect ? MVBp : MKBp; *(v4u*)(B + (size_t)row * D + c) = pack8(v0, v1);
            float* o = out + (sect ? O_MVP : O_MKP) + (size_t)row * D + c; *(f32x4*)o = v0; *(f32x4*)(o + 4) = v1;
        EPI_LOOP_END
    }
};
struct EpiSsmA {
    float* SST;
    __device__ __forceinline__ void operator()(const f32x4 (&acc)[2][2][4][2], const pg8::Unit& u, int wr, int wc, int fr_, int fq_) const { int fr = fr_, fq = fq_; asm volatile("" : "+v"(fr), "+v"(fq));
        _Pragma("unroll") for (int ai = 0; ai < 2; ++ai) _Pragma("unroll") for (int m = 0; m < 4; ++m) { const int row = u.pm * 256 + ai * 128 + wr * 64 + m * 16 + fr;
            const int col = wc * 32 + 8 * fq; float* o = SST + ((size_t)row * NG + u.pn) * 128 + col; *(f32x4*)o = acc[ai][0][m][0]; *(f32x4*)(o + 4) = acc[ai][0][m][1]; }
    }
};
struct EpiSsmC {
    bf16* YG;
    __device__ __forceinline__ void operator()(const f32x4 (&acc)[2][2][4][2], const pg8::Unit& u, int wr, int wc, int fr_, int fq_) const { int fr = fr_, fq = fq_; asm volatile("" : "+v"(fr), "+v"(fq));
        _Pragma("unroll") for (int ai = 0; ai < 2; ++ai) _Pragma("unroll") for (int m = 0; m < 4; ++m) { const int ch = ai * 128 + wr * 64 + m * 16 + fr;
            _Pragma("unroll") for (int bj = 0; bj < 2; ++bj) { const int col = bj * 128 + wc * 32 + 8 * fq, t = col >> 4, p0 = col & 15; f32x4 v0 = acc[ai][bj][m][0], v1 = acc[ai][bj][m][1];
                _Pragma("unroll") for (int e = 0; e < 4; ++e) { v0[e] = gelu_tanh_f(v0[e]); v1[e] = gelu_tanh_f(v1[e]); }
                *(v4u*)(YG + ((size_t)u.pm * T + ch * LC + t) * SBW + u.pn * GP + p0) = pack8(v0, v1); } }
    }
};
struct EpiGlu {
    const bf16* YG; const float* bglu; bf16* OSSM;
    __device__ __forceinline__ void operator()(const f32x4 (&acc)[2][2][4][2], const pg8::Unit& u, int wr, int wc, int fr_, int fq_) const { int fr = fr_, fq = fq_; asm volatile("" : "+v"(fr), "+v"(fq));
        EPI_LOOP_BEGIN
            if (row < MALL) {
                const v4u yw = *(const v4u*)(YG + (size_t)row * SBW + col); const f32x4 b0 = *(const f32x4*)(bglu + col), b1 = *(const f32x4*)(bglu + col + 4);
                const float y[8] = {bflo(yw.x), bfhi(yw.x), bflo(yw.y), bfhi(yw.y), bflo(yw.z), bfhi(yw.z), bflo(yw.w), bfhi(yw.w)};
                _Pragma("unroll") for (int e = 0; e < 4; ++e) { v0[e] = y[e] * __builtin_amdgcn_rcpf(1.f + __builtin_amdgcn_exp2f(-(v0[e] + b0[e]) * LOG2E));
                                                                 v1[e] = y[4 + e] * __builtin_amdgcn_rcpf(1.f + __builtin_amdgcn_exp2f(-(v1[e] + b1[e]) * LOG2E)); }
                *(v4u*)(OSSM + (size_t)row * SBW + col) = pack8(v0, v1);
            }
        EPI_LOOP_END
    }
};
struct EpiResid {
    const float* base0; const float* base1; float* xo; bf16* xb; float* ssq;
    __device__ __forceinline__ void operator()(const f32x4 (&acc)[2][2][4][2], const pg8::Unit& u, int wr, int wc, int fr_, int fq_) const { int fr = fr_, fq = fq_; asm volatile("" : "+v"(fr), "+v"(fq));
        _Pragma("unroll") for (int ai = 0; ai < 2; ++ai) _Pragma("unroll") for (int m = 0; m < 4; ++m) { const int row = u.pm * 256 + ai * 128 + wr * 64 + m * 16 + fr; float sq = 0.f;
            const bool ok = row < MALL; const float* bp = (row < MPR) ? base0 + (size_t)row * D : base1 + (size_t)(row - MPR) * D;
            _Pragma("unroll") for (int bj = 0; bj < 2; ++bj) { const int col = u.pn * 256 + bj * 128 + wc * 32 + 8 * fq; f32x4 v0 = acc[ai][bj][m][0], v1 = acc[ai][bj][m][1];
                if (ok) { v0 = v0 + *(const f32x4*)(bp + col); v1 = v1 + *(const f32x4*)(bp + col + 4);
                    float* o = xo + (size_t)row * D + col; *(f32x4*)o = v0; *(f32x4*)(o + 4) = v1;
                    if (xb) *(v4u*)(xb + (size_t)row * D + col) = pack8(v0, v1);
                    sq += (v0[0] * v0[0] + v0[1] * v0[1]) + (v0[2] * v0[2] + v0[3] * v0[3]) + (v1[0] * v1[0] + v1[1] * v1[1]) + (v1[2] * v1[2] + v1[3] * v1[3]); } }
            sq += __shfl_xor(sq, 16); sq += __shfl_xor(sq, 32);
            if (ok && fq == 0) atomicAdd(ssq + row, sq); }
    }
};
struct EpiScaleBf16 {
    const float* ssq; float scale; bf16* O;
    __device__ __forceinline__ void operator()(const f32x4 (&acc)[2][2][4][2], const pg8::Unit& u, int wr, int wc, int fr_, int fq_) const { int fr = fr_, fq = fq_; asm volatile("" : "+v"(fr), "+v"(fq));
        EPI_LOOP_BEGIN
            if (row < MALL) { const float rs = scale / sqrtf(ssq[row] * (1.f / D) + EPS); v0 = v0 * rs; v1 = v1 * rs; *(v4u*)(O + (size_t)row * D + col) = pack8(v0, v1); }
        EPI_LOOP_END
    }
};
struct EpiGateUp {
    const float* ssq; bf16 *GBp, *UBp; float* out;
    __device__ __forceinline__ void operator()(const f32x4 (&acc)[2][2][4][2], const pg8::Unit& u, int wr, int wc, int fr_, int fq_) const { int fr = fr_, fq = fq_; asm volatile("" : "+v"(fr), "+v"(fq));
        const bool up = u.pn >= 11;
        EPI_LOOP_BEGIN
            if (row < MALL) { const float rs = 1.f / sqrtf(ssq[row] * (1.f / D) + EPS); v0 = v0 * rs; v1 = v1 * rs;
                if (up) *(v4u*)(UBp + (size_t)row * FF + (col - FF)) = pack8(v0, v1);
                else { *(v4u*)(GBp + (size_t)row * FF + col) = pack8(v0, v1);
                    if (row >= MPR) { float* o = out + O_CVS + ((size_t)(row - MPR) * 2 + 1) * FF + col; *(f32x4*)o = v0; *(f32x4*)(o + 4) = v1; }
                    else { const int t = row & 4095; if (t >= T - 2) { float* o = out + O_CVP + ((size_t)(row >> 12) * 2 + (t - (T - 2))) * FF + col; *(f32x4*)o = v0; *(f32x4*)(o + 4) = v1; } } } }
        EPI_LOOP_END
    }
};
struct SsmOrder {
    int G, c; size_t bstride;
    __device__ bool next(int i, pg8::Unit& u) const { const int L = i * G + c; if (L >= NG * NB) return false; u.pn = L >> 2; u.pm = L & 3; return true; }
    __device__ __forceinline__ size_t aoff(const pg8::Unit& u) const { return ((size_t)u.pm * NCH * NG * XHP + (size_t)u.pn * XHP) * 2; }
    __device__ __forceinline__ size_t boff(const pg8::Unit& u) const { return (size_t)u.pn * bstride; }
};
template <class Epi>
__device__ __forceinline__ void skinny_gemm(Frame& F, const bf16* A, int lda, const bf16* Bt, int ldb, int N, int K, const Epi& E, int u0, int ustride, int ustep = 32, int nb1off = 16) {
    const int lane = F.lane, wid = F.wave; const int kw = K >> 3, nks = kw >> 5;
    LAS float* red = (LAS float*)(F.lds + RING_OFF);
    for (int u = u0; u < N / ustep; u += ustride) {
        f32x4 acc[2][8];
#pragma unroll
        for (int nb = 0; nb < 2; ++nb)
#pragma unroll
            for (int mb = 0; mb < 8; ++mb) acc[nb][mb] = (f32x4){0.f, 0.f, 0.f, 0.f};
        const bf16* wp = Bt + (size_t)(u * ustep + (lane & 15)) * ldb + wid * kw + 8 * (lane >> 4);
        const bf16* ap = A + (size_t)(lane & 15) * lda + wid * kw + 8 * (lane >> 4);
        for (int ks = 0; ks < nks; ++ks) {
            bf16x8 wf[2], af[8];
            wf[0] = *(const bf16x8*)(wp + ks * 32); wf[1] = *(const bf16x8*)(wp + (size_t)nb1off * ldb + ks * 32);
#pragma unroll
            for (int mb = 0; mb < 8; ++mb) af[mb] = *(const bf16x8*)(ap + (size_t)mb * 16 * lda + ks * 32);
#pragma unroll
            for (int nb = 0; nb < 2; ++nb)
#pragma unroll
                for (int mb = 0; mb < 8; ++mb) acc[nb][mb] = __builtin_amdgcn_mfma_f32_16x16x32_bf16(wf[nb], af[mb], acc[nb][mb], 0, 0, 0);
        }
        __syncthreads();
#pragma unroll
        for (int nb = 0; nb < 2; ++nb)
#pragma unroll
            for (int mb = 0; mb < 8; ++mb) *(LAS f32x4*)(red + ((wid * 16 + nb * 8 + mb) * 64 + lane) * 4) = acc[nb][mb];
        __syncthreads();
        f32x4 sj[2];
#pragma unroll
        for (int j = 0; j < 2; ++j) { const int idx = F.tid + NTHR * j, blk = idx >> 6, l = idx & 63;
            f32x4 s = {0.f, 0.f, 0.f, 0.f};
#pragma unroll
            for (int w = 0; w < 8; ++w) s = s + *(const LAS f32x4*)(red + ((w * 16 + blk) * 64 + l) * 4);
            sj[j] = s;
            if constexpr (!Epi::PAIR) E(16 * (blk & 7) + (l & 15), u * 32 + 16 * (blk >> 3) + 4 * (l >> 4), s); }
        if constexpr (Epi::PAIR) E(16 * (F.tid >> 6) + (F.tid & 15), u * 16 + 4 * ((F.tid & 63) >> 4), sj[0], sj[1]);
    }
    __syncthreads();
}
__device__ __forceinline__ v2u pack4(f32x4 a) { v2u w; w.x = cvtpk(a[0], a[1]); w.y = cvtpk(a[2], a[3]); return w; }
struct SkInProj { static constexpr bool PAIR = false;
    const float* rstd; bf16* QBp; float *QSp, *USp, *out;
    __device__ __forceinline__ void operator()(int m, int n, f32x4 v) const {
        v = v * rstd[MPR + m]; const int sect = n >> 9, c = n & 511;
        if (sect == 0) { v = v * C2; *(f32x4*)(QSp + (size_t)m * SBW + c) = v; }
        else if (sect == 1) *(f32x4*)(out + O_KS + (size_t)m * SBW + c) = v;
        else if (sect == 2) *(f32x4*)(out + O_VS + (size_t)m * SBW + c) = v;
        else *(f32x4*)(USp + (size_t)m * SBW + c) = v;
    }
};
struct SkGlu { static constexpr bool PAIR = false;
    const bf16* YG; const float* bglu; bf16* OSSM;
    __device__ __forceinline__ void operator()(int m, int n, f32x4 v) const {
        const size_t o = (size_t)(MPR + m) * SBW + n; const v2u yw = *(const v2u*)(YG + o); const f32x4 b = *(const f32x4*)(bglu + n);
        const float y[4] = {bflo(yw.x), bfhi(yw.x), bflo(yw.y), bfhi(yw.y)};
#pragma unroll
        for (int e = 0; e < 4; ++e) v[e] = y[e] * __builtin_amdgcn_rcpf(1.f + __builtin_amdgcn_exp2f(-(v[e] + b[e]) * LOG2E));
        *(v2u*)(OSSM + o) = pack4(v);
    }
};
struct SkResid { static constexpr bool PAIR = false;
    const float* base; float* xo; bf16* xb; float* ssq;
    __device__ __forceinline__ void operator()(int m, int n, f32x4 v) const {
        v = v + *(const f32x4*)(base + (size_t)m * D + n); const size_t o = (size_t)(MPR + m) * D + n;
        *(f32x4*)(xo + o) = v; if (xb) *(v2u*)(xb + o) = pack4(v);
        atomicAdd(ssq + MPR + m, (v[0] * v[0] + v[1] * v[1]) + (v[2] * v[2] + v[3] * v[3]));
    }
};
struct SkScale { static constexpr bool PAIR = false;
    const float* ssq; float scale; bf16* O;
    __device__ __forceinline__ void operator()(int m, int n, f32x4 v) const {
        const float rs = scale / sqrtf(ssq[MPR + m] * (1.f / D) + EPS); v = v * rs; *(v2u*)(O + (size_t)(MPR + m) * D + n) = pack4(v);
    }
};
struct SkGateUp { static constexpr bool PAIR = false;
    const float* ssq; bf16 *GBp, *UBp; float* out;
    __device__ __forceinline__ void operator()(int m, int n, f32x4 v) const {
        const float rs = 1.f / sqrtf(ssq[MPR + m] * (1.f / D) + EPS); v = v * rs;
        if (n >= FF) *(v2u*)(UBp + (size_t)(MPR + m) * FF + (n - FF)) = pack4(v);
        else { *(v2u*)(GBp + (size_t)(MPR + m) * FF + n) = pack4(v); *(f32x4*)(out + O_CVS + ((size_t)m * 2 + 1) * FF + n) = v; }
    }
};

constexpr int HALO_OFF = RING_BYTES + 1024;
__device__ __forceinline__ float dpp_ror1(float x) { return __builtin_bit_cast(float, __builtin_amdgcn_update_dpp(0, __builtin_bit_cast(int, x), 0x121, 0xf, 0xf, true)); }
__device__ __forceinline__ float dpp_ror2(float x) { return __builtin_bit_cast(float, __builtin_amdgcn_update_dpp(0, __builtin_bit_cast(int, x), 0x122, 0xf, 0xf, true)); }
struct EpiGateUpConv {
    const float* ssq; bf16* ACT; float* out; const float* cw; const float* cb; LAS float* halo;
    __device__ __forceinline__ void operator()(const f32x4 (&acc)[2][2][4][2], const pg8::Unit& u, int wr, int wc, int fr_, int fq_) const {
        int fr = fr_, fq = fq_; asm volatile("" : "+v"(fr), "+v"(fq));
        const int cl = wc * 32 + 8 * fq, col = u.pn * 128 + cl, prow0 = u.pm * 254;
        float rs[2][4];
#pragma unroll
        for (int ai = 0; ai < 2; ++ai)
#pragma unroll
            for (int m = 0; m < 4; ++m) { const int row = prow0 + ai * 128 + wr * 64 + m * 16 + fr; rs[ai][m] = (row < MPR) ? 1.f / sqrtf(ssq[row < MPR ? row : 0] * (1.f / D) + EPS) : 0.f; }
        if (fr >= 14) {
#pragma unroll
            for (int ai = 0; ai < 2; ++ai) { LAS float* hp = halo + (((2 * ai + wr) * 2 + (fr - 14)) * 128 + cl); *(LAS f32x4*)hp = acc[ai][0][3][0] * rs[ai][3]; *(LAS f32x4*)(hp + 4) = acc[ai][0][3][1] * rs[ai][3]; }
        }
        asm volatile("s_waitcnt lgkmcnt(0)\n\ts_barrier" ::: "memory");
        f32x4 w0[2], w1[2], w2[2], bb[2];
#pragma unroll
        for (int n = 0; n < 2; ++n) { w0[n] = *(const f32x4*)(cw + col + 4 * n); w1[n] = *(const f32x4*)(cw + FF + col + 4 * n); w2[n] = *(const f32x4*)(cw + 2 * FF + col + 4 * n); bb[n] = *(const f32x4*)(cb + col + 4 * n); }
#pragma unroll
        for (int ai = 0; ai < 2; ++ai) {
            const int blk = 2 * ai + wr;
            f32x4 r1p[2], r2p[2];
            if (blk == 0) { r1p[0] = r1p[1] = r2p[0] = r2p[1] = (f32x4){0.f, 0.f, 0.f, 0.f}; }
            else { const LAS float* hb = halo + ((blk - 1) * 2) * 128 + cl;
                const f32x4 a0 = *(const LAS f32x4*)hb, a1 = *(const LAS f32x4*)(hb + 4), b0 = *(const LAS f32x4*)(hb + 128), b1 = *(const LAS f32x4*)(hb + 132);
                r1p[0] = b0; r1p[1] = b1; r2p[0] = (fr == 0) ? a0 : b0; r2p[1] = (fr == 0) ? a1 : b1; }
#pragma unroll
            for (int m = 0; m < 4; ++m) {
                const int lr = ai * 128 + wr * 64 + m * 16 + fr, row = prow0 + lr, t = row & (T - 1); const float rsv = rs[ai][m];
                f32x4 g[2], up[2], R1[2], R2[2];
#pragma unroll
                for (int n = 0; n < 2; ++n) { g[n] = acc[ai][0][m][n] * rsv; up[n] = acc[ai][1][m][n] * rsv;
#pragma unroll
                    for (int e = 0; e < 4; ++e) { R1[n][e] = dpp_ror1(g[n][e]); R2[n][e] = dpp_ror2(g[n][e]); } }
                const bool valid = (row < MPR) && (lr >= 2 || u.pm == 0);
                f32x4 av[2];
#pragma unroll
                for (int n = 0; n < 2; ++n) { f32x4 g1 = (fr == 0) ? r1p[n] : R1[n], g2 = (fr < 2) ? r2p[n] : R2[n];
                    if (t < 1) g1 = (f32x4){0.f, 0.f, 0.f, 0.f}; if (t < 2) g2 = (f32x4){0.f, 0.f, 0.f, 0.f};
                    const f32x4 cv = bb[n] + w0[n] * g2 + w1[n] * g1 + w2[n] * g[n];
#pragma unroll
                    for (int e = 0; e < 4; ++e) av[n][e] = gelu_tanh_f(cv[e]) * up[n][e]; }
                if (valid) { *(v4u*)(ACT + (size_t)row * FF + col) = pack8(av[0], av[1]);
                    if (t >= T - 2) { float* o = out + O_CVP + ((size_t)(row >> 12) * 2 + (t - (T - 2))) * FF + col; *(f32x4*)o = g[0]; *(f32x4*)(o + 4) = g[1]; } }
                r1p[0] = R1[0]; r1p[1] = R1[1]; r2p[0] = R2[0]; r2p[1] = R2[1];
            }
        }
    }
};
struct PanelOrder254 {
    pg8::GridOrder Gd;
    __device__ bool next(int i, pg8::Unit& u) const { return Gd.next(i, u); }
    __device__ __forceinline__ size_t aoff(const pg8::Unit& u) const { return (size_t)u.pm * 254 * D * 2; }
    __device__ __forceinline__ size_t boff(const pg8::Unit& u) const { return (size_t)u.pn * 128 * D * 2; }
};
struct SkGateUpConv { static constexpr bool PAIR = true;
    const float* ssq; bf16* ACT; float* out; const float* cw; const float* cb; const float* sc;
    __device__ __forceinline__ void operator()(int m, int n, f32x4 g, f32x4 up) const {
        const float rs = 1.f / sqrtf(ssq[MPR + m] * (1.f / D) + EPS); g = g * rs; up = up * rs;
        const f32x4 s0 = *(const f32x4*)(sc + ((size_t)m * 2 + 0) * FF + n), s1 = *(const f32x4*)(sc + ((size_t)m * 2 + 1) * FF + n);
        *(f32x4*)(out + O_CVS + ((size_t)m * 2 + 0) * FF + n) = s1; *(f32x4*)(out + O_CVS + ((size_t)m * 2 + 1) * FF + n) = g;
        const f32x4 cv = *(const f32x4*)(cb + n) + *(const f32x4*)(cw + n) * s0 + *(const f32x4*)(cw + FF + n) * s1 + *(const f32x4*)(cw + 2 * FF + n) * g;
        f32x4 a;
#pragma unroll
        for (int e = 0; e < 4; ++e) a[e] = gelu_tanh_f(cv[e]) * up[e];
        *(v2u*)(ACT + (size_t)(MPR + m) * FF + n) = pack4(a);
    }
};
__device__ __forceinline__ int crow(int r, int hi) { return (r & 3) + 8 * (r >> 2) + 4 * hi; }
__device__ __forceinline__ void glds16(const void* gsrc, unsigned lds_dst) { unsigned keep;
    asm volatile("s_mov_b32 %0, m0\n\ts_mov_b32 m0, %2\n\ts_nop 0\n\tglobal_load_lds_dwordx4 %1, off\n\ts_mov_b32 m0, %0" : "=&s"(keep) : "v"(gsrc), "s"(lds_dst) : "memory"); }
#define WAIT_BAR(N) asm volatile("s_waitcnt vmcnt(" #N ") lgkmcnt(0)\n\ts_barrier" ::: "memory")
typedef LAS const char* lds_cptr;
typedef short v4i16_t __attribute__((ext_vector_type(4)));
__device__ __forceinline__ s16x4 vtr(lds_cptr p) { return __builtin_bit_cast(s16x4, __builtin_amdgcn_ds_read_tr16_b64_v4i16((LAS v4i16_t*)p)); }
__device__ __forceinline__ bf16x8 ldsq(lds_cptr p) { return *(const LAS bf16x8*)p; }
#define MFMA32(a, b, c) __builtin_amdgcn_mfma_f32_32x32x16_bf16((a), (b), (c), 0, 0, 0)
__device__ __forceinline__ bf16x8 pack_bf8(const f32x16& p, int base) {
    v4u w; w.x = cvtpk(p[base], p[base + 1]); w.y = cvtpk(p[base + 2], p[base + 3]); w.z = cvtpk(p[base + 4], p[base + 5]); w.w = cvtpk(p[base + 6], p[base + 7]); return __builtin_bit_cast(bf16x8, w);
}
__device__ __forceinline__ float swap_half(float v) { auto rr = __builtin_amdgcn_permlane32_swap(__float_as_uint(v), __float_as_uint(v), false, false); return __uint_as_float((threadIdx.x & 32) ? rr[0] : rr[1]); }

constexpr int SBA_K = 0, SBA_V = 16384, SBA_OST = 32768;
__device__ __forceinline__ void sb_attn_unit(Frame& F, int b, int h, int qb, float b2) {
    const int lane = F.lane, r32 = lane & 31, hi = lane >> 5, wid = F.wave;
    const bf16* QBp = WSP(bf16, WS_QB); const bf16* KBp = WSP(bf16, WS_KB); const bf16* VBp = WSP(bf16, WS_VB); bf16* OSB = WSP(bf16, WS_OSB);
    const long rowbase = (long)b * T; const int q0 = qb * 256;
    const bf16* Qw = QBp + (rowbase + q0 + wid * 32) * SBW + h * HD;
    const bf16* Kh = KBp + rowbase * SBW + h * HD; const bf16* Vh = VBp + rowbase * SBW + h * HD;
    const unsigned lds0 = (unsigned)(uintptr_t)(F.lds + RING_OFF);
    const bf16* ksrc = Kh + (long)lane * SBW + wid * 8;
    const bf16* vsrc = Vh + (long)(16 * (wid & 3) + (lane >> 2)) * SBW + (wid >> 2) * 32 + (lane & 3) * 8;
    const unsigned kdst = lds0 + SBA_K + wid * 1024, vdst = lds0 + SBA_V + wid * 1024;
    const lds_cptr base3 = (lds_cptr)(F.lds + RING_OFF);
    const lds_cptr kp0 = base3 + SBA_K + hi * 1024 + r32 * 16;
    const lds_cptr vp0 = base3 + SBA_V + ((lane >> 4) & 1) * 32 + (lane & 3) * 8 + (4 * hi + ((lane & 15) >> 2)) * 64;
    const int NT = (q0 + 256) / 64;
#define DMA_KV(t, slot) do { glds16(ksrc + (long)(t) * 64 * SBW, (unsigned)__builtin_amdgcn_readfirstlane(kdst + (slot) * 8192)); glds16(vsrc + (long)(t) * 64 * SBW, (unsigned)__builtin_amdgcn_readfirstlane(vdst + (slot) * 8192)); } while (0)
    DMA_KV(NT - 1, 0);
    bf16x8 qr[4];
#pragma unroll
    for (int d0 = 0; d0 < 4; ++d0) qr[d0] = *reinterpret_cast<const bf16x8*>(&Qw[(long)r32 * SBW + d0 * 16 + hi * 8]);
    bf16x8 A0, A1, AN;
#pragma unroll
    for (int j = 0; j < 8; ++j) { const int kv = crow(j, hi); A0[j] = (short)((kv > r32) ? 0xBF80 : 0); A1[j] = (short)((kv + 16 > r32) ? 0xBF80 : 0); AN[j] = (short)0xBF80; }
    f32x16 o0 = {}, o1 = {}, racc = {}, bt;
#pragma unroll
    for (int r = 0; r < 16; ++r) bt[r] = b2;
    const int qrel = wid * 32 + r32;
    for (int it = 0; it < NT; ++it) {
        const int t = NT - 1 - it, cur = it & 1;
        if (it + 1 < NT) { DMA_KV(t - 1, cur ^ 1); WAIT_BAR(2); } else { WAIT_BAR(0); }
        const int jb = t - (NT - 4);
        if (jb <= (wid >> 1)) {
            const lds_cptr kp = kp0 + cur * 8192; const lds_cptr vp = vp0 + cur * 8192;
            f32x16 p0 = bt, p1 = bt;
#pragma unroll
            for (int d0 = 0; d0 < 4; ++d0) { const bf16x8 k0 = ldsq(kp + d0 * 2048), k1 = ldsq(kp + d0 * 2048 + 512); p0 = MFMA32(k0, qr[d0], p0); p1 = MFMA32(k1, qr[d0], p1); }
            if (jb == (wid >> 1)) {
                const float NEG = -INFINITY; const int kb = 64 * jb + 4 * hi;
#pragma unroll
                for (int r = 0; r < 16; ++r) { const int kv = kb + (r & 3) + 8 * (r >> 2); if (kv >= qrel) p0[r] = NEG; if (kv + 32 >= qrel) p1[r] = NEG; }
            }
            f32x16 s0, s1;
#pragma unroll
            for (int r = 0; r < 16; ++r) { s0[r] = __builtin_amdgcn_logf(1.f + __builtin_amdgcn_exp2f(p0[r])); s1[r] = __builtin_amdgcn_logf(1.f + __builtin_amdgcn_exp2f(p1[r])); }
            const bf16x8 sb0 = pack_bf8(s0, 0), sb1 = pack_bf8(s0, 8), sb2 = pack_bf8(s1, 0), sb3 = pack_bf8(s1, 8);
            f32x16 d1 = MFMA32(A0, sb2, racc); d1 = MFMA32(A1, sb3, d1);
            f32x16 d0 = MFMA32(A0, sb0, racc); d0 = MFMA32(A1, sb1, d0); d0 = MFMA32(AN, sb2, d0); d0 = MFMA32(AN, sb3, d0);
            racc = MFMA32(AN, sb0, racc); racc = MFMA32(AN, sb1, racc); racc = MFMA32(AN, sb2, racc); racc = MFMA32(AN, sb3, racc);
#pragma unroll
            for (int r = 0; r < 16; ++r) { p0[r] = __builtin_amdgcn_exp2f((p0[r] - s0[r]) + d0[r]); p1[r] = __builtin_amdgcn_exp2f((p1[r] - s1[r]) + d1[r]); }
            const bf16x8 pa0 = pack_bf8(p0, 0), pa1 = pack_bf8(p0, 8), pa2 = pack_bf8(p1, 0), pa3 = pack_bf8(p1, 8);
#pragma unroll
            for (int dh = 0; dh < 2; ++dh) {
                f32x16& o = dh ? o1 : o0;
#pragma unroll
                for (int rg = 0; rg < 4; ++rg) { const s16x4 lo = vtr(vp + dh * 4096 + rg * 1024), hh = vtr(vp + dh * 4096 + rg * 1024 + 512);
                    const bf16x8 vf = (bf16x8){lo[0], lo[1], lo[2], lo[3], hh[0], hh[1], hh[2], hh[3]};
                    o = MFMA32(rg == 0 ? pa0 : rg == 1 ? pa1 : rg == 2 ? pa2 : pa3, vf, o); }
            }
        }
        WAIT_BAR(0);
    }
#undef DMA_KV
    { int l2 = lane; asm volatile("" : "+v"(l2)); const int e32 = l2 & 31, ehi = l2 >> 5;
      LAS bf16* stg = (LAS bf16*)(F.lds + RING_OFF + SBA_OST) + wid * 2048; LAS bf16* sb = stg + (4 * ehi) * 64 + e32;
#pragma unroll
      for (int r = 0; r < 16; ++r) { sb[((r & 3) + 8 * (r >> 2)) * 64] = (bf16)f2bf(o0[r]); sb[((r & 3) + 8 * (r >> 2)) * 64 + 32] = (bf16)f2bf(o1[r]); }
      LDS_WAIT();
      bf16* Ow = OSB + (rowbase + q0 + wid * 32 + (l2 >> 3)) * SBW + h * HD + (l2 & 7) * 8; const LAS bf16* sr = stg + (l2 >> 3) * 64 + (l2 & 7) * 8;
#pragma unroll
      for (int i = 0; i < 4; ++i) { const v4u v = *(const LAS v4u*)(sr + i * 512); *(v4u*)(Ow + (long)i * 8 * SBW) = v; } }
    asm volatile("s_waitcnt vmcnt(0) lgkmcnt(0)\n\ts_barrier" ::: "memory");
}

__device__ __forceinline__ float dpp_sum16(float x) {
    x += __builtin_bit_cast(float, __builtin_amdgcn_update_dpp(0, __builtin_bit_cast(int, x), 0xB1, 0xf, 0xf, true));
    x += __builtin_bit_cast(float, __builtin_amdgcn_update_dpp(0, __builtin_bit_cast(int, x), 0x4E, 0xf, 0xf, true));
    x += __builtin_bit_cast(float, __builtin_amdgcn_update_dpp(0, __builtin_bit_cast(int, x), 0x141, 0xf, 0xf, true));
    x += __builtin_bit_cast(float, __builtin_amdgcn_update_dpp(0, __builtin_bit_cast(int, x), 0x140, 0xf, 0xf, true));
    return x;
}
__device__ __forceinline__ float wave_sum_fast(float x) { x = dpp_sum16(x); x += __shfl_xor(x, 16); x += swap_half(x); return x; }
__device__ __forceinline__ void sb_sample_unit(Frame& F, int b, int pg) {
    const int lane = F.lane, h = F.wave, ts = lane >> 4, d4 = lane & 15;
    const float* QS = WSP(float, WS_QS); const float* ck = INF(2); const float* cv = INF(3); const int* pt = (const int*)F.in[4];
    const float b2 = INF(13)[h] * LOG2E;
    const f32x4 q4 = *(const f32x4*)(QS + (size_t)b * SBW + h * HD + 4 * d4);
    const int page = pt[b * NPG + pg];
    const float* kb = ck + ((size_t)page * PAGE + ts) * (NH * HD) + h * HD + 4 * d4;
    const float* vb = cv + ((size_t)page * PAGE + ts) * (NH * HD) + h * HD + 4 * d4;
    float z[32];
    { f32x4 kk[32];
#pragma unroll
      for (int i = 0; i < 32; ++i) kk[i] = __builtin_nontemporal_load((const f32x4*)(kb + (size_t)i * 4 * NH * HD));
#pragma unroll
      for (int i = 0; i < 32; ++i) z[i] = dpp_sum16((q4[0] * kk[i][0] + q4[1] * kk[i][1]) + (q4[2] * kk[i][2] + q4[3] * kk[i][3])) + b2; }
    f32x4 vv[32];
#pragma unroll
    for (int i = 0; i < 32; ++i) vv[i] = __builtin_nontemporal_load((const f32x4*)(vb + (size_t)i * 4 * NH * HD));
    float run = 0.f;
#pragma unroll
    for (int i = 31; i >= 0; --i) {
        const float sp = __builtin_amdgcn_logf(1.f + __builtin_amdgcn_exp2f(z[i]));
        const float nb = __shfl_xor(sp, 16), v1 = sp + nb, po = swap_half(v1);
        const float aft = ((ts & 1) ? 0.f : nb) + ((ts & 2) ? 0.f : po);
        z[i] = __builtin_amdgcn_exp2f(z[i] - sp - (run + aft));
        run += v1 + po;
    }
    f32x4 acc = {0.f, 0.f, 0.f, 0.f};
#pragma unroll
    for (int i = 0; i < 32; ++i) acc = acc + vv[i] * z[i];
#pragma unroll
    for (int e = 0; e < 4; ++e) { acc[e] += __shfl_xor(acc[e], 16); acc[e] += swap_half(acc[e]); }
    if (ts == 0) *(f32x4*)(WSP(float, WS_SBPO) + (((size_t)b * NPG + pg) * NH + h) * HD + 4 * d4) = acc;
    if (lane == 0) WSP(float, WS_SBPL)[((size_t)b * NPG + pg) * NH + h] = -run;
}
__device__ __forceinline__ void sb_sample_combine(Frame& F, int b, int h) {
    const float* PO = WSP(float, WS_SBPO); const float* PL = WSP(float, WS_SBPL); float o = 0.f, run = 0.f;
#pragma unroll
    for (int pg = NPG - 1; pg >= 0; --pg) { o += __builtin_amdgcn_exp2f(run) * PO[(((size_t)b * NPG + pg) * NH + h) * HD + F.lane]; run += PL[((size_t)b * NPG + pg) * NH + h]; }
    WSP(bf16, WS_OSB)[(size_t)(MPR + b) * SBW + h * HD + F.lane] = (bf16)f2bf(o);
}
__device__ __forceinline__ void ssm_sample_unit(Frame& F, int b, int g) {
    const int n = F.lane;
    const float lr = INF(14)[g * NST + n], li = INF(15)[g * NST + n], ldt = INF(16)[g];
    float lbr, lbi, cr, ci; lam_pow(lr, li, ldt, 1, lbr, lbi); lam_coef(lr, li, ldt, cr, ci);
    const float* u = WSP(float, WS_US) + (size_t)b * SBW + g * GP;
    float br = 0.f, bi = 0.f;
#pragma unroll
    for (int p = 0; p < 16; ++p) { const float bre = INF(17)[(g * NST + n) * GP + p], bim = INF(18)[(g * NST + n) * GP + p]; const float uv = u[p]; br += (cr * bre - ci * bim) * uv; bi += (cr * bim + ci * bre) * uv; }
    const float h0r = INF(5)[(b * NG + g) * NST + n], h0i = INF(6)[(b * NG + g) * NST + n];
    const float hr = lbr * h0r - lbi * h0i + br, hi = lbr * h0i + lbi * h0r + bi;
    F.out[O_RES + (size_t)(b * NG + g) * NST + n] = hr; F.out[O_IMS + (size_t)(b * NG + g) * NST + n] = hi;
    float y = 0.f;
#pragma unroll
    for (int p = 0; p < 16; ++p) { const float v = wave_sum(INF(19)[(g * GP + p) * NST + n] * hr - INF(20)[(g * GP + p) * NST + n] * hi); if (n == p) y = v; }
    if (n < 16) { y += INF(21)[g * GP + n] * u[n]; WSP(bf16, WS_YG)[(size_t)(MPR + b) * SBW + g * GP + n] = (bf16)f2bf(gelu_tanh_f(y)); }
}
__device__ __forceinline__ void ssm_scan_unit(Frame& F, int unit) {
    const int b = unit >> 6, g = (unit >> 1) & 31, nh = unit & 1, nl = F.tid & 31, seg = F.tid >> 5, n = nh * 32 + nl;
    LAS float* tot = (LAS float*)(F.lds + RING_OFF);
    const float lr = INF(14)[g * NST + n], li = INF(15)[g * NST + n], ldt = INF(16)[g];
    float Lr, Li, Sr, Si; lam_pow(lr, li, ldt, LC, Lr, Li); lam_pow(lr, li, ldt, LC * 16, Sr, Si);
    const float* SST = WSP(float, WS_SST); bf16* XH = WSP(bf16, WS_XH);
    f32x2 s[16];
#pragma unroll
    for (int k = 0; k < 16; ++k) s[k] = *(const f32x2*)(SST + ((size_t)(b * NCH + seg * 16 + k) * NG + g) * 128 + 2 * n);
    float pr = 0.f, pi = 0.f;
#pragma unroll
    for (int k = 0; k < 16; ++k) { const float nr = Lr * pr - Li * pi + s[k].x, ni = Lr * pi + Li * pr + s[k].y; pr = nr; pi = ni; s[k].x = pr; s[k].y = pi; }
    __syncthreads();
    tot[(seg * 32 + nl) * 2] = pr; tot[(seg * 32 + nl) * 2 + 1] = pi;
    __syncthreads();
    float cr = 0.f, ci = 0.f;
    for (int s2 = 0; s2 < seg; ++s2) { const float tr = tot[(s2 * 32 + nl) * 2], ti = tot[(s2 * 32 + nl) * 2 + 1]; const float nr = Sr * cr - Si * ci + tr, ni = Sr * ci + Si * cr + ti; cr = nr; ci = ni; }
    if (seg == 0) *(GAS unsigned*)(XH + ((size_t)(b * NCH) * NG + g) * XHP + 256 + 2 * n) = 0u;
    float wr_ = Lr, wi_ = Li;
#pragma unroll
    for (int k = 0; k < 16; ++k) {
        const float hr = wr_ * cr - wi_ * ci + s[k].x, hi = wr_ * ci + wi_ * cr + s[k].y;
        const int c = seg * 16 + k;
        if (c + 1 < NCH) *(GAS unsigned*)(XH + ((size_t)(b * NCH + c + 1) * NG + g) * XHP + 256 + 2 * n) = pk2(hr, hi);
        else { F.out[O_REP + (size_t)(b * NG + g) * NST + n] = hr; F.out[O_IMP + (size_t)(b * NG + g) * NST + n] = hi; }
        const float nr = wr_ * Lr - wi_ * Li, ni = wr_ * Li + wi_ * Lr; wr_ = nr; wi_ = ni;
    }
}
__device__ __forceinline__ void xattn_prompt_unit(Frame& F, int b, int h, int qb) {
    const int lane = F.lane, r32 = lane & 31, hi = lane >> 5, wid = F.wave;
    const bf16* QM = WSP(bf16, WS_QM); const bf16* MKB = WSP(bf16, WS_MKB); const bf16* MVB = WSP(bf16, WS_MVB); bf16* OM = WSP(bf16, WS_OMEM);
    const unsigned lds0 = (unsigned)(uintptr_t)(F.lds + RING_OFF); const lds_cptr base3 = (lds_cptr)(F.lds + RING_OFF);
    const long qrow0 = (long)b * T + qb * 256 + wid * 32;
#pragma unroll
    for (int t = 0; t < 4; ++t)
#pragma unroll
        for (int j = 0; j < 4; ++j) { const int c = wid + 8 * j;
            glds16(MKB + ((long)b * MT + t * 64 + lane) * D + h * MHD + c * 8, (unsigned)__builtin_amdgcn_readfirstlane(lds0 + t * 32768 + c * 1024)); }
    bf16x8 qr[16];
#pragma unroll
    for (int ks = 0; ks < 16; ++ks) qr[ks] = *reinterpret_cast<const bf16x8*>(QM + (qrow0 + r32) * D + h * MHD + ks * 16 + hi * 8);
    WAIT_BAR(0);
    f32x16 S[8];
#pragma unroll
    for (int t = 0; t < 4; ++t)
#pragma unroll
        for (int blk = 0; blk < 2; ++blk) { f32x16 p = {};
#pragma unroll
            for (int ks = 0; ks < 16; ++ks) p = MFMA32(ldsq(base3 + t * 32768 + (2 * ks + hi) * 1024 + (32 * blk + r32) * 16), qr[ks], p);
            S[t * 2 + blk] = p; }
    WAIT_BAR(0);
#pragma unroll
    for (int t = 0; t < 4; ++t)
#pragma unroll
        for (int j = 0; j < 4; ++j) { const int p = wid + 8 * j, dblk = p >> 2, rg = p & 3;
            glds16(MVB + ((long)b * MT + t * 64 + 16 * rg + (lane >> 2)) * D + h * MHD + dblk * 32 + (lane & 3) * 8, (unsigned)__builtin_amdgcn_readfirstlane(lds0 + t * 32768 + p * 1024)); }
    float mx = -INFINITY;
#pragma unroll
    for (int i = 0; i < 8; ++i)
#pragma unroll
        for (int r = 0; r < 16; ++r) mx = fmaxf(mx, S[i][r]);
    mx = fmaxf(mx, swap_half(mx));
    float l = 0.f;
#pragma unroll
    for (int i = 0; i < 8; ++i)
#pragma unroll
        for (int r = 0; r < 16; ++r) { S[i][r] = __builtin_amdgcn_exp2f(S[i][r] - mx); l += S[i][r]; }
    l += swap_half(l);
    bf16x8 pa[16];
#pragma unroll
    for (int i = 0; i < 8; ++i) { pa[2 * i] = pack_bf8(S[i], 0); pa[2 * i + 1] = pack_bf8(S[i], 8); }
    WAIT_BAR(0);
    f32x16 o[8];
#pragma unroll
    for (int dblk = 0; dblk < 8; ++dblk) o[dblk] = (f32x16){};
    const lds_cptr vp0 = base3 + ((lane >> 4) & 1) * 32 + (lane & 3) * 8 + (4 * hi + ((lane & 15) >> 2)) * 64;
#pragma unroll
    for (int t = 0; t < 4; ++t)
#pragma unroll
        for (int dblk = 0; dblk < 8; ++dblk)
#pragma unroll
            for (int rg = 0; rg < 4; ++rg) { const s16x4 lo = vtr(vp0 + t * 32768 + dblk * 4096 + rg * 1024), hh = vtr(vp0 + t * 32768 + dblk * 4096 + rg * 1024 + 512);
                const bf16x8 vf = (bf16x8){lo[0], lo[1], lo[2], lo[3], hh[0], hh[1], hh[2], hh[3]};
                o[dblk] = MFMA32(pa[t * 4 + rg], vf, o[dblk]); }
    WAIT_BAR(0);
    int l2 = lane; asm volatile("" : "+v"(l2));
    const int e32 = l2 & 31, ehi = l2 >> 5;
    LAS bf16* stg = (LAS bf16*)(F.lds + RING_OFF) + wid * 8192;
    LAS float* lsw = (LAS float*)stg;
    if (ehi == 0) lsw[e32] = l;
    LDS_WAIT();
    float rli[16];
    { const LAS float* lb = lsw + 4 * ehi;
#pragma unroll
      for (int r = 0; r < 16; ++r) rli[r] = __builtin_amdgcn_rcpf(lb[(r & 3) + 8 * (r >> 2)]); }
    LDS_WAIT(); asm volatile("" ::: "memory");
    { LAS bf16* sb = stg + (4 * ehi) * 256 + e32;
#pragma unroll
      for (int dblk = 0; dblk < 8; ++dblk)
#pragma unroll
        for (int r = 0; r < 16; ++r) sb[((r & 3) + 8 * (r >> 2)) * 256 + dblk * 32] = (bf16)f2bf(o[dblk][r] * rli[r]); }
    LDS_WAIT();
    { bf16* Ow = OM + (qrow0 + (l2 >> 5)) * D + h * MHD + (l2 & 31) * 8; const LAS bf16* sr = stg + (l2 >> 5) * 256 + (l2 & 31) * 8;
#pragma unroll
      for (int i = 0; i < 16; ++i) { const v4u v = *(const LAS v4u*)(sr + i * 512); *(v4u*)(Ow + (long)i * 2 * D) = v; } }
    asm volatile("s_waitcnt vmcnt(0) lgkmcnt(0)\n\ts_barrier" ::: "memory");
}
__device__ __forceinline__ void xattn_sample_unit(Frame& F, int b, int h) {
    const int lane = F.lane, wid = F.wave;
    const bf16* QM = WSP(bf16, WS_QM); const float* ck = INF(8); const float* cv = INF(9);
    LAS float* xm = (LAS float*)(F.lds + RING_OFF);
    const v2u qw = *(const v2u*)(QM + (size_t)(MPR + b) * D + h * MHD + 4 * lane);
    const f32x4 q4 = {bflo(qw.x), bfhi(qw.x), bflo(qw.y), bfhi(qw.y)};
    const float* kb = ck + (((size_t)b * MT + wid * 32) * MH + h) * MHD + 4 * lane;
    const float* vb = cv + (((size_t)b * MT + wid * 32) * MH + h) * MHD + 4 * lane;
    float s[32];
#pragma unroll
    for (int i0 = 0; i0 < 32; i0 += 8) {
        f32x4 kk[8];
#pragma unroll
        for (int i = 0; i < 8; ++i) kk[i] = __builtin_nontemporal_load((const f32x4*)(kb + (size_t)(i0 + i) * MH * MHD));
#pragma unroll
        for (int i = 0; i < 8; ++i) s[i0 + i] = wave_sum((q4[0] * kk[i][0] + q4[1] * kk[i][1]) + (q4[2] * kk[i][2] + q4[3] * kk[i][3]));
    }
    float mx = s[0];
#pragma unroll
    for (int i = 1; i < 32; ++i) mx = fmaxf(mx, s[i]);
    __syncthreads();
    if (lane == 0) xm[wid] = mx;
    __syncthreads();
    float gm = xm[0];
#pragma unroll
    for (int w = 1; w < 8; ++w) gm = fmaxf(gm, xm[w]);
    float l = 0.f;
#pragma unroll
    for (int i = 0; i < 32; ++i) { s[i] = __builtin_amdgcn_exp2f(s[i] - gm); l += s[i]; }
    f32x4 acc = {0.f, 0.f, 0.f, 0.f};
#pragma unroll
    for (int i0 = 0; i0 < 32; i0 += 8) {
        f32x4 vv[8];
#pragma unroll
        for (int i = 0; i < 8; ++i) vv[i] = __builtin_nontemporal_load((const f32x4*)(vb + (size_t)(i0 + i) * MH * MHD));
#pragma unroll
        for (int i = 0; i < 8; ++i) acc = acc + vv[i] * s[i0 + i];
    }
    if (lane == 0) xm[8 + wid] = l;
    *(LAS f32x4*)(xm + 64 + wid * 256 + 4 * lane) = acc;
    __syncthreads();
    if (F.tid < 256) { float lt = 0.f, ov = 0.f;
#pragma unroll
        for (int w = 0; w < 8; ++w) { lt += xm[8 + w]; ov += xm[64 + w * 256 + F.tid]; }
        WSP(bf16, WS_OMEM)[(size_t)(MPR + b) * D + h * MHD + F.tid] = (bf16)f2bf(ov / lt); }
}
__device__ __forceinline__ void mix_row(Frame& F, int row) {
    const int lane = F.lane;
#pragma unroll
    for (int half = 0; half < 2; ++half) {
        const bf16* src = (half ? WSP(bf16, WS_OSSM) : WSP(bf16, WS_OSB)) + (size_t)row * SBW + 8 * lane;
        const v4u w = *(const v4u*)src; float v[8] = {bflo(w.x), bfhi(w.x), bflo(w.y), bfhi(w.y), bflo(w.z), bfhi(w.z), bflo(w.w), bfhi(w.w)};
        float s = 0.f;
#pragma unroll
        for (int e = 0; e < 8; ++e) s += v[e] * v[e];
        s = wave_sum(s); const float rs = 1.f / sqrtf(s * (1.f / SBW) + EPS);
        v4u o; o.x = pk2(v[0] * rs, v[1] * rs); o.y = pk2(v[2] * rs, v[3] * rs); o.z = pk2(v[4] * rs, v[5] * rs); o.w = pk2(v[6] * rs, v[7] * rs);
        *(v4u*)(WSP(bf16, WS_MIX) + (size_t)row * D + half * SBW + 8 * lane) = o;
    }
}
__device__ __forceinline__ void conv_act_item(Frame& F, long item) {
    const int row = (int)(item / (FF / 8)), j = (int)(item % (FF / 8)) * 8;
    const bf16* GB = WSP(bf16, WS_GB); bf16* UB = WSP(bf16, WS_UB);
    const float* cw = INF(36); const float* cb = INF(37); const float* sc = INF(7);
    float g0[8], g1[8], g2[8], uu[8];
    { const v4u w = *(const v4u*)(GB + (size_t)row * FF + j); g0[0] = bflo(w.x); g0[1] = bfhi(w.x); g0[2] = bflo(w.y); g0[3] = bfhi(w.y); g0[4] = bflo(w.z); g0[5] = bfhi(w.z); g0[6] = bflo(w.w); g0[7] = bfhi(w.w); }
    { const v4u w = *(const v4u*)(UB + (size_t)row * FF + j); uu[0] = bflo(w.x); uu[1] = bfhi(w.x); uu[2] = bflo(w.y); uu[3] = bfhi(w.y); uu[4] = bflo(w.z); uu[5] = bfhi(w.z); uu[6] = bflo(w.w); uu[7] = bfhi(w.w); }
    if (row < MPR) { const int t = row & 4095;
        if (t >= 1) { const v4u w = *(const v4u*)(GB + (size_t)(row - 1) * FF + j); g1[0] = bflo(w.x); g1[1] = bfhi(w.x); g1[2] = bflo(w.y); g1[3] = bfhi(w.y); g1[4] = bflo(w.z); g1[5] = bfhi(w.z); g1[6] = bflo(w.w); g1[7] = bfhi(w.w); }
        else { _Pragma("unroll") for (int e = 0; e < 8; ++e) g1[e] = 0.f; }
        if (t >= 2) { const v4u w = *(const v4u*)(GB + (size_t)(row - 2) * FF + j); g2[0] = bflo(w.x); g2[1] = bfhi(w.x); g2[2] = bflo(w.y); g2[3] = bfhi(w.y); g2[4] = bflo(w.z); g2[5] = bfhi(w.z); g2[6] = bflo(w.w); g2[7] = bfhi(w.w); }
        else { _Pragma("unroll") for (int e = 0; e < 8; ++e) g2[e] = 0.f; }
    } else { const int b = row - MPR;
        _Pragma("unroll") for (int e = 0; e < 8; ++e) { g2[e] = sc[((size_t)b * 2 + 0) * FF + j + e]; g1[e] = sc[((size_t)b * 2 + 1) * FF + j + e]; F.out[O_CVS + ((size_t)b * 2 + 0) * FF + j + e] = g1[e]; } }
    float r[8];
#pragma unroll
    for (int e = 0; e < 8; ++e) { const float c = cb[j + e] + cw[j + e] * g2[e] + cw[FF + j + e] * g1[e] + cw[2 * FF + j + e] * g0[e]; r[e] = gelu_tanh_f(c) * uu[e]; }
    v4u o; o.x = pk2(r[0], r[1]); o.y = pk2(r[2], r[3]); o.z = pk2(r[4], r[5]); o.w = pk2(r[6], r[7]);
    *(v4u*)(UB + (size_t)row * FF + j) = o;
}
__device__ __forceinline__ void final_norm_row(Frame& F, int row) {
    const float rs = 1.f / sqrtf(((const float*)(F.ctl + CW_SSQ3))[row] * (1.f / D) + EPS);
    float* y = F.out + O_YP + (size_t)row * D; const float* g = INF(39);
#pragma unroll
    for (int j = 0; j < 4; ++j) { const int c = 4 * F.lane + 256 * j; f32x4 v = *(const f32x4*)(y + c); const f32x4 gv = *(const f32x4*)(g + c); v = v * rs * gv; *(f32x4*)(y + c) = v; }
}
constexpr int N_PHASES = 15;
__global__ void __launch_bounds__(NTHR, 2) mk_fwd(Args args) {
    extern __shared__ __attribute__((aligned(16))) unsigned char lds[];
    Frame F;
    F.lds = (LAS unsigned char*)lds; F.MISC = (volatile LAS unsigned*)(F.lds + MISC_OFF);
    F.tid = threadIdx.x; F.lane = F.tid & 63; F.wave = __builtin_amdgcn_readfirstlane(F.tid >> 6);
    F.G = gridDim.x; { const int bx = blockIdx.x; F.vcu = (F.G % 8 == 0) ? (bx % 8) * (F.G / 8) + bx / 8 : bx; }
    F.ws = args.ws; F.out = args.out; F.in = args.in; F.ctl = (unsigned*)(args.ws + WS_CTL);
    for (int u = F.tid; u < (LDS_BYTES - LDSCTL_OFF) / 4; u += NTHR) ((LAS unsigned*)(F.lds + LDSCTL_OFF))[u] = 0u;
    __syncthreads();
    XcdBarrier bar; bar.bar = F.ctl + CW_BAR; bar.x = 0; bar.st = nullptr;
    if (args.use_bar) bar = xcd_barrier_post(F.ctl + CW_BAR, F.MISC + 8);
    const int lo = args.ph_lo, hi = args.ph_hi;
#define IN(k) (lo <= (k) && (k) < hi)
#define SEAM(k) do { if (IN(k) && IN((k) + 1)) xcd_barrier(bar); } while (0)
    const int gw = F.vcu * NWAVES + F.wave, NGW = F.G * NWAVES;
    LAS unsigned char* ring = F.lds + RING_OFF;

    if (IN(0)) { p0_prologue(F);
#if MK_PROBE == 100
        __syncthreads(); p0_prologue(F);
#endif
    } SEAM(0);
    if (IN(1)) {
        { pg8::Gemm g{WSP(bf16, WS_XB), WSP(bf16, WS_WIN), D, D, D}; pg8::GridOrder S; S.init(MPR / 256, INW / 256, F.G, (int)blockIdx.x, 0, D, D);
          EpiInProj E{WSP(float, WS_RSTD0), WSP(bf16, WS_QB), WSP(bf16, WS_KB), WSP(bf16, WS_VB), WSP(bf16, WS_XH), WSP(float, WS_QS), WSP(float, WS_US), F.out};
          pg8::gemm_phase<EpiInProj, pg8::GridOrder>(ring, g, S, E); }
        { SkInProj E{WSP(float, WS_RSTD0), WSP(bf16, WS_QB), WSP(float, WS_QS), WSP(float, WS_US), F.out};
          skinny_gemm(F, WSP(bf16, WS_XB) + (size_t)MPR * D, D, WSP(bf16, WS_WIN), D, INW, D, E, (int)blockIdx.x, F.G); }
    } SEAM(1);
    if (IN(2)) {
        { pg8::Gemm g{WSP(bf16, WS_XH), WSP(bf16, WS_W1), NG * XHP, 256, 256}; SsmOrder S{F.G, (int)blockIdx.x, (size_t)128 * 256 * 2};
          EpiSsmA E{WSP(float, WS_SST)};
          pg8::gemm_phase<EpiSsmA, SsmOrder>(ring, g, S, E); }
        { pg8::Gemm g{WSP(bf16, WS_MB), WSP(bf16, WS_WMKV), D, D, D}; pg8::GridOrder S; S.init(4, 8, F.G, (int)blockIdx.x, 128, D, D);
          EpiMemKV E{WSP(float, WS_RSTDM), WSP(bf16, WS_MKB), WSP(bf16, WS_MVB), F.out};
          pg8::gemm_phase<EpiMemKV, pg8::GridOrder>(ring, g, S, E); }
        for (int u = gw; u < MS * NG; u += NGW) ssm_sample_unit(F, u >> 5, u & 31);
        { int mode = (F.vcu % 3 == 2) ? 1 : 0; bool adone = false, mdone = false;
          while (!(adone && mdone)) {
              if (mode == 0 && adone) mode = 1; else if (mode == 1 && mdone) mode = 0;
              __syncthreads();
              if (F.tid == 0) F.MISC[16] = __hip_atomic_fetch_add(F.ctl + (mode ? CW_QM : CW_QA), 1u, __ATOMIC_RELAXED, __HIP_MEMORY_SCOPE_AGENT);
              __syncthreads();
              const int idx = (int)F.MISC[16];
              if (mode == 0) { if (idx >= 512) { adone = true; continue; }
                  const int qb = 15 - (idx >> 5), bh = idx & 31; sb_attn_unit(F, bh >> 3, bh & 7, qb, INF(13)[bh & 7] * LOG2E); }
              else { if (idx >= (MS * NPG) / 4) { mdone = true; continue; }
#pragma unroll 1
                  for (int j = 0; j < 4; ++j) { const int u = idx * 4 + j; sb_sample_unit(F, u >> 4, u & 15); } }
          } }
    } SEAM(2);
    if (IN(3)) {
        for (int u = F.vcu; u < 256; u += F.G) ssm_scan_unit(F, u);
        for (int u = gw; u < MS * NH; u += NGW) sb_sample_combine(F, u >> 3, u & 7);
    } SEAM(3);
    if (IN(4)) {
        pg8::Gemm g{WSP(bf16, WS_XH), WSP(bf16, WS_BTC), NG * XHP, XHP, XHP}; SsmOrder S{F.G, (int)blockIdx.x, (size_t)256 * XHP * 2};
        EpiSsmC E{WSP(bf16, WS_YG)};
        pg8::gemm_phase<EpiSsmC, SsmOrder>(ring, g, S, E);
    } SEAM(4);
    if (IN(5)) {
        pg8::Gemm g{WSP(bf16, WS_YG), WSP(bf16, WS_WGLU), SBW, SBW, SBW}; pg8::GridOrder S; S.init(MPR / 256, 2, F.G, (int)blockIdx.x, 0, SBW, SBW);
        EpiGlu E{WSP(bf16, WS_YG), INF(23), WSP(bf16, WS_OSSM)};
        pg8::gemm_phase<EpiGlu, pg8::GridOrder>(ring, g, S, E);
        SkGlu E2{WSP(bf16, WS_YG), INF(23), WSP(bf16, WS_OSSM)};
        skinny_gemm(F, WSP(bf16, WS_YG) + (size_t)MPR * SBW, SBW, WSP(bf16, WS_WGLU), SBW, SBW, SBW, E2, ((int)blockIdx.x + F.G - 128) % F.G, F.G);
    } SEAM(5);
    if (IN(6)) { for (int m = gw; m < MALL; m += NGW) mix_row(F, m);
#if MK_PROBE == 6
        for (int m = gw; m < MALL; m += NGW) mix_row(F, m);
#endif
    } SEAM(6);
    if (IN(7)) {
        pg8::Gemm g{WSP(bf16, WS_MIX), WSP(bf16, WS_WOUT), D, D, D}; pg8::GridOrder S; S.init(MPR / 256, 4, F.G, (int)blockIdx.x, 0, D, D);
        EpiResid E{INF(0), INF(1), WSP(float, WS_X1), WSP(bf16, WS_X1B), (float*)(F.ctl + CW_SSQ1)};
        pg8::gemm_phase<EpiResid, pg8::GridOrder>(ring, g, S, E);
        SkResid E2{INF(1), WSP(float, WS_X1), WSP(bf16, WS_X1B), (float*)(F.ctl + CW_SSQ1)};
        skinny_gemm(F, WSP(bf16, WS_MIX) + (size_t)MPR * D, D, WSP(bf16, WS_WOUT), D, D, D, E2, (int)blockIdx.x, F.G);
    } SEAM(7);
    if (IN(8)) {
        pg8::Gemm g{WSP(bf16, WS_X1B), WSP(bf16, WS_WMQ), D, D, D}; pg8::GridOrder S; S.init(MPR / 256, 4, F.G, (int)blockIdx.x, 0, D, D);
        EpiScaleBf16 E{(const float*)(F.ctl + CW_SSQ1), CM, WSP(bf16, WS_QM)};
        pg8::gemm_phase<EpiScaleBf16, pg8::GridOrder>(ring, g, S, E);
#if MK_PROBE == 8
        pg8::gemm_phase<EpiScaleBf16, pg8::GridOrder>(ring, g, S, E);
#endif
        SkScale E2{(const float*)(F.ctl + CW_SSQ1), CM, WSP(bf16, WS_QM)};
        skinny_gemm(F, WSP(bf16, WS_X1B) + (size_t)MPR * D, D, WSP(bf16, WS_WMQ), D, D, D, E2, (int)blockIdx.x, F.G);
    } SEAM(8);
    if (IN(9)) {
        for (int u = F.vcu; u < 256; u += F.G) xattn_prompt_unit(F, u >> 6, (u >> 4) & 3, u & 15);
#if MK_PROBE == 9
        for (int u = F.vcu; u < 256; u += F.G) xattn_prompt_unit(F, u >> 6, (u >> 4) & 3, u & 15);
#endif
        for (int u = F.vcu; u < MS * MH; u += F.G) xattn_sample_unit(F, u >> 2, u & 3);
#if MK_PROBE == 91
        for (int u = F.vcu; u < MS * MH; u += F.G) xattn_sample_unit(F, u >> 2, u & 3);
#endif
    } SEAM(9);
    if (IN(10)) {
        pg8::Gemm g{WSP(bf16, WS_OMEM), WSP(bf16, WS_WMO), D, D, D}; pg8::GridOrder S; S.init(MPR / 256, 4, F.G, (int)blockIdx.x, 0, D, D);
        EpiResid E{WSP(float, WS_X1), WSP(float, WS_X1) + (size_t)MPR * D, WSP(float, WS_X2), WSP(bf16, WS_X2B), (float*)(F.ctl + CW_SSQ2)};
        pg8::gemm_phase<EpiResid, pg8::GridOrder>(ring, g, S, E);
        SkResid E2{WSP(float, WS_X1) + (size_t)MPR * D, WSP(float, WS_X2), WSP(bf16, WS_X2B), (float*)(F.ctl + CW_SSQ2)};
        skinny_gemm(F, WSP(bf16, WS_OMEM) + (size_t)MPR * D, D, WSP(bf16, WS_WMO), D, D, D, E2, (int)blockIdx.x, F.G);
    } SEAM(10);
    if (IN(11)) {
        pg8::Gemm g{WSP(bf16, WS_X2B), WSP(bf16, WS_WGU), D, D, D, FF}; PanelOrder254 S; S.Gd.init(65, 22, F.G, (int)blockIdx.x, 0, D, D);
        EpiGateUpConv E{(const float*)(F.ctl + CW_SSQ2), WSP(bf16, WS_UB), F.out, INF(36), INF(37), (LAS float*)(F.lds + HALO_OFF)};
        pg8::gemm_phase<EpiGateUpConv, PanelOrder254>(ring, g, S, E);
#if MK_PROBE == 11
        pg8::gemm_phase<EpiGateUpConv, PanelOrder254>(ring, g, S, E);
#endif
        SkGateUpConv E2{(const float*)(F.ctl + CW_SSQ2), WSP(bf16, WS_UB), F.out, INF(36), INF(37), INF(7)};
        skinny_gemm(F, WSP(bf16, WS_X2B) + (size_t)MPR * D, D, WSP(bf16, WS_WGU), D, FF, D, E2, ((int)blockIdx.x + F.G - 150) % F.G, F.G, 16, FF);
    } SEAM(11);
    if (IN(13)) {
        pg8::Gemm g{WSP(bf16, WS_UB), WSP(bf16, WS_WDN), FF, FF, FF}; pg8::GridOrder S; S.init(MPR / 256, 4, F.G, (int)blockIdx.x, 0, FF, FF);
        EpiResid E{WSP(float, WS_X2), WSP(float, WS_X2) + (size_t)MPR * D, F.out + O_YP, nullptr, (float*)(F.ctl + CW_SSQ3)};
        pg8::gemm_phase<EpiResid, pg8::GridOrder>(ring, g, S, E);
        SkResid E2{WSP(float, WS_X2) + (size_t)MPR * D, F.out + O_YP, nullptr, (float*)(F.ctl + CW_SSQ3)};
        skinny_gemm(F, WSP(bf16, WS_UB) + (size_t)MPR * FF, FF, WSP(bf16, WS_WDN), FF, D, FF, E2, (int)blockIdx.x, F.G);
    } SEAM(13);
    if (IN(14)) { for (int m = gw; m < MALL; m += NGW) final_norm_row(F, m); }
#undef IN
#undef SEAM
}
#ifndef MK_DEBUG
#define MK_DEBUG 0
#endif
#ifndef MK_ONE_LAUNCH
#define MK_ONE_LAUNCH 1
#endif
#if MK_DEBUG
struct Chk { const void* fast; const float* ref; int isbf; long rows, cols, ldf, ldr; float scale; };
__global__ void k_compare(Chk c, double* acc) {
    __shared__ double se[256], sr[256];
    double e = 0.0, r = 0.0; const long n = c.rows * c.cols;
    for (long i = (long)blockIdx.x * 256 + threadIdx.x; i < n; i += (long)gridDim.x * 256) { const long rr = i / c.cols, cc = i % c.cols;
        const float f = (c.isbf ? bf2f(((const unsigned short*)c.fast)[rr * c.ldf + cc]) : ((const float*)c.fast)[rr * c.ldf + cc]) * c.scale; const float g = c.ref[rr * c.ldr + cc];
        const double d = (double)f - (double)g; e += d * d; r += (double)g * (double)g; }
    se[threadIdx.x] = e; sr[threadIdx.x] = r; __syncthreads();
    for (int k = 128; k > 0; k >>= 1) { if ((int)threadIdx.x < k) { se[threadIdx.x] += se[threadIdx.x + k]; sr[threadIdx.x] += sr[threadIdx.x + k]; } __syncthreads(); }
    if (threadIdx.x == 0) { atomicAdd(acc, se[0]); atomicAdd(acc + 1, sr[0]); }
}
__global__ void k_compare_xh(const unsigned short* XH, const float* proj, const float* hs, int part, double* acc) {
    __shared__ double se[256], sr[256];
    double e = 0.0, r = 0.0; const int w = part ? 128 : 256; const long n = (long)1024 * NG * w;
    for (long i = (long)blockIdx.x * 256 + threadIdx.x; i < n; i += (long)gridDim.x * 256) { const int j = (int)(i % w); const long bcg = i / w; const int g = (int)(bcg % NG); const long bc = bcg / NG; const int b = (int)(bc / NCH), c = (int)(bc % NCH);
        const float f = bf2f(XH[bcg * XHP + (part ? 256 : 0) + j]); float gref;
        if (!part) { const int s = j >> 4, q = j & 15; gref = proj[((size_t)b * T + c * LC + s) * INW + 1536 + g * GP + q]; }
        else { const int nn = j >> 1, ri = j & 1; gref = (c == 0) ? 0.f : hs[((((size_t)b * T + c * LC - 1) * NG + g) * NST + nn) * 2 + ri]; }
        const double d = (double)f - (double)gref; e += d * d; r += (double)gref * (double)gref; }
    se[threadIdx.x] = e; sr[threadIdx.x] = r; __syncthreads();
    for (int k = 128; k > 0; k >>= 1) { if ((int)threadIdx.x < k) { se[threadIdx.x] += se[threadIdx.x + k]; sr[threadIdx.x] += sr[threadIdx.x + k]; } __syncthreads(); }
    if (threadIdx.x == 0) { atomicAdd(acc, se[0]); atomicAdd(acc + 1, sr[0]); }
}
__global__ void k_judge(const double* acc, int n, float tol, float* out) {
    if (threadIdx.x != 0 || blockIdx.x != 0) return;
    for (int k = 0; k < n; ++k) { const double rv = acc[2 * k] / acc[2 * k + 1];
        if (!(rv < (double)tol)) { int m = 5; if (rv != rv) m = 0; else if (rv >= 1.0) m = 9; else if (rv >= 0.1) m = 8; else if (rv >= 0.01) m = 7; else if (rv >= 0.001) m = 6;
            const int grp = k / 9, kk = k % 9 + 1; float code = (float)(10 * kk + m) * 100.f; for (int i = 0; i < grp; ++i) code *= 100.f; out[0] = code; return; } }
}
#endif

extern "C" void kernel_launch(void* const* d_in, const int* in_sizes, int n_in, void* d_out, int out_size, void* d_ws, size_t ws_size, hipStream_t stream) {
    static int grid = 0;
    if (grid == 0) {
        if (n_in != 40 || (size_t)out_size != O_END || ws_size < WS_FAST_END) { fprintf(stderr, "kernel_launch: unexpected shapes: n_in %d out %d ws %zu\n", n_in, out_size, ws_size); grid = -1; return; }
        int dev = 0, cus = 0, per_cu = 0;
        if (hipGetDevice(&dev) != hipSuccess || hipDeviceGetAttribute(&cus, hipDeviceAttributeMultiprocessorCount, dev) != hipSuccess) { grid = -1; return; }
        if (hipFuncSetAttribute((const void*)mk_fwd, hipFuncAttributeMaxDynamicSharedMemorySize, LDS_BYTES) != hipSuccess) { fprintf(stderr, "kernel_launch: hipFuncSetAttribute failed\n"); grid = -1; return; }
        if (hipOccupancyMaxActiveBlocksPerMultiprocessor(&per_cu, (const void*)mk_fwd, NTHR, LDS_BYTES) != hipSuccess || per_cu < 1) { fprintf(stderr, "kernel_launch: occupancy query says %d\n", per_cu); }
        (void)hipGetLastError();
        grid = cus;
    }
    if (grid < 0) return;
    (void)hipMemsetAsync((char*)d_ws + WS_CTL, 0, CTL_ZERO_BYTES, stream);
    Args a{};
    for (int i = 0; i < 40; ++i) a.in[i] = d_in[i];
    a.out = (float*)d_out; a.ws = (unsigned char*)d_ws;
#if MK_DEBUG
    const size_t fo_off = (WS_FAST_END + 4095) & ~(size_t)4095, nv_off = fo_off + (((size_t)O_END * 4 + 4095) & ~(size_t)4095), chk_off = nv_off + (((size_t)nv::WS_FLOATS * 4 + 4095) & ~(size_t)4095);
    if (ws_size < chk_off + 4096) { fprintf(stderr, "debug build: workspace too small (%zu < %zu)\n", ws_size, chk_off + 4096); return; }
    float* fast_out = (float*)((char*)d_ws + fo_off); float* nvws = (float*)((char*)d_ws + nv_off); double* chk = (double*)((char*)d_ws + chk_off);
    nv::forward(d_in, (float*)d_out, nvws, stream);
    a.out = fast_out;
    (void)hipMemsetAsync(chk, 0, 4096, stream);
#endif
#if MK_ONE_LAUNCH
    a.ph_lo = 0; a.ph_hi = N_PHASES; a.use_bar = 1;
    hipLaunchKernelGGL(mk_fwd, dim3(grid), dim3(NTHR), LDS_BYTES, stream, a);
#else
    for (int p = 0; p < N_PHASES; ++p) { a.ph_lo = p; a.ph_hi = p + 1; a.use_bar = 0; hipLaunchKernelGGL(mk_fwd, dim3(grid), dim3(NTHR), LDS_BYTES, stream, a); }
#endif
#if MK_DEBUG
    {
        const nv::Bufs B = nv::carve(nvws); unsigned char* ws = (unsigned char*)d_ws; int k = 0; const float* no = (const float*)d_out;
        auto cmp = [&](const void* fast, int isbf, long ldf, const float* ref, long ldr, long rows, long cols, float scale) {
            Chk c{fast, ref, isbf, rows, cols, ldf, ldr, scale}; hipLaunchKernelGGL(k_compare, dim3(1024), dim3(256), 0, stream, c, chk + 2 * k); ++k; };
        cmp(ws + WS_KB, 1, SBW, B.PROJ + 512, INW, MPR, SBW, 1.f);
        cmp(ws + WS_VB, 1, SBW, B.PROJ + 1024, INW, MPR, SBW, 1.f);
        cmp(ws + WS_QB, 1, SBW, B.PROJ, INW, MPR, SBW, 1.f / C2);
        hipLaunchKernelGGL(k_compare_xh, dim3(1024), dim3(256), 0, stream, (const unsigned short*)(ws + WS_XH), B.PROJ, B.HS, 0, chk + 2 * k); ++k;
        cmp(ws + WS_MKB, 1, D, no + O_MKP, D, NB * MT, D, 1.f);
        cmp(ws + WS_MVB, 1, D, no + O_MVP, D, NB * MT, D, 1.f);
        cmp(ws + WS_OSB, 1, SBW, B.OSB, SBW, MPR, SBW, 1.f);
        cmp(ws + WS_OSB + (size_t)MPR * SBW * 2, 1, SBW, B.OSB + (size_t)MPR * SBW, SBW, MS, SBW, 1.f);
        hipLaunchKernelGGL(k_compare_xh, dim3(1024), dim3(256), 0, stream, (const unsigned short*)(ws + WS_XH), B.PROJ, B.HS, 1, chk + 2 * k); ++k;
        cmp(ws + WS_YG, 1, SBW, B.YG, SBW, MPR, SBW, 1.f);
        cmp(ws + WS_YG + (size_t)MPR * SBW * 2, 1, SBW, B.YG + (size_t)MPR * SBW, SBW, MS, SBW, 1.f);
        cmp(ws + WS_OSSM, 1, SBW, B.OSSM, SBW, MALL, SBW, 1.f);
        cmp(ws + WS_X1, 0, D, B.X1, D, MALL, D, 1.f);
        cmp(ws + WS_QM, 1, D, B.Q, D, MALL, D, 1.f / CM);
        cmp(ws + WS_OMEM, 1, D, B.OM, D, MPR, D, 1.f);
        cmp(ws + WS_OMEM + (size_t)MPR * D * 2, 1, D, B.OM + (size_t)MPR * D, D, MS, D, 1.f);
        cmp(ws + WS_X2, 0, D, B.X2, D, MALL, D, 1.f);
        cmp(ws + WS_X2B, 1, D, B.X2, D, MALL, D, 1.f);
        cmp(ws + WS_UB, 1, FF, B.ACT, FF, MALL, FF, 1.f);
        const size_t offs[15] = {O_YP, O_YS, O_KP, O_VP, O_REP, O_IMP, O_CVP, O_MKP, O_MVP, O_KS, O_VS, O_RES, O_IMS, O_CVS, O_END};
        for (int i = 0; i < 14; ++i) cmp(fast_out + offs[i], 0, 1, no + offs[i], 1, (long)(offs[i + 1] - offs[i]), 1, 1.f);
        hipLaunchKernelGGL(k_judge, dim3(1), dim3(64), 0, stream, (const double*)chk, k, 2e-3f, (float*)d_out);
    }
#endif
}
```

```cpp
#define MK_DEBUG 0
#define MK_ONE_LAUNCH 1
#define MK_PROBE 0
#include <hip/hip_runtime.h>
#include <cstdio>
#include <cstdint>
#include <cmath>
namespace pg8 {
#define PG8_LAS __attribute__((address_space(3)))
typedef unsigned short bf16_t;
typedef short bf16x8 __attribute__((ext_vector_type(8)));
typedef float f32x4 __attribute__((ext_vector_type(4)));
typedef unsigned u32x4 __attribute__((ext_vector_type(4)));
constexpr int BM = 256, BK = 64, HALF = 128, HTB = HALF * BK * 2  , STAGE_BYTES = 8 * HTB, NXCD = 8, WGM = 8;

__host__ __device__ __forceinline__ int lds_byte(int r, int c) { const int st = (r >> 4) * 2 + (c >> 5), rr = r & 15, cc = c & 31, ob = rr * 64 + cc * 2; return st * 1024 + (ob ^ (((ob >> 9) & 1) << 5)); }
__host__ __device__ __forceinline__ void stage_rc(int b, int& R, int& C) { const int st = b / 1024, sb = b % 1024, swz = sb ^ (((sb >> 9) & 1) << 5); R = (st >> 1) * 16 + swz / 64; C = (st & 1) * 32 + (swz % 64) / 2; }
__host__ __device__ __forceinline__ int perm32(int rho) { const int n = rho >> 4, i = rho & 15; return 8 * (i >> 2) + 4 * n + (i & 3); }

struct Unit { int pm, pn; };
struct Gemm { const bf16_t* A; const bf16_t* Bt; int lda, ldb, K; int bhalf = HALF; };

struct GridOrder {
    int nM, nN, nwg, G, c; size_t astep, bstep;
    __device__ void init(int nM_, int nN_, int G_, int c_, int shift, int lda, int ldb) { nM = nM_; nN = nN_; nwg = nM * nN; G = G_; c = (c_ + G_ - (shift % G_)) % G_; astep = (size_t)BM * lda * 2; bstep = (size_t)BM * ldb * 2; }
    __device__ bool next(int i, Unit& u) const {
        const long L = (long)i * G + c; if (L >= nwg) return false;
        int wgid = (int)L; { const int q = nwg / NXCD, r = nwg % NXCD, xcd = wgid % NXCD, off = wgid / NXCD; wgid = (xcd < r ? xcd * (q + 1) : r * (q + 1) + (xcd - r) * q) + off; }
        const int nig = WGM * nN, gid = wgid / nig, fm = gid * WGM, gsz = (nM - fm) < WGM ? (nM - fm) : WGM;
        u.pm = fm + ((wgid % nig) % gsz); u.pn = (wgid % nig) / gsz; return true;
    }
    __device__ __forceinline__ size_t aoff(const Unit& u) const { return (size_t)u.pm * astep; }
    __device__ __forceinline__ size_t boff(const Unit& u) const { return (size_t)u.pn * bstep; }
};

__device__ __forceinline__ unsigned cvt_pk_bf16(float lo, float hi) { unsigned r; asm volatile("v_cvt_pk_bf16_f32 %0, %1, %2" : "=v"(r) : "v"(lo), "v"(hi)); return r; }

template <class Epi, class Sched, bool ALIGN_EPI = true, bool SP2 = true>
__device__ __forceinline__ void gemm_phase(PG8_LAS unsigned char* lds, const Gemm g, const Sched& S, const Epi& E) {
    const int tid = threadIdx.x, wid = __builtin_amdgcn_readfirstlane(tid >> 6), lane = tid & 63, wr = wid >> 2, wc = wid & 3, fr = lane & 15, fq = lane >> 4;
    const int K = g.K, nt = K / BK;
    unsigned voffA[2], voffB[2];
#pragma unroll
    for (int i = 0; i < 2; ++i) { int R, C; stage_rc(tid * 16 + i * 8192, R, C); const int Rb = (R & ~31) + perm32(R & 31);
        voffA[i] = (unsigned)(R * g.lda + C) * 2u; voffB[i] = (unsigned)(Rb * g.ldb + C) * 2u; }
    const size_t kstep = (size_t)(BK * 2);
    const size_t hstepA = (size_t)HALF * g.lda * 2, hstepB = (size_t)g.bhalf * g.ldb * 2;
    const unsigned ldsw = (unsigned)wid * 1024u;
    const int aoff = lds_byte(wr * 64 + fr, fq * 8), boff = lds_byte(wc * 32 + fr, fq * 8);
#define PG8_SA(b, h) (((b) * 2 + (h)) * HTB)
#define PG8_SB(b, h) ((4 + (b) * 2 + (h)) * HTB)
#define PG8_STAGE(bufoff, gbase, voff) do { _Pragma("unroll") for (int _i = 0; _i < 2; ++_i) \
        __builtin_amdgcn_global_load_lds((const unsigned*)((const char*)(gbase) + (voff)[_i]), (PG8_LAS unsigned*)(lds + (bufoff) + ldsw + _i * 8192), 16, 0, 0); } while (0)
#define PG8_LDA(dst, b, h) do { _Pragma("unroll") for (int m = 0; m < 4; ++m) _Pragma("unroll") for (int k = 0; k < 2; ++k) dst[m][k] = *(const PG8_LAS bf16x8*)(lds + PG8_SA(b, h) + aoff + m * 2048 + k * 1024); } while (0)
#define PG8_LDB(dst, b, h) do { _Pragma("unroll") for (int n = 0; n < 2; ++n) _Pragma("unroll") for (int k = 0; k < 2; ++k) dst[n][k] = *(const PG8_LAS bf16x8*)(lds + PG8_SB(b, h) + boff + n * 2048 + k * 1024); } while (0)
#define PG8_MMA(ai, bj, At, Bt) do { __builtin_amdgcn_s_setprio(1); _Pragma("unroll") for (int m = 0; m < 4; ++m) _Pragma("unroll") for (int n = 0; n < 2; ++n) _Pragma("unroll") for (int k = 0; k < 2; ++k) \
        acc[ai][bj][m][n] = __builtin_amdgcn_mfma_f32_16x16x32_bf16(Bt[n][k], At[m][k], acc[ai][bj][m][n], 0, 0, 0); __builtin_amdgcn_s_setprio(0); } while (0)
#define PG8_WAIT_V(n) asm volatile("s_waitcnt vmcnt(" #n ")" ::: "memory")
#define PG8_WAIT_L(n) asm volatile("s_waitcnt lgkmcnt(" #n ")" ::: "memory")
#define PG8_BAR __builtin_amdgcn_s_barrier()
#define PG8_SCHED __builtin_amdgcn_sched_barrier(0)
    Unit cur, nxt; int ui = 0;
    if (!S.next(0, cur)) return;
    f32x4 acc[2][2][4][2];
#pragma unroll
    for (int a = 0; a < 2; ++a)
#pragma unroll
        for (int b = 0; b < 2; ++b)
#pragma unroll
            for (int m = 0; m < 4; ++m)
#pragma unroll
                for (int n = 0; n < 2; ++n) acc[a][b][m][n] = (f32x4){0.f, 0.f, 0.f, 0.f};
    bf16x8 At[4][2], B0[2][2], B1[2][2];
    const char* cA = (const char*)g.A + S.aoff(cur); const char* cB = (const char*)g.Bt + S.boff(cur);
    static_assert(SP2, "only the SP2 loop is kept in this file");
    PG8_STAGE(PG8_SB(0, 0), cB, voffB); PG8_STAGE(PG8_SB(0, 1), cB + hstepB, voffB); PG8_STAGE(PG8_SA(0, 0), cA, voffA); PG8_STAGE(PG8_SA(0, 1), cA + hstepA, voffA);
    if (wr == 1) PG8_BAR;
    PG8_WAIT_V(2); PG8_BAR;
    PG8_STAGE(PG8_SB(1, 0), cB + kstep, voffB); PG8_STAGE(PG8_SA(1, 0), cA + kstep, voffA); PG8_STAGE(PG8_SB(1, 1), cB + hstepB + kstep, voffB);
    PG8_WAIT_V(6); PG8_BAR;
    for (;;) {
        const bool has_next = S.next(ui + 1, nxt);
        const char* nA = has_next ? (const char*)g.A + S.aoff(nxt) : cA; const char* nB = has_next ? (const char*)g.Bt + S.boff(nxt) : cB;
        for (int t = 0; t < nt; t += 2) {
            const bool last = (t == nt - 2);
            const char* a1 = cA + (size_t)(t + 1) * kstep;
            const char* a2 = last ? nA : cA + (size_t)(t + 2) * kstep; const char* b2 = last ? nB : cB + (size_t)(t + 2) * kstep;
            const char* a3 = a2 + kstep; const char* b3 = b2 + kstep;
            PG8_LDB(B0, 0, 0); PG8_LDB(B1, 0, 1); PG8_SCHED; PG8_LDA(At, 0, 0); PG8_STAGE(PG8_SA(1, 1), a1 + hstepA, voffA);
            PG8_WAIT_V(8); PG8_WAIT_L(0); PG8_BAR; PG8_MMA(0, 0, At, B0); PG8_MMA(0, 1, At, B1); PG8_BAR; PG8_SCHED;
            PG8_LDA(At, 0, 1); PG8_STAGE(PG8_SB(0, 0), b2, voffB); PG8_STAGE(PG8_SB(0, 1), b2 + hstepB, voffB); PG8_STAGE(PG8_SA(0, 0), a2, voffA);
            PG8_WAIT_V(8); PG8_WAIT_L(0); PG8_BAR; PG8_MMA(1, 0, At, B0); PG8_MMA(1, 1, At, B1); PG8_BAR; PG8_SCHED;
            PG8_LDB(B0, 1, 0); PG8_LDB(B1, 1, 1); PG8_SCHED; PG8_LDA(At, 1, 0); PG8_STAGE(PG8_SA(0, 1), a2 + hstepA, voffA);
            PG8_WAIT_V(8); PG8_WAIT_L(0); PG8_BAR; PG8_MMA(0, 0, At, B0); PG8_MMA(0, 1, At, B1); PG8_BAR; PG8_SCHED;
            PG8_LDA(At, 1, 1); PG8_STAGE(PG8_SB(1, 0), b3, voffB); PG8_STAGE(PG8_SB(1, 1), b3 + hstepB, voffB); PG8_STAGE(PG8_SA(1, 0), a3, voffA);
            PG8_WAIT_V(8); PG8_WAIT_L(0); PG8_BAR; PG8_MMA(1, 0, At, B0); PG8_MMA(1, 1, At, B1); PG8_BAR; PG8_SCHED;
        }
        if constexpr (ALIGN_EPI) { if (wr == 0) PG8_BAR; }
        E(acc, cur, wr, wc, fr, fq);
        if (!has_next) break;
#pragma unroll
        for (int a = 0; a < 2; ++a)
#pragma unroll
            for (int b = 0; b < 2; ++b)
#pragma unroll
                for (int m = 0; m < 4; ++m)
#pragma unroll
                    for (int n = 0; n < 2; ++n) acc[a][b][m][n] = (f32x4){0.f, 0.f, 0.f, 0.f};
        cur = nxt; cA = nA; cB = nB; ++ui;
        if constexpr (ALIGN_EPI) { if (wr == 1) PG8_BAR; }
    }
    PG8_WAIT_V(0);
    if constexpr (!ALIGN_EPI) { if (wr == 0) PG8_BAR; }
    PG8_BAR;
#undef PG8_SA
#undef PG8_SB
#undef PG8_STAGE
#undef PG8_LDA
#undef PG8_LDB
#undef PG8_MMA
#undef PG8_WAIT_V
#undef PG8_WAIT_L
#undef PG8_BAR
#undef PG8_SCHED
}
}
constexpr int NWAVES = 8, NTHR = 512;
constexpr int D = 1024, NB = 4, T = 4096, MPR = NB * T, MS = 128, MALL = MPR + MS, MPAD = 16640;
constexpr int SBW = 512, NH = 8, HD = 64, NG = 32, GP = 16, NST = 64, INW = 2048, FF = 2816, NFF2 = 2 * FF;
constexpr int MT = 256, MH = 4, MHD = 256, PAST = 2048, PAGE = 128, NPG = 16;
constexpr int LC = 16, NCH = T / LC, XHP = 384;
constexpr float EPS = 1e-6f, LOG2E = 1.4426950408889634f;
constexpr float C2 = 0.125f * LOG2E;
constexpr float CM = 0.0625f * LOG2E;

constexpr size_t O_YP = 0, O_YS = O_YP + (size_t)MPR * D, O_KP = O_YS + (size_t)MS * D, O_VP = O_KP + (size_t)MPR * SBW, O_REP = O_VP + (size_t)MPR * SBW,
    O_IMP = O_REP + NB * NG * NST, O_CVP = O_IMP + NB * NG * NST, O_MKP = O_CVP + (size_t)NB * 2 * FF, O_MVP = O_MKP + (size_t)NB * MT * D, O_KS = O_MVP + (size_t)NB * MT * D,
    O_VS = O_KS + (size_t)MS * SBW, O_RES = O_VS + (size_t)MS * SBW, O_IMS = O_RES + (size_t)MS * NG * NST, O_CVS = O_IMS + (size_t)MS * NG * NST, O_END = O_CVS + (size_t)MS * 2 * FF;

constexpr size_t MiB = 1u << 20;
constexpr size_t al(size_t x) { return (x + 4095) & ~(size_t)4095; }
constexpr size_t WS_CTL = 0, CTL_ZERO_BYTES = 1 * MiB;
constexpr size_t WS_WIN = 1 * MiB;
constexpr size_t WS_WMKV = WS_WIN + al((size_t)INW * D * 2);
constexpr size_t WS_WGLU = WS_WMKV + al((size_t)2048 * D * 2);
constexpr size_t WS_WOUT = WS_WGLU + al((size_t)SBW * SBW * 2);
constexpr size_t WS_WMQ = WS_WOUT + al((size_t)D * D * 2);
constexpr size_t WS_WMO = WS_WMQ + al((size_t)D * D * 2);
constexpr size_t WS_WGU = WS_WMO + al((size_t)D * D * 2);
constexpr size_t WS_WDN = WS_WGU + al((size_t)NFF2 * D * 2);
constexpr size_t WS_W1 = WS_WDN + al((size_t)D * FF * 2);
constexpr size_t WS_BTC = WS_W1 + al((size_t)33 * 128 * 256 * 2);
constexpr size_t WS_XB = WS_BTC + al((size_t)NG * 256 * XHP * 2);
constexpr size_t WS_RSTD0 = WS_XB + al((size_t)MPAD * D * 2);
constexpr size_t WS_MB = WS_RSTD0 + al((size_t)MPAD * 4);
constexpr size_t WS_RSTDM = WS_MB + al((size_t)1024 * D * 2);
constexpr size_t WS_QB = WS_RSTDM + al(4096);
constexpr size_t WS_KB = WS_QB + al((size_t)MPAD * SBW * 2);
constexpr size_t WS_VB = WS_KB + al((size_t)MPAD * SBW * 2);
constexpr size_t WS_QS = WS_VB + al((size_t)MPAD * SBW * 2);
constexpr size_t WS_US = WS_QS + al((size_t)MS * SBW * 4);
constexpr size_t WS_XH = WS_US + al((size_t)MS * SBW * 4);
constexpr size_t WS_SST = WS_XH + al((size_t)1024 * NG * XHP * 2 + 65536);
constexpr size_t WS_YG = WS_SST + al((size_t)1024 * NG * 128 * 4);
constexpr size_t WS_OSB = WS_YG + al((size_t)MPAD * SBW * 2);
constexpr size_t WS_OSSM = WS_OSB + al((size_t)MPAD * SBW * 2);
constexpr size_t WS_SBPO = WS_OSSM + al((size_t)MPAD * SBW * 2);
constexpr size_t WS_SBPL = WS_SBPO + al((size_t)MS * NPG * NH * HD * 4);
constexpr size_t WS_MIX = WS_SBPL + al((size_t)MS * NPG * NH * 4);
constexpr size_t WS_X1 = WS_MIX + al((size_t)MPAD * D * 2);
constexpr size_t WS_X1B = WS_X1 + al((size_t)MPAD * D * 4);
constexpr size_t WS_MKB = WS_X1B + al((size_t)MPAD * D * 2);
constexpr size_t WS_MVB = WS_MKB + al((size_t)1024 * D * 2);
constexpr size_t WS_QM = WS_MVB + al((size_t)1024 * D * 2);
constexpr size_t WS_OMEM = WS_QM + al((size_t)MPAD * D * 2);
constexpr size_t WS_X2 = WS_OMEM + al((size_t)MPAD * D * 2);
constexpr size_t WS_X2B = WS_X2 + al((size_t)MPAD * D * 4);
constexpr size_t WS_GB = WS_X2B + al((size_t)MPAD * D * 2);
constexpr size_t WS_UB = WS_GB + al((size_t)MPAD * FF * 2);
constexpr size_t WS_FAST_END = WS_UB + al((size_t)MPAD * FF * 2);
constexpr int CW_TMO = 0, CW_CODE = 1, CW_QA = 2048, CW_QM = 2112, CW_BAR = 4096;
constexpr int CW_SSQ1 = 16384, CW_SSQ2 = CW_SSQ1 + MPAD, CW_SSQ3 = CW_SSQ2 + MPAD;
static_assert((CW_SSQ3 + MPAD) * 4 <= (int)CTL_ZERO_BYTES, "CTL words inside the memset region");

constexpr int RING_OFF = 0, RING_BYTES = 131072;
constexpr int LDSCTL_OFF = RING_BYTES, MISC_OFF = LDSCTL_OFF + 320;
constexpr int LDS_BYTES = 147456;
static_assert(MISC_OFF + 128 <= LDS_BYTES, "LDS map");

#define GAS __attribute__((address_space(1)))
#define LAS __attribute__((address_space(3)))
typedef unsigned short bf16;
typedef unsigned v4u __attribute__((ext_vector_type(4)));
typedef unsigned v2u __attribute__((ext_vector_type(2)));
typedef float f32x4 __attribute__((ext_vector_type(4)));
typedef float f32x2 __attribute__((ext_vector_type(2)));
typedef float f32x16 __attribute__((ext_vector_type(16)));
typedef short bf16x8 __attribute__((ext_vector_type(8)));
typedef short s16x4 __attribute__((ext_vector_type(4)));
typedef GAS unsigned gu32;
#define RLX_AGENT __ATOMIC_RELAXED, __HIP_MEMORY_SCOPE_AGENT
#define LDS_WAIT() asm volatile("s_waitcnt lgkmcnt(0)" ::: "memory")
#define VM_WAIT() asm volatile("s_waitcnt vmcnt(0)" ::: "memory")
__device__ __forceinline__ unsigned f2bf(float f) { unsigned u = __builtin_bit_cast(unsigned, f); return (u + 0x7fffu + ((u >> 16) & 1u)) >> 16; }
__device__ __forceinline__ unsigned pk2(float lo, float hi) { return f2bf(lo) | (f2bf(hi) << 16); }
__device__ __forceinline__ float bf2f(unsigned short h) { return __builtin_bit_cast(float, (unsigned)h << 16); }
__device__ __forceinline__ float bflo(unsigned w) { return __builtin_bit_cast(float, w << 16); }
__device__ __forceinline__ float bfhi(unsigned w) { return __builtin_bit_cast(float, w & 0xffff0000u); }
__device__ __forceinline__ unsigned cvtpk(float lo, float hi) { return pg8::cvt_pk_bf16(lo, hi); }
__device__ __forceinline__ float gelu_tanh_f(float x) {
    const float u2 = 2.f * 0.7978845608028654f * (x + 0.044715f * x * x * x);
    return x * __builtin_amdgcn_rcpf(1.f + __builtin_amdgcn_exp2f(-u2 * LOG2E));
}
__device__ __forceinline__ float wave_sum(float v) {
#pragma unroll
    for (int o = 1; o < 64; o <<= 1) v += __shfl_xor(v, o);
    return v;
}

#define XB_TMO      128
#define XB_XCNT(j)  (256  + 64 * (j))
#define XB_XSUB(j)  (1280 + 64 * (j))
#define XB_XGEN(j)  (2304 + 64 * (j))
#define XB_TOP      3328
#define XB_TOPGEN   3392
#define XCD_BAR_WORDS 3456
#define XB_SPIN_CAP (1u << 18)
__device__ __forceinline__ unsigned xb_ld(unsigned* p)              { return __hip_atomic_load(p, __ATOMIC_RELAXED, __HIP_MEMORY_SCOPE_AGENT); }
__device__ __forceinline__ unsigned xb_add(unsigned* p, unsigned v) { return __hip_atomic_fetch_add(p, v, __ATOMIC_RELAXED, __HIP_MEMORY_SCOPE_AGENT); }
__device__ __forceinline__ unsigned xb_xcc_id() { return (unsigned)__builtin_amdgcn_s_getreg((3 << 11) | 20) & 0xFu; }
#define XB_SPIN(cond, bar) do { unsigned _sp = 0; while (cond) { __builtin_amdgcn_s_sleep(1); \
    if ((++_sp & 255u) == 0u) { if (xb_ld(&(bar)[XB_TMO])) break; if (_sp > XB_SPIN_CAP) { atomicAdd(&(bar)[XB_TMO], 1u); break; } } } } while (0)
struct XcdBarrier { unsigned* bar; unsigned x; volatile LAS unsigned* st; };
__device__ __forceinline__ XcdBarrier xcd_barrier_post(unsigned* bar, volatile LAS unsigned* st) {
    XcdBarrier b; b.bar = bar; b.x = xb_xcc_id(); b.st = st;
    if (threadIdx.x == 0) (void)xb_add(&bar[XB_XCNT(b.x)], 1u);
    return b;
}
__device__ __forceinline__ void xcd_barrier_complete(unsigned* bar, unsigned x, unsigned& nloc, unsigned& nx) {
    const unsigned G = gridDim.x * gridDim.y * gridDim.z;
    unsigned sum, cnt, mine, sp = 0u;
    for (;;) {
        sum = 0u; cnt = 0u; mine = 0u;
#pragma unroll
        for (unsigned j = 0; j < 16; ++j) { const unsigned c = xb_ld(&bar[XB_XCNT(j)]); sum += c; cnt += (c > 0u) ? 1u : 0u; mine = (j == x) ? c : mine; }
        if (sum == G) break;
        __builtin_amdgcn_s_sleep(1);
        if ((++sp & 255u) == 0u) { if (xb_ld(&bar[XB_TMO])) break; if (sp > XB_SPIN_CAP) { atomicAdd(&bar[XB_TMO], 1u); break; } }
    }
    nloc = mine > 0u ? mine : 1u; nx = cnt > 0u ? cnt : 1u;
}
__device__ __forceinline__ void xcd_barrier(const XcdBarrier& b) {
    asm volatile("s_waitcnt vmcnt(0)" ::: "memory");
    __syncthreads();
    if (threadIdx.x == 0) {
        unsigned* bar = b.bar;
        __builtin_amdgcn_s_waitcnt(0);
        unsigned nloc = b.st[0], nx = b.st[1];
        if (nloc == 0u) { xcd_barrier_complete(bar, b.x, nloc, nx); b.st[0] = nloc; b.st[1] = nx; }
        const unsigned old = xb_add(&bar[XB_XSUB(b.x)], 1u);
        const unsigned gen = old / nloc;
        if (old + 1u == (gen + 1u) * nloc) {
            __builtin_amdgcn_fence(__ATOMIC_RELEASE, "agent");
            asm volatile("s_waitcnt vmcnt(0)" ::: "memory");
            const unsigned og = xb_add(&bar[XB_TOP], 1u);
            const unsigned tg = og / nx;
            if (og + 1u == (tg + 1u) * nx) xb_add(&bar[XB_TOPGEN], 1u);
            else XB_SPIN(xb_ld(&bar[XB_TOPGEN]) == tg, bar);
            __builtin_amdgcn_fence(__ATOMIC_ACQUIRE, "agent");
            xb_add(&bar[XB_XGEN(b.x)], 1u);
            asm volatile("s_waitcnt vmcnt(0)" ::: "memory");
        } else {
            XB_SPIN(xb_ld(&bar[XB_XGEN(b.x)]) == gen, bar);
            __builtin_amdgcn_fence(__ATOMIC_ACQUIRE, "agent");
            asm volatile("s_waitcnt vmcnt(0)" ::: "memory");
        }
    }
    __syncthreads();
}

struct Args { const void* in[40]; float* out; unsigned char* ws; int ph_lo, ph_hi, use_bar, pad; };
struct Frame {
    LAS unsigned char* lds; volatile LAS unsigned* MISC; unsigned* ctl;
    int tid, lane, wave, vcu, G;
    unsigned char* ws; float* out; const void* const* in;
};
#define INF(i) ((const float*)F.in[i])
#define WSP(T_, off) ((T_*)(F.ws + (off)))
__device__ __forceinline__ void p0_transpose_item(const float* W, int K, int N, bf16* WT, int row_off, const float* gain, LAS float* scr, int item, int lane) {
    const int nblk = N / 32, kb = item / nblk, nb = item % nblk, k0 = 64 * kb, n0 = 32 * nb;
    float wv[32];
#pragma unroll
    for (int i = 0; i < 32; ++i) wv[i] = W[(size_t)(k0 + 2 * i + (lane >> 5)) * N + n0 + (lane & 31)];
#pragma unroll
    for (int i = 0; i < 32; ++i) { const int kk = 2 * i + (lane >> 5); const float gv = gain ? gain[k0 + kk] : 1.f; scr[kk * 33 + (lane & 31)] = wv[i] * gv; }
    LDS_WAIT(); asm volatile("" ::: "memory");
    const int c = lane & 7;
#pragma unroll
    for (int j = 0; j < 4; ++j) { const int n = (lane >> 3) + 8 * j; const LAS float* s = scr + (8 * c) * 33 + n;
        v4u o; o.x = pk2(s[0 * 33], s[1 * 33]); o.y = pk2(s[2 * 33], s[3 * 33]); o.z = pk2(s[4 * 33], s[5 * 33]); o.w = pk2(s[6 * 33], s[7 * 33]);
        *(GAS v4u*)(WT + (size_t)(row_off + n0 + n) * K + k0 + 8 * c) = o; }
    LDS_WAIT(); asm volatile("" ::: "memory");
}
__device__ __forceinline__ void rows2_to_bf16_rstd(const float* xrow, bf16* orow, float* rstd, int lane) {
    f32x4 v[2][4]; float s[2] = {0.f, 0.f};
#pragma unroll
    for (int r = 0; r < 2; ++r)
#pragma unroll
        for (int j = 0; j < 4; ++j) v[r][j] = ((const GAS f32x4*)(xrow + (size_t)r * D) + lane)[64 * j];
#pragma unroll
    for (int r = 0; r < 2; ++r) {
#pragma unroll
        for (int j = 0; j < 4; ++j) s[r] += (v[r][j].x * v[r][j].x + v[r][j].y * v[r][j].y) + (v[r][j].z * v[r][j].z + v[r][j].w * v[r][j].w);
        GAS v2u* o8 = (GAS v2u*)(orow + (size_t)r * D) + lane;
#pragma unroll
        for (int j = 0; j < 4; ++j) { v2u w; w.x = pk2(v[r][j].x, v[r][j].y); w.y = pk2(v[r][j].z, v[r][j].w); o8[64 * j] = w; }
    }
    s[0] = wave_sum(s[0]); s[1] = wave_sum(s[1]);
    if (lane < 2) rstd[lane] = 1.f / sqrtf((lane ? s[1] : s[0]) * (1.f / D) + EPS);
}
__device__ __forceinline__ void lam_pow(float lr, float li, float logdt, int tau, float& pr, float& pi) {
    const double dt = exp((double)logdt);
    const double ang = (double)li * dt * (double)tau;
    const double k = rint(ang * 0.15915494309189535);
    double r = fma(-k, 6.283185307179586, ang); r = fma(-k, 2.4492935982947064e-16, r);
    const float rf = (float)r, mag = (float)exp((double)lr * dt * (double)tau);
    pr = mag * cosf(rf); pi = mag * sinf(rf);
}
__device__ __forceinline__ void lam_coef(float lr, float li, float logdt, float& cr, float& ci) {
    const double dt = exp((double)logdt);
    const double ang = (double)li * dt;
    const double k = rint(ang * 0.15915494309189535);
    double r = fma(-k, 6.283185307179586, ang); r = fma(-k, 2.4492935982947064e-16, r);
    const float th = (float)r, a = (float)((double)lr * dt);
    const float sh = sinf(0.5f * th);
    const float nr = expm1f(a) * cosf(th) - 2.f * sh * sh, ni = expf(a) * sinf(th);
    const float den = lr * lr + li * li;
    cr = (nr * lr + ni * li) / den; ci = (ni * lr - nr * li) / den;
}
__device__ __forceinline__ void ssm_table_unit(Frame& F, int g, int tau) {
    LAS float* Mr = (LAS float*)(F.lds + RING_OFF); LAS float* Mi = Mr + 1024; LAS float* Pr = Mi + 1024; LAS float* Pi = Pr + 64; LAS float* Cr = Pi + 64; LAS float* Ci = Cr + 64;
    LAS float* Kt = Ci + 64; LAS float* CRE = Kt + 256; LAS float* CIM = CRE + 1024;
    const float* lam_re = INF(14); const float* lam_im = INF(15); const float* log_dt = INF(16); const float* b_re = INF(17); const float* b_im = INF(18);
    const float* c_re = INF(19); const float* c_im = INF(20); const float* d_skip = INF(21);
    bf16* W1 = WSP(bf16, WS_W1); bf16* BTC = WSP(bf16, WS_BTC);
    const int tid = F.tid; const float ldt = log_dt[g];
    __syncthreads();
    if (tid < 64) { float pr, pi, cr, ci; const float lr = lam_re[g * NST + tid], li = lam_im[g * NST + tid]; lam_pow(lr, li, ldt, tau, pr, pi); lam_coef(lr, li, ldt, cr, ci); Pr[tid] = pr; Pi[tid] = pi; Cr[tid] = cr; Ci[tid] = ci; }
    for (int i = tid; i < 1024; i += NTHR) { CRE[i] = c_re[g * 1024 + i]; CIM[i] = c_im[g * 1024 + i]; }
    __syncthreads();
    for (int i = tid; i < 1024; i += NTHR) { const int n = i >> 4; const float cr = Cr[n], ci = Ci[n];
        const float br = b_re[g * 1024 + i], bi = b_im[g * 1024 + i]; const float bbr = cr * br - ci * bi, bbi = cr * bi + ci * br;
        const float pr = Pr[n], pi = Pi[n]; Mr[i] = pr * bbr - pi * bbi; Mi[i] = pr * bbi + pi * bbr; }
    __syncthreads();
    if (tau <= 15) {
        const int s = 15 - tau;
        for (int i = tid; i < 2048; i += NTHR) { const int n = i >> 5, ri = (i >> 4) & 1, q = i & 15; const float v = ri ? Mi[n * 16 + q] : Mr[n * 16 + q];
            W1[((size_t)g * 128 + 2 * n + ri) * 256 + s * 16 + q] = (bf16)f2bf(v); }
        if (tid < 256) { const int p = tid >> 4, q = tid & 15; float acc = 0.f;
#pragma unroll 8
            for (int n = 0; n < NST; ++n) acc += CRE[p * NST + n] * Mr[n * 16 + q] - CIM[p * NST + n] * Mi[n * 16 + q];
            if (tau == 0 && p == q) acc += d_skip[g * GP + p];
            Kt[tid] = acc; }
        __syncthreads();
        for (int idx = tid; idx < (16 - tau) * 256; idx += NTHR) { const int blk = idx >> 8, e = idx & 255, p = e >> 4, q = e & 15; const int s2 = blk, t2 = s2 + tau;
            BTC[((size_t)g * 256 + t2 * 16 + p) * XHP + s2 * 16 + q] = (bf16)f2bf(Kt[e]);
            if (tau >= 1) BTC[((size_t)g * 256 + s2 * 16 + p) * XHP + t2 * 16 + q] = (bf16)0; }
    }
    if (tau >= 1) {
        const int t2 = tau - 1;
        for (int idx = tid; idx < 1024; idx += NTHR) { const int p = idx >> 6, n = idx & 63; const float cr = CRE[idx], ci = CIM[idx], pr = Pr[n], pi = Pi[n];
            const unsigned w = pk2(cr * pr - ci * pi, -(cr * pi + ci * pr));
            *(GAS unsigned*)(BTC + ((size_t)g * 256 + t2 * 16 + p) * XHP + 256 + 2 * n) = w; }
    }
    __syncthreads();
}
__device__ __forceinline__ void p0_prologue(Frame& F) {
    LAS float* scr = (LAS float*)(F.lds + RING_OFF + F.wave * 16384);
    const int gw = F.vcu * NWAVES + F.wave, NGW = F.G * NWAVES;
    constexpr int I_IN = 16 * 64, I_MK = 16 * 32, I_GLU = 8 * 16, I_SQ = 16 * 32, I_G = 16 * 88, I_DN = 44 * 32;
    constexpr int NITEMS = I_IN + 2 * I_MK + I_GLU + 3 * I_SQ + 2 * I_G + I_DN;
    for (int it = gw; it < NITEMS; it += NGW) {
        int r = it;
        if (r < I_IN) { p0_transpose_item(INF(12), D, INW, WSP(bf16, WS_WIN), 0, INF(11), scr, r, F.lane); continue; } r -= I_IN;
        if (r < I_MK) { p0_transpose_item(INF(30), D, D, WSP(bf16, WS_WMKV), 0, INF(28), scr, r, F.lane); continue; } r -= I_MK;
        if (r < I_MK) { p0_transpose_item(INF(31), D, D, WSP(bf16, WS_WMKV), D, INF(28), scr, r, F.lane); continue; } r -= I_MK;
        if (r < I_GLU) { p0_transpose_item(INF(22), SBW, SBW, WSP(bf16, WS_WGLU), 0, nullptr, scr, r, F.lane); continue; } r -= I_GLU;
        if (r < I_SQ) { const int kb = r / (D / 32); const float* gn = (kb < 8) ? INF(24) : INF(25) - SBW; p0_transpose_item(INF(26), D, D, WSP(bf16, WS_WOUT), 0, gn, scr, r, F.lane); continue; } r -= I_SQ;
        if (r < I_SQ) { p0_transpose_item(INF(29), D, D, WSP(bf16, WS_WMQ), 0, INF(27), scr, r, F.lane); continue; } r -= I_SQ;
        if (r < I_SQ) { p0_transpose_item(INF(32), D, D, WSP(bf16, WS_WMO), 0, nullptr, scr, r, F.lane); continue; } r -= I_SQ;
        if (r < I_G) { p0_transpose_item(INF(34), D, FF, WSP(bf16, WS_WGU), 0, INF(33), scr, r, F.lane); continue; } r -= I_G;
        if (r < I_G) { p0_transpose_item(INF(35), D, FF, WSP(bf16, WS_WGU), FF, INF(33), scr, r, F.lane); continue; } r -= I_G;
        p0_transpose_item(INF(38), FF, D, WSP(bf16, WS_WDN), 0, nullptr, scr, r, F.lane);
    }
    for (int m = 2 * gw; m < MALL; m += 2 * NGW) { const float* xr = (m < MPR) ? INF(0) + (size_t)m * D : INF(1) + (size_t)(m - MPR) * D;
        rows2_to_bf16_rstd(xr, WSP(bf16, WS_XB) + (size_t)m * D, WSP(float, WS_RSTD0) + m, F.lane); }
    for (int m = 2 * gw; m < NB * MT; m += 2 * NGW) rows2_to_bf16_rstd(INF(10) + (size_t)m * D, WSP(bf16, WS_MB) + (size_t)m * D, WSP(float, WS_RSTDM) + m, F.lane);
    for (int u = F.vcu; u < NG * 17; u += F.G) ssm_table_unit(F, u / 17, u % 17);
    { bf16* W1 = WSP(bf16, WS_W1); for (int i = gw * 64 + F.lane; i < 128 * 256 / 8; i += NGW * 64) *(GAS v4u*)(W1 + (size_t)32 * 128 * 256 + (size_t)i * 8) = (v4u){0u, 0u, 0u, 0u}; }
}

#define EPI_LOOP_BEGIN \
    _Pragma("unroll") for (int ai = 0; ai < 2; ++ai) _Pragma("unroll") for (int m = 0; m < 4; ++m) { const int row = u.pm * 256 + ai * 128 + wr * 64 + m * 16 + fr; \
    _Pragma("unroll") for (int bj = 0; bj < 2; ++bj) { const int col = u.pn * 256 + bj * 128 + wc * 32 + 8 * fq; f32x4 v0 = acc[ai][bj][m][0], v1 = acc[ai][bj][m][1];
#define EPI_LOOP_END } }
__device__ __forceinline__ v4u pack8(f32x4 a, f32x4 b) { v4u w; w.x = cvtpk(a[0], a[1]); w.y = cvtpk(a[2], a[3]); w.z = cvtpk(b[0], b[1]); w.w = cvtpk(b[2], b[3]); return w; }

struct EpiInProj {
    const float* rstd; bf16 *QBp, *KBp, *VBp, *XHp; float *QSp, *USp, *out;
    __device__ __forceinline__ void operator()(const f32x4 (&acc)[2][2][4][2], const pg8::Unit& u, int wr, int wc, int fr_, int fq_) const { int fr = fr_, fq = fq_; asm volatile("" : "+v"(fr), "+v"(fq));
        const int sect = u.pn >> 1;
        EPI_LOOP_BEGIN
            if (row < MALL) {
                const float rs = rstd[row]; v0 = v0 * rs; v1 = v1 * rs;
                const int c = col - sect * SBW;
                if (sect == 0) { v0 = v0 * C2; v1 = v1 * C2; *(v4u*)(QBp + (size_t)row * SBW + c) = pack8(v0, v1);
                    if (row >= MPR) { float* q = QSp + (size_t)(row - MPR) * SBW + c; *(f32x4*)q = v0; *(f32x4*)(q + 4) = v1; } }
                else if (sect == 1 || sect == 2) { bf16* B = (sect == 1) ? KBp : VBp; *(v4u*)(B + (size_t)row * SBW + c) = pack8(v0, v1);
                    float* o = (row < MPR) ? out + (sect == 1 ? O_KP : O_VP) + (size_t)row * SBW + c : out + (sect == 1 ? O_KS : O_VS) + (size_t)(row - MPR) * SBW + c;
                    *(f32x4*)o = v0; *(f32x4*)(o + 4) = v1; }
                else { if (row < MPR) { const int b = row >> 12, t = row & 4095, ch = t >> 4, s = t & 15, g = c >> 4, q0 = c & 15;
                        *(v4u*)(XHp + ((size_t)(b * NCH + ch) * NG + g) * XHP + s * 16 + q0) = pack8(v0, v1); }
                    else { float* q = USp + (size_t)(row - MPR) * SBW + c; *(f32x4*)q = v0; *(f32x4*)(q + 4) = v1; } }
            }
        EPI_LOOP_END
    }
};
struct EpiMemKV {
    const float* rstd; bf16 *MKBp, *MVBp; float* out;
    __device__ __forceinline__ void operator()(const f32x4 (&acc)[2][2][4][2], const pg8::Unit& u, int wr, int wc, int fr_, int fq_) const { int fr = fr_, fq = fq_; asm volatile("" : "+v"(fr), "+v"(fq));
        const int sect = u.pn >> 2;
        EPI_LOOP_BEGIN
            const float rs = rstd[row]; v0 = v0 * rs; v1 = v1 * rs; const int c = col - sect * D;
            bf16* B = sect ? MVBp : MKBp; *(v4u*)(B + (size_t)row * D + c) = pack8(v0, v1);
            float* o = out + (sect ? O_MVP : O_MKP) + (size_t)row * D + c; *(f32x4*)o = v0; *(f32x4*)(o + 4) = v1;
        EPI_LOOP_END
    }
};
struct EpiSsmA {
    float* SST;
    __device__ __forceinline__ void operator()(const f32x4 (&acc)[2][2][4][2], const pg8::Unit& u, int wr, int wc, int fr_, int fq_) const { int fr = fr_, fq = fq_; asm volatile("" : "+v"(fr), "+v"(fq));
        _Pragma("unroll") for (int ai = 0; ai < 2; ++ai) _Pragma("unroll") for (int m = 0; m < 4; ++m) { const int row = u.pm * 256 + ai * 128 + wr * 64 + m * 16 + fr;
            const int col = wc * 32 + 8 * fq; float* o = SST + ((size_t)row * NG + u.pn) * 128 + col; *(f32x4*)o = acc[ai][0][m][0]; *(f32x4*)(o + 4) = acc[ai][0][m][1]; }
    }
};
struct EpiSsmC {
    bf16* YG;
    __device__ __forceinline__ void operator()(const f32x4 (&acc)[2][2][4][2], const pg8::Unit& u, int wr, int wc, int fr_, int fq_) const { int fr = fr_, fq = fq_; asm volatile("" : "+v"(fr), "+v"(fq));
        _Pragma("unroll") for (int ai = 0; ai < 2; ++ai) _Pragma("unroll") for (int m = 0; m < 4; ++m) { const int ch = ai * 128 + wr * 64 + m * 16 + fr;
            _Pragma("unroll") for (int bj = 0; bj < 2; ++bj) { const int col = bj * 128 + wc * 32 + 8 * fq, t = col >> 4, p0 = col & 15; f32x4 v0 = acc[ai][bj][m][0], v1 = acc[ai][bj][m][1];
                _Pragma("unroll") for (int e = 0; e < 4; ++e) { v0[e] = gelu_tanh_f(v0[e]); v1[e] = gelu_tanh_f(v1[e]); }
                *(v4u*)(YG + ((size_t)u.pm * T + ch * LC + t) * SBW + u.pn * GP + p0) = pack8(v0, v1); } }
    }
};
struct EpiGlu {
    const bf16* YG; const float* bglu; bf16* OSSM;
    __device__ __forceinline__ void operator()(const f32x4 (&acc)[2][2][4][2], const pg8::Unit& u, int wr, int wc, int fr_, int fq_) const { int fr = fr_, fq = fq_; asm volatile("" : "+v"(fr), "+v"(fq));
        EPI_LOOP_BEGIN
            if (row < MALL) {
                const v4u yw = *(const v4u*)(YG + (size_t)row * SBW + col); const f32x4 b0 = *(const f32x4*)(bglu + col), b1 = *(const f32x4*)(bglu + col + 4);
                const float y[8] = {bflo(yw.x), bfhi(yw.x), bflo(yw.y), bfhi(yw.y), bflo(yw.z), bfhi(yw.z), bflo(yw.w), bfhi(yw.w)};
                _Pragma("unroll") for (int e = 0; e < 4; ++e) { v0[e] = y[e] * __builtin_amdgcn_rcpf(1.f + __builtin_amdgcn_exp2f(-(v0[e] + b0[e]) * LOG2E));
                                                                 v1[e] = y[4 + e] * __builtin_amdgcn_rcpf(1.f + __builtin_amdgcn_exp2f(-(v1[e] + b1[e]) * LOG2E)); }
                *(v4u*)(OSSM + (size_t)row * SBW + col) = pack8(v0, v1);
            }
        EPI_LOOP_END
    }
};
struct EpiResid {
    const float* base0; const float* base1; float* xo; bf16* xb; float* ssq;
    __device__ __forceinline__ void operator()(const f32x4 (&acc)[2][2][4][2], const pg8::Unit& u, int wr, int wc, int fr_, int fq_) const { int fr = fr_, fq = fq_; asm volatile("" : "+v"(fr), "+v"(fq));
        _Pragma("unroll") for (int ai = 0; ai < 2; ++ai) _Pragma("unroll") for (int m = 0; m < 4; ++m) { const int row = u.pm * 256 + ai * 128 + wr * 64 + m * 16 + fr; float sq = 0.f;
            const bool ok = row < MALL; const float* bp = (row < MPR) ? base0 + (size_t)row * D : base1 + (size_t)(row - MPR) * D;
            _Pragma("unroll") for (int bj = 0; bj < 2; ++bj) { const int col = u.pn * 256 + bj * 128 + wc * 32 + 8 * fq; f32x4 v0 = acc[ai][bj][m][0], v1 = acc[ai][bj][m][1];
                if (ok) { v0 = v0 + *(const f32x4*)(bp + col); v1 = v1 + *(const f32x4*)(bp + col + 4);
                    if (xo) { float* o = xo + (size_t)row * D + col; *(f32x4*)o = v0; *(f32x4*)(o + 4) = v1; }
                    if (xb) *(v4u*)(xb + (size_t)row * D + col) = pack8(v0, v1);
                    sq += (v0[0] * v0[0] + v0[1] * v0[1]) + (v0[2] * v0[2] + v0[3] * v0[3]) + (v1[0] * v1[0] + v1[1] * v1[1]) + (v1[2] * v1[2] + v1[3] * v1[3]); } }
            sq += __shfl_xor(sq, 16); sq += __shfl_xor(sq, 32);
            if (ok && fq == 0) atomicAdd(ssq + row, sq); }
    }
};
struct EpiScaleBf16 {
    const float* ssq; float scale; bf16* O;
    __device__ __forceinline__ void operator()(const f32x4 (&acc)[2][2][4][2], const pg8::Unit& u, int wr, int wc, int fr_, int fq_) const { int fr = fr_, fq = fq_; asm volatile("" : "+v"(fr), "+v"(fq));
        EPI_LOOP_BEGIN
            if (row < MALL) { const float rs = scale / sqrtf(ssq[row] * (1.f / D) + EPS); v0 = v0 * rs; v1 = v1 * rs; *(v4u*)(O + (size_t)row * D + col) = pack8(v0, v1); }
        EPI_LOOP_END
    }
};
struct EpiGateUp {
    const float* ssq; bf16 *GBp, *UBp; float* out;
    __device__ __forceinline__ void operator()(const f32x4 (&acc)[2][2][4][2], const pg8::Unit& u, int wr, int wc, int fr_, int fq_) const { int fr = fr_, fq = fq_; asm volatile("" : "+v"(fr), "+v"(fq));
        const bool up = u.pn >= 11;
        EPI_LOOP_BEGIN
            if (row < MALL) { const float rs = 1.f / sqrtf(ssq[row] * (1.f / D) + EPS); v0 = v0 * rs; v1 = v1 * rs;
                if (up) *(v4u*)(UBp + (size_t)row * FF + (col - FF)) = pack8(v0, v1);
                else { *(v4u*)(GBp + (size_t)row * FF + col) = pack8(v0, v1);
                    if (row >= MPR) { float* o = out + O_CVS + ((size_t)(row - MPR) * 2 + 1) * FF + col; *(f32x4*)o = v0; *(f32x4*)(o + 4) = v1; }
                    else { const int t = row & 4095; if (t >= T - 2) { float* o = out + O_CVP + ((size_t)(row >> 12) * 2 + (t - (T - 2))) * FF + col; *(f32x4*)o = v0; *(f32x4*)(o + 4) = v1; } } } }
        EPI_LOOP_END
    }
};
struct SsmOrder {
    int G, c; size_t bstride;
    __device__ bool next(int i, pg8::Unit& u) const { const int L = i * G + c; if (L >= NG * NB) return false; u.pn = L >> 2; u.pm = L & 3; return true; }
    __device__ __forceinline__ size_t aoff(const pg8::Unit& u) const { return ((size_t)u.pm * NCH * NG * XHP + (size_t)u.pn * XHP) * 2; }
    __device__ __forceinline__ size_t boff(const pg8::Unit& u) const { return (size_t)u.pn * bstride; }
};
template <class Epi>
__device__ __forceinline__ void skinny_gemm(Frame& F, const bf16* A, int lda, const bf16* Bt, int ldb, int N, int K, const Epi& E, int u0, int ustride, int ustep = 32, int nb1off = 16) {
    const int lane = F.lane, wid = F.wave; const int kw = K >> 3, nks = kw >> 5;
    LAS float* red = (LAS float*)(F.lds + RING_OFF);
    for (int u = u0; u < N / ustep; u += ustride) {
        f32x4 acc[2][8];
#pragma unroll
        for (int nb = 0; nb < 2; ++nb)
#pragma unroll
            for (int mb = 0; mb < 8; ++mb) acc[nb][mb] = (f32x4){0.f, 0.f, 0.f, 0.f};
        const bf16* wp = Bt + (size_t)(u * ustep + (lane & 15)) * ldb + wid * kw + 8 * (lane >> 4);
        const bf16* ap = A + (size_t)(lane & 15) * lda + wid * kw + 8 * (lane >> 4);
        for (int ks = 0; ks < nks; ++ks) {
            bf16x8 wf[2], af[8];
            wf[0] = *(const bf16x8*)(wp + ks * 32); wf[1] = *(const bf16x8*)(wp + (size_t)nb1off * ldb + ks * 32);
#pragma unroll
            for (int mb = 0; mb < 8; ++mb) af[mb] = *(const bf16x8*)(ap + (size_t)mb * 16 * lda + ks * 32);
#pragma unroll
            for (int nb = 0; nb < 2; ++nb)
#pragma unroll
                for (int mb = 0; mb < 8; ++mb) acc[nb][mb] = __builtin_amdgcn_mfma_f32_16x16x32_bf16(wf[nb], af[mb], acc[nb][mb], 0, 0, 0);
        }
        __syncthreads();
#pragma unroll
        for (int nb = 0; nb < 2; ++nb)
#pragma unroll
            for (int mb = 0; mb < 8; ++mb) *(LAS f32x4*)(red + ((wid * 16 + nb * 8 + mb) * 64 + lane) * 4) = acc[nb][mb];
        __syncthreads();
        f32x4 sj[2];
#pragma unroll
        for (int j = 0; j < 2; ++j) { const int idx = F.tid + NTHR * j, blk = idx >> 6, l = idx & 63;
            f32x4 s = {0.f, 0.f, 0.f, 0.f};
#pragma unroll
            for (int w = 0; w < 8; ++w) s = s + *(const LAS f32x4*)(red + ((w * 16 + blk) * 64 + l) * 4);
            sj[j] = s;
            if constexpr (!Epi::PAIR) E(16 * (blk & 7) + (l & 15), u * 32 + 16 * (blk >> 3) + 4 * (l >> 4), s); }
        if constexpr (Epi::PAIR) E(16 * (F.tid >> 6) + (F.tid & 15), u * 16 + 4 * ((F.tid & 63) >> 4), sj[0], sj[1]);
    }
    __syncthreads();
}
__device__ __forceinline__ v2u pack4(f32x4 a) { v2u w; w.x = cvtpk(a[0], a[1]); w.y = cvtpk(a[2], a[3]); return w; }
struct SkInProj { static constexpr bool PAIR = false;
    const float* rstd; bf16* QBp; float *QSp, *USp, *out;
    __device__ __forceinline__ void operator()(int m, int n, f32x4 v) const {
        v = v * rstd[MPR + m]; const int sect = n >> 9, c = n & 511;
        if (sect == 0) { v = v * C2; *(f32x4*)(QSp + (size_t)m * SBW + c) = v; }
        else if (sect == 1) *(f32x4*)(out + O_KS + (size_t)m * SBW + c) = v;
        else if (sect == 2) *(f32x4*)(out + O_VS + (size_t)m * SBW + c) = v;
        else *(f32x4*)(USp + (size_t)m * SBW + c) = v;
    }
};
struct SkGlu { static constexpr bool PAIR = false;
    const bf16* YG; const float* bglu; bf16* OSSM;
    __device__ __forceinline__ void operator()(int m, int n, f32x4 v) const {
        const size_t o = (size_t)(MPR + m) * SBW + n; const v2u yw = *(const v2u*)(YG + o); const f32x4 b = *(const f32x4*)(bglu + n);
        const float y[4] = {bflo(yw.x), bfhi(yw.x), bflo(yw.y), bfhi(yw.y)};
#pragma unroll
        for (int e = 0; e < 4; ++e) v[e] = y[e] * __builtin_amdgcn_rcpf(1.f + __builtin_amdgcn_exp2f(-(v[e] + b[e]) * LOG2E));
        *(v2u*)(OSSM + o) = pack4(v);
    }
};
struct SkResid { static constexpr bool PAIR = false;
    const float* base; float* xo; bf16* xb; float* ssq;
    __device__ __forceinline__ void operator()(int m, int n, f32x4 v) const {
        v = v + *(const f32x4*)(base + (size_t)m * D + n); const size_t o = (size_t)(MPR + m) * D + n;
        if (xo) *(f32x4*)(xo + o) = v; if (xb) *(v2u*)(xb + o) = pack4(v);
        atomicAdd(ssq + MPR + m, (v[0] * v[0] + v[1] * v[1]) + (v[2] * v[2] + v[3] * v[3]));
    }
};
struct SkScale { static constexpr bool PAIR = false;
    const float* ssq; float scale; bf16* O;
    __device__ __forceinline__ void operator()(int m, int n, f32x4 v) const {
        const float rs = scale / sqrtf(ssq[MPR + m] * (1.f / D) + EPS); v = v * rs; *(v2u*)(O + (size_t)(MPR + m) * D + n) = pack4(v);
    }
};
struct SkGateUp { static constexpr bool PAIR = false;
    const float* ssq; bf16 *GBp, *UBp; float* out;
    __device__ __forceinline__ void operator()(int m, int n, f32x4 v) const {
        const float rs = 1.f / sqrtf(ssq[MPR + m] * (1.f / D) + EPS); v = v * rs;
        if (n >= FF) *(v2u*)(UBp + (size_t)(MPR + m) * FF + (n - FF)) = pack4(v);
        else { *(v2u*)(GBp + (size_t)(MPR + m) * FF + n) = pack4(v); *(f32x4*)(out + O_CVS + ((size_t)m * 2 + 1) * FF + n) = v; }
    }
};

constexpr int HALO_OFF = RING_BYTES + 1024;
__device__ __forceinline__ float dpp_ror1(float x) { return __builtin_bit_cast(float, __builtin_amdgcn_update_dpp(0, __builtin_bit_cast(int, x), 0x121, 0xf, 0xf, true)); }
__device__ __forceinline__ float dpp_ror2(float x) { return __builtin_bit_cast(float, __builtin_amdgcn_update_dpp(0, __builtin_bit_cast(int, x), 0x122, 0xf, 0xf, true)); }
struct EpiGateUpConv {
    const float* ssq; bf16* ACT; float* out; const float* cw; const float* cb; LAS float* halo;
    __device__ __forceinline__ void operator()(const f32x4 (&acc)[2][2][4][2], const pg8::Unit& u, int wr, int wc, int fr_, int fq_) const {
        int fr = fr_, fq = fq_; asm volatile("" : "+v"(fr), "+v"(fq));
        const int cl = wc * 32 + 8 * fq, col = u.pn * 128 + cl, prow0 = u.pm * 254;
        float rs[2][4];
#pragma unroll
        for (int ai = 0; ai < 2; ++ai)
#pragma unroll
            for (int m = 0; m < 4; ++m) { const int row = prow0 + ai * 128 + wr * 64 + m * 16 + fr; rs[ai][m] = (row < MPR) ? 1.f / sqrtf(ssq[row < MPR ? row : 0] * (1.f / D) + EPS) : 0.f; }
        if (fr >= 14) {
#pragma unroll
            for (int ai = 0; ai < 2; ++ai) { LAS float* hp = halo + (((2 * ai + wr) * 2 + (fr - 14)) * 128 + cl); *(LAS f32x4*)hp = acc[ai][0][3][0] * rs[ai][3]; *(LAS f32x4*)(hp + 4) = acc[ai][0][3][1] * rs[ai][3]; }
        }
        asm volatile("s_waitcnt lgkmcnt(0)\n\ts_barrier" ::: "memory");
        f32x4 w0[2], w1[2], w2[2], bb[2];
#pragma unroll
        for (int n = 0; n < 2; ++n) { w0[n] = *(const f32x4*)(cw + col + 4 * n); w1[n] = *(const f32x4*)(cw + FF + col + 4 * n); w2[n] = *(const f32x4*)(cw + 2 * FF + col + 4 * n); bb[n] = *(const f32x4*)(cb + col + 4 * n); }
#pragma unroll
        for (int ai = 0; ai < 2; ++ai) {
            const int blk = 2 * ai + wr;
            f32x4 r1p[2], r2p[2];
            if (blk == 0) { r1p[0] = r1p[1] = r2p[0] = r2p[1] = (f32x4){0.f, 0.f, 0.f, 0.f}; }
            else { const LAS float* hb = halo + ((blk - 1) * 2) * 128 + cl;
                const f32x4 a0 = *(const LAS f32x4*)hb, a1 = *(const LAS f32x4*)(hb + 4), b0 = *(const LAS f32x4*)(hb + 128), b1 = *(const LAS f32x4*)(hb + 132);
                r1p[0] = b0; r1p[1] = b1; r2p[0] = (fr == 0) ? a0 : b0; r2p[1] = (fr == 0) ? a1 : b1; }
#pragma unroll
            for (int m = 0; m < 4; ++m) {
                const int lr = ai * 128 + wr * 64 + m * 16 + fr, row = prow0 + lr, t = row & (T - 1); const float rsv = rs[ai][m];
                f32x4 g[2], up[2], R1[2], R2[2];
#pragma unroll
                for (int n = 0; n < 2; ++n) { g[n] = acc[ai][0][m][n] * rsv; up[n] = acc[ai][1][m][n] * rsv;
#pragma unroll
                    for (int e = 0; e < 4; ++e) { R1[n][e] = dpp_ror1(g[n][e]); R2[n][e] = dpp_ror2(g[n][e]); } }
                const bool valid = (row < MPR) && (lr >= 2 || u.pm == 0);
                f32x4 av[2];
#pragma unroll
                for (int n = 0; n < 2; ++n) { f32x4 g1 = (fr == 0) ? r1p[n] : R1[n], g2 = (fr < 2) ? r2p[n] : R2[n];
                    if (t < 1) g1 = (f32x4){0.f, 0.f, 0.f, 0.f}; if (t < 2) g2 = (f32x4){0.f, 0.f, 0.f, 0.f};
                    const f32x4 cv = bb[n] + w0[n] * g2 + w1[n] * g1 + w2[n] * g[n];
#pragma unroll
                    for (int e = 0; e < 4; ++e) av[n][e] = gelu_tanh_f(cv[e]) * up[n][e]; }
                if (valid) { *(v4u*)(ACT + (size_t)row * FF + col) = pack8(av[0], av[1]);
                    if (t >= T - 2) { float* o = out + O_CVP + ((size_t)(row >> 12) * 2 + (t - (T - 2))) * FF + col; *(f32x4*)o = g[0]; *(f32x4*)(o + 4) = g[1]; } }
                r1p[0] = R1[0]; r1p[1] = R1[1]; r2p[0] = R2[0]; r2p[1] = R2[1];
            }
        }
    }
};
struct PanelOrder254 {
    pg8::GridOrder Gd;
    __device__ bool next(int i, pg8::Unit& u) const { return Gd.next(i, u); }
    __device__ __forceinline__ size_t aoff(const pg8::Unit& u) const { return (size_t)u.pm * 254 * D * 2; }
    __device__ __forceinline__ size_t boff(const pg8::Unit& u) const { return (size_t)u.pn * 128 * D * 2; }
};
struct SkGateUpConv { static constexpr bool PAIR = true;
    const float* ssq; bf16* ACT; float* out; const float* cw; const float* cb; const float* sc;
    __device__ __forceinline__ void operator()(int m, int n, f32x4 g, f32x4 up) const {
        const float rs = 1.f / sqrtf(ssq[MPR + m] * (1.f / D) + EPS); g = g * rs; up = up * rs;
        const f32x4 s0 = *(const f32x4*)(sc + ((size_t)m * 2 + 0) * FF + n), s1 = *(const f32x4*)(sc + ((size_t)m * 2 + 1) * FF + n);
        *(f32x4*)(out + O_CVS + ((size_t)m * 2 + 0) * FF + n) = s1; *(f32x4*)(out + O_CVS + ((size_t)m * 2 + 1) * FF + n) = g;
        const f32x4 cv = *(const f32x4*)(cb + n) + *(const f32x4*)(cw + n) * s0 + *(const f32x4*)(cw + FF + n) * s1 + *(const f32x4*)(cw + 2 * FF + n) * g;
        f32x4 a;
#pragma unroll
        for (int e = 0; e < 4; ++e) a[e] = gelu_tanh_f(cv[e]) * up[e];
        *(v2u*)(ACT + (size_t)(MPR + m) * FF + n) = pack4(a);
    }
};

struct EpiResidB {
    const bf16* base; float* xo; bf16* xb; float* ssq;
    __device__ __forceinline__ void operator()(const f32x4 (&acc)[2][2][4][2], const pg8::Unit& u, int wr, int wc, int fr_, int fq_) const { int fr = fr_, fq = fq_; asm volatile("" : "+v"(fr), "+v"(fq));
        _Pragma("unroll") for (int ai = 0; ai < 2; ++ai) _Pragma("unroll") for (int m = 0; m < 4; ++m) { const int row = u.pm * 256 + ai * 128 + wr * 64 + m * 16 + fr; float sq = 0.f;
            _Pragma("unroll") for (int bj = 0; bj < 2; ++bj) { const int col = u.pn * 256 + bj * 128 + wc * 32 + 8 * fq; f32x4 v0 = acc[ai][bj][m][0], v1 = acc[ai][bj][m][1];
                const v4u bw = *(const v4u*)(base + (size_t)row * D + col);
                v0 = v0 + (f32x4){bflo(bw.x), bfhi(bw.x), bflo(bw.y), bfhi(bw.y)}; v1 = v1 + (f32x4){bflo(bw.z), bfhi(bw.z), bflo(bw.w), bfhi(bw.w)};
                if (xo) { float* o = xo + (size_t)row * D + col; *(f32x4*)o = v0; *(f32x4*)(o + 4) = v1; }
                if (xb) *(v4u*)(xb + (size_t)row * D + col) = pack8(v0, v1);
                sq += (v0[0] * v0[0] + v0[1] * v0[1]) + (v0[2] * v0[2] + v0[3] * v0[3]) + (v1[0] * v1[0] + v1[1] * v1[1]) + (v1[2] * v1[2] + v1[3] * v1[3]); }
            sq += __shfl_xor(sq, 16); sq += __shfl_xor(sq, 32);
            if (fq == 0) atomicAdd(ssq + row, sq); }
    }
};
struct SkResidB { static constexpr bool PAIR = false;
    const bf16* base; float* xo; bf16* xb; float* ssq;
    __device__ __forceinline__ void operator()(int m, int n, f32x4 v) const {
        const size_t o = (size_t)(MPR + m) * D + n; const v2u bw = *(const v2u*)(base + o);
        v = v + (f32x4){bflo(bw.x), bfhi(bw.x), bflo(bw.y), bfhi(bw.y)};
        if (xo) *(f32x4*)(xo + o) = v; if (xb) *(v2u*)(xb + o) = pack4(v);
        atomicAdd(ssq + MPR + m, (v[0] * v[0] + v[1] * v[1]) + (v[2] * v[2] + v[3] * v[3]));
    }
};
__device__ __forceinline__ int crow(int r, int hi) { return (r & 3) + 8 * (r >> 2) + 4 * hi; }
__device__ __forceinline__ void glds16(const void* gsrc, unsigned lds_dst) { unsigned keep;
    asm volatile("s_mov_b32 %0, m0\n\ts_mov_b32 m0, %2\n\ts_nop 0\n\tglobal_load_lds_dwordx4 %1, off\n\ts_mov_b32 m0, %0" : "=&s"(keep) : "v"(gsrc), "s"(lds_dst) : "memory"); }
#define WAIT_BAR(N) asm volatile("s_waitcnt vmcnt(" #N ") lgkmcnt(0)\n\ts_barrier" ::: "memory")
typedef LAS const char* lds_cptr;
typedef short v4i16_t __attribute__((ext_vector_type(4)));
__device__ __forceinline__ s16x4 vtr(lds_cptr p) { return __builtin_bit_cast(s16x4, __builtin_amdgcn_ds_read_tr16_b64_v4i16((LAS v4i16_t*)p)); }
__device__ __forceinline__ bf16x8 ldsq(lds_cptr p) { return *(const LAS bf16x8*)p; }
#define MFMA32(a, b, c) __builtin_amdgcn_mfma_f32_32x32x16_bf16((a), (b), (c), 0, 0, 0)
__device__ __forceinline__ bf16x8 pack_bf8(const f32x16& p, int base) {
    v4u w; w.x = cvtpk(p[base], p[base + 1]); w.y = cvtpk(p[base + 2], p[base + 3]); w.z = cvtpk(p[base + 4], p[base + 5]); w.w = cvtpk(p[base + 6], p[base + 7]); return __builtin_bit_cast(bf16x8, w);
}
__device__ __forceinline__ float swap_half(float v) { auto rr = __builtin_amdgcn_permlane32_swap(__float_as_uint(v), __float_as_uint(v), false, false); return __uint_as_float((threadIdx.x & 32) ? rr[0] : rr[1]); }

constexpr int SBA_K = 0, SBA_V = 16384, SBA_OST = 32768;
__device__ __forceinline__ void sb_attn_unit(Frame& F, int b, int h, int qb, float b2) {
    const int lane = F.lane, r32 = lane & 31, hi = lane >> 5, wid = F.wave;
    const bf16* QBp = WSP(bf16, WS_QB); const bf16* KBp = WSP(bf16, WS_KB); const bf16* VBp = WSP(bf16, WS_VB); bf16* OSB = WSP(bf16, WS_OSB);
    const long rowbase = (long)b * T; const int q0 = qb * 256;
    const bf16* Qw = QBp + (rowbase + q0 + wid * 32) * SBW + h * HD;
    const bf16* Kh = KBp + rowbase * SBW + h * HD; const bf16* Vh = VBp + rowbase * SBW + h * HD;
    const unsigned lds0 = (unsigned)(uintptr_t)(F.lds + RING_OFF);
    const bf16* ksrc = Kh + (long)lane * SBW + wid * 8;
    const bf16* vsrc = Vh + (long)(16 * (wid & 3) + (lane >> 2)) * SBW + (wid >> 2) * 32 + (lane & 3) * 8;
    const unsigned kdst = lds0 + SBA_K + wid * 1024, vdst = lds0 + SBA_V + wid * 1024;
    const lds_cptr base3 = (lds_cptr)(F.lds + RING_OFF);
    const lds_cptr kp0 = base3 + SBA_K + hi * 1024 + r32 * 16;
    const lds_cptr vp0 = base3 + SBA_V + ((lane >> 4) & 1) * 32 + (lane & 3) * 8 + (4 * hi + ((lane & 15) >> 2)) * 64;
    const int NT = (q0 + 256) / 64;
#define DMA_KV(t, slot) do { glds16(ksrc + (long)(t) * 64 * SBW, (unsigned)__builtin_amdgcn_readfirstlane(kdst + (slot) * 8192)); glds16(vsrc + (long)(t) * 64 * SBW, (unsigned)__builtin_amdgcn_readfirstlane(vdst + (slot) * 8192)); } while (0)
    DMA_KV(NT - 1, 0);
    bf16x8 qr[4];
#pragma unroll
    for (int d0 = 0; d0 < 4; ++d0) qr[d0] = *reinterpret_cast<const bf16x8*>(&Qw[(long)r32 * SBW + d0 * 16 + hi * 8]);
    bf16x8 A0, A1, AN;
#pragma unroll
    for (int j = 0; j < 8; ++j) { const int kv = crow(j, hi); A0[j] = (short)((kv > r32) ? 0xBF80 : 0); A1[j] = (short)((kv + 16 > r32) ? 0xBF80 : 0); AN[j] = (short)0xBF80; }
    f32x16 o0 = {}, o1 = {}, racc = {}, bt;
#pragma unroll
    for (int r = 0; r < 16; ++r) bt[r] = b2;
    const int qrel = wid * 32 + r32;
    for (int it = 0; it < NT; ++it) {
        const int t = NT - 1 - it, cur = it & 1;
        if (it + 1 < NT) { DMA_KV(t - 1, cur ^ 1); WAIT_BAR(2); } else { WAIT_BAR(0); }
        const int jb = t - (NT - 4);
        if (jb <= (wid >> 1)) {
            const lds_cptr kp = kp0 + cur * 8192; const lds_cptr vp = vp0 + cur * 8192;
            f32x16 p0 = bt, p1 = bt;
#pragma unroll
            for (int d0 = 0; d0 < 4; ++d0) { const bf16x8 k0 = ldsq(kp + d0 * 2048), k1 = ldsq(kp + d0 * 2048 + 512); p0 = MFMA32(k0, qr[d0], p0); p1 = MFMA32(k1, qr[d0], p1); }
            if (jb == (wid >> 1)) {
                const float NEG = -INFINITY; const int kb = 64 * jb + 4 * hi;
#pragma unroll
                for (int r = 0; r < 16; ++r) { const int kv = kb + (r & 3) + 8 * (r >> 2); if (kv >= qrel) p0[r] = NEG; if (kv + 32 >= qrel) p1[r] = NEG; }
            }
            f32x16 s0, s1;
#pragma unroll
            for (int r = 0; r < 16; ++r) { s0[r] = __builtin_amdgcn_logf(1.f + __builtin_amdgcn_exp2f(p0[r])); s1[r] = __builtin_amdgcn_logf(1.f + __builtin_amdgcn_exp2f(p1[r])); }
            const bf16x8 sb0 = pack_bf8(s0, 0), sb1 = pack_bf8(s0, 8), sb2 = pack_bf8(s1, 0), sb3 = pack_bf8(s1, 8);
            f32x16 d1 = MFMA32(A0, sb2, racc); d1 = MFMA32(A1, sb3, d1);
            f32x16 d0 = MFMA32(A0, sb0, racc); d0 = MFMA32(A1, sb1, d0); d0 = MFMA32(AN, sb2, d0); d0 = MFMA32(AN, sb3, d0);
            racc = MFMA32(AN, sb0, racc); racc = MFMA32(AN, sb1, racc); racc = MFMA32(AN, sb2, racc); racc = MFMA32(AN, sb3, racc);
#pragma unroll
            for (int r = 0; r < 16; ++r) { p0[r] = __builtin_amdgcn_exp2f((p0[r] - s0[r]) + d0[r]); p1[r] = __builtin_amdgcn_exp2f((p1[r] - s1[r]) + d1[r]); }
            const bf16x8 pa0 = pack_bf8(p0, 0), pa1 = pack_bf8(p0, 8), pa2 = pack_bf8(p1, 0), pa3 = pack_bf8(p1, 8);
#pragma unroll
            for (int dh = 0; dh < 2; ++dh) {
                f32x16& o = dh ? o1 : o0;
#pragma unroll
                for (int rg = 0; rg < 4; ++rg) { const s16x4 lo = vtr(vp + dh * 4096 + rg * 1024), hh = vtr(vp + dh * 4096 + rg * 1024 + 512);
                    const bf16x8 vf = (bf16x8){lo[0], lo[1], lo[2], lo[3], hh[0], hh[1], hh[2], hh[3]};
                    o = MFMA32(rg == 0 ? pa0 : rg == 1 ? pa1 : rg == 2 ? pa2 : pa3, vf, o); }
            }
        }
        WAIT_BAR(0);
    }
#undef DMA_KV
    { int l2 = lane; asm volatile("" : "+v"(l2)); const int e32 = l2 & 31, ehi = l2 >> 5;
      LAS bf16* stg = (LAS bf16*)(F.lds + RING_OFF + SBA_OST) + wid * 2048; LAS bf16* sb = stg + (4 * ehi) * 64 + e32;
#pragma unroll
      for (int r = 0; r < 16; ++r) { sb[((r & 3) + 8 * (r >> 2)) * 64] = (bf16)f2bf(o0[r]); sb[((r & 3) + 8 * (r >> 2)) * 64 + 32] = (bf16)f2bf(o1[r]); }
      LDS_WAIT();
      bf16* Ow = OSB + (rowbase + q0 + wid * 32 + (l2 >> 3)) * SBW + h * HD + (l2 & 7) * 8; const LAS bf16* sr = stg + (l2 >> 3) * 64 + (l2 & 7) * 8;
#pragma unroll
      for (int i = 0; i < 4; ++i) { const v4u v = *(const LAS v4u*)(sr + i * 512); *(v4u*)(Ow + (long)i * 8 * SBW) = v; } }
    asm volatile("s_waitcnt vmcnt(0) lgkmcnt(0)\n\ts_barrier" ::: "memory");
}

__device__ __forceinline__ float dpp_sum16(float x) {
    x += __builtin_bit_cast(float, __builtin_amdgcn_update_dpp(0, __builtin_bit_cast(int, x), 0xB1, 0xf, 0xf, true));
    x += __builtin_bit_cast(float, __builtin_amdgcn_update_dpp(0, __builtin_bit_cast(int, x), 0x4E, 0xf, 0xf, true));
    x += __builtin_bit_cast(float, __builtin_amdgcn_update_dpp(0, __builtin_bit_cast(int, x), 0x141, 0xf, 0xf, true));
    x += __builtin_bit_cast(float, __builtin_amdgcn_update_dpp(0, __builtin_bit_cast(int, x), 0x140, 0xf, 0xf, true));
    return x;
}
__device__ __forceinline__ float wave_sum_fast(float x) { x = dpp_sum16(x); x += __shfl_xor(x, 16); x += swap_half(x); return x; }
__device__ __forceinline__ void sb_sample_unit(Frame& F, int b, int pg) {
    const int lane = F.lane, h = F.wave, ts = lane >> 4, d4 = lane & 15;
    const float* QS = WSP(float, WS_QS); const float* ck = INF(2); const float* cv = INF(3); const int* pt = (const int*)F.in[4];
    const float b2 = INF(13)[h] * LOG2E;
    const f32x4 q4 = *(const f32x4*)(QS + (size_t)b * SBW + h * HD + 4 * d4);
    const int page = pt[b * NPG + pg];
    const float* kb = ck + ((size_t)page * PAGE + ts) * (NH * HD) + h * HD + 4 * d4;
    const float* vb = cv + ((size_t)page * PAGE + ts) * (NH * HD) + h * HD + 4 * d4;
    float z[32];
    { f32x4 kk[32];
#pragma unroll
      for (int i = 0; i < 32; ++i) kk[i] = __builtin_nontemporal_load((const f32x4*)(kb + (size_t)i * 4 * NH * HD));
#pragma unroll
      for (int i = 0; i < 32; ++i) z[i] = dpp_sum16((q4[0] * kk[i][0] + q4[1] * kk[i][1]) + (q4[2] * kk[i][2] + q4[3] * kk[i][3])) + b2; }
    f32x4 vv[32];
#pragma unroll
    for (int i = 0; i < 32; ++i) vv[i] = __builtin_nontemporal_load((const f32x4*)(vb + (size_t)i * 4 * NH * HD));
    float run = 0.f;
#pragma unroll
    for (int i = 31; i >= 0; --i) {
        const float sp = __builtin_amdgcn_logf(1.f + __builtin_amdgcn_exp2f(z[i]));
        const float nb = __shfl_xor(sp, 16), v1 = sp + nb, po = swap_half(v1);
        const float aft = ((ts & 1) ? 0.f : nb) + ((ts & 2) ? 0.f : po);
        z[i] = __builtin_amdgcn_exp2f(z[i] - sp - (run + aft));
        run += v1 + po;
    }
    f32x4 acc = {0.f, 0.f, 0.f, 0.f};
#pragma unroll
    for (int i = 0; i < 32; ++i) acc = acc + vv[i] * z[i];
#pragma unroll
    for (int e = 0; e < 4; ++e) { acc[e] += __shfl_xor(acc[e], 16); acc[e] += swap_half(acc[e]); }
    if (ts == 0) *(f32x4*)(WSP(float, WS_SBPO) + (((size_t)b * NPG + pg) * NH + h) * HD + 4 * d4) = acc;
    if (lane == 0) WSP(float, WS_SBPL)[((size_t)b * NPG + pg) * NH + h] = -run;
}
__device__ __forceinline__ void sb_sample_combine(Frame& F, int b, int h) {
    const float* PO = WSP(float, WS_SBPO); const float* PL = WSP(float, WS_SBPL); float o = 0.f, run = 0.f;
#pragma unroll
    for (int pg = NPG - 1; pg >= 0; --pg) { o += __builtin_amdgcn_exp2f(run) * PO[(((size_t)b * NPG + pg) * NH + h) * HD + F.lane]; run += PL[((size_t)b * NPG + pg) * NH + h]; }
    WSP(bf16, WS_OSB)[(size_t)(MPR + b) * SBW + h * HD + F.lane] = (bf16)f2bf(o);
}
__device__ __forceinline__ void ssm_sample_unit(Frame& F, int b, int g) {
    const int n = F.lane;
    const float lr = INF(14)[g * NST + n], li = INF(15)[g * NST + n], ldt = INF(16)[g];
    float lbr, lbi, cr, ci; lam_pow(lr, li, ldt, 1, lbr, lbi); lam_coef(lr, li, ldt, cr, ci);
    const float* u = WSP(float, WS_US) + (size_t)b * SBW + g * GP;
    float br = 0.f, bi = 0.f;
#pragma unroll
    for (int p = 0; p < 16; ++p) { const float bre = INF(17)[(g * NST + n) * GP + p], bim = INF(18)[(g * NST + n) * GP + p]; const float uv = u[p]; br += (cr * bre - ci * bim) * uv; bi += (cr * bim + ci * bre) * uv; }
    const float h0r = INF(5)[(b * NG + g) * NST + n], h0i = INF(6)[(b * NG + g) * NST + n];
    const float hr = lbr * h0r - lbi * h0i + br, hi = lbr * h0i + lbi * h0r + bi;
    F.out[O_RES + (size_t)(b * NG + g) * NST + n] = hr; F.out[O_IMS + (size_t)(b * NG + g) * NST + n] = hi;
    float y = 0.f;
#pragma unroll
    for (int p = 0; p < 16; ++p) { const float v = wave_sum(INF(19)[(g * GP + p) * NST + n] * hr - INF(20)[(g * GP + p) * NST + n] * hi); if (n == p) y = v; }
    if (n < 16) { y += INF(21)[g * GP + n] * u[n]; WSP(bf16, WS_YG)[(size_t)(MPR + b) * SBW + g * GP + n] = (bf16)f2bf(gelu_tanh_f(y)); }
}
__device__ __forceinline__ void ssm_scan_unit(Frame& F, int unit) {
    const int b = unit >> 6, g = (unit >> 1) & 31, nh = unit & 1, nl = F.tid & 31, seg = F.tid >> 5, n = nh * 32 + nl;
    LAS float* tot = (LAS float*)(F.lds + RING_OFF);
    const float lr = INF(14)[g * NST + n], li = INF(15)[g * NST + n], ldt = INF(16)[g];
    float Lr, Li, Sr, Si; lam_pow(lr, li, ldt, LC, Lr, Li); lam_pow(lr, li, ldt, LC * 16, Sr, Si);
    const float* SST = WSP(float, WS_SST); bf16* XH = WSP(bf16, WS_XH);
    f32x2 s[16];
#pragma unroll
    for (int k = 0; k < 16; ++k) s[k] = *(const f32x2*)(SST + ((size_t)(b * NCH + seg * 16 + k) * NG + g) * 128 + 2 * n);
    float pr = 0.f, pi = 0.f;
#pragma unroll
    for (int k = 0; k < 16; ++k) { const float nr = Lr * pr - Li * pi + s[k].x, ni = Lr * pi + Li * pr + s[k].y; pr = nr; pi = ni; s[k].x = pr; s[k].y = pi; }
    __syncthreads();
    tot[(seg * 32 + nl) * 2] = pr; tot[(seg * 32 + nl) * 2 + 1] = pi;
    __syncthreads();
    float cr = 0.f, ci = 0.f;
    for (int s2 = 0; s2 < seg; ++s2) { const float tr = tot[(s2 * 32 + nl) * 2], ti = tot[(s2 * 32 + nl) * 2 + 1]; const float nr = Sr * cr - Si * ci + tr, ni = Sr * ci + Si * cr + ti; cr = nr; ci = ni; }
    if (seg == 0) *(GAS unsigned*)(XH + ((size_t)(b * NCH) * NG + g) * XHP + 256 + 2 * n) = 0u;
    float wr_ = Lr, wi_ = Li;
#pragma unroll
    for (int k = 0; k < 16; ++k) {
        const float hr = wr_ * cr - wi_ * ci + s[k].x, hi = wr_ * ci + wi_ * cr + s[k].y;
        const int c = seg * 16 + k;
        if (c + 1 < NCH) *(GAS unsigned*)(XH + ((size_t)(b * NCH + c + 1) * NG + g) * XHP + 256 + 2 * n) = pk2(hr, hi);
        else { F.out[O_REP + (size_t)(b * NG + g) * NST + n] = hr; F.out[O_IMP + (size_t)(b * NG + g) * NST + n] = hi; }
        const float nr = wr_ * Lr - wi_ * Li, ni = wr_ * Li + wi_ * Lr; wr_ = nr; wi_ = ni;
    }
}
__device__ __forceinline__ void xattn_prompt_unit(Frame& F, int b, int h, int qb) {
    const int lane = F.lane, r32 = lane & 31, hi = lane >> 5, wid = F.wave;
    const bf16* QM = WSP(bf16, WS_QM); const bf16* MKB = WSP(bf16, WS_MKB); const bf16* MVB = WSP(bf16, WS_MVB); bf16* OM = WSP(bf16, WS_OMEM);
    const unsigned lds0 = (unsigned)(uintptr_t)(F.lds + RING_OFF); const lds_cptr base3 = (lds_cptr)(F.lds + RING_OFF);
    const long qrow0 = (long)b * T + qb * 256 + wid * 32;
#pragma unroll
    for (int t = 0; t < 4; ++t)
#pragma unroll
        for (int j = 0; j < 4; ++j) { const int c = wid + 8 * j;
            glds16(MKB + ((long)b * MT + t * 64 + lane) * D + h * MHD + c * 8, (unsigned)__builtin_amdgcn_readfirstlane(lds0 + t * 32768 + c * 1024)); }
    bf16x8 qr[16];
#pragma unroll
    for (int ks = 0; ks < 16; ++ks) qr[ks] = *reinterpret_cast<const bf16x8*>(QM + (qrow0 + r32) * D + h * MHD + ks * 16 + hi * 8);
    WAIT_BAR(0);
    f32x16 S[8];
#pragma unroll
    for (int t = 0; t < 4; ++t)
#pragma unroll
        for (int blk = 0; blk < 2; ++blk) { f32x16 p = {};
#pragma unroll
            for (int ks = 0; ks < 16; ++ks) p = MFMA32(ldsq(base3 + t * 32768 + (2 * ks + hi) * 1024 + (32 * blk + r32) * 16), qr[ks], p);
            S[t * 2 + blk] = p; }
    WAIT_BAR(0);
#pragma unroll
    for (int t = 0; t < 4; ++t)
#pragma unroll
        for (int j = 0; j < 4; ++j) { const int p = wid + 8 * j, dblk = p >> 2, rg = p & 3;
            glds16(MVB + ((long)b * MT + t * 64 + 16 * rg + (lane >> 2)) * D + h * MHD + dblk * 32 + (lane & 3) * 8, (unsigned)__builtin_amdgcn_readfirstlane(lds0 + t * 32768 + p * 1024)); }
    float mx = -INFINITY;
#pragma unroll
    for (int i = 0; i < 8; ++i)
#pragma unroll
        for (int r = 0; r < 16; ++r) mx = fmaxf(mx, S[i][r]);
    mx = fmaxf(mx, swap_half(mx));
    float l = 0.f;
#pragma unroll
    for (int i = 0; i < 8; ++i)
#pragma unroll
        for (int r = 0; r < 16; ++r) { S[i][r] = __builtin_amdgcn_exp2f(S[i][r] - mx); l += S[i][r]; }
    l += swap_half(l);
    bf16x8 pa[16];
#pragma unroll
    for (int i = 0; i < 8; ++i) { pa[2 * i] = pack_bf8(S[i], 0); pa[2 * i + 1] = pack_bf8(S[i], 8); }
    WAIT_BAR(0);
    f32x16 o[8];
#pragma unroll
    for (int dblk = 0; dblk < 8; ++dblk) o[dblk] = (f32x16){};
    const lds_cptr vp0 = base3 + ((lane >> 4) & 1) * 32 + (lane & 3) * 8 + (4 * hi + ((lane & 15) >> 2)) * 64;
#pragma unroll
    for (int t = 0; t < 4; ++t)
#pragma unroll
        for (int dblk = 0; dblk < 8; ++dblk)
#pragma unroll
            for (int rg = 0; rg < 4; ++rg) { const s16x4 lo = vtr(vp0 + t * 32768 + dblk * 4096 + rg * 1024), hh = vtr(vp0 + t * 32768 + dblk * 4096 + rg * 1024 + 512);
                const bf16x8 vf = (bf16x8){lo[0], lo[1], lo[2], lo[3], hh[0], hh[1], hh[2], hh[3]};
                o[dblk] = MFMA32(pa[t * 4 + rg], vf, o[dblk]); }
    WAIT_BAR(0);
    int l2 = lane; asm volatile("" : "+v"(l2));
    const int e32 = l2 & 31, ehi = l2 >> 5;
    LAS bf16* stg = (LAS bf16*)(F.lds + RING_OFF) + wid * 8192;
    LAS float* lsw = (LAS float*)stg;
    if (ehi == 0) lsw[e32] = l;
    LDS_WAIT();
    float rli[16];
    { const LAS float* lb = lsw + 4 * ehi;
#pragma unroll
      for (int r = 0; r < 16; ++r) rli[r] = __builtin_amdgcn_rcpf(lb[(r & 3) + 8 * (r >> 2)]); }
    LDS_WAIT(); asm volatile("" ::: "memory");
    { LAS bf16* sb = stg + (4 * ehi) * 256 + e32;
#pragma unroll
      for (int dblk = 0; dblk < 8; ++dblk)
#pragma unroll
        for (int r = 0; r < 16; ++r) sb[((r & 3) + 8 * (r >> 2)) * 256 + dblk * 32] = (bf16)f2bf(o[dblk][r] * rli[r]); }
    LDS_WAIT();
    { bf16* Ow = OM + (qrow0 + (l2 >> 5)) * D + h * MHD + (l2 & 31) * 8; const LAS bf16* sr = stg + (l2 >> 5) * 256 + (l2 & 31) * 8;
#pragma unroll
      for (int i = 0; i < 16; ++i) { const v4u v = *(const LAS v4u*)(sr + i * 512); *(v4u*)(Ow + (long)i * 2 * D) = v; } }
    asm volatile("s_waitcnt vmcnt(0) lgkmcnt(0)\n\ts_barrier" ::: "memory");
}
__device__ __forceinline__ void xattn_sample_unit(Frame& F, int b, int h) {
    const int lane = F.lane, wid = F.wave;
    const bf16* QM = WSP(bf16, WS_QM); const float* ck = INF(8); const float* cv = INF(9);
    LAS float* xm = (LAS float*)(F.lds + RING_OFF);
    const v2u qw = *(const v2u*)(QM + (size_t)(MPR + b) * D + h * MHD + 4 * lane);
    const f32x4 q4 = {bflo(qw.x), bfhi(qw.x), bflo(qw.y), bfhi(qw.y)};
    const float* kb = ck + (((size_t)b * MT + wid * 32) * MH + h) * MHD + 4 * lane;
    const float* vb = cv + (((size_t)b * MT + wid * 32) * MH + h) * MHD + 4 * lane;
    float s[32];
#pragma unroll
    for (int i0 = 0; i0 < 32; i0 += 8) {
        f32x4 kk[8];
#pragma unroll
        for (int i = 0; i < 8; ++i) kk[i] = __builtin_nontemporal_load((const f32x4*)(kb + (size_t)(i0 + i) * MH * MHD));
#pragma unroll
        for (int i = 0; i < 8; ++i) s[i0 + i] = wave_sum((q4[0] * kk[i][0] + q4[1] * kk[i][1]) + (q4[2] * kk[i][2] + q4[3] * kk[i][3]));
    }
    float mx = s[0];
#pragma unroll
    for (int i = 1; i < 32; ++i) mx = fmaxf(mx, s[i]);
    __syncthreads();
    if (lane == 0) xm[wid] = mx;
    __syncthreads();
    float gm = xm[0];
#pragma unroll
    for (int w = 1; w < 8; ++w) gm = fmaxf(gm, xm[w]);
    float l = 0.f;
#pragma unroll
    for (int i = 0; i < 32; ++i) { s[i] = __builtin_amdgcn_exp2f(s[i] - gm); l += s[i]; }
    f32x4 acc = {0.f, 0.f, 0.f, 0.f};
#pragma unroll
    for (int i0 = 0; i0 < 32; i0 += 8) {
        f32x4 vv[8];
#pragma unroll
        for (int i = 0; i < 8; ++i) vv[i] = __builtin_nontemporal_load((const f32x4*)(vb + (size_t)(i0 + i) * MH * MHD));
#pragma unroll
        for (int i = 0; i < 8; ++i) acc = acc + vv[i] * s[i0 + i];
    }
    if (lane == 0) xm[8 + wid] = l;
    *(LAS f32x4*)(xm + 64 + wid * 256 + 4 * lane) = acc;
    __syncthreads();
    if (F.tid < 256) { float lt = 0.f, ov = 0.f;
#pragma unroll
        for (int w = 0; w < 8; ++w) { lt += xm[8 + w]; ov += xm[64 + w * 256 + F.tid]; }
        WSP(bf16, WS_OMEM)[(size_t)(MPR + b) * D + h * MHD + F.tid] = (bf16)f2bf(ov / lt); }
}
__device__ __forceinline__ void mix_row(Frame& F, int row) {
    const int lane = F.lane;
#pragma unroll
    for (int half = 0; half < 2; ++half) {
        const bf16* src = (half ? WSP(bf16, WS_OSSM) : WSP(bf16, WS_OSB)) + (size_t)row * SBW + 8 * lane;
        const v4u w = *(const v4u*)src; float v[8] = {bflo(w.x), bfhi(w.x), bflo(w.y), bfhi(w.y), bflo(w.z), bfhi(w.z), bflo(w.w), bfhi(w.w)};
        float s = 0.f;
#pragma unroll
        for (int e = 0; e < 8; ++e) s += v[e] * v[e];
        s = wave_sum(s); const float rs = 1.f / sqrtf(s * (1.f / SBW) + EPS);
        v4u o; o.x = pk2(v[0] * rs, v[1] * rs); o.y = pk2(v[2] * rs, v[3] * rs); o.z = pk2(v[4] * rs, v[5] * rs); o.w = pk2(v[6] * rs, v[7] * rs);
        *(v4u*)(WSP(bf16, WS_MIX) + (size_t)row * D + half * SBW + 8 * lane) = o;
    }
}
__device__ __forceinline__ void conv_act_item(Frame& F, long item) {
    const int row = (int)(item / (FF / 8)), j = (int)(item % (FF / 8)) * 8;
    const bf16* GB = WSP(bf16, WS_GB); bf16* UB = WSP(bf16, WS_UB);
    const float* cw = INF(36); const float* cb = INF(37); const float* sc = INF(7);
    float g0[8], g1[8], g2[8], uu[8];
    { const v4u w = *(const v4u*)(GB + (size_t)row * FF + j); g0[0] = bflo(w.x); g0[1] = bfhi(w.x); g0[2] = bflo(w.y); g0[3] = bfhi(w.y); g0[4] = bflo(w.z); g0[5] = bfhi(w.z); g0[6] = bflo(w.w); g0[7] = bfhi(w.w); }
    { const v4u w = *(const v4u*)(UB + (size_t)row * FF + j); uu[0] = bflo(w.x); uu[1] = bfhi(w.x); uu[2] = bflo(w.y); uu[3] = bfhi(w.y); uu[4] = bflo(w.z); uu[5] = bfhi(w.z); uu[6] = bflo(w.w); uu[7] = bfhi(w.w); }
    if (row < MPR) { const int t = row & 4095;
        if (t >= 1) { const v4u w = *(const v4u*)(GB + (size_t)(row - 1) * FF + j); g1[0] = bflo(w.x); g1[1] = bfhi(w.x); g1[2] = bflo(w.y); g1[3] = bfhi(w.y); g1[4] = bflo(w.z); g1[5] = bfhi(w.z); g1[6] = bflo(w.w); g1[7] = bfhi(w.w); }
        else { _Pragma("unroll") for (int e = 0; e < 8; ++e) g1[e] = 0.f; }
        if (t >= 2) { const v4u w = *(const v4u*)(GB + (size_t)(row - 2) * FF + j); g2[0] = bflo(w.x); g2[1] = bfhi(w.x); g2[2] = bflo(w.y); g2[3] = bfhi(w.y); g2[4] = bflo(w.z); g2[5] = bfhi(w.z); g2[6] = bflo(w.w); g2[7] = bfhi(w.w); }
        else { _Pragma("unroll") for (int e = 0; e < 8; ++e) g2[e] = 0.f; }
    } else { const int b = row - MPR;
        _Pragma("unroll") for (int e = 0; e < 8; ++e) { g2[e] = sc[((size_t)b * 2 + 0) * FF + j + e]; g1[e] = sc[((size_t)b * 2 + 1) * FF + j + e]; F.out[O_CVS + ((size_t)b * 2 + 0) * FF + j + e] = g1[e]; } }
    float r[8];
#pragma unroll
    for (int e = 0; e < 8; ++e) { const float c = cb[j + e] + cw[j + e] * g2[e] + cw[FF + j + e] * g1[e] + cw[2 * FF + j + e] * g0[e]; r[e] = gelu_tanh_f(c) * uu[e]; }
    v4u o; o.x = pk2(r[0], r[1]); o.y = pk2(r[2], r[3]); o.z = pk2(r[4], r[5]); o.w = pk2(r[6], r[7]);
    *(v4u*)(UB + (size_t)row * FF + j) = o;
}
__device__ __forceinline__ void final_norm_row(Frame& F, int row) {
    const float rs = 1.f / sqrtf(((const float*)(F.ctl + CW_SSQ3))[row] * (1.f / D) + EPS);
    float* y = F.out + O_YP + (size_t)row * D; const float* g = INF(39);
#pragma unroll
    for (int j = 0; j < 4; ++j) { const int c = 4 * F.lane + 256 * j; f32x4 v = *(const f32x4*)(y + c); const f32x4 gv = *(const f32x4*)(g + c); v = v * rs * gv; *(f32x4*)(y + c) = v; }
}
constexpr int N_PHASES = 15;
__global__ void __launch_bounds__(NTHR, 2) mk_fwd(Args args) {
    extern __shared__ __attribute__((aligned(16))) unsigned char lds[];
    Frame F;
    F.lds = (LAS unsigned char*)lds; F.MISC = (volatile LAS unsigned*)(F.lds + MISC_OFF);
    F.tid = threadIdx.x; F.lane = F.tid & 63; F.wave = __builtin_amdgcn_readfirstlane(F.tid >> 6);
    F.G = gridDim.x; { const int bx = blockIdx.x; F.vcu = (F.G % 8 == 0) ? (bx % 8) * (F.G / 8) + bx / 8 : bx; }
    F.ws = args.ws; F.out = args.out; F.in = args.in; F.ctl = (unsigned*)(args.ws + WS_CTL);
    for (int u = F.tid; u < (LDS_BYTES - LDSCTL_OFF) / 4; u += NTHR) ((LAS unsigned*)(F.lds + LDSCTL_OFF))[u] = 0u;
    __syncthreads();
    XcdBarrier bar; bar.bar = F.ctl + CW_BAR; bar.x = 0; bar.st = nullptr;
    if (args.use_bar) bar = xcd_barrier_post(F.ctl + CW_BAR, F.MISC + 8);
    const int lo = args.ph_lo, hi = args.ph_hi;
#define IN(k) (lo <= (k) && (k) < hi)
#define SEAM(k) do { if (IN(k) && IN((k) + 1)) xcd_barrier(bar); } while (0)
    const int gw = F.vcu * NWAVES + F.wave, NGW = F.G * NWAVES;
    LAS unsigned char* ring = F.lds + RING_OFF;

    if (IN(0)) { p0_prologue(F);
#if MK_PROBE == 100
        __syncthreads(); p0_prologue(F);
#endif
    } SEAM(0);
    if (IN(1)) {
        { pg8::Gemm g{WSP(bf16, WS_XB), WSP(bf16, WS_WIN), D, D, D}; pg8::GridOrder S; S.init(MPR / 256, INW / 256, F.G, (int)blockIdx.x, 0, D, D);
          EpiInProj E{WSP(float, WS_RSTD0), WSP(bf16, WS_QB), WSP(bf16, WS_KB), WSP(bf16, WS_VB), WSP(bf16, WS_XH), WSP(float, WS_QS), WSP(float, WS_US), F.out};
          pg8::gemm_phase<EpiInProj, pg8::GridOrder>(ring, g, S, E); }
        { SkInProj E{WSP(float, WS_RSTD0), WSP(bf16, WS_QB), WSP(float, WS_QS), WSP(float, WS_US), F.out};
          skinny_gemm(F, WSP(bf16, WS_XB) + (size_t)MPR * D, D, WSP(bf16, WS_WIN), D, INW, D, E, (int)blockIdx.x, F.G); }
    } SEAM(1);
    if (IN(2)) {
        { pg8::Gemm g{WSP(bf16, WS_XH), WSP(bf16, WS_W1), NG * XHP, 256, 256}; SsmOrder S{F.G, (int)blockIdx.x, (size_t)128 * 256 * 2};
          EpiSsmA E{WSP(float, WS_SST)};
          pg8::gemm_phase<EpiSsmA, SsmOrder>(ring, g, S, E); }
        { pg8::Gemm g{WSP(bf16, WS_MB), WSP(bf16, WS_WMKV), D, D, D}; pg8::GridOrder S; S.init(4, 8, F.G, (int)blockIdx.x, 128, D, D);
          EpiMemKV E{WSP(float, WS_RSTDM), WSP(bf16, WS_MKB), WSP(bf16, WS_MVB), F.out};
          pg8::gemm_phase<EpiMemKV, pg8::GridOrder>(ring, g, S, E); }
        for (int u = gw; u < MS * NG; u += NGW) ssm_sample_unit(F, u >> 5, u & 31);
        { int mode = (F.vcu % 3 == 2) ? 1 : 0; bool adone = false, mdone = false;
          while (!(adone && mdone)) {
              if (mode == 0 && adone) mode = 1; else if (mode == 1 && mdone) mode = 0;
              __syncthreads();
              if (F.tid == 0) F.MISC[16] = __hip_atomic_fetch_add(F.ctl + (mode ? CW_QM : CW_QA), 1u, __ATOMIC_RELAXED, __HIP_MEMORY_SCOPE_AGENT);
              __syncthreads();
              const int idx = (int)F.MISC[16];
              if (mode == 0) { if (idx >= 512) { adone = true; continue; }
                  const int qb = 15 - (idx >> 5), bh = idx & 31; sb_attn_unit(F, bh >> 3, bh & 7, qb, INF(13)[bh & 7] * LOG2E); }
              else { if (idx >= (MS * NPG) / 4) { mdone = true; continue; }
#pragma unroll 1
                  for (int j = 0; j < 4; ++j) { const int u = idx * 4 + j; sb_sample_unit(F, u >> 4, u & 15); } }
          } }
    } SEAM(2);
    if (IN(3)) {
        for (int u = F.vcu; u < 256; u += F.G) ssm_scan_unit(F, u);
        for (int u = gw; u < MS * NH; u += NGW) sb_sample_combine(F, u >> 3, u & 7);
    } SEAM(3);
    if (IN(4)) {
        pg8::Gemm g{WSP(bf16, WS_XH), WSP(bf16, WS_BTC), NG * XHP, XHP, XHP}; SsmOrder S{F.G, (int)blockIdx.x, (size_t)256 * XHP * 2};
        EpiSsmC E{WSP(bf16, WS_YG)};
        pg8::gemm_phase<EpiSsmC, SsmOrder>(ring, g, S, E);
    } SEAM(4);
    if (IN(5)) {
        pg8::Gemm g{WSP(bf16, WS_YG), WSP(bf16, WS_WGLU), SBW, SBW, SBW}; pg8::GridOrder S; S.init(MPR / 256, 2, F.G, (int)blockIdx.x, 0, SBW, SBW);
        EpiGlu E{WSP(bf16, WS_YG), INF(23), WSP(bf16, WS_OSSM)};
        pg8::gemm_phase<EpiGlu, pg8::GridOrder>(ring, g, S, E);
        SkGlu E2{WSP(bf16, WS_YG), INF(23), WSP(bf16, WS_OSSM)};
        skinny_gemm(F, WSP(bf16, WS_YG) + (size_t)MPR * SBW, SBW, WSP(bf16, WS_WGLU), SBW, SBW, SBW, E2, ((int)blockIdx.x + F.G - 128) % F.G, F.G);
    } SEAM(5);
    if (IN(6)) { for (int m = gw; m < MALL; m += NGW) mix_row(F, m);
#if MK_PROBE == 6
        for (int m = gw; m < MALL; m += NGW) mix_row(F, m);
#endif
    } SEAM(6);
    if (IN(7)) {
        pg8::Gemm g{WSP(bf16, WS_MIX), WSP(bf16, WS_WOUT), D, D, D}; pg8::GridOrder S; S.init(MPR / 256, 4, F.G, (int)blockIdx.x, 0, D, D);
        EpiResid E{INF(0), INF(1), nullptr, WSP(bf16, WS_X1B), (float*)(F.ctl + CW_SSQ1)};
        pg8::gemm_phase<EpiResid, pg8::GridOrder>(ring, g, S, E);
        SkResid E2{INF(1), nullptr, WSP(bf16, WS_X1B), (float*)(F.ctl + CW_SSQ1)};
        skinny_gemm(F, WSP(bf16, WS_MIX) + (size_t)MPR * D, D, WSP(bf16, WS_WOUT), D, D, D, E2, (int)blockIdx.x, F.G);
    } SEAM(7);
    if (IN(8)) {
        pg8::Gemm g{WSP(bf16, WS_X1B), WSP(bf16, WS_WMQ), D, D, D}; pg8::GridOrder S; S.init(MPR / 256, 4, F.G, (int)blockIdx.x, 0, D, D);
        EpiScaleBf16 E{(const float*)(F.ctl + CW_SSQ1), CM, WSP(bf16, WS_QM)};
        pg8::gemm_phase<EpiScaleBf16, pg8::GridOrder>(ring, g, S, E);
#if MK_PROBE == 8
        pg8::gemm_phase<EpiScaleBf16, pg8::GridOrder>(ring, g, S, E);
#endif
        SkScale E2{(const float*)(F.ctl + CW_SSQ1), CM, WSP(bf16, WS_QM)};
        skinny_gemm(F, WSP(bf16, WS_X1B) + (size_t)MPR * D, D, WSP(bf16, WS_WMQ), D, D, D, E2, (int)blockIdx.x, F.G);
    } SEAM(8);
    if (IN(9)) {
        for (int u = F.vcu; u < 256; u += F.G) xattn_prompt_unit(F, u >> 6, (u >> 4) & 3, u & 15);
#if MK_PROBE == 9
        for (int u = F.vcu; u < 256; u += F.G) xattn_prompt_unit(F, u >> 6, (u >> 4) & 3, u & 15);
#endif
        for (int u = F.vcu; u < MS * MH; u += F.G) xattn_sample_unit(F, u >> 2, u & 3);
#if MK_PROBE == 91
        for (int u = F.vcu; u < MS * MH; u += F.G) xattn_sample_unit(F, u >> 2, u & 3);
#endif
    } SEAM(9);
    if (IN(10)) {
        pg8::Gemm g{WSP(bf16, WS_OMEM), WSP(bf16, WS_WMO), D, D, D}; pg8::GridOrder S; S.init(MPR / 256, 4, F.G, (int)blockIdx.x, 0, D, D);
        EpiResidB E{WSP(bf16, WS_X1B), nullptr, WSP(bf16, WS_X2B), (float*)(F.ctl + CW_SSQ2)};
        pg8::gemm_phase<EpiResidB, pg8::GridOrder>(ring, g, S, E);
        SkResidB E2{WSP(bf16, WS_X1B), nullptr, WSP(bf16, WS_X2B), (float*)(F.ctl + CW_SSQ2)};
        skinny_gemm(F, WSP(bf16, WS_OMEM) + (size_t)MPR * D, D, WSP(bf16, WS_WMO), D, D, D, E2, (int)blockIdx.x, F.G);
    } SEAM(10);
    if (IN(11)) {
        pg8::Gemm g{WSP(bf16, WS_X2B), WSP(bf16, WS_WGU), D, D, D, FF}; PanelOrder254 S; S.Gd.init(65, 22, F.G, (int)blockIdx.x, 0, D, D);
        EpiGateUpConv E{(const float*)(F.ctl + CW_SSQ2), WSP(bf16, WS_UB), F.out, INF(36), INF(37), (LAS float*)(F.lds + HALO_OFF)};
        pg8::gemm_phase<EpiGateUpConv, PanelOrder254>(ring, g, S, E);
#if MK_PROBE == 11
        pg8::gemm_phase<EpiGateUpConv, PanelOrder254>(ring, g, S, E);
#endif
        SkGateUpConv E2{(const float*)(F.ctl + CW_SSQ2), WSP(bf16, WS_UB), F.out, INF(36), INF(37), INF(7)};
        skinny_gemm(F, WSP(bf16, WS_X2B) + (size_t)MPR * D, D, WSP(bf16, WS_WGU), D, FF, D, E2, ((int)blockIdx.x + F.G - 150) % F.G, F.G, 16, FF);
    } SEAM(11);
    if (IN(13)) {
        pg8::Gemm g{WSP(bf16, WS_UB), WSP(bf16, WS_WDN), FF, FF, FF}; pg8::GridOrder S; S.init(MPR / 256, 4, F.G, (int)blockIdx.x, 0, FF, FF);
        EpiResidB E{WSP(bf16, WS_X2B), F.out + O_YP, nullptr, (float*)(F.ctl + CW_SSQ3)};
        pg8::gemm_phase<EpiResidB, pg8::GridOrder>(ring, g, S, E);
        SkResidB E2{WSP(bf16, WS_X2B), F.out + O_YP, nullptr, (float*)(F.ctl + CW_SSQ3)};
        skinny_gemm(F, WSP(bf16, WS_UB) + (size_t)MPR * FF, FF, WSP(bf16, WS_WDN), FF, D, FF, E2, (int)blockIdx.x, F.G);
    } SEAM(13);
    if (IN(14)) { for (int m = gw; m < MALL; m += NGW) final_norm_row(F, m); }
#undef IN
#undef SEAM
}
#ifndef MK_DEBUG
#define MK_DEBUG 0
#endif
#ifndef MK_ONE_LAUNCH
#define MK_ONE_LAUNCH 1
#endif
#if MK_DEBUG
struct Chk { const void* fast; const float* ref; int isbf; long rows, cols, ldf, ldr; float scale; };
__global__ void k_compare(Chk c, double* acc) {
    __shared__ double se[256], sr[256];
    double e = 0.0, r = 0.0; const long n = c.rows * c.cols;
    for (long i = (long)blockIdx.x * 256 + threadIdx.x; i < n; i += (long)gridDim.x * 256) { const long rr = i / c.cols, cc = i % c.cols;
        const float f = (c.isbf ? bf2f(((const unsigned short*)c.fast)[rr * c.ldf + cc]) : ((const float*)c.fast)[rr * c.ldf + cc]) * c.scale; const float g = c.ref[rr * c.ldr + cc];
        const double d = (double)f - (double)g; e += d * d; r += (double)g * (double)g; }
    se[threadIdx.x] = e; sr[threadIdx.x] = r; __syncthreads();
    for (int k = 128; k > 0; k >>= 1) { if ((int)threadIdx.x < k) { se[threadIdx.x] += se[threadIdx.x + k]; sr[threadIdx.x] += sr[threadIdx.x + k]; } __syncthreads(); }
    if (threadIdx.x == 0) { atomicAdd(acc, se[0]); atomicAdd(acc + 1, sr[0]); }
}
__global__ void k_compare_xh(const unsigned short* XH, const float* proj, const float* hs, int part, double* acc) {
    __shared__ double se[256], sr[256];
    double e = 0.0, r = 0.0; const int w = part ? 128 : 256; const long n = (long)1024 * NG * w;
    for (long i = (long)blockIdx.x * 256 + threadIdx.x; i < n; i += (long)gridDim.x * 256) { const int j = (int)(i % w); const long bcg = i / w; const int g = (int)(bcg % NG); const long bc = bcg / NG; const int b = (int)(bc / NCH), c = (int)(bc % NCH);
        const float f = bf2f(XH[bcg * XHP + (part ? 256 : 0) + j]); float gref;
        if (!part) { const int s = j >> 4, q = j & 15; gref = proj[((size_t)b * T + c * LC + s) * INW + 1536 + g * GP + q]; }
        else { const int nn = j >> 1, ri = j & 1; gref = (c == 0) ? 0.f : hs[((((size_t)b * T + c * LC - 1) * NG + g) * NST + nn) * 2 + ri]; }
        const double d = (double)f - (double)gref; e += d * d; r += (double)gref * (double)gref; }
    se[threadIdx.x] = e; sr[threadIdx.x] = r; __syncthreads();
    for (int k = 128; k > 0; k >>= 1) { if ((int)threadIdx.x < k) { se[threadIdx.x] += se[threadIdx.x + k]; sr[threadIdx.x] += sr[threadIdx.x + k]; } __syncthreads(); }
    if (threadIdx.x == 0) { atomicAdd(acc, se[0]); atomicAdd(acc + 1, sr[0]); }
}
__global__ void k_judge(const double* acc, int n, float tol, float* out) {
    if (threadIdx.x != 0 || blockIdx.x != 0) return;
    for (int k = 0; k < n; ++k) { const double rv = acc[2 * k] / acc[2 * k + 1];
        if (!(rv < (double)tol)) { int m = 5; if (rv != rv) m = 0; else if (rv >= 1.0) m = 9; else if (rv >= 0.1) m = 8; else if (rv >= 0.01) m = 7; else if (rv >= 0.001) m = 6;
            const int grp = k / 9, kk = k % 9 + 1; float code = (float)(10 * kk + m) * 100.f; for (int i = 0; i < grp; ++i) code *= 100.f; out[0] = code; return; } }
}
#endif

extern "C" void kernel_launch(void* const* d_in, const int* in_sizes, int n_in, void* d_out, int out_size, void* d_ws, size_t ws_size, hipStream_t stream) {
    static int grid = 0;
    if (grid == 0) {
        if (n_in != 40 || (size_t)out_size != O_END || ws_size < WS_FAST_END) { fprintf(stderr, "kernel_launch: unexpected shapes: n_in %d out %d ws %zu\n", n_in, out_size, ws_size); grid = -1; return; }
        int dev = 0, cus = 0, per_cu = 0;
        if (hipGetDevice(&dev) != hipSuccess || hipDeviceGetAttribute(&cus, hipDeviceAttributeMultiprocessorCount, dev) != hipSuccess) { grid = -1; return; }
        if (hipFuncSetAttribute((const void*)mk_fwd, hipFuncAttributeMaxDynamicSharedMemorySize, LDS_BYTES) != hipSuccess) { fprintf(stderr, "kernel_launch: hipFuncSetAttribute failed\n"); grid = -1; return; }
        if (hipOccupancyMaxActiveBlocksPerMultiprocessor(&per_cu, (const void*)mk_fwd, NTHR, LDS_BYTES) != hipSuccess || per_cu < 1) { fprintf(stderr, "kernel_launch: occupancy query says %d\n", per_cu); }
        (void)hipGetLastError();
        grid = cus;
    }
    if (grid < 0) return;
    (void)hipMemsetAsync((char*)d_ws + WS_CTL, 0, CTL_ZERO_BYTES, stream);
    Args a{};
    for (int i = 0; i < 40; ++i) a.in[i] = d_in[i];
    a.out = (float*)d_out; a.ws = (unsigned char*)d_ws;
#if MK_DEBUG
    const size_t fo_off = (WS_FAST_END + 4095) & ~(size_t)4095, nv_off = fo_off + (((size_t)O_END * 4 + 4095) & ~(size_t)4095), chk_off = nv_off + (((size_t)nv::WS_FLOATS * 4 + 4095) & ~(size_t)4095);
    if (ws_size < chk_off + 4096) { fprintf(stderr, "debug build: workspace too small (%zu < %zu)\n", ws_size, chk_off + 4096); return; }
    float* fast_out = (float*)((char*)d_ws + fo_off); float* nvws = (float*)((char*)d_ws + nv_off); double* chk = (double*)((char*)d_ws + chk_off);
    nv::forward(d_in, (float*)d_out, nvws, stream);
    a.out = fast_out;
    (void)hipMemsetAsync(chk, 0, 4096, stream);
#endif
#if MK_ONE_LAUNCH
    a.ph_lo = 0; a.ph_hi = N_PHASES; a.use_bar = 1;
    hipLaunchKernelGGL(mk_fwd, dim3(grid), dim3(NTHR), LDS_BYTES, stream, a);
#else
    for (int p = 0; p < N_PHASES; ++p) { a.ph_lo = p; a.ph_hi = p + 1; a.use_bar = 0; hipLaunchKernelGGL(mk_fwd, dim3(grid), dim3(NTHR), LDS_BYTES, stream, a); }
#endif
#if MK_DEBUG
    {
        const nv::Bufs B = nv::carve(nvws); unsigned char* ws = (unsigned char*)d_ws; int k = 0; const float* no = (const float*)d_out;
        auto cmp = [&](const void* fast, int isbf, long ldf, const float* ref, long ldr, long rows, long cols, float scale) {
            Chk c{fast, ref, isbf, rows, cols, ldf, ldr, scale}; hipLaunchKernelGGL(k_compare, dim3(1024), dim3(256), 0, stream, c, chk + 2 * k); ++k; };
        cmp(ws + WS_KB, 1, SBW, B.PROJ + 512, INW, MPR, SBW, 1.f);
        cmp(ws + WS_VB, 1, SBW, B.PROJ + 1024, INW, MPR, SBW, 1.f);
        cmp(ws + WS_QB, 1, SBW, B.PROJ, INW, MPR, SBW, 1.f / C2);
        hipLaunchKernelGGL(k_compare_xh, dim3(1024), dim3(256), 0, stream, (const unsigned short*)(ws + WS_XH), B.PROJ, B.HS, 0, chk + 2 * k); ++k;
        cmp(ws + WS_MKB, 1, D, no + O_MKP, D, NB * MT, D, 1.f);
        cmp(ws + WS_MVB, 1, D, no + O_MVP, D, NB * MT, D, 1.f);
        cmp(ws + WS_OSB, 1, SBW, B.OSB, SBW, MPR, SBW, 1.f);
        cmp(ws + WS_OSB + (size_t)MPR * SBW * 2, 1, SBW, B.OSB + (size_t)MPR * SBW, SBW, MS, SBW, 1.f);
        hipLaunchKernelGGL(k_compare_xh, dim3(1024), dim3(256), 0, stream, (const unsigned short*)(ws + WS_XH), B.PROJ, B.HS, 1, chk + 2 * k); ++k;
        cmp(ws + WS_YG, 1, SBW, B.YG, SBW, MPR, SBW, 1.f);
        cmp(ws + WS_YG + (size_t)MPR * SBW * 2, 1, SBW, B.YG + (size_t)MPR * SBW, SBW, MS, SBW, 1.f);
        cmp(ws + WS_OSSM, 1, SBW, B.OSSM, SBW, MALL, SBW, 1.f);
        cmp(ws + WS_X1B, 1, D, B.X1, D, MALL, D, 1.f);
        cmp(ws + WS_QM, 1, D, B.Q, D, MALL, D, 1.f / CM);
        cmp(ws + WS_OMEM, 1, D, B.OM, D, MPR, D, 1.f);
        cmp(ws + WS_OMEM + (size_t)MPR * D * 2, 1, D, B.OM + (size_t)MPR * D, D, MS, D, 1.f);
        cmp(ws + WS_X2B, 1, D, B.X2, D, MALL, D, 1.f);
        cmp(ws + WS_X2B, 1, D, B.X2, D, MALL, D, 1.f);
        cmp(ws + WS_UB, 1, FF, B.ACT, FF, MALL, FF, 1.f);
        const size_t offs[15] = {O_YP, O_YS, O_KP, O_VP, O_REP, O_IMP, O_CVP, O_MKP, O_MVP, O_KS, O_VS, O_RES, O_IMS, O_CVS, O_END};
        for (int i = 0; i < 14; ++i) cmp(fast_out + offs[i], 0, 1, no + offs[i], 1, (long)(offs[i + 1] - offs[i]), 1, 1.f);
        hipLaunchKernelGGL(k_judge, dim3(1), dim3(64), 0, stream, (const double*)chk, k, 2e-3f, (float*)d_out);
    }
#endif
}
```

```cpp
#define MK_DEBUG 0
#define MK_ONE_LAUNCH 1
#define MK_PROBE 0
#define MK_STREAM_DIV 2
#define MK_XSTAG 1
#include <hip/hip_runtime.h>
#include <cstdio>
#include <cstdint>
#include <cmath>
#include <cstring>
namespace pg8 {
#define PG8_LAS __attribute__((address_space(3)))
typedef unsigned short bf16_t;
typedef short bf16x8 __attribute__((ext_vector_type(8)));
typedef float f32x4 __attribute__((ext_vector_type(4)));
typedef unsigned u32x4 __attribute__((ext_vector_type(4)));
constexpr int BM = 256, BK = 64, HALF = 128, HTB = HALF * BK * 2  , STAGE_BYTES = 8 * HTB, NXCD = 8, WGM = 8;

__host__ __device__ __forceinline__ int lds_byte(int r, int c) { const int st = (r >> 4) * 2 + (c >> 5), rr = r & 15, cc = c & 31, ob = rr * 64 + cc * 2; return st * 1024 + (ob ^ (((ob >> 9) & 1) << 5)); }
__host__ __device__ __forceinline__ void stage_rc(int b, int& R, int& C) { const int st = b / 1024, sb = b % 1024, swz = sb ^ (((sb >> 9) & 1) << 5); R = (st >> 1) * 16 + swz / 64; C = (st & 1) * 32 + (swz % 64) / 2; }
__host__ __device__ __forceinline__ int perm32(int rho) { const int n = rho >> 4, i = rho & 15; return 8 * (i >> 2) + 4 * n + (i & 3); }

struct Unit { int pm, pn; };
struct Gemm { const bf16_t* A; const bf16_t* Bt; int lda, ldb, K; int bhalf = HALF; };

struct GridOrder {
    int nM, nN, nwg, G, c; size_t astep, bstep;
    __device__ void init(int nM_, int nN_, int G_, int c_, int shift, int lda, int ldb) { nM = nM_; nN = nN_; nwg = nM * nN; G = G_; c = (c_ + G_ - (shift % G_)) % G_; astep = (size_t)BM * lda * 2; bstep = (size_t)BM * ldb * 2; }
    __device__ bool next(int i, Unit& u) const {
        const long L = (long)i * G + c; if (L >= nwg) return false;
        int wgid = (int)L; { const int q = nwg / NXCD, r = nwg % NXCD, xcd = wgid % NXCD, off = wgid / NXCD; wgid = (xcd < r ? xcd * (q + 1) : r * (q + 1) + (xcd - r) * q) + off; }
        const int nig = WGM * nN, gid = wgid / nig, fm = gid * WGM, gsz = (nM - fm) < WGM ? (nM - fm) : WGM;
        u.pm = fm + ((wgid % nig) % gsz); u.pn = (wgid % nig) / gsz; return true;
    }
    __device__ __forceinline__ size_t aoff(const Unit& u) const { return (size_t)u.pm * astep; }
    __device__ __forceinline__ size_t boff(const Unit& u) const { return (size_t)u.pn * bstep; }
};

__device__ __forceinline__ unsigned cvt_pk_bf16(float lo, float hi) { unsigned r; asm volatile("v_cvt_pk_bf16_f32 %0, %1, %2" : "=v"(r) : "v"(lo), "v"(hi)); return r; }

template <class Epi, class Sched, bool ALIGN_EPI = true, bool SP2 = true>
__device__ __forceinline__ void gemm_phase(PG8_LAS unsigned char* lds, const Gemm g, const Sched& S, const Epi& E) {
    const int tid = threadIdx.x, wid = __builtin_amdgcn_readfirstlane(tid >> 6), lane = tid & 63, wr = wid >> 2, wc = wid & 3, fr = lane & 15, fq = lane >> 4;
    const int K = g.K, nt = K / BK;
    unsigned voffA[2], voffB[2];
#pragma unroll
    for (int i = 0; i < 2; ++i) { int R, C; stage_rc(tid * 16 + i * 8192, R, C); const int Rb = (R & ~31) + perm32(R & 31);
        voffA[i] = (unsigned)(R * g.lda + C) * 2u; voffB[i] = (unsigned)(Rb * g.ldb + C) * 2u; }
    const size_t kstep = (size_t)(BK * 2);
    const size_t hstepA = (size_t)HALF * g.lda * 2, hstepB = (size_t)g.bhalf * g.ldb * 2;
    const unsigned ldsw = (unsigned)wid * 1024u;
    const int aoff = lds_byte(wr * 64 + fr, fq * 8), boff = lds_byte(wc * 32 + fr, fq * 8);
#define PG8_SA(b, h) (((b) * 2 + (h)) * HTB)
#define PG8_SB(b, h) ((4 + (b) * 2 + (h)) * HTB)
#define PG8_STAGE(bufoff, gbase, voff) do { _Pragma("unroll") for (int _i = 0; _i < 2; ++_i) \
        __builtin_amdgcn_global_load_lds((const unsigned*)((const char*)(gbase) + (voff)[_i]), (PG8_LAS unsigned*)(lds + (bufoff) + ldsw + _i * 8192), 16, 0, 0); } while (0)
#define PG8_LDA(dst, b, h) do { _Pragma("unroll") for (int m = 0; m < 4; ++m) _Pragma("unroll") for (int k = 0; k < 2; ++k) dst[m][k] = *(const PG8_LAS bf16x8*)(lds + PG8_SA(b, h) + aoff + m * 2048 + k * 1024); } while (0)
#define PG8_LDB(dst, b, h) do { _Pragma("unroll") for (int n = 0; n < 2; ++n) _Pragma("unroll") for (int k = 0; k < 2; ++k) dst[n][k] = *(const PG8_LAS bf16x8*)(lds + PG8_SB(b, h) + boff + n * 2048 + k * 1024); } while (0)
#define PG8_MMA(ai, bj, At, Bt) do { __builtin_amdgcn_s_setprio(1); _Pragma("unroll") for (int m = 0; m < 4; ++m) _Pragma("unroll") for (int n = 0; n < 2; ++n) _Pragma("unroll") for (int k = 0; k < 2; ++k) \
        acc[ai][bj][m][n] = __builtin_amdgcn_mfma_f32_16x16x32_bf16(Bt[n][k], At[m][k], acc[ai][bj][m][n], 0, 0, 0); __builtin_amdgcn_s_setprio(0); } while (0)
#define PG8_WAIT_V(n) asm volatile("s_waitcnt vmcnt(" #n ")" ::: "memory")
#define PG8_WAIT_L(n) asm volatile("s_waitcnt lgkmcnt(" #n ")" ::: "memory")
#define PG8_BAR __builtin_amdgcn_s_barrier()
#define PG8_SCHED __builtin_amdgcn_sched_barrier(0)
    Unit cur, nxt; int ui = 0;
    if (!S.next(0, cur)) return;
    f32x4 acc[2][2][4][2];
#pragma unroll
    for (int a = 0; a < 2; ++a)
#pragma unroll
        for (int b = 0; b < 2; ++b)
#pragma unroll
            for (int m = 0; m < 4; ++m)
#pragma unroll
                for (int n = 0; n < 2; ++n) acc[a][b][m][n] = (f32x4){0.f, 0.f, 0.f, 0.f};
    bf16x8 At[4][2], B0[2][2], B1[2][2];
    const char* cA = (const char*)g.A + S.aoff(cur); const char* cB = (const char*)g.Bt + S.boff(cur);
    static_assert(SP2, "only the SP2 loop is kept in this file");
    PG8_STAGE(PG8_SB(0, 0), cB, voffB); PG8_STAGE(PG8_SB(0, 1), cB + hstepB, voffB); PG8_STAGE(PG8_SA(0, 0), cA, voffA); PG8_STAGE(PG8_SA(0, 1), cA + hstepA, voffA);
    if (wr == 1) PG8_BAR;
    PG8_WAIT_V(2); PG8_BAR;
    PG8_STAGE(PG8_SB(1, 0), cB + kstep, voffB); PG8_STAGE(PG8_SA(1, 0), cA + kstep, voffA); PG8_STAGE(PG8_SB(1, 1), cB + hstepB + kstep, voffB);
    PG8_WAIT_V(6); PG8_BAR;
    for (;;) {
        const bool has_next = S.next(ui + 1, nxt);
        const char* nA = has_next ? (const char*)g.A + S.aoff(nxt) : cA; const char* nB = has_next ? (const char*)g.Bt + S.boff(nxt) : cB;
        for (int t = 0; t < nt; t += 2) {
            const bool last = (t == nt - 2);
            const char* a1 = cA + (size_t)(t + 1) * kstep;
            const char* a2 = last ? nA : cA + (size_t)(t + 2) * kstep; const char* b2 = last ? nB : cB + (size_t)(t + 2) * kstep;
            const char* a3 = a2 + kstep; const char* b3 = b2 + kstep;
            PG8_LDB(B0, 0, 0); PG8_LDB(B1, 0, 1); PG8_SCHED; PG8_LDA(At, 0, 0); PG8_STAGE(PG8_SA(1, 1), a1 + hstepA, voffA);
            PG8_WAIT_V(8); PG8_WAIT_L(0); PG8_BAR; PG8_MMA(0, 0, At, B0); PG8_MMA(0, 1, At, B1); PG8_BAR; PG8_SCHED;
            PG8_LDA(At, 0, 1); PG8_STAGE(PG8_SB(0, 0), b2, voffB); PG8_STAGE(PG8_SB(0, 1), b2 + hstepB, voffB); PG8_STAGE(PG8_SA(0, 0), a2, voffA);
            PG8_WAIT_V(8); PG8_WAIT_L(0); PG8_BAR; PG8_MMA(1, 0, At, B0); PG8_MMA(1, 1, At, B1); PG8_BAR; PG8_SCHED;
            PG8_LDB(B0, 1, 0); PG8_LDB(B1, 1, 1); PG8_SCHED; PG8_LDA(At, 1, 0); PG8_STAGE(PG8_SA(0, 1), a2 + hstepA, voffA);
            PG8_WAIT_V(8); PG8_WAIT_L(0); PG8_BAR; PG8_MMA(0, 0, At, B0); PG8_MMA(0, 1, At, B1); PG8_BAR; PG8_SCHED;
            PG8_LDA(At, 1, 1); PG8_STAGE(PG8_SB(1, 0), b3, voffB); PG8_STAGE(PG8_SB(1, 1), b3 + hstepB, voffB); PG8_STAGE(PG8_SA(1, 0), a3, voffA);
            PG8_WAIT_V(8); PG8_WAIT_L(0); PG8_BAR; PG8_MMA(1, 0, At, B0); PG8_MMA(1, 1, At, B1); PG8_BAR; PG8_SCHED;
            if constexpr (Epi::MIDK) { if (t + 2 == nt / 2) E.mid(acc, cur, wr, wc, fr, fq); }
        }
        if constexpr (ALIGN_EPI) { if (wr == 0) PG8_BAR; }
        E(acc, cur, wr, wc, fr, fq);
        if (!has_next) break;
#pragma unroll
        for (int a = 0; a < 2; ++a)
#pragma unroll
            for (int b = 0; b < 2; ++b)
#pragma unroll
                for (int m = 0; m < 4; ++m)
#pragma unroll
                    for (int n = 0; n < 2; ++n) acc[a][b][m][n] = (f32x4){0.f, 0.f, 0.f, 0.f};
        cur = nxt; cA = nA; cB = nB; ++ui;
        if constexpr (ALIGN_EPI) { if (wr == 1) PG8_BAR; }
    }
    PG8_WAIT_V(0);
    if constexpr (!ALIGN_EPI) { if (wr == 0) PG8_BAR; }
    PG8_BAR;
#undef PG8_SA
#undef PG8_SB
#undef PG8_STAGE
#undef PG8_LDA
#undef PG8_LDB
#undef PG8_MMA
#undef PG8_WAIT_V
#undef PG8_WAIT_L
#undef PG8_BAR
#undef PG8_SCHED
}
}
constexpr int NWAVES = 8, NTHR = 512;
constexpr int D = 1024, NB = 4, T = 4096, MPR = NB * T, MS = 128, MALL = MPR + MS, MPAD = 16640;
constexpr int SBW = 512, NH = 8, HD = 64, NG = 32, GP = 16, NST = 64, INW = 2048, FF = 2816, NFF2 = 2 * FF;
constexpr int MT = 256, MH = 4, MHD = 256, PAST = 2048, PAGE = 128, NPG = 16;
constexpr int LC = 16, NCH = T / LC, XHP = 384;
constexpr float EPS = 1e-6f, LOG2E = 1.4426950408889634f;
constexpr float C2 = 0.125f * LOG2E;
constexpr float CM = 0.0625f * LOG2E;

constexpr size_t O_YP = 0, O_YS = O_YP + (size_t)MPR * D, O_KP = O_YS + (size_t)MS * D, O_VP = O_KP + (size_t)MPR * SBW, O_REP = O_VP + (size_t)MPR * SBW,
    O_IMP = O_REP + NB * NG * NST, O_CVP = O_IMP + NB * NG * NST, O_MKP = O_CVP + (size_t)NB * 2 * FF, O_MVP = O_MKP + (size_t)NB * MT * D, O_KS = O_MVP + (size_t)NB * MT * D,
    O_VS = O_KS + (size_t)MS * SBW, O_RES = O_VS + (size_t)MS * SBW, O_IMS = O_RES + (size_t)MS * NG * NST, O_CVS = O_IMS + (size_t)MS * NG * NST, O_END = O_CVS + (size_t)MS * 2 * FF;

constexpr size_t MiB = 1u << 20;
constexpr size_t al(size_t x) { return (x + 4095) & ~(size_t)4095; }
constexpr size_t WS_CTL = 0, CTL_ZERO_BYTES = 1 * MiB;
constexpr size_t WS_WIN = 1 * MiB;
constexpr size_t WS_WMKV = WS_WIN + al((size_t)INW * D * 2);
constexpr size_t WS_WGLU = WS_WMKV + al((size_t)2048 * D * 2);
constexpr size_t WS_WOUT = WS_WGLU + al((size_t)SBW * SBW * 2);
constexpr size_t WS_WMQ = WS_WOUT + al((size_t)D * D * 2);
constexpr size_t WS_WMO = WS_WMQ + al((size_t)D * D * 2);
constexpr size_t WS_WGU = WS_WMO + al((size_t)D * D * 2);
constexpr size_t WS_WDN = WS_WGU + al((size_t)NFF2 * D * 2);
constexpr size_t WS_W1 = WS_WDN + al((size_t)D * FF * 2);
constexpr size_t WS_BTC = WS_W1 + al((size_t)33 * 128 * 256 * 2);
constexpr size_t WS_XB = WS_BTC + al((size_t)NG * 256 * XHP * 2);
constexpr size_t WS_RSTD0 = WS_XB + al((size_t)MPAD * D * 2);
constexpr size_t WS_MB = WS_RSTD0 + al((size_t)MPAD * 4);
constexpr size_t WS_RSTDM = WS_MB + al((size_t)1024 * D * 2);
constexpr size_t WS_QB = WS_RSTDM + al(4096);
constexpr size_t WS_KB = WS_QB + al((size_t)MPAD * SBW * 2);
constexpr size_t WS_VB = WS_KB + al((size_t)MPAD * SBW * 2);
constexpr size_t WS_QS = WS_VB + al((size_t)MPAD * SBW * 2);
constexpr size_t WS_US = WS_QS + al((size_t)MS * SBW * 4);
constexpr size_t WS_XH = WS_US + al((size_t)MS * SBW * 4);
constexpr size_t WS_SST = WS_XH + al((size_t)1024 * NG * XHP * 2 + 65536);
constexpr size_t WS_YG = WS_SST + al((size_t)1024 * NG * 128 * 4);
constexpr size_t WS_OSB = WS_YG + al((size_t)MPAD * SBW * 2);
constexpr size_t WS_OSSM = WS_OSB + al((size_t)MPAD * SBW * 2);
constexpr size_t WS_SBPO = WS_OSSM + al((size_t)MPAD * SBW * 2);
constexpr size_t WS_SBPL = WS_SBPO + al((size_t)MS * NPG * NH * HD * 4);
constexpr size_t WS_MIX = WS_SBPL + al((size_t)MS * NPG * NH * 4);
constexpr size_t WS_X1 = WS_MIX + al((size_t)MPAD * D * 2);
constexpr size_t WS_X1B = WS_X1 + al((size_t)MPAD * D * 4);
constexpr size_t WS_MKB = WS_X1B + al((size_t)MPAD * D * 2);
constexpr size_t WS_MVB = WS_MKB + al((size_t)1024 * D * 2);
constexpr size_t WS_QM = WS_MVB + al((size_t)1024 * D * 2);
constexpr size_t WS_OMEM = WS_QM + al((size_t)MPAD * D * 2);
constexpr size_t WS_X2 = WS_OMEM + al((size_t)MPAD * D * 2);
constexpr size_t WS_X2B = WS_X2 + al((size_t)MPAD * D * 4);
constexpr size_t WS_GB = WS_X2B + al((size_t)MPAD * D * 2);
constexpr size_t WS_UB = WS_GB + al((size_t)MPAD * FF * 2);
constexpr size_t WS_FAST_END = WS_UB + al((size_t)MPAD * FF * 2);
constexpr int CW_TMO = 0, CW_CODE = 1, CW_QA = 2048, CW_QM = 2112, CW_SCNT = 2240  , CW_PCNT = 2304  , CW_BAR = 4096;
constexpr int CW_SSQ1 = 16384, CW_SSQ2 = CW_SSQ1 + MPAD, CW_SSQ3 = CW_SSQ2 + MPAD, CW_SSQD = CW_SSQ3 + MPAD, CW_SSQA = CW_SSQD + MPAD, CW_SSQB = CW_SSQA + MPAD;
static_assert((CW_SSQB + MPAD) * 4 <= (int)CTL_ZERO_BYTES, "CTL words inside the memset region");

constexpr int RING_OFF = 0, RING_BYTES = 131072;
constexpr int LDSCTL_OFF = RING_BYTES, MISC_OFF = LDSCTL_OFF + 320;
constexpr int LDS_BYTES = 147456;
static_assert(MISC_OFF + 128 <= LDS_BYTES, "LDS map");

#define GAS __attribute__((address_space(1)))
#define LAS __attribute__((address_space(3)))
typedef unsigned short bf16;
typedef unsigned v4u __attribute__((ext_vector_type(4)));
typedef unsigned v2u __attribute__((ext_vector_type(2)));
typedef float f32x4 __attribute__((ext_vector_type(4)));
typedef float f32x2 __attribute__((ext_vector_type(2)));
typedef float f32x16 __attribute__((ext_vector_type(16)));
typedef short bf16x8 __attribute__((ext_vector_type(8)));
typedef short s16x4 __attribute__((ext_vector_type(4)));
typedef GAS unsigned gu32;
#define RLX_AGENT __ATOMIC_RELAXED, __HIP_MEMORY_SCOPE_AGENT
#define LDS_WAIT() asm volatile("s_waitcnt lgkmcnt(0)" ::: "memory")
#define VM_WAIT() asm volatile("s_waitcnt vmcnt(0)" ::: "memory")
__device__ __forceinline__ unsigned f2bf(float f) { unsigned u = __builtin_bit_cast(unsigned, f); return (u + 0x7fffu + ((u >> 16) & 1u)) >> 16; }
__device__ __forceinline__ unsigned pk2(float lo, float hi) { return f2bf(lo) | (f2bf(hi) << 16); }
__device__ __forceinline__ float bf2f(unsigned short h) { return __builtin_bit_cast(float, (unsigned)h << 16); }
__device__ __forceinline__ float bflo(unsigned w) { return __builtin_bit_cast(float, w << 16); }
__device__ __forceinline__ float bfhi(unsigned w) { return __builtin_bit_cast(float, w & 0xffff0000u); }
typedef float f32x2_c __attribute__((ext_vector_type(2))); typedef __bf16 bf16x2_c __attribute__((ext_vector_type(2)));
__device__ __forceinline__ unsigned cvtpk(float lo, float hi) { f32x2_c v = {lo, hi}; bf16x2_c r = __builtin_convertvector(v, bf16x2_c); return __builtin_bit_cast(unsigned, r); }
__device__ __forceinline__ float gelu_tanh_f(float x) {
    const float u2 = 2.f * 0.7978845608028654f * (x + 0.044715f * x * x * x);
    return x * __builtin_amdgcn_rcpf(1.f + __builtin_amdgcn_exp2f(-u2 * LOG2E));
}

__device__ __forceinline__ float swap16(float v) { auto rr = __builtin_amdgcn_permlane16_swap(__float_as_uint(v), __float_as_uint(v), false, false); return __uint_as_float((threadIdx.x & 16) ? rr[0] : rr[1]); }
__device__ __forceinline__ float swap_half(float v) { auto rr = __builtin_amdgcn_permlane32_swap(__float_as_uint(v), __float_as_uint(v), false, false); return __uint_as_float((threadIdx.x & 32) ? rr[0] : rr[1]); }
__device__ __forceinline__ float wave_sum(float x) {
    x += __builtin_bit_cast(float, __builtin_amdgcn_update_dpp(0, __builtin_bit_cast(int, x), 0xB1, 0xf, 0xf, true));
    x += __builtin_bit_cast(float, __builtin_amdgcn_update_dpp(0, __builtin_bit_cast(int, x), 0x4E, 0xf, 0xf, true));
    x += __builtin_bit_cast(float, __builtin_amdgcn_update_dpp(0, __builtin_bit_cast(int, x), 0x141, 0xf, 0xf, true));
    x += __builtin_bit_cast(float, __builtin_amdgcn_update_dpp(0, __builtin_bit_cast(int, x), 0x140, 0xf, 0xf, true));
    x += swap16(x); x += swap_half(x); return x;
}
#define XB_TMO      128
#define XB_XCNT(j)  (256  + 64 * (j))
#define XB_XSUB(j)  (1280 + 64 * (j))
#define XB_XGEN(j)  (2304 + 64 * (j))
#define XB_TOP      3328
#define XB_TOPGEN   3392
#define XCD_BAR_WORDS 3456
#define XB_SPIN_CAP (1u << 18)
__device__ __forceinline__ unsigned xb_ld(unsigned* p)              { return __hip_atomic_load(p, __ATOMIC_RELAXED, __HIP_MEMORY_SCOPE_AGENT); }
__device__ __forceinline__ unsigned xb_add(unsigned* p, unsigned v) { return __hip_atomic_fetch_add(p, v, __ATOMIC_RELAXED, __HIP_MEMORY_SCOPE_AGENT); }
__device__ __forceinline__ unsigned xb_xcc_id() { return (unsigned)__builtin_amdgcn_s_getreg((3 << 11) | 20) & 0xFu; }
#define XB_SPIN(cond, bar) do { unsigned _sp = 0; while (cond) { __builtin_amdgcn_s_sleep(1); \
    if ((++_sp & 255u) == 0u) { if (xb_ld(&(bar)[XB_TMO])) break; if (_sp > XB_SPIN_CAP) { atomicAdd(&(bar)[XB_TMO], 1u); break; } } } } while (0)
struct XcdBarrier { unsigned* bar; unsigned x; volatile LAS unsigned* st; };
__device__ __forceinline__ XcdBarrier xcd_barrier_post(unsigned* bar, volatile LAS unsigned* st) {
    XcdBarrier b; b.bar = bar; b.x = xb_xcc_id(); b.st = st;
    if (threadIdx.x == 0) (void)xb_add(&bar[XB_XCNT(b.x)], 1u);
    return b;
}
__device__ __forceinline__ void xcd_barrier_complete(unsigned* bar, unsigned x, unsigned& nloc, unsigned& nx) {
    const unsigned G = gridDim.x * gridDim.y * gridDim.z;
    unsigned sum, cnt, mine, sp = 0u;
    for (;;) {
        sum = 0u; cnt = 0u; mine = 0u;
#pragma unroll
        for (unsigned j = 0; j < 16; ++j) { const unsigned c = xb_ld(&bar[XB_XCNT(j)]); sum += c; cnt += (c > 0u) ? 1u : 0u; mine = (j == x) ? c : mine; }
        if (sum == G) break;
        __builtin_amdgcn_s_sleep(1);
        if ((++sp & 255u) == 0u) { if (xb_ld(&bar[XB_TMO])) break; if (sp > XB_SPIN_CAP) { atomicAdd(&bar[XB_TMO], 1u); break; } }
    }
    nloc = mine > 0u ? mine : 1u; nx = cnt > 0u ? cnt : 1u;
}
__device__ __forceinline__ void xcd_barrier(const XcdBarrier& b) {
    asm volatile("s_waitcnt vmcnt(0)" ::: "memory");
    __syncthreads();
    if (threadIdx.x == 0) {
        unsigned* bar = b.bar;
        __builtin_amdgcn_s_waitcnt(0);
        unsigned nloc = b.st[0], nx = b.st[1];
        if (nloc == 0u) { xcd_barrier_complete(bar, b.x, nloc, nx); b.st[0] = nloc; b.st[1] = nx; }
        const unsigned old = xb_add(&bar[XB_XSUB(b.x)], 1u);
        const unsigned gen = old / nloc;
        if (old + 1u == (gen + 1u) * nloc) {
            __builtin_amdgcn_fence(__ATOMIC_RELEASE, "agent");
            asm volatile("s_waitcnt vmcnt(0)" ::: "memory");
            const unsigned og = xb_add(&bar[XB_TOP], 1u);
            const unsigned tg = og / nx;
            if (og + 1u == (tg + 1u) * nx) xb_add(&bar[XB_TOPGEN], 1u);
            else XB_SPIN(xb_ld(&bar[XB_TOPGEN]) == tg, bar);
            __builtin_amdgcn_fence(__ATOMIC_ACQUIRE, "agent");
            xb_add(&bar[XB_XGEN(b.x)], 1u);
            asm volatile("s_waitcnt vmcnt(0)" ::: "memory");
        } else {
            XB_SPIN(xb_ld(&bar[XB_XGEN(b.x)]) == gen, bar);
            __builtin_amdgcn_fence(__ATOMIC_ACQUIRE, "agent");
            asm volatile("s_waitcnt vmcnt(0)" ::: "memory");
        }
    }
    __syncthreads();
}

struct Args { const void* in[40]; float* out; unsigned char* ws; int ph_lo, ph_hi, use_bar, pad; };
struct Frame {
    LAS unsigned char* lds; volatile LAS unsigned* MISC; unsigned* ctl;
    int tid, lane, wave, vcu, G;
    unsigned char* ws; float* out; const void* const* in;
};
#define INF(i) ((const float*)F.in[i])
#define WSP(T_, off) ((T_*)(F.ws + (off)))
struct TrItem { const float* W; const float* gain; bf16* WT; int K, N, row_off, k0, n0; };
__device__ __forceinline__ void tr_load(const TrItem& t, float (&wv)[32], int lane) {
#pragma unroll
    for (int i = 0; i < 32; ++i) wv[i] = t.W[(size_t)(t.k0 + 2 * i + (lane >> 5)) * t.N + t.n0 + (lane & 31)];
}
__device__ __forceinline__ void tr_finish(const TrItem& t, const float (&wv)[32], LAS float* scr, int lane) {
#pragma unroll
    for (int i = 0; i < 32; ++i) { const int kk = 2 * i + (lane >> 5); const float gv = t.gain ? t.gain[t.k0 + kk] : 1.f; scr[kk * 33 + (lane & 31)] = wv[i] * gv; }
    LDS_WAIT(); asm volatile("" ::: "memory");
    const int c = lane & 7;
#pragma unroll
    for (int j = 0; j < 4; ++j) { const int n = (lane >> 3) + 8 * j; const LAS float* s = scr + (8 * c) * 33 + n;
        v4u o; o.x = pk2(s[0 * 33], s[1 * 33]); o.y = pk2(s[2 * 33], s[3 * 33]); o.z = pk2(s[4 * 33], s[5 * 33]); o.w = pk2(s[6 * 33], s[7 * 33]);
        *(GAS v4u*)(t.WT + (size_t)(t.row_off + t.n0 + n) * t.K + t.k0 + 8 * c) = o; }
    LDS_WAIT(); asm volatile("" ::: "memory");
}
__device__ __forceinline__ void rows2_load(const float* xrow, f32x4 (&v)[2][4], int lane) {
#pragma unroll
    for (int r = 0; r < 2; ++r)
#pragma unroll
        for (int j = 0; j < 4; ++j) v[r][j] = ((const GAS f32x4*)(xrow + (size_t)r * D) + lane)[64 * j];
}
__device__ __forceinline__ void rows2_finish(const f32x4 (&v)[2][4], bf16* orow, float* rstd, int lane) {
    float s[2] = {0.f, 0.f};
#pragma unroll
    for (int r = 0; r < 2; ++r) {
#pragma unroll
        for (int j = 0; j < 4; ++j) s[r] += (v[r][j].x * v[r][j].x + v[r][j].y * v[r][j].y) + (v[r][j].z * v[r][j].z + v[r][j].w * v[r][j].w);
        GAS v2u* o8 = (GAS v2u*)(orow + (size_t)r * D) + lane;
#pragma unroll
        for (int j = 0; j < 4; ++j) { v2u w; w.x = pk2(v[r][j].x, v[r][j].y); w.y = pk2(v[r][j].z, v[r][j].w); o8[64 * j] = w; }
    }
    s[0] = wave_sum(s[0]); s[1] = wave_sum(s[1]);
    if (lane < 2) rstd[lane] = 1.f / sqrtf((lane ? s[1] : s[0]) * (1.f / D) + EPS);
}
__device__ __forceinline__ void lam_pow(float lr, float li, float logdt, int tau, float& pr, float& pi) {
    const double dt = exp((double)logdt);
    const double ang = (double)li * dt * (double)tau;
    const double k = rint(ang * 0.15915494309189535);
    double r = fma(-k, 6.283185307179586, ang); r = fma(-k, 2.4492935982947064e-16, r);
    const float rf = (float)r, mag = (float)exp((double)lr * dt * (double)tau);
    pr = mag * cosf(rf); pi = mag * sinf(rf);
}
__device__ __forceinline__ void lam_coef(float lr, float li, float logdt, float& cr, float& ci) {
    const double dt = exp((double)logdt);
    const double ang = (double)li * dt;
    const double k = rint(ang * 0.15915494309189535);
    double r = fma(-k, 6.283185307179586, ang); r = fma(-k, 2.4492935982947064e-16, r);
    const float th = (float)r, a = (float)((double)lr * dt);
    const float sh = sinf(0.5f * th);
    const float nr = expm1f(a) * cosf(th) - 2.f * sh * sh, ni = expf(a) * sinf(th);
    const float den = lr * lr + li * li;
    cr = (nr * lr + ni * li) / den; ci = (ni * lr - nr * li) / den;
}
__device__ __forceinline__ void ssm_table_unit(Frame& F, int g, int tau) {
    LAS float* Mr = (LAS float*)(F.lds + RING_OFF); LAS float* Mi = Mr + 1024; LAS float* Pr = Mi + 1024; LAS float* Pi = Pr + 64; LAS float* Cr = Pi + 64; LAS float* Ci = Cr + 64;
    LAS float* Kt = Ci + 64; LAS float* CRE = Kt + 256; LAS float* CIM = CRE + 1024; LAS float* Qr = CIM + 1024; LAS float* Qi = Qr + 64;
    const float* lam_re = INF(14); const float* lam_im = INF(15); const float* log_dt = INF(16); const float* b_re = INF(17); const float* b_im = INF(18);
    const float* c_re = INF(19); const float* c_im = INF(20); const float* d_skip = INF(21);
    bf16* W1 = WSP(bf16, WS_W1); bf16* BTC = WSP(bf16, WS_BTC);
    const int tid = F.tid; const float ldt = log_dt[g];
    __syncthreads();
    if (tid < 64) { float pr, pi, cr, ci; const float lr = lam_re[g * NST + tid], li = lam_im[g * NST + tid]; lam_pow(lr, li, ldt, tau, pr, pi); lam_coef(lr, li, ldt, cr, ci); Pr[tid] = pr; Pi[tid] = pi; Cr[tid] = cr; Ci[tid] = ci; lam_pow(lr, li, ldt, tau + 1, pr, pi); Qr[tid] = pr; Qi[tid] = pi; }
    for (int i = tid; i < 1024; i += NTHR) { CRE[i] = c_re[g * 1024 + i]; CIM[i] = c_im[g * 1024 + i]; }
    __syncthreads();
    for (int i = tid; i < 1024; i += NTHR) { const int n = i >> 4; const float cr = Cr[n], ci = Ci[n];
        const float br = b_re[g * 1024 + i], bi = b_im[g * 1024 + i]; const float bbr = cr * br - ci * bi, bbi = cr * bi + ci * br;
        const float pr = Pr[n], pi = Pi[n]; Mr[i] = pr * bbr - pi * bbi; Mi[i] = pr * bbi + pi * bbr; }
    __syncthreads();
    {
        const int s = 15 - tau;
        for (int i = tid; i < 2048; i += NTHR) { const int n = i >> 5, ri = (i >> 4) & 1, q = i & 15; const float v = ri ? Mi[n * 16 + q] : Mr[n * 16 + q];
            W1[((size_t)g * 128 + 2 * n + ri) * 256 + s * 16 + q] = (bf16)f2bf(v); }
        if (tid < 256) { const int p = tid >> 4, q = tid & 15; float acc = 0.f;
#pragma unroll 8
            for (int n = 0; n < NST; ++n) acc += CRE[p * NST + n] * Mr[n * 16 + q] - CIM[p * NST + n] * Mi[n * 16 + q];
            if (tau == 0 && p == q) acc += d_skip[g * GP + p];
            Kt[tid] = acc; }
        __syncthreads();
        for (int idx = tid; idx < (16 - tau) * 256; idx += NTHR) { const int blk = idx >> 8, e = idx & 255, p = e >> 4, q = e & 15; const int s2 = blk, t2 = s2 + tau;
            BTC[((size_t)g * 256 + t2 * 16 + p) * XHP + s2 * 16 + q] = (bf16)f2bf(Kt[e]);
            if (tau >= 1) BTC[((size_t)g * 256 + s2 * 16 + p) * XHP + t2 * 16 + q] = (bf16)0; }
    }
    {
        for (int idx = tid; idx < 1024; idx += NTHR) { const int p = idx >> 6, n = idx & 63; const float cr = CRE[idx], ci = CIM[idx], pr = Qr[n], pi = Qi[n];
            const unsigned w = pk2(cr * pr - ci * pi, -(cr * pi + ci * pr));
            *(GAS unsigned*)(BTC + ((size_t)g * 256 + tau * 16 + p) * XHP + 256 + 2 * n) = w; }
    }
    __syncthreads();
}
__device__ __forceinline__ TrItem tr_item(Frame& F, int it) {
    constexpr int I_IN = 16 * 64, I_MK = 16 * 32, I_GLU = 8 * 16, I_SQ = 16 * 32, I_G = 16 * 88;
    TrItem t; int r = it; t.row_off = 0; t.K = D;
    if (r < I_IN) { t.W = INF(12); t.N = INW; t.WT = WSP(bf16, WS_WIN); t.gain = INF(11); }
    else if ((r -= I_IN) < I_MK) { t.W = INF(30); t.N = D; t.WT = WSP(bf16, WS_WMKV); t.gain = INF(28); }
    else if ((r -= I_MK) < I_MK) { t.W = INF(31); t.N = D; t.WT = WSP(bf16, WS_WMKV); t.gain = INF(28); t.row_off = D; }
    else if ((r -= I_MK) < I_GLU) { t.W = INF(22); t.N = SBW; t.K = SBW; t.WT = WSP(bf16, WS_WGLU); t.gain = nullptr; }
    else if ((r -= I_GLU) < I_SQ) { t.W = INF(26); t.N = D; t.WT = WSP(bf16, WS_WOUT); t.gain = (r / (D / 32) < 8) ? INF(24) : INF(25) - SBW; }
    else if ((r -= I_SQ) < I_SQ) { t.W = INF(29); t.N = D; t.WT = WSP(bf16, WS_WMQ); t.gain = INF(27); }
    else if ((r -= I_SQ) < I_SQ) { t.W = INF(32); t.N = D; t.WT = WSP(bf16, WS_WMO); t.gain = nullptr; }
    else if ((r -= I_SQ) < I_G) { t.W = INF(34); t.N = FF; t.WT = WSP(bf16, WS_WGU); t.gain = INF(33); }
    else if ((r -= I_G) < I_G) { t.W = INF(35); t.N = FF; t.WT = WSP(bf16, WS_WGU); t.gain = INF(33); t.row_off = FF; }
    else { r -= I_G; t.W = INF(38); t.N = D; t.K = FF; t.WT = WSP(bf16, WS_WDN); t.gain = nullptr; }
    const int nblk = t.N / 32; t.k0 = 64 * (r / nblk); t.n0 = 32 * (r % nblk); return t;
}
constexpr int NITEMS_EARLY = 16 * 64 + 2 * 16 * 32, NITEMS_GLU = NITEMS_EARLY + 8 * 16, NITEMS_ALL = 16 * 64 + 2 * 16 * 32 + 8 * 16 + 3 * 16 * 32 + 2 * 16 * 88 + 44 * 32;
constexpr int NITEMS_MID = NITEMS_GLU + 3 * 16 * 32 + 2 * 16 * 88;
__device__ __forceinline__ void weight_copies(Frame& F, int lo, int hi, int cu0 = 0, int ncu = 0) {
    LAS float* scr = (LAS float*)(F.lds + RING_OFF + F.wave * 16384);
    if (ncu && ((int)blockIdx.x < cu0 || (int)blockIdx.x >= cu0 + ncu)) return;
    const int gw = (ncu ? (int)blockIdx.x - cu0 : F.vcu) * NWAVES + F.wave, NGW = (ncu ? ncu : F.G) * NWAVES;
    if (lo + gw < hi) {
        float wa[32], wb[32]; TrItem ta = tr_item(F, lo + gw), tb; tr_load(ta, wa, F.lane);
        for (int it = lo + gw; it < hi; it += NGW) {
            const bool more = it + NGW < hi;
            if (more) { tb = tr_item(F, it + NGW); tr_load(tb, wb, F.lane); }
            tr_finish(ta, wa, scr, F.lane);
            if (more) { ta = tb;
#pragma unroll
                for (int i = 0; i < 32; ++i) wa[i] = wb[i]; }
        }
    }
}
__device__ __forceinline__ void p0_prologue(Frame& F) {
    LAS float* scr = (LAS float*)(F.lds + RING_OFF + F.wave * 16384);
    const int gw = F.vcu * NWAVES + F.wave, NGW = F.G * NWAVES;
    weight_copies(F, 0, NITEMS_EARLY);
    {
        f32x4 va[2][4], vb[2][4];
        auto src = [&](int m) -> const float* { return (m < MPR) ? INF(0) + (size_t)m * D : (m < MALL) ? INF(1) + (size_t)(m - MPR) * D : INF(10) + (size_t)(m - MALL) * D; };
        constexpr int NR = MALL + NB * MT;
        int m = 2 * gw;
        if (m < NR) { rows2_load(src(m), va, F.lane);
            for (; m < NR; m += 2 * NGW) {
                const bool more = m + 2 * NGW < NR;
                if (more) rows2_load(src(m + 2 * NGW), vb, F.lane);
                if (m < MALL) rows2_finish(va, WSP(bf16, WS_XB) + (size_t)m * D, WSP(float, WS_RSTD0) + m, F.lane);
                else rows2_finish(va, WSP(bf16, WS_MB) + (size_t)(m - MALL) * D, WSP(float, WS_RSTDM) + (m - MALL), F.lane);
                if (more) {
#pragma unroll
                    for (int r = 0; r < 2; ++r)
#pragma unroll
                        for (int j = 0; j < 4; ++j) va[r][j] = vb[r][j]; }
            } }
    }
    for (int u = F.vcu; u < NG * 16; u += F.G) ssm_table_unit(F, u >> 4, u & 15);
    { bf16* W1 = WSP(bf16, WS_W1); for (int i = gw * 64 + F.lane; i < 128 * 256 / 8; i += NGW * 64) *(GAS v4u*)(W1 + (size_t)32 * 128 * 256 + (size_t)i * 8) = (v4u){0u, 0u, 0u, 0u}; }
}

constexpr int HALO_OFF_C = RING_BYTES + 1024;
#define EPI_LOOP_BEGIN \
    _Pragma("unroll") for (int ai = 0; ai < 2; ++ai) _Pragma("unroll") for (int m = 0; m < 4; ++m) { const int row = u.pm * 256 + ai * 128 + wr * 64 + m * 16 + fr; \
    _Pragma("unroll") for (int bj = 0; bj < 2; ++bj) { const int col = u.pn * 256 + bj * 128 + wc * 32 + 8 * fq; f32x4 v0 = acc[ai][bj][m][0], v1 = acc[ai][bj][m][1];
#define EPI_LOOP_END } }
__device__ __forceinline__ v4u pack8(f32x4 a, f32x4 b) { v4u w; w.x = cvtpk(a[0], a[1]); w.y = cvtpk(a[2], a[3]); w.z = cvtpk(b[0], b[1]); w.w = cvtpk(b[2], b[3]); return w; }

struct EpiInProj { static constexpr bool MIDK = false;
    const float* rstd; bf16 *QBp, *KBp, *VBp, *XHp; float *QSp, *USp, *out;
    __device__ __forceinline__ void operator()(const f32x4 (&acc)[2][2][4][2], const pg8::Unit& u, int wr, int wc, int fr_, int fq_) const { int fr = fr_, fq = fq_; asm volatile("" : "+v"(fr), "+v"(fq));
        const int sect = u.pn >> 1;
        EPI_LOOP_BEGIN
            if (row < MALL) {
                const float rs = rstd[row]; v0 = v0 * rs; v1 = v1 * rs;
                const int c = col - sect * SBW;
                if (sect == 0) { v0 = v0 * C2; v1 = v1 * C2; *(v4u*)(QBp + (size_t)row * SBW + c) = pack8(v0, v1);
                    if (row >= MPR) { float* q = QSp + (size_t)(row - MPR) * SBW + c; *(f32x4*)q = v0; *(f32x4*)(q + 4) = v1; } }
                else if (sect == 1 || sect == 2) { bf16* B = (sect == 1) ? KBp : VBp; *(v4u*)(B + (size_t)row * SBW + c) = pack8(v0, v1);
                    float* o = (row < MPR) ? out + (sect == 1 ? O_KP : O_VP) + (size_t)row * SBW + c : out + (sect == 1 ? O_KS : O_VS) + (size_t)(row - MPR) * SBW + c;
                    *(f32x4*)o = v0; *(f32x4*)(o + 4) = v1; }
                else { if (row < MPR) { const int b = row >> 12, t = row & 4095, ch = t >> 4, s = t & 15, g = c >> 4, q0 = c & 15;
                        *(v4u*)(XHp + ((size_t)(b * NCH + ch) * NG + g) * XHP + s * 16 + q0) = pack8(v0, v1); }
                    else { float* q = USp + (size_t)(row - MPR) * SBW + c; *(f32x4*)q = v0; *(f32x4*)(q + 4) = v1; } }
            }
        EPI_LOOP_END
    }
};
struct EpiMemKV { static constexpr bool MIDK = false;
    const float* rstd; bf16 *MKBp, *MVBp; float* out;
    __device__ __forceinline__ void operator()(const f32x4 (&acc)[2][2][4][2], const pg8::Unit& u, int wr, int wc, int fr_, int fq_) const { int fr = fr_, fq = fq_; asm volatile("" : "+v"(fr), "+v"(fq));
        const int sect = u.pn >> 2;
        EPI_LOOP_BEGIN
            const float rs = rstd[row]; v0 = v0 * rs; v1 = v1 * rs; const int c = col - sect * D;
            bf16* B = sect ? MVBp : MKBp; *(v4u*)(B + (size_t)row * D + c) = pack8(v0, v1);
            float* o = out + (sect ? O_MVP : O_MKP) + (size_t)row * D + c; *(f32x4*)o = v0; *(f32x4*)(o + 4) = v1;
        EPI_LOOP_END
    }
};
struct EpiSsmA { static constexpr bool MIDK = false;
    float* SST;
    __device__ __forceinline__ void operator()(const f32x4 (&acc)[2][2][4][2], const pg8::Unit& u, int wr, int wc, int fr_, int fq_) const { int fr = fr_, fq = fq_; asm volatile("" : "+v"(fr), "+v"(fq));
        _Pragma("unroll") for (int ai = 0; ai < 2; ++ai) _Pragma("unroll") for (int m = 0; m < 4; ++m) { const int row = u.pm * 256 + ai * 128 + wr * 64 + m * 16 + fr;
            const int col = wc * 32 + 8 * fq; float* o = SST + ((size_t)row * NG + u.pn) * 128 + col; *(f32x4*)o = acc[ai][0][m][0]; *(f32x4*)(o + 4) = acc[ai][0][m][1]; }
    }
};
struct EpiSsmC { static constexpr bool MIDK = false;
    bf16* YG;
    __device__ __forceinline__ void operator()(const f32x4 (&acc)[2][2][4][2], const pg8::Unit& u, int wr, int wc, int fr_, int fq_) const { int fr = fr_, fq = fq_; asm volatile("" : "+v"(fr), "+v"(fq));
        _Pragma("unroll") for (int ai = 0; ai < 2; ++ai) _Pragma("unroll") for (int m = 0; m < 4; ++m) { const int ch = ai * 128 + wr * 64 + m * 16 + fr;
            _Pragma("unroll") for (int bj = 0; bj < 2; ++bj) { const int col = bj * 128 + wc * 32 + 8 * fq, t = col >> 4, p0 = col & 15; f32x4 v0 = acc[ai][bj][m][0], v1 = acc[ai][bj][m][1];
                _Pragma("unroll") for (int e = 0; e < 4; ++e) { v0[e] = gelu_tanh_f(v0[e]); v1[e] = gelu_tanh_f(v1[e]); }
                *(v4u*)(YG + ((size_t)u.pm * T + ch * LC + t) * SBW + u.pn * GP + p0) = pack8(v0, v1); } }
    }
};
struct EpiGlu { static constexpr bool MIDK = false;
    const bf16* YG; const float* bglu; bf16* MIXU; float* ssq;
    __device__ __forceinline__ void operator()(const f32x4 (&acc)[2][2][4][2], const pg8::Unit& u, int wr, int wc, int fr_, int fq_) const { int fr = fr_, fq = fq_; asm volatile("" : "+v"(fr), "+v"(fq));
        _Pragma("unroll") for (int ai = 0; ai < 2; ++ai) _Pragma("unroll") for (int m = 0; m < 4; ++m) { const int row = u.pm * 256 + ai * 128 + wr * 64 + m * 16 + fr; float sq = 0.f;
            _Pragma("unroll") for (int bj = 0; bj < 2; ++bj) { const int col = u.pn * 256 + bj * 128 + wc * 32 + 8 * fq; f32x4 v0 = acc[ai][bj][m][0], v1 = acc[ai][bj][m][1];
                const v4u yw = *(const v4u*)(YG + (size_t)row * SBW + col); const f32x4 b0 = *(const f32x4*)(bglu + col), b1 = *(const f32x4*)(bglu + col + 4);
                const float y[8] = {bflo(yw.x), bfhi(yw.x), bflo(yw.y), bfhi(yw.y), bflo(yw.z), bfhi(yw.z), bflo(yw.w), bfhi(yw.w)};
                _Pragma("unroll") for (int e = 0; e < 4; ++e) { v0[e] = y[e] * __builtin_amdgcn_rcpf(1.f + __builtin_amdgcn_exp2f(-(v0[e] + b0[e]) * LOG2E));
                                                                 v1[e] = y[4 + e] * __builtin_amdgcn_rcpf(1.f + __builtin_amdgcn_exp2f(-(v1[e] + b1[e]) * LOG2E)); }
                *(v4u*)(MIXU + (size_t)row * D + SBW + col) = pack8(v0, v1);
                sq += (v0[0] * v0[0] + v0[1] * v0[1]) + (v0[2] * v0[2] + v0[3] * v0[3]) + (v1[0] * v1[0] + v1[1] * v1[1]) + (v1[2] * v1[2] + v1[3] * v1[3]); }
            sq += swap16(sq); sq += swap_half(sq);
            if (fq == 0) atomicAdd(ssq + row, sq); }
    }
};
struct EpiResid { static constexpr bool MIDK = false;
    const float* base0; const float* base1; float* xo; bf16* xb; float* ssq;
    __device__ __forceinline__ void operator()(const f32x4 (&acc)[2][2][4][2], const pg8::Unit& u, int wr, int wc, int fr_, int fq_) const { int fr = fr_, fq = fq_; asm volatile("" : "+v"(fr), "+v"(fq));
        _Pragma("unroll") for (int ai = 0; ai < 2; ++ai) _Pragma("unroll") for (int m = 0; m < 4; ++m) { const int row = u.pm * 256 + ai * 128 + wr * 64 + m * 16 + fr; float sq = 0.f;
            const bool ok = row < MALL; const float* bp = (row < MPR) ? base0 + (size_t)row * D : base1 + (size_t)(row - MPR) * D;
            _Pragma("unroll") for (int bj = 0; bj < 2; ++bj) { const int col = u.pn * 256 + bj * 128 + wc * 32 + 8 * fq; f32x4 v0 = acc[ai][bj][m][0], v1 = acc[ai][bj][m][1];
                if (ok) { v0 = v0 + *(const f32x4*)(bp + col); v1 = v1 + *(const f32x4*)(bp + col + 4);
                    if (xo) { float* o = xo + (size_t)row * D + col; *(f32x4*)o = v0; *(f32x4*)(o + 4) = v1; }
                    if (xb) *(v4u*)(xb + (size_t)row * D + col) = pack8(v0, v1);
                    sq += (v0[0] * v0[0] + v0[1] * v0[1]) + (v0[2] * v0[2] + v0[3] * v0[3]) + (v1[0] * v1[0] + v1[1] * v1[1]) + (v1[2] * v1[2] + v1[3] * v1[3]); } }
            sq += swap16(sq); sq += swap_half(sq);
            if (ok && fq == 0) atomicAdd(ssq + row, sq); }
    }
};
struct EpiScaleBf16 { static constexpr bool MIDK = false;
    const float* ssq; float scale; bf16* O;
    __device__ __forceinline__ void operator()(const f32x4 (&acc)[2][2][4][2], const pg8::Unit& u, int wr, int wc, int fr_, int fq_) const { int fr = fr_, fq = fq_; asm volatile("" : "+v"(fr), "+v"(fq));
        EPI_LOOP_BEGIN
            if (row < MALL) { const float rs = scale / sqrtf(ssq[row] * (1.f / D) + EPS); v0 = v0 * rs; v1 = v1 * rs; *(v4u*)(O + (size_t)row * D + col) = pack8(v0, v1); }
        EPI_LOOP_END
    }
};
struct EpiGateUp { static constexpr bool MIDK = false;
    const float* ssq; bf16 *GBp, *UBp; float* out;
    __device__ __forceinline__ void operator()(const f32x4 (&acc)[2][2][4][2], const pg8::Unit& u, int wr, int wc, int fr_, int fq_) const { int fr = fr_, fq = fq_; asm volatile("" : "+v"(fr), "+v"(fq));
        const bool up = u.pn >= 11;
        EPI_LOOP_BEGIN
            if (row < MALL) { const float rs = 1.f / sqrtf(ssq[row] * (1.f / D) + EPS); v0 = v0 * rs; v1 = v1 * rs;
                if (up) *(v4u*)(UBp + (size_t)row * FF + (col - FF)) = pack8(v0, v1);
                else { *(v4u*)(GBp + (size_t)row * FF + col) = pack8(v0, v1);
                    if (row >= MPR) { float* o = out + O_CVS + ((size_t)(row - MPR) * 2 + 1) * FF + col; *(f32x4*)o = v0; *(f32x4*)(o + 4) = v1; }
                    else { const int t = row & 4095; if (t >= T - 2) { float* o = out + O_CVP + ((size_t)(row >> 12) * 2 + (t - (T - 2))) * FF + col; *(f32x4*)o = v0; *(f32x4*)(o + 4) = v1; } } } }
        EPI_LOOP_END
    }
};
struct SsmOrder {
    int G, c; size_t bstride;
    __device__ bool next(int i, pg8::Unit& u) const { const int L = i * G + c; if (L >= NG * NB) return false; u.pn = L >> 2; u.pm = L & 3; return true; }
    __device__ __forceinline__ size_t aoff(const pg8::Unit& u) const { return ((size_t)u.pm * NCH * NG * XHP + (size_t)u.pn * XHP) * 2; }
    __device__ __forceinline__ size_t boff(const pg8::Unit& u) const { return (size_t)u.pn * bstride; }
};
template <class Epi>
__device__ __forceinline__ void skinny_gemm(Frame& F, const bf16* A, int lda, const bf16* Bt, int ldb, int N, int K, const Epi& E, int u0, int ustride, int ustep = 32, int nb1off = 16) {
    const int lane = F.lane, wid = F.wave; const int kw = K >> 3, nks = kw >> 5;
    LAS float* red = (LAS float*)(F.lds + RING_OFF);
    for (int u = u0; u < 2 * (N / ustep); u += ustride) {
        const int uc = u >> 1, rh = u & 1;
        f32x4 acc[2][4];
#pragma unroll
        for (int nb = 0; nb < 2; ++nb)
#pragma unroll
            for (int mb = 0; mb < 4; ++mb) acc[nb][mb] = (f32x4){0.f, 0.f, 0.f, 0.f};
        const bf16* wp = Bt + (size_t)(uc * ustep + (lane & 15)) * ldb + wid * kw + 8 * (lane >> 4);
        const bf16* ap = A + (size_t)(rh * 64 + (lane & 15)) * lda + wid * kw + 8 * (lane >> 4);
#pragma unroll 1
        for (int ks0 = 0; ks0 < nks; ks0 += 4) {
            bf16x8 wf[4][2], af[4][4];
#pragma unroll
            for (int j = 0; j < 4; ++j) { const int ks = (ks0 + j < nks) ? ks0 + j : nks - 1;
                wf[j][0] = *(const bf16x8*)(wp + ks * 32); wf[j][1] = *(const bf16x8*)(wp + (size_t)nb1off * ldb + ks * 32);
#pragma unroll
                for (int mb = 0; mb < 4; ++mb) af[j][mb] = *(const bf16x8*)(ap + (size_t)mb * 16 * lda + ks * 32); }
#pragma unroll
            for (int j = 0; j < 4; ++j) if (ks0 + j < nks) {
#pragma unroll
                for (int nb = 0; nb < 2; ++nb)
#pragma unroll
                    for (int mb = 0; mb < 4; ++mb) acc[nb][mb] = __builtin_amdgcn_mfma_f32_16x16x32_bf16(wf[j][nb], af[j][mb], acc[nb][mb], 0, 0, 0); }
        }
        __syncthreads();
#pragma unroll
        for (int nb = 0; nb < 2; ++nb)
#pragma unroll
            for (int mb = 0; mb < 4; ++mb) *(LAS f32x4*)(red + ((wid * 8 + nb * 4 + mb) * 64 + lane) * 4) = acc[nb][mb];
        __syncthreads();
        if constexpr (!Epi::PAIR) { const int blk = F.tid >> 6, l = F.tid & 63;
            f32x4 s = {0.f, 0.f, 0.f, 0.f}, s2 = {0.f, 0.f, 0.f, 0.f};
#pragma unroll
            for (int w = 0; w < 4; ++w) s = s + *(const LAS f32x4*)(red + ((w * 8 + blk) * 64 + l) * 4);
#pragma unroll
            for (int w = 4; w < 8; ++w) s2 = s2 + *(const LAS f32x4*)(red + ((w * 8 + blk) * 64 + l) * 4);
            const int em = rh * 64 + 16 * (blk & 3) + (l & 15), en = uc * 32 + 16 * (blk >> 2) + 4 * (l >> 4);
            if constexpr (Epi::STATS) {
                float sq; if constexpr (Epi::SPLIT2) sq = E(em, en, s, s2); else sq = E(em, en, s + s2);
                sq += swap16(sq); sq += swap_half(sq);
                LAS float* r2 = red + 8 * 8 * 64 * 4;
                if ((l >> 4) == 0) r2[blk * 16 + (l & 15)] = sq;
                __syncthreads();
                if (F.tid < 64) atomicAdd(E.ssq + MPR + rh * 64 + F.tid, r2[(F.tid >> 4) * 16 + (F.tid & 15)] + r2[(4 + (F.tid >> 4)) * 16 + (F.tid & 15)]);
            } else {
                if constexpr (Epi::SPLIT2) E(em, en, s, s2);
                else E(em, en, s + s2); } }
        else if (F.tid < 256) { const int mb = F.tid >> 6, l = F.tid & 63;
            f32x4 s0 = {0.f, 0.f, 0.f, 0.f}, s1 = {0.f, 0.f, 0.f, 0.f};
#pragma unroll
            for (int w = 0; w < 8; ++w) { s0 = s0 + *(const LAS f32x4*)(red + ((w * 8 + mb) * 64 + l) * 4); s1 = s1 + *(const LAS f32x4*)(red + ((w * 8 + 4 + mb) * 64 + l) * 4); }
            E(rh * 64 + 16 * mb + (l & 15), uc * 16 + 4 * (l >> 4), s0, s1); }
    }
    __syncthreads();
}
__device__ __forceinline__ v2u pack4(f32x4 a) { v2u w; w.x = cvtpk(a[0], a[1]); w.y = cvtpk(a[2], a[3]); return w; }
struct SkInProj { static constexpr bool STATS = false; static constexpr bool SPLIT2 = false; static constexpr bool PAIR = false;
    const float* rstd; bf16* QBp; float *QSp, *USp, *out;
    __device__ __forceinline__ void operator()(int m, int n, f32x4 v) const {
        v = v * rstd[MPR + m]; const int sect = n >> 9, c = n & 511;
        if (sect == 0) { v = v * C2; *(f32x4*)(QSp + (size_t)m * SBW + c) = v; }
        else if (sect == 1) *(f32x4*)(out + O_KS + (size_t)m * SBW + c) = v;
        else if (sect == 2) *(f32x4*)(out + O_VS + (size_t)m * SBW + c) = v;
        else *(f32x4*)(USp + (size_t)m * SBW + c) = v;
    }
};
struct SkGlu { static constexpr bool STATS = true; static constexpr bool SPLIT2 = false; static constexpr bool PAIR = false;
    const bf16* YG; const float* bglu; bf16* MIXU; float* ssq;
    __device__ __forceinline__ float operator()(int m, int n, f32x4 v) const {
        const v2u yw = *(const v2u*)(YG + (size_t)(MPR + m) * SBW + n); const f32x4 b = *(const f32x4*)(bglu + n);
        const float y[4] = {bflo(yw.x), bfhi(yw.x), bflo(yw.y), bfhi(yw.y)};
#pragma unroll
        for (int e = 0; e < 4; ++e) v[e] = y[e] * __builtin_amdgcn_rcpf(1.f + __builtin_amdgcn_exp2f(-(v[e] + b[e]) * LOG2E));
        *(v2u*)(MIXU + (size_t)(MPR + m) * D + SBW + n) = pack4(v);
        return (v[0] * v[0] + v[1] * v[1]) + (v[2] * v[2] + v[3] * v[3]);
    }
};
struct SkResid { static constexpr bool STATS = true; static constexpr bool SPLIT2 = false; static constexpr bool PAIR = false;
    const float* base; float* xo; bf16* xb; float* ssq;
    __device__ __forceinline__ float operator()(int m, int n, f32x4 v) const {
        v = v + *(const f32x4*)(base + (size_t)m * D + n); const size_t o = (size_t)(MPR + m) * D + n;
        if (xo) *(f32x4*)(xo + o) = v; if (xb) *(v2u*)(xb + o) = pack4(v);
        return (v[0] * v[0] + v[1] * v[1]) + (v[2] * v[2] + v[3] * v[3]);
    }
};
struct SkScale { static constexpr bool STATS = false; static constexpr bool SPLIT2 = false; static constexpr bool PAIR = false;
    const float* ssq; float scale; bf16* O;
    __device__ __forceinline__ void operator()(int m, int n, f32x4 v) const {
        const float rs = scale / sqrtf(ssq[MPR + m] * (1.f / D) + EPS); v = v * rs; *(v2u*)(O + (size_t)(MPR + m) * D + n) = pack4(v);
    }
};
struct SkGateUp { static constexpr bool STATS = false; static constexpr bool SPLIT2 = false; static constexpr bool PAIR = false;
    const float* ssq; bf16 *GBp, *UBp; float* out;
    __device__ __forceinline__ void operator()(int m, int n, f32x4 v) const {
        const float rs = 1.f / sqrtf(ssq[MPR + m] * (1.f / D) + EPS); v = v * rs;
        if (n >= FF) *(v2u*)(UBp + (size_t)(MPR + m) * FF + (n - FF)) = pack4(v);
        else { *(v2u*)(GBp + (size_t)(MPR + m) * FF + n) = pack4(v); *(f32x4*)(out + O_CVS + ((size_t)m * 2 + 1) * FF + n) = v; }
    }
};

constexpr int HALO_OFF = RING_BYTES + 1024;
__device__ __forceinline__ float dpp_ror1(float x) { return __builtin_bit_cast(float, __builtin_amdgcn_update_dpp(0, __builtin_bit_cast(int, x), 0x121, 0xf, 0xf, true)); }
__device__ __forceinline__ float dpp_ror2(float x) { return __builtin_bit_cast(float, __builtin_amdgcn_update_dpp(0, __builtin_bit_cast(int, x), 0x122, 0xf, 0xf, true)); }
struct EpiGateUpConv { static constexpr bool MIDK = false;
    const float* ssq; bf16* ACT; float* out; const float* cw; const float* cb; LAS float* halo;
    __device__ __forceinline__ void operator()(const f32x4 (&acc)[2][2][4][2], const pg8::Unit& u, int wr, int wc, int fr_, int fq_) const {
        int fr = fr_, fq = fq_; asm volatile("" : "+v"(fr), "+v"(fq));
        const int cl = wc * 32 + 8 * fq, col = u.pn * 128 + cl, prow0 = u.pm * 254;
        float rs[2][4];
#pragma unroll
        for (int ai = 0; ai < 2; ++ai)
#pragma unroll
            for (int m = 0; m < 4; ++m) { const int row = prow0 + ai * 128 + wr * 64 + m * 16 + fr; rs[ai][m] = (row < MPR) ? 1.f / sqrtf(ssq[row < MPR ? row : 0] * (1.f / D) + EPS) : 0.f; }
        if (fr >= 14) {
#pragma unroll
            for (int ai = 0; ai < 2; ++ai) { LAS float* hp = halo + (((2 * ai + wr) * 2 + (fr - 14)) * 128 + cl); *(LAS f32x4*)hp = acc[ai][0][3][0] * rs[ai][3]; *(LAS f32x4*)(hp + 4) = acc[ai][0][3][1] * rs[ai][3]; }
        }
        asm volatile("s_waitcnt lgkmcnt(0)\n\ts_barrier" ::: "memory");
        f32x4 w0[2], w1[2], w2[2], bb[2];
#pragma unroll
        for (int n = 0; n < 2; ++n) { w0[n] = *(const f32x4*)(cw + col + 4 * n); w1[n] = *(const f32x4*)(cw + FF + col + 4 * n); w2[n] = *(const f32x4*)(cw + 2 * FF + col + 4 * n); bb[n] = *(const f32x4*)(cb + col + 4 * n); }
#pragma unroll
        for (int ai = 0; ai < 2; ++ai) {
            const int blk = 2 * ai + wr;
            f32x4 r1p[2], r2p[2];
            if (blk == 0) { r1p[0] = r1p[1] = r2p[0] = r2p[1] = (f32x4){0.f, 0.f, 0.f, 0.f}; }
            else { const LAS float* hb = halo + ((blk - 1) * 2) * 128 + cl;
                const f32x4 a0 = *(const LAS f32x4*)hb, a1 = *(const LAS f32x4*)(hb + 4), b0 = *(const LAS f32x4*)(hb + 128), b1 = *(const LAS f32x4*)(hb + 132);
                r1p[0] = b0; r1p[1] = b1; r2p[0] = (fr == 0) ? a0 : b0; r2p[1] = (fr == 0) ? a1 : b1; }
#pragma unroll
            for (int m = 0; m < 4; ++m) {
                const int lr = ai * 128 + wr * 64 + m * 16 + fr, row = prow0 + lr, t = row & (T - 1); const float rsv = rs[ai][m];
                f32x4 g[2], up[2], R1[2], R2[2];
#pragma unroll
                for (int n = 0; n < 2; ++n) { g[n] = acc[ai][0][m][n] * rsv; up[n] = acc[ai][1][m][n] * rsv;
#pragma unroll
                    for (int e = 0; e < 4; ++e) { R1[n][e] = dpp_ror1(g[n][e]); R2[n][e] = dpp_ror2(g[n][e]); } }
                const bool valid = (row < MPR) && (lr >= 2 || u.pm == 0);
                f32x4 av[2];
#pragma unroll
                for (int n = 0; n < 2; ++n) { f32x4 g1 = (fr == 0) ? r1p[n] : R1[n], g2 = (fr < 2) ? r2p[n] : R2[n];
                    if (t < 1) g1 = (f32x4){0.f, 0.f, 0.f, 0.f}; if (t < 2) g2 = (f32x4){0.f, 0.f, 0.f, 0.f};
                    const f32x4 cv = bb[n] + w0[n] * g2 + w1[n] * g1 + w2[n] * g[n];
#pragma unroll
                    for (int e = 0; e < 4; ++e) av[n][e] = gelu_tanh_f(cv[e]) * up[n][e]; }
                if (valid) { *(v4u*)(ACT + (size_t)row * FF + col) = pack8(av[0], av[1]);
                    if (t >= T - 2) { float* o = out + O_CVP + ((size_t)(row >> 12) * 2 + (t - (T - 2))) * FF + col; *(f32x4*)o = g[0]; *(f32x4*)(o + 4) = g[1]; } }
                r1p[0] = R1[0]; r1p[1] = R1[1]; r2p[0] = R2[0]; r2p[1] = R2[1];
            }
        }
    }
};
struct PanelOrder254 {
    pg8::GridOrder Gd;
    __device__ bool next(int i, pg8::Unit& u) const { return Gd.next(i, u); }
    __device__ __forceinline__ size_t aoff(const pg8::Unit& u) const { return (size_t)u.pm * 254 * D * 2; }
    __device__ __forceinline__ size_t boff(const pg8::Unit& u) const { return (size_t)u.pn * 128 * D * 2; }
};
struct SkGateUpConv { static constexpr bool STATS = false; static constexpr bool SPLIT2 = false; static constexpr bool PAIR = true;
    const float* ssq; bf16* ACT; float* out; const float* cw; const float* cb; const float* sc;
    __device__ __forceinline__ void operator()(int m, int n, f32x4 g, f32x4 up) const {
        const float rs = 1.f / sqrtf(ssq[MPR + m] * (1.f / D) + EPS); g = g * rs; up = up * rs;
        const f32x4 s0 = *(const f32x4*)(sc + ((size_t)m * 2 + 0) * FF + n), s1 = *(const f32x4*)(sc + ((size_t)m * 2 + 1) * FF + n);
        *(f32x4*)(out + O_CVS + ((size_t)m * 2 + 0) * FF + n) = s1; *(f32x4*)(out + O_CVS + ((size_t)m * 2 + 1) * FF + n) = g;
        const f32x4 cv = *(const f32x4*)(cb + n) + *(const f32x4*)(cw + n) * s0 + *(const f32x4*)(cw + FF + n) * s1 + *(const f32x4*)(cw + 2 * FF + n) * g;
        f32x4 a;
#pragma unroll
        for (int e = 0; e < 4; ++e) a[e] = gelu_tanh_f(cv[e]) * up[e];
        *(v2u*)(ACT + (size_t)(MPR + m) * FF + n) = pack4(a);
    }
};

struct EpiResidB { static constexpr bool MIDK = false;
    const bf16* base; float* xo; bf16* xb; float* ssq; LAS float* rowpart;
    __device__ __forceinline__ void operator()(const f32x4 (&acc)[2][2][4][2], const pg8::Unit& u, int wr, int wc, int fr_, int fq_) const { int fr = fr_, fq = fq_; asm volatile("" : "+v"(fr), "+v"(fq));
        _Pragma("unroll") for (int ai = 0; ai < 2; ++ai) _Pragma("unroll") for (int m = 0; m < 4; ++m) { const int row = u.pm * 256 + ai * 128 + wr * 64 + m * 16 + fr; float sq = 0.f;
            _Pragma("unroll") for (int bj = 0; bj < 2; ++bj) { const int col = u.pn * 256 + bj * 128 + wc * 32 + 8 * fq; f32x4 v0 = acc[ai][bj][m][0], v1 = acc[ai][bj][m][1];
                const v4u bw = *(const v4u*)(base + (size_t)row * D + col);
                v0 = v0 + (f32x4){bflo(bw.x), bfhi(bw.x), bflo(bw.y), bfhi(bw.y)}; v1 = v1 + (f32x4){bflo(bw.z), bfhi(bw.z), bflo(bw.w), bfhi(bw.w)};
                if (xo) { float* o = xo + (size_t)row * D + col; *(f32x4*)o = v0; *(f32x4*)(o + 4) = v1; }
                if (xb) *(v4u*)(xb + (size_t)row * D + col) = pack8(v0, v1);
                sq += (v0[0] * v0[0] + v0[1] * v0[1]) + (v0[2] * v0[2] + v0[3] * v0[3]) + (v1[0] * v1[0] + v1[1] * v1[1]) + (v1[2] * v1[2] + v1[3] * v1[3]); }
            sq += swap16(sq); sq += swap_half(sq);
            if (fq == 0) rowpart[(ai * 128 + wr * 64 + m * 16 + fr) * 4 + wc] = sq; }
        asm volatile("s_waitcnt lgkmcnt(0)\n\ts_barrier" ::: "memory");
        if (threadIdx.x < 256) { const f32x4 pp = *(const LAS f32x4*)(rowpart + threadIdx.x * 4); atomicAdd(ssq + u.pm * 256 + threadIdx.x, (pp[0] + pp[1]) + (pp[2] + pp[3])); }
    }
};
struct EpiResidFinal { static constexpr bool MIDK = false;
    const bf16* base; float* ssq; LAS float* rowpart; unsigned* pcnt; unsigned* bar; const float* gain; float* y;
    __device__ __forceinline__ void operator()(const f32x4 (&acc)[2][2][4][2], const pg8::Unit& u, int wr, int wc, int fr_, int fq_) const { int fr = fr_, fq = fq_; asm volatile("" : "+v"(fr), "+v"(fq));
        _Pragma("unroll") for (int ai = 0; ai < 2; ++ai) _Pragma("unroll") for (int m = 0; m < 4; ++m) { const int row = u.pm * 256 + ai * 128 + wr * 64 + m * 16 + fr; float sq = 0.f;
            _Pragma("unroll") for (int bj = 0; bj < 2; ++bj) { const int col = u.pn * 256 + bj * 128 + wc * 32 + 8 * fq; f32x4 v0 = acc[ai][bj][m][0], v1 = acc[ai][bj][m][1];
                const v4u bw = *(const v4u*)(base + (size_t)row * D + col);
                v0 = v0 + (f32x4){bflo(bw.x), bfhi(bw.x), bflo(bw.y), bfhi(bw.y)}; v1 = v1 + (f32x4){bflo(bw.z), bfhi(bw.z), bflo(bw.w), bfhi(bw.w)};
                sq += (v0[0] * v0[0] + v0[1] * v0[1]) + (v0[2] * v0[2] + v0[3] * v0[3]) + (v1[0] * v1[0] + v1[1] * v1[1]) + (v1[2] * v1[2] + v1[3] * v1[3]); }
            sq += swap16(sq); sq += swap_half(sq);
            if (fq == 0) rowpart[(ai * 128 + wr * 64 + m * 16 + fr) * 4 + wc] = sq; }
        asm volatile("s_waitcnt lgkmcnt(0)\n\ts_barrier" ::: "memory");
        if (threadIdx.x < 256) { const f32x4 pp = *(const LAS f32x4*)(rowpart + threadIdx.x * 4); atomicAdd(ssq + u.pm * 256 + threadIdx.x, (pp[0] + pp[1]) + (pp[2] + pp[3])); }
        asm volatile("s_waitcnt vmcnt(0)" ::: "memory");
        __syncthreads();
        if (threadIdx.x == 0) {
            unsigned* pc = pcnt + u.pm * 16;
            (void)xb_add(pc, 1u);
            XB_SPIN(xb_ld(pc) < 4u, bar);
            __builtin_amdgcn_fence(__ATOMIC_ACQUIRE, "agent");
        }
        __syncthreads();
        if (threadIdx.x < 256) { const unsigned tb = __hip_atomic_load((const unsigned*)ssq + u.pm * 256 + threadIdx.x, __ATOMIC_RELAXED, __HIP_MEMORY_SCOPE_AGENT);
            rowpart[threadIdx.x * 4] = 1.f / sqrtf(__builtin_bit_cast(float, tb) * (1.f / D) + EPS); }
        asm volatile("s_waitcnt lgkmcnt(0)\n\ts_barrier" ::: "memory");
        int fr2 = fr_, fq2 = fq_; asm volatile("" : "+v"(fr2), "+v"(fq2));
        _Pragma("unroll") for (int ai = 0; ai < 2; ++ai) _Pragma("unroll") for (int m = 0; m < 4; ++m) { const int rl = ai * 128 + wr * 64 + m * 16 + fr2; const int row = u.pm * 256 + rl; const float rs = rowpart[rl * 4];
            _Pragma("unroll") for (int bj = 0; bj < 2; ++bj) { const int col = u.pn * 256 + bj * 128 + wc * 32 + 8 * fq2; f32x4 v0 = acc[ai][bj][m][0], v1 = acc[ai][bj][m][1];
                const v4u bw = *(const v4u*)(base + (size_t)row * D + col); const f32x4 g0 = *(const f32x4*)(gain + col), g1 = *(const f32x4*)(gain + col + 4);
                v0 = (v0 + (f32x4){bflo(bw.x), bfhi(bw.x), bflo(bw.y), bfhi(bw.y)}) * rs * g0; v1 = (v1 + (f32x4){bflo(bw.z), bfhi(bw.z), bflo(bw.w), bfhi(bw.w)}) * rs * g1;
                float* o = y + (size_t)row * D + col; *(f32x4*)o = v0; *(f32x4*)(o + 4) = v1; } }
    }
};
struct SkResidB { static constexpr bool STATS = true; static constexpr bool SPLIT2 = false; static constexpr bool PAIR = false;
    const bf16* base; float* xo; bf16* xb; float* ssq;
    __device__ __forceinline__ float operator()(int m, int n, f32x4 v) const {
        const size_t o = (size_t)(MPR + m) * D + n; const v2u bw = *(const v2u*)(base + o);
        v = v + (f32x4){bflo(bw.x), bfhi(bw.x), bflo(bw.y), bfhi(bw.y)};
        if (xo) *(f32x4*)(xo + o) = v; if (xb) *(v2u*)(xb + o) = pack4(v);
        return (v[0] * v[0] + v[1] * v[1]) + (v[2] * v[2] + v[3] * v[3]);
    }
};

struct SsmOne {
    int b, g; size_t bstride; int cnt;
    __device__ bool next(int i, pg8::Unit& u) const { if (i >= cnt) return false; u.pm = b; u.pn = g; return true; }
    __device__ __forceinline__ size_t aoff(const pg8::Unit& u) const { return ((size_t)u.pm * NCH * NG * XHP + (size_t)u.pn * XHP) * 2; }
    __device__ __forceinline__ size_t boff(const pg8::Unit& u) const { return (size_t)u.pn * bstride; }
};

struct EpiResidMix { static constexpr bool MIDK = true;
    const bf16* base; bf16* xb; float* ssq; const float* ssqA; const float* ssqB; LAS float* rowpart;
    __device__ __forceinline__ void mid(f32x4 (&acc)[2][2][4][2], const pg8::Unit& u, int wr, int wc, int fr_, int fq_) const { int fr = fr_; asm volatile("" : "+v"(fr));
        _Pragma("unroll") for (int ai = 0; ai < 2; ++ai) _Pragma("unroll") for (int m = 0; m < 4; ++m) { const int row = u.pm * 256 + ai * 128 + wr * 64 + m * 16 + fr;
            const float ratio = sqrtf((ssqB[row] * (1.f / SBW) + EPS) / (ssqA[row] * (1.f / SBW) + EPS));
            _Pragma("unroll") for (int bj = 0; bj < 2; ++bj) _Pragma("unroll") for (int n = 0; n < 2; ++n) acc[ai][bj][m][n] = acc[ai][bj][m][n] * ratio; }
    }
    __device__ __forceinline__ void operator()(const f32x4 (&acc)[2][2][4][2], const pg8::Unit& u, int wr, int wc, int fr_, int fq_) const { int fr = fr_, fq = fq_; asm volatile("" : "+v"(fr), "+v"(fq));
        _Pragma("unroll") for (int ai = 0; ai < 2; ++ai) _Pragma("unroll") for (int m = 0; m < 4; ++m) { const int row = u.pm * 256 + ai * 128 + wr * 64 + m * 16 + fr; float sq = 0.f;
            const float rsB = 1.f / sqrtf(ssqB[row] * (1.f / SBW) + EPS);
            _Pragma("unroll") for (int bj = 0; bj < 2; ++bj) { const int col = u.pn * 256 + bj * 128 + wc * 32 + 8 * fq; f32x4 v0 = acc[ai][bj][m][0] * rsB, v1 = acc[ai][bj][m][1] * rsB;
                const v4u bw = *(const v4u*)(base + (size_t)row * D + col);
                v0 = v0 + (f32x4){bflo(bw.x), bfhi(bw.x), bflo(bw.y), bfhi(bw.y)}; v1 = v1 + (f32x4){bflo(bw.z), bfhi(bw.z), bflo(bw.w), bfhi(bw.w)};
                *(v4u*)(xb + (size_t)row * D + col) = pack8(v0, v1);
                sq += (v0[0] * v0[0] + v0[1] * v0[1]) + (v0[2] * v0[2] + v0[3] * v0[3]) + (v1[0] * v1[0] + v1[1] * v1[1]) + (v1[2] * v1[2] + v1[3] * v1[3]); }
            sq += swap16(sq); sq += swap_half(sq);
            if (fq == 0) rowpart[(ai * 128 + wr * 64 + m * 16 + fr) * 4 + wc] = sq; }
        asm volatile("s_waitcnt lgkmcnt(0)\n\ts_barrier" ::: "memory");
        if (threadIdx.x < 256) { const f32x4 pp = *(const LAS f32x4*)(rowpart + threadIdx.x * 4); atomicAdd(ssq + u.pm * 256 + threadIdx.x, (pp[0] + pp[1]) + (pp[2] + pp[3])); }
    }
};
struct SkResidMix { static constexpr bool STATS = true; static constexpr bool SPLIT2 = true; static constexpr bool PAIR = false;
    const bf16* base; bf16* xb; float* ssq; const float* ssqA; const float* ssqB;
    __device__ __forceinline__ float operator()(int m, int n, f32x4 sA, f32x4 sB) const {
        const float rsA = 1.f / sqrtf(ssqA[MPR + m] * (1.f / SBW) + EPS), rsB = 1.f / sqrtf(ssqB[MPR + m] * (1.f / SBW) + EPS);
        const size_t o = (size_t)(MPR + m) * D + n; const v2u bw = *(const v2u*)(base + o);
        const f32x4 v = sA * rsA + sB * rsB + (f32x4){bflo(bw.x), bfhi(bw.x), bflo(bw.y), bfhi(bw.y)};
        *(v2u*)(xb + o) = pack4(v);
        return (v[0] * v[0] + v[1] * v[1]) + (v[2] * v[2] + v[3] * v[3]);
    }
};
__device__ __forceinline__ int crow(int r, int hi) { return (r & 3) + 8 * (r >> 2) + 4 * hi; }
__device__ __forceinline__ void glds16(const void* gsrc, unsigned lds_dst) { unsigned keep;
    asm volatile("s_mov_b32 %0, m0\n\ts_mov_b32 m0, %2\n\ts_nop 0\n\tglobal_load_lds_dwordx4 %1, off\n\ts_mov_b32 m0, %0" : "=&s"(keep) : "v"(gsrc), "s"(lds_dst) : "memory"); }
#define WAIT_BAR(N) asm volatile("s_waitcnt vmcnt(" #N ") lgkmcnt(0)\n\ts_barrier" ::: "memory")
typedef LAS const char* lds_cptr;
typedef short v4i16_t __attribute__((ext_vector_type(4)));
__device__ __forceinline__ s16x4 vtr(lds_cptr p) { return __builtin_bit_cast(s16x4, __builtin_amdgcn_ds_read_tr16_b64_v4i16((LAS v4i16_t*)p)); }
__device__ __forceinline__ bf16x8 ldsq(lds_cptr p) { return *(const LAS bf16x8*)p; }
#define MFMA32(a, b, c) __builtin_amdgcn_mfma_f32_32x32x16_bf16((a), (b), (c), 0, 0, 0)
typedef float f32x2_t __attribute__((ext_vector_type(2))); typedef __bf16 bf16x2_t __attribute__((ext_vector_type(2)));
__device__ __forceinline__ unsigned cvtpk_s(float lo, float hi) { f32x2_t v = {lo, hi}; bf16x2_t b = __builtin_convertvector(v, bf16x2_t); return __builtin_bit_cast(unsigned, b); }
__device__ __forceinline__ bf16x8 pack_bf8(const f32x16& p, int base) {
    v4u w; w.x = cvtpk_s(p[base], p[base + 1]); w.y = cvtpk_s(p[base + 2], p[base + 3]); w.z = cvtpk_s(p[base + 4], p[base + 5]); w.w = cvtpk_s(p[base + 6], p[base + 7]); return __builtin_bit_cast(bf16x8, w);
}
template <int CTRL> __device__ __forceinline__ float dppf(float x) { return __builtin_bit_cast(float, __builtin_amdgcn_update_dpp(0, __builtin_bit_cast(int, x), CTRL, 0xf, 0xf, true)); }

constexpr int SBA_K = 0, SBA_V = 24576, SBA_OST = 49152;
__device__ __forceinline__ void sb_attn_unit(Frame& F, int b, int h, int qb, float b2) {
    int lane = F.lane; asm volatile("" : "+v"(lane));
    const int r32 = lane & 31, hi = lane >> 5, wid = F.wave;
    const bf16* QBp = WSP(bf16, WS_QB); const bf16* KBp = WSP(bf16, WS_KB); const bf16* VBp = WSP(bf16, WS_VB); bf16* MIXU = WSP(bf16, WS_MIX); float* SSQA = (float*)(F.ctl + CW_SSQA);
    const long rowbase = (long)b * T; const int q0 = qb * 256;
    const bf16* Qw = QBp + (rowbase + q0 + wid * 32) * SBW + h * HD;
    const bf16* Kh = KBp + rowbase * SBW + h * HD; const bf16* Vh = VBp + rowbase * SBW + h * HD;
    const unsigned lds0 = (unsigned)(uintptr_t)(F.lds + RING_OFF);
    const bf16* ksrc = Kh + (long)lane * SBW + wid * 8;
    const bf16* vsrc = Vh + (long)(16 * (wid & 3) + (lane >> 2)) * SBW + (wid >> 2) * 32 + (lane & 3) * 8;
    const unsigned kdst = lds0 + SBA_K + wid * 1024, vdst = lds0 + SBA_V + wid * 1024;
    const lds_cptr base3 = (lds_cptr)(F.lds + RING_OFF);
    const lds_cptr kp0 = base3 + SBA_K + hi * 1024 + r32 * 16;
    const lds_cptr vp0 = base3 + SBA_V + ((lane >> 4) & 1) * 32 + (lane & 3) * 8 + (4 * hi + ((lane & 15) >> 2)) * 64;
    const int NT = (q0 + 256) / 64;
#define DMA_KV(t, slot) do { glds16(ksrc + (long)(t) * 64 * SBW, (unsigned)__builtin_amdgcn_readfirstlane(kdst + (slot) * 8192)); glds16(vsrc + (long)(t) * 64 * SBW, (unsigned)__builtin_amdgcn_readfirstlane(vdst + (slot) * 8192)); } while (0)
    DMA_KV(NT - 1, 0); DMA_KV(NT - 2, 1);
    bf16x8 qr[4];
#pragma unroll
    for (int d0 = 0; d0 < 4; ++d0) qr[d0] = *reinterpret_cast<const bf16x8*>(&Qw[(long)r32 * SBW + d0 * 16 + hi * 8]);
    asm volatile("" : "+v"(qr[0]), "+v"(qr[1]), "+v"(qr[2]), "+v"(qr[3]));
    bf16x8 A0, A1, AN;
#pragma unroll
    for (int j = 0; j < 8; ++j) { const int kv = crow(j, hi); A0[j] = (short)((kv >= r32) ? 0xBF80 : 0); A1[j] = (short)((kv + 16 >= r32) ? 0xBF80 : 0); AN[j] = (short)0xBF80; }
    f32x16 o0 = {}, o1 = {}, racc, bt;
#pragma unroll
    for (int r = 0; r < 16; ++r) { bt[r] = b2; racc[r] = b2; }
    const int qrel = wid * 32 + r32;
    for (int it = 0; it < NT; ++it) {
        const int t = NT - 1 - it, cur = it % 3;
        if (it + 1 < NT) { WAIT_BAR(2); } else { WAIT_BAR(0); }
        if (it + 2 < NT) DMA_KV(t - 2, (it + 2) % 3);
        const int jb = t - (NT - 4);
        if (jb <= (wid >> 1)) {
            int so = cur * 8192; asm volatile("" : "+s"(so));
            const lds_cptr kp = kp0 + so; const lds_cptr vp = vp0 + so;
            f32x16 p0 = bt, p1 = bt, d0 = racc, d1 = racc;
#pragma unroll
            for (int dd = 0; dd < 4; ++dd) { const bf16x8 k0 = ldsq(kp + dd * 2048), k1 = ldsq(kp + dd * 2048 + 512);
                p0 = MFMA32(k0, qr[dd], p0); p1 = MFMA32(k1, qr[dd], p1); d0 = MFMA32(k0, qr[dd], d0); d1 = MFMA32(k1, qr[dd], d1); }
            const bool diag = (jb == (wid >> 1));
            if (diag) {
                const float NEG = -INFINITY; const int kb = 64 * jb + 4 * hi;
#pragma unroll
                for (int r = 0; r < 16; ++r) { const int kv = kb + (r & 3) + 8 * (r >> 2); if (kv >= qrel) p0[r] = NEG; if (kv + 32 >= qrel) p1[r] = NEG; }
            }
            f32x16 s0, s1;
#pragma unroll
            for (int r = 0; r < 16; ++r) { s0[r] = __builtin_amdgcn_logf(1.f + __builtin_amdgcn_exp2f(p0[r])); s1[r] = __builtin_amdgcn_logf(1.f + __builtin_amdgcn_exp2f(p1[r])); }
            const bf16x8 sb0 = pack_bf8(s0, 0), sb1 = pack_bf8(s0, 8), sb2 = pack_bf8(s1, 0), sb3 = pack_bf8(s1, 8);
            d1 = MFMA32(A0, sb2, d1); d1 = MFMA32(A1, sb3, d1);
            d0 = MFMA32(A0, sb0, d0); d0 = MFMA32(A1, sb1, d0); d0 = MFMA32(AN, sb2, d0); d0 = MFMA32(AN, sb3, d0);
            racc = MFMA32(AN, sb0, racc); racc = MFMA32(AN, sb1, racc); racc = MFMA32(AN, sb2, racc); racc = MFMA32(AN, sb3, racc);
            if (diag) { const float NEG = -INFINITY; const int kb = 64 * jb + 4 * hi;
#pragma unroll
                for (int r = 0; r < 16; ++r) { const int kv = kb + (r & 3) + 8 * (r >> 2); if (kv >= qrel) d0[r] = NEG; if (kv + 32 >= qrel) d1[r] = NEG; } }
#pragma unroll
            for (int r = 0; r < 16; ++r) { p0[r] = __builtin_amdgcn_exp2f(d0[r]); p1[r] = __builtin_amdgcn_exp2f(d1[r]); }
            const bf16x8 pa0 = pack_bf8(p0, 0), pa1 = pack_bf8(p0, 8), pa2 = pack_bf8(p1, 0), pa3 = pack_bf8(p1, 8);
#pragma unroll
            for (int dh = 0; dh < 2; ++dh) {
                f32x16& o = dh ? o1 : o0;
#pragma unroll
                for (int rg = 0; rg < 4; ++rg) { const s16x4 lo = vtr(vp + dh * 4096 + rg * 1024), hh = vtr(vp + dh * 4096 + rg * 1024 + 512);
                    const bf16x8 vf = (bf16x8){lo[0], lo[1], lo[2], lo[3], hh[0], hh[1], hh[2], hh[3]};
                    o = MFMA32(rg == 0 ? pa0 : rg == 1 ? pa1 : rg == 2 ? pa2 : pa3, vf, o); }
            }
        }
    }
#undef DMA_KV
    { int l2 = lane; asm volatile("" : "+v"(l2)); const int e32 = l2 & 31, ehi = l2 >> 5;
      LAS bf16* stg = (LAS bf16*)(F.lds + RING_OFF + SBA_OST) + wid * 2048; LAS bf16* sb = stg + (4 * ehi) * 64 + e32;
#pragma unroll
      for (int r = 0; r < 16; ++r) { sb[((r & 3) + 8 * (r >> 2)) * 64] = (bf16)f2bf(o0[r]); sb[((r & 3) + 8 * (r >> 2)) * 64 + 32] = (bf16)f2bf(o1[r]); }
      LDS_WAIT();
      const long orow = rowbase + q0 + wid * 32 + (l2 >> 3);
      bf16* Ow = MIXU + orow * D + h * HD + (l2 & 7) * 8; const LAS bf16* sr = stg + (l2 >> 3) * 64 + (l2 & 7) * 8;
#pragma unroll
      for (int i = 0; i < 4; ++i) { const v4u v = *(const LAS v4u*)(sr + i * 512); *(v4u*)(Ow + (long)i * 8 * D) = v;
          float sq = (bflo(v.x) * bflo(v.x) + bfhi(v.x) * bfhi(v.x)) + (bflo(v.y) * bflo(v.y) + bfhi(v.y) * bfhi(v.y)) + (bflo(v.z) * bflo(v.z) + bfhi(v.z) * bfhi(v.z)) + (bflo(v.w) * bflo(v.w) + bfhi(v.w) * bfhi(v.w));
          sq += dppf<0xB1>(sq); sq += dppf<0x4E>(sq); sq += dppf<0x141>(sq);
          if ((l2 & 7) == 0) atomicAdd(SSQA + orow + i * 8, sq); } }
    asm volatile("s_waitcnt vmcnt(0) lgkmcnt(0)\n\ts_barrier" ::: "memory");
}

__device__ __forceinline__ float dpp_sum16(float x) {
    x += __builtin_bit_cast(float, __builtin_amdgcn_update_dpp(0, __builtin_bit_cast(int, x), 0xB1, 0xf, 0xf, true));
    x += __builtin_bit_cast(float, __builtin_amdgcn_update_dpp(0, __builtin_bit_cast(int, x), 0x4E, 0xf, 0xf, true));
    x += __builtin_bit_cast(float, __builtin_amdgcn_update_dpp(0, __builtin_bit_cast(int, x), 0x141, 0xf, 0xf, true));
    x += __builtin_bit_cast(float, __builtin_amdgcn_update_dpp(0, __builtin_bit_cast(int, x), 0x140, 0xf, 0xf, true));
    return x;
}
__device__ __forceinline__ float wave_sum_fast(float x) { x = dpp_sum16(x); x += swap16(x); x += swap_half(x); return x; }
__device__ __forceinline__ float swz_xor4(float x) { return __builtin_bit_cast(float, __builtin_amdgcn_ds_swizzle(__builtin_bit_cast(int, x), 0x101F)); }
__device__ __forceinline__ void sb_sample_unit(Frame& F, int b, int pg) {
    int lane = F.lane; asm volatile("" : "+v"(lane));
    const int h = F.wave, ts = lane >> 4, d4 = lane & 15;
    const float* QS = WSP(float, WS_QS); const float* ck = INF(2); const float* cv = INF(3); const int* pt = (const int*)F.in[4];
    const float bl2 = INF(13)[h] * LOG2E;
    const f32x4 q4 = *(const f32x4*)(QS + (size_t)b * SBW + h * HD + 4 * d4);
    const int page = pt[b * NPG + pg];
    const float* kb = ck + ((size_t)page * PAGE + ts) * (NH * HD) + h * HD + 4 * d4;
    const float* vb = cv + ((size_t)page * PAGE + ts) * (NH * HD) + h * HD + 4 * d4;
    float p[32];
    { f32x4 kk[32];
#pragma unroll
      for (int i = 0; i < 32; ++i) kk[i] = __builtin_nontemporal_load((const f32x4*)(kb + (size_t)i * 4 * NH * HD));
#pragma unroll
      for (int i = 0; i < 32; ++i) p[i] = (q4[0] * kk[i][0] + q4[1] * kk[i][1]) + (q4[2] * kk[i][2] + q4[3] * kk[i][3]); }
    f32x4 vv[32];
#pragma unroll
    for (int i = 0; i < 32; ++i) vv[i] = __builtin_nontemporal_load((const f32x4*)(vb + (size_t)i * 4 * NH * HD));
    const bool c0 = d4 & 1, c1 = d4 & 2, c2 = d4 & 4, c3 = d4 & 8;
    float v1[16], v2[8], v3[4], zz[2];
#pragma unroll
    for (int k = 0; k < 16; ++k) { const float keep = c0 ? p[2 * k + 1] : p[2 * k], send = c0 ? p[2 * k] : p[2 * k + 1]; v1[k] = keep + dppf<0xB1>(send); }
#pragma unroll
    for (int k = 0; k < 8; ++k) { const float keep = c1 ? v1[2 * k + 1] : v1[2 * k], send = c1 ? v1[2 * k] : v1[2 * k + 1]; v2[k] = keep + dppf<0x4E>(send); }
#pragma unroll
    for (int k = 0; k < 4; ++k) { const float keep = c2 ? v2[2 * k + 1] : v2[2 * k], send = c2 ? v2[2 * k] : v2[2 * k + 1]; v3[k] = keep + swz_xor4(send); }
#pragma unroll
    for (int k = 0; k < 2; ++k) { const float keep = c3 ? v3[2 * k + 1] : v3[2 * k], send = c3 ? v3[2 * k] : v3[2 * k + 1]; zz[k] = keep + dppf<0x128>(send) + bl2; }
    float sp[2], aft[2], G[2], sfx[2];
#pragma unroll
    for (int k = 0; k < 2; ++k) {
        sp[k] = __builtin_amdgcn_logf(1.f + __builtin_amdgcn_exp2f(zz[k]));
        const float nb = swap16(sp[k]), w1 = sp[k] + nb, po = swap_half(w1);
        aft[k] = ((ts & 1) ? 0.f : nb) + ((ts & 2) ? 0.f : po); G[k] = w1 + po;
        float s2 = G[k]; s2 += dppf<0x101>(s2); s2 += dppf<0x102>(s2); s2 += dppf<0x104>(s2); s2 += dppf<0x108>(s2); sfx[k] = s2;
    }
    const float tot1 = __builtin_bit_cast(float, __builtin_amdgcn_readlane(__builtin_bit_cast(int, sfx[1]), 0)), tot0 = __builtin_bit_cast(float, __builtin_amdgcn_readlane(__builtin_bit_cast(int, sfx[0]), 0));
    const float a1 = __builtin_amdgcn_exp2f(zz[1] - sp[1] - (aft[1] + (sfx[1] - G[1])));
    const float a0 = __builtin_amdgcn_exp2f(zz[0] - sp[0] - (aft[0] + (sfx[0] - G[0]) + tot1));
    LAS float* aw = (LAS float*)(F.lds + RING_OFF) + h * 128 + ts * 32;
    aw[d4] = a0; aw[d4 + 16] = a1;
    LDS_WAIT(); asm volatile("" ::: "memory");
    f32x4 acc = {0.f, 0.f, 0.f, 0.f};
#pragma unroll
    for (int i4 = 0; i4 < 8; ++i4) { const f32x4 a4 = *(const LAS f32x4*)(aw + 4 * i4);
#pragma unroll
        for (int e2 = 0; e2 < 4; ++e2) acc = acc + vv[4 * i4 + e2] * a4[e2]; }
    LDS_WAIT(); asm volatile("" ::: "memory");
#pragma unroll
    for (int e2 = 0; e2 < 4; ++e2) { acc[e2] += swap16(acc[e2]); acc[e2] += swap_half(acc[e2]); }
    if (ts == 0) *(f32x4*)(WSP(float, WS_SBPO) + (((size_t)b * NPG + pg) * NH + h) * HD + 4 * d4) = acc;
    if (lane == 0) WSP(float, WS_SBPL)[((size_t)b * NPG + pg) * NH + h] = -(tot0 + tot1);
}
__device__ __forceinline__ void sb_sample_combine(Frame& F, int b, int h) {
    const float* PO = WSP(float, WS_SBPO); const float* PL = WSP(float, WS_SBPL); float o = 0.f, run = 0.f;
#pragma unroll
    for (int pg = NPG - 1; pg >= 0; --pg) { o += __builtin_amdgcn_exp2f(run) * PO[(((size_t)b * NPG + pg) * NH + h) * HD + F.lane]; run += PL[((size_t)b * NPG + pg) * NH + h]; }
    const unsigned ob = f2bf(o); const float orr = bf2f((unsigned short)ob);
    WSP(bf16, WS_MIX)[(size_t)(MPR + b) * D + h * HD + F.lane] = (bf16)ob;
    const float sq = wave_sum_fast(orr * orr);
    if (F.lane == 0) atomicAdd((float*)(F.ctl + CW_SSQA) + MPR + b, sq);
}
__device__ __forceinline__ void ssm_sample_unit(Frame& F, int b, int g) {
    const int n = F.lane;
    const float lr = INF(14)[g * NST + n], li = INF(15)[g * NST + n], ldt = INF(16)[g];
    float lbr, lbi, cr, ci; lam_pow(lr, li, ldt, 1, lbr, lbi); lam_coef(lr, li, ldt, cr, ci);
    const float* u = WSP(float, WS_US) + (size_t)b * SBW + g * GP;
    float br = 0.f, bi = 0.f;
#pragma unroll
    for (int p = 0; p < 16; ++p) { const float bre = INF(17)[(g * NST + n) * GP + p], bim = INF(18)[(g * NST + n) * GP + p]; const float uv = u[p]; br += (cr * bre - ci * bim) * uv; bi += (cr * bim + ci * bre) * uv; }
    const float h0r = INF(5)[(b * NG + g) * NST + n], h0i = INF(6)[(b * NG + g) * NST + n];
    const float hr = lbr * h0r - lbi * h0i + br, hi = lbr * h0i + lbi * h0r + bi;
    F.out[O_RES + (size_t)(b * NG + g) * NST + n] = hr; F.out[O_IMS + (size_t)(b * NG + g) * NST + n] = hi;
    float y = 0.f;
#pragma unroll
    for (int p = 0; p < 16; ++p) { const float v = wave_sum(INF(19)[(g * GP + p) * NST + n] * hr - INF(20)[(g * GP + p) * NST + n] * hi); if (n == p) y = v; }
    if (n < 16) { y += INF(21)[g * GP + n] * u[n]; WSP(bf16, WS_YG)[(size_t)(MPR + b) * SBW + g * GP + n] = (bf16)f2bf(gelu_tanh_f(y)); }
}
__device__ __forceinline__ void ssm_scan_bg(Frame& F, int b, int g) {
    const int n = F.tid & 63, seg = F.tid >> 6;
    LAS float* tot = (LAS float*)(F.lds + RING_OFF);
    const float lr = INF(14)[g * NST + n], li = INF(15)[g * NST + n], ldt = INF(16)[g];
    float Lr, Li, Sr, Si; lam_pow(lr, li, ldt, LC, Lr, Li); lam_pow(lr, li, ldt, LC * 32, Sr, Si);
    const float* SST = WSP(float, WS_SST); bf16* XH = WSP(bf16, WS_XH);
    f32x2 s[32];
#pragma unroll
    for (int k = 0; k < 32; ++k) s[k] = *(const f32x2*)(SST + ((size_t)(b * NCH + seg * 32 + k) * NG + g) * 128 + 2 * n);
    float pr = 0.f, pi = 0.f;
#pragma unroll
    for (int k = 0; k < 32; ++k) { const float nr = Lr * pr - Li * pi + s[k].x, ni = Lr * pi + Li * pr + s[k].y; pr = nr; pi = ni; s[k].x = pr; s[k].y = pi; }
    tot[(seg * 64 + n) * 2] = pr; tot[(seg * 64 + n) * 2 + 1] = pi;
    __syncthreads();
    float cr = 0.f, ci = 0.f;
    for (int s2 = 0; s2 < seg; ++s2) { const float tr = tot[(s2 * 64 + n) * 2], ti = tot[(s2 * 64 + n) * 2 + 1]; const float nr = Sr * cr - Si * ci + tr, ni = Sr * ci + Si * cr + ti; cr = nr; ci = ni; }
    if (seg == 0) *(GAS unsigned*)(XH + ((size_t)(b * NCH) * NG + g) * XHP + 256 + 2 * n) = 0u;
    float wr_ = Lr, wi_ = Li;
#pragma unroll
    for (int k = 0; k < 32; ++k) {
        const float hr = wr_ * cr - wi_ * ci + s[k].x, hi = wr_ * ci + wi_ * cr + s[k].y;
        const int c = seg * 32 + k;
        if (c + 1 < NCH) *(GAS unsigned*)(XH + ((size_t)(b * NCH + c + 1) * NG + g) * XHP + 256 + 2 * n) = pk2(hr, hi);
        else { F.out[O_REP + (size_t)(b * NG + g) * NST + n] = hr; F.out[O_IMP + (size_t)(b * NG + g) * NST + n] = hi; }
        const float nr = wr_ * Lr - wi_ * Li, ni = wr_ * Li + wi_ * Lr; wr_ = nr; wi_ = ni;
    }
}
__device__ __forceinline__ void xattn_prompt_kload(Frame& F, int b, int h) {
    const int lane = F.lane, wid = F.wave; const bf16* MKB = WSP(bf16, WS_MKB);
    const unsigned lds0 = (unsigned)(uintptr_t)(F.lds + RING_OFF);
#pragma unroll
    for (int t = 0; t < 4; ++t)
#pragma unroll
        for (int j = 0; j < 4; ++j) { const int c = wid + 8 * j;
            glds16(MKB + ((long)b * MT + t * 64 + lane) * D + h * MHD + c * 8, (unsigned)__builtin_amdgcn_readfirstlane(lds0 + t * 32768 + c * 1024)); }
}
__device__ __forceinline__ void xattn_prompt_unit(Frame& F, int b, int h, int qb, bool have_k) {
    const int lane = F.lane, r32 = lane & 31, hi = lane >> 5, wid = F.wave;
    const bf16* QM = WSP(bf16, WS_QM); const bf16* MVB = WSP(bf16, WS_MVB); bf16* OM = WSP(bf16, WS_OMEM);
    const unsigned lds0 = (unsigned)(uintptr_t)(F.lds + RING_OFF); const lds_cptr base3 = (lds_cptr)(F.lds + RING_OFF);
    const long qrow0 = (long)b * T + qb * 256 + wid * 32;
    if (!have_k) xattn_prompt_kload(F, b, h);
    bf16x8 qr[16];
#pragma unroll
    for (int ks = 0; ks < 16; ++ks) qr[ks] = *reinterpret_cast<const bf16x8*>(QM + (qrow0 + r32) * D + h * MHD + ks * 16 + hi * 8);
    WAIT_BAR(0);
    f32x16 S[8];
#pragma unroll
    for (int t = 0; t < 4; ++t)
#pragma unroll
        for (int blk = 0; blk < 2; ++blk) { f32x16 p = {};
#pragma unroll
            for (int ks = 0; ks < 16; ++ks) p = MFMA32(ldsq(base3 + t * 32768 + (2 * ks + hi) * 1024 + (32 * blk + r32) * 16), qr[ks], p);
            S[t * 2 + blk] = p; }
    WAIT_BAR(0);
#pragma unroll
    for (int t = 0; t < 4; ++t)
#pragma unroll
        for (int j = 0; j < 4; ++j) { const int p = wid + 8 * j, dblk = p >> 2, rg = p & 3;
            glds16(MVB + ((long)b * MT + t * 64 + 16 * rg + (lane >> 2)) * D + h * MHD + dblk * 32 + (lane & 3) * 8, (unsigned)__builtin_amdgcn_readfirstlane(lds0 + t * 32768 + p * 1024)); }
    float mx = -INFINITY;
#pragma unroll
    for (int i = 0; i < 8; ++i)
#pragma unroll
        for (int r = 0; r < 16; ++r) mx = fmaxf(mx, S[i][r]);
    mx = fmaxf(mx, swap_half(mx));
    float l = 0.f;
#pragma unroll
    for (int i = 0; i < 8; ++i)
#pragma unroll
        for (int r = 0; r < 16; ++r) { S[i][r] = __builtin_amdgcn_exp2f(S[i][r] - mx); l += S[i][r]; }
    l += swap_half(l);
    bf16x8 pa[16];
#pragma unroll
    for (int i = 0; i < 8; ++i) { pa[2 * i] = pack_bf8(S[i], 0); pa[2 * i + 1] = pack_bf8(S[i], 8); }
    WAIT_BAR(0);
    f32x16 o[8];
#pragma unroll
    for (int dblk = 0; dblk < 8; ++dblk) o[dblk] = (f32x16){};
    const lds_cptr vp0 = base3 + ((lane >> 4) & 1) * 32 + (lane & 3) * 8 + (4 * hi + ((lane & 15) >> 2)) * 64;
#pragma unroll
    for (int t = 0; t < 4; ++t)
#pragma unroll
        for (int dblk = 0; dblk < 8; ++dblk)
#pragma unroll
            for (int rg = 0; rg < 4; ++rg) { const s16x4 lo = vtr(vp0 + t * 32768 + dblk * 4096 + rg * 1024), hh = vtr(vp0 + t * 32768 + dblk * 4096 + rg * 1024 + 512);
                const bf16x8 vf = (bf16x8){lo[0], lo[1], lo[2], lo[3], hh[0], hh[1], hh[2], hh[3]};
                o[dblk] = MFMA32(pa[t * 4 + rg], vf, o[dblk]); }
    WAIT_BAR(0);
    int l2 = lane; asm volatile("" : "+v"(l2));
    const int e32 = l2 & 31, ehi = l2 >> 5;
    LAS bf16* stg = (LAS bf16*)(F.lds + RING_OFF) + wid * 8192;
    LAS float* lsw = (LAS float*)stg;
    if (ehi == 0) lsw[e32] = l;
    LDS_WAIT();
    float rli[16];
    { const LAS float* lb = lsw + 4 * ehi;
#pragma unroll
      for (int r = 0; r < 16; ++r) rli[r] = __builtin_amdgcn_rcpf(lb[(r & 3) + 8 * (r >> 2)]); }
    LDS_WAIT(); asm volatile("" ::: "memory");
    { LAS bf16* sb = stg + (4 * ehi) * 256 + e32;
#pragma unroll
      for (int dblk = 0; dblk < 8; ++dblk)
#pragma unroll
        for (int r = 0; r < 16; ++r) sb[((r & 3) + 8 * (r >> 2)) * 256 + dblk * 32] = (bf16)f2bf(o[dblk][r] * rli[r]); }
    LDS_WAIT();
    { bf16* Ow = OM + (qrow0 + (l2 >> 5)) * D + h * MHD + (l2 & 31) * 8; const LAS bf16* sr = stg + (l2 >> 5) * 256 + (l2 & 31) * 8;
#pragma unroll
      for (int i = 0; i < 16; ++i) { const v4u v = *(const LAS v4u*)(sr + i * 512); *(v4u*)(Ow + (long)i * 2 * D) = v; } }
    asm volatile("s_waitcnt vmcnt(0) lgkmcnt(0)\n\ts_barrier" ::: "memory");
}
__device__ __forceinline__ void xattn_sample_unit(Frame& F, int b, int h) {
    const int lane = F.lane, wid = F.wave;
    const bf16* QM = WSP(bf16, WS_QM); const float* ck = INF(8); const float* cv = INF(9);
    LAS float* xm = (LAS float*)(F.lds + HALO_OFF);
    const v2u qw = *(const v2u*)(QM + (size_t)(MPR + b) * D + h * MHD + 4 * lane);
    const f32x4 q4 = {bflo(qw.x), bfhi(qw.x), bflo(qw.y), bfhi(qw.y)};
    const float* kb = ck + (((size_t)b * MT + wid * 32) * MH + h) * MHD + 4 * lane;
    const float* vb = cv + (((size_t)b * MT + wid * 32) * MH + h) * MHD + 4 * lane;
    float s[32];
    f32x4 kk[32], vv[32];
#pragma unroll
    for (int i = 0; i < 32; ++i) kk[i] = __builtin_nontemporal_load((const f32x4*)(kb + (size_t)i * MH * MHD));
#pragma unroll
    for (int i0 = 0; i0 < 32; i0 += 16) {
#pragma unroll
        for (int i = 0; i < 16; ++i) s[i0 + i] = wave_sum_fast((q4[0] * kk[i0 + i][0] + q4[1] * kk[i0 + i][1]) + (q4[2] * kk[i0 + i][2] + q4[3] * kk[i0 + i][3]));
#pragma unroll
        for (int i = 0; i < 16; ++i) vv[i0 + i] = __builtin_nontemporal_load((const f32x4*)(vb + (size_t)(i0 + i) * MH * MHD));
        __builtin_amdgcn_sched_barrier(0);
    }
    float mx = s[0];
#pragma unroll
    for (int i = 1; i < 32; ++i) mx = fmaxf(mx, s[i]);
    float l = 0.f;
#pragma unroll
    for (int i = 0; i < 32; ++i) { s[i] = __builtin_amdgcn_exp2f(s[i] - mx); l += s[i]; }
    f32x4 acc = {0.f, 0.f, 0.f, 0.f};
#pragma unroll
    for (int i = 0; i < 32; ++i) acc = acc + vv[i] * s[i];
    WAIT_BAR(0);
    if (lane == 0) { xm[wid] = mx; xm[8 + wid] = l; }
    *(LAS f32x4*)(xm + 64 + wid * 256 + 4 * lane) = acc;
    WAIT_BAR(0);
    if (F.tid < 256) { float gm = xm[0];
#pragma unroll
        for (int w = 1; w < 8; ++w) gm = fmaxf(gm, xm[w]);
        float lt = 0.f, ov = 0.f;
#pragma unroll
        for (int w = 0; w < 8; ++w) { const float f = __builtin_amdgcn_exp2f(xm[w] - gm); lt += xm[8 + w] * f; ov += xm[64 + w * 256 + F.tid] * f; }
        WSP(bf16, WS_OMEM)[(size_t)(MPR + b) * D + h * MHD + F.tid] = (bf16)f2bf(ov / lt); }
}
__device__ __forceinline__ void mix_row(Frame& F, int row) {
    const int lane = F.lane;
#pragma unroll
    for (int half = 0; half < 2; ++half) {
        const bf16* src = (half ? WSP(bf16, WS_OSSM) : WSP(bf16, WS_OSB)) + (size_t)row * SBW + 8 * lane;
        const v4u w = *(const v4u*)src; float v[8] = {bflo(w.x), bfhi(w.x), bflo(w.y), bfhi(w.y), bflo(w.z), bfhi(w.z), bflo(w.w), bfhi(w.w)};
        float s = 0.f;
#pragma unroll
        for (int e = 0; e < 8; ++e) s += v[e] * v[e];
        s = wave_sum(s); const float rs = 1.f / sqrtf(s * (1.f / SBW) + EPS);
        v4u o; o.x = pk2(v[0] * rs, v[1] * rs); o.y = pk2(v[2] * rs, v[3] * rs); o.z = pk2(v[4] * rs, v[5] * rs); o.w = pk2(v[6] * rs, v[7] * rs);
        *(v4u*)(WSP(bf16, WS_MIX) + (size_t)row * D + half * SBW + 8 * lane) = o;
    }
}
__device__ __forceinline__ void conv_act_item(Frame& F, long item) {
    const int row = (int)(item / (FF / 8)), j = (int)(item % (FF / 8)) * 8;
    const bf16* GB = WSP(bf16, WS_GB); bf16* UB = WSP(bf16, WS_UB);
    const float* cw = INF(36); const float* cb = INF(37); const float* sc = INF(7);
    float g0[8], g1[8], g2[8], uu[8];
    { const v4u w = *(const v4u*)(GB + (size_t)row * FF + j); g0[0] = bflo(w.x); g0[1] = bfhi(w.x); g0[2] = bflo(w.y); g0[3] = bfhi(w.y); g0[4] = bflo(w.z); g0[5] = bfhi(w.z); g0[6] = bflo(w.w); g0[7] = bfhi(w.w); }
    { const v4u w = *(const v4u*)(UB + (size_t)row * FF + j); uu[0] = bflo(w.x); uu[1] = bfhi(w.x); uu[2] = bflo(w.y); uu[3] = bfhi(w.y); uu[4] = bflo(w.z); uu[5] = bfhi(w.z); uu[6] = bflo(w.w); uu[7] = bfhi(w.w); }
    if (row < MPR) { const int t = row & 4095;
        if (t >= 1) { const v4u w = *(const v4u*)(GB + (size_t)(row - 1) * FF + j); g1[0] = bflo(w.x); g1[1] = bfhi(w.x); g1[2] = bflo(w.y); g1[3] = bfhi(w.y); g1[4] = bflo(w.z); g1[5] = bfhi(w.z); g1[6] = bflo(w.w); g1[7] = bfhi(w.w); }
        else { _Pragma("unroll") for (int e = 0; e < 8; ++e) g1[e] = 0.f; }
        if (t >= 2) { const v4u w = *(const v4u*)(GB + (size_t)(row - 2) * FF + j); g2[0] = bflo(w.x); g2[1] = bfhi(w.x); g2[2] = bflo(w.y); g2[3] = bfhi(w.y); g2[4] = bflo(w.z); g2[5] = bfhi(w.z); g2[6] = bflo(w.w); g2[7] = bfhi(w.w); }
        else { _Pragma("unroll") for (int e = 0; e < 8; ++e) g2[e] = 0.f; }
    } else { const int b = row - MPR;
        _Pragma("unroll") for (int e = 0; e < 8; ++e) { g2[e] = sc[((size_t)b * 2 + 0) * FF + j + e]; g1[e] = sc[((size_t)b * 2 + 1) * FF + j + e]; F.out[O_CVS + ((size_t)b * 2 + 0) * FF + j + e] = g1[e]; } }
    float r[8];
#pragma unroll
    for (int e = 0; e < 8; ++e) { const float c = cb[j + e] + cw[j + e] * g2[e] + cw[FF + j + e] * g1[e] + cw[2 * FF + j + e] * g0[e]; r[e] = gelu_tanh_f(c) * uu[e]; }
    v4u o; o.x = pk2(r[0], r[1]); o.y = pk2(r[2], r[3]); o.z = pk2(r[4], r[5]); o.w = pk2(r[6], r[7]);
    *(v4u*)(UB + (size_t)row * FF + j) = o;
}
__device__ __forceinline__ void final_norm_row(Frame& F, int row) {
    const float rs = 1.f / sqrtf(((const float*)(F.ctl + CW_SSQ3))[row] * (1.f / D) + EPS);
    float* y = F.out + O_YP + (size_t)row * D; const float* g = INF(39); const bf16* x3 = WSP(bf16, WS_X1B) + (size_t)row * D;
#pragma unroll
    for (int j = 0; j < 2; ++j) { const int c = 8 * F.lane + 512 * j; const v4u w = *(const v4u*)(x3 + c); const f32x4 g0 = *(const f32x4*)(g + c), g1 = *(const f32x4*)(g + c + 4);
        const f32x4 v0 = (f32x4){bflo(w.x), bfhi(w.x), bflo(w.y), bfhi(w.y)} * rs * g0, v1 = (f32x4){bflo(w.z), bfhi(w.z), bflo(w.w), bfhi(w.w)} * rs * g1;
        *(f32x4*)(y + c) = v0; *(f32x4*)(y + c + 4) = v1; }
}
constexpr int N_PHASES = 15;
__global__ void __launch_bounds__(NTHR, 2) mk_fwd(Args args) {
    extern __shared__ __attribute__((aligned(16))) unsigned char lds[];
    Frame F;
    F.lds = (LAS unsigned char*)lds; F.MISC = (volatile LAS unsigned*)(F.lds + MISC_OFF);
    F.tid = threadIdx.x; F.lane = F.tid & 63; F.wave = __builtin_amdgcn_readfirstlane(F.tid >> 6);
    F.G = gridDim.x; { const int bx = blockIdx.x; F.vcu = (F.G % 8 == 0) ? (bx % 8) * (F.G / 8) + bx / 8 : bx; }
    F.ws = args.ws; F.out = args.out; F.in = args.in; F.ctl = (unsigned*)(args.ws + WS_CTL);
    for (int u = F.tid; u < (LDS_BYTES - LDSCTL_OFF) / 4; u += NTHR) ((LAS unsigned*)(F.lds + LDSCTL_OFF))[u] = 0u;
    __syncthreads();
    XcdBarrier bar; bar.bar = F.ctl + CW_BAR; bar.x = 0; bar.st = nullptr;
    if (args.use_bar) bar = xcd_barrier_post(F.ctl + CW_BAR, F.MISC + 8);
    const int lo = args.ph_lo, hi = args.ph_hi;
#define IN(k) (lo <= (k) && (k) < hi)
#if MK_PROBE >= 200
    unsigned long long tp0 = 0, tpd = 0;
#define TP_BEGIN(k) do { if ((k) == MK_PROBE - 200) tp0 = __builtin_amdgcn_s_memrealtime(); } while (0)
#define TP_END(k) do { if ((k) == MK_PROBE - 200) tpd = __builtin_amdgcn_s_memrealtime() - tp0; } while (0)
#else
#define TP_BEGIN(k) do {} while (0)
#define TP_END(k) do {} while (0)
#endif
#define SEAM(k) do { if (IN(k) && IN((k) + 1)) xcd_barrier(bar); TP_END(k); TP_BEGIN((k) + 1); TP_BEGIN((k) + 2); TP_BEGIN((k) + 3); } while (0)
    const int gw = F.vcu * NWAVES + F.wave, NGW = F.G * NWAVES;
    LAS unsigned char* ring = F.lds + RING_OFF;

    TP_BEGIN(0);
    if (IN(0)) { p0_prologue(F);
#if MK_PROBE == 100
        __syncthreads(); p0_prologue(F);
#endif
    } SEAM(0);
    if (IN(1)) {
        { pg8::Gemm g{WSP(bf16, WS_XB), WSP(bf16, WS_WIN), D, D, D}; pg8::GridOrder S; S.init(MPR / 256, INW / 256, F.G, (int)blockIdx.x, 0, D, D);
          EpiInProj E{WSP(float, WS_RSTD0), WSP(bf16, WS_QB), WSP(bf16, WS_KB), WSP(bf16, WS_VB), WSP(bf16, WS_XH), WSP(float, WS_QS), WSP(float, WS_US), F.out};
          pg8::gemm_phase<EpiInProj, pg8::GridOrder>(ring, g, S, E);
#if MK_PROBE == 1
          pg8::gemm_phase<EpiInProj, pg8::GridOrder>(ring, g, S, E);
#endif
        }
        { SkInProj E{WSP(float, WS_RSTD0), WSP(bf16, WS_QB), WSP(float, WS_QS), WSP(float, WS_US), F.out};
          skinny_gemm(F, WSP(bf16, WS_XB) + (size_t)MPR * D, D, WSP(bf16, WS_WIN), D, INW, D, E, (int)blockIdx.x, F.G); }
    } SEAM(1);
    if (IN(2)) {
        if ((int)blockIdx.x < NG * NB) { const int u = (int)blockIdx.x; const int sb_ = u & 3, sg_ = u >> 2; int one = 1; asm volatile("" : "+s"(one));
          { pg8::Gemm g{WSP(bf16, WS_XH), WSP(bf16, WS_W1), NG * XHP, 256, 256}; SsmOne S{sb_, sg_, (size_t)128 * 256 * 2, one};
            EpiSsmA E{WSP(float, WS_SST)};
            pg8::gemm_phase<EpiSsmA, SsmOne>(ring, g, S, E); }
          VM_WAIT(); __syncthreads();
          ssm_scan_bg(F, sb_, sg_);
          VM_WAIT(); __syncthreads();
        }
        { pg8::Gemm g{WSP(bf16, WS_MB), WSP(bf16, WS_WMKV), D, D, D}; pg8::GridOrder S; S.init(4, 8, F.G, (int)blockIdx.x, 128, D, D);
          EpiMemKV E{WSP(float, WS_RSTDM), WSP(bf16, WS_MKB), WSP(bf16, WS_MVB), F.out};
          pg8::gemm_phase<EpiMemKV, pg8::GridOrder>(ring, g, S, E); }
        for (int u = gw; u < MS * NG; u += NGW) ssm_sample_unit(F, u >> 5, u & 31);
        weight_copies(F, NITEMS_EARLY, NITEMS_GLU);
        __syncthreads();
        { int mode = (MK_STREAM_DIV > 0 ? (F.vcu % MK_STREAM_DIV == MK_STREAM_DIV - 1) : (F.vcu % (-MK_STREAM_DIV) != 0)) ? 1 : 0; bool adone = false, mdone = false;
          while (!(adone && mdone)) {
              if (mode == 0 && adone) mode = 1; else if (mode == 1 && mdone) mode = 0;
              __syncthreads();
              if (F.tid == 0) F.MISC[16] = __hip_atomic_fetch_add(F.ctl + (mode ? CW_QM : CW_QA), 1u, __ATOMIC_RELAXED, __HIP_MEMORY_SCOPE_AGENT);
              __syncthreads();
              const int idx = (int)F.MISC[16];
              if (mode == 0) { if (idx >= 512) { adone = true; continue; }
                  const int qb = 15 - (idx >> 5), bh = idx & 31; sb_attn_unit(F, bh >> 3, bh & 7, qb, INF(13)[bh & 7] * LOG2E); }
              else { if (idx >= MS * NPG) { mdone = true; continue; }
                  sb_sample_unit(F, idx >> 4, idx & 15); }
          } }
#if MK_PROBE == 22
        if (args.use_bar) { xcd_barrier(bar); if (blockIdx.x == 0 && F.tid == 0) { __hip_atomic_store(F.ctl + CW_QA, 0u, __ATOMIC_RELAXED, __HIP_MEMORY_SCOPE_AGENT); __hip_atomic_store(F.ctl + CW_QM, 0u, __ATOMIC_RELAXED, __HIP_MEMORY_SCOPE_AGENT); } xcd_barrier(bar);
        { int mode = (MK_STREAM_DIV > 0 ? (F.vcu % MK_STREAM_DIV == MK_STREAM_DIV - 1) : (F.vcu % (-MK_STREAM_DIV) != 0)) ? 1 : 0; bool adone = false, mdone = false;
          while (!(adone && mdone)) {
              if (mode == 0 && adone) mode = 1; else if (mode == 1 && mdone) mode = 0;
              __syncthreads();
              if (F.tid == 0) F.MISC[16] = __hip_atomic_fetch_add(F.ctl + (mode ? CW_QM : CW_QA), 1u, __ATOMIC_RELAXED, __HIP_MEMORY_SCOPE_AGENT);
              __syncthreads();
              const int idx = (int)F.MISC[16];
              if (mode == 0) { if (idx >= 512) { adone = true; continue; }
                  const int qb = 15 - (idx >> 5), bh = idx & 31; sb_attn_unit(F, bh >> 3, bh & 7, qb, INF(13)[bh & 7] * LOG2E); }
              else { if (idx >= MS * NPG) { mdone = true; continue; }
                  sb_sample_unit(F, idx >> 4, idx & 15); }
          } }
        }
#endif
        __syncthreads();
        if ((int)blockIdx.x < NG * NB) { const int u = (int)blockIdx.x; const int sb_ = u & 3, sg_ = u >> 2; int one = 1; asm volatile("" : "+s"(one));
          { pg8::Gemm g{WSP(bf16, WS_XH), WSP(bf16, WS_BTC), NG * XHP, XHP, XHP}; SsmOne S{sb_, sg_, (size_t)256 * XHP * 2, one};
            EpiSsmC E{WSP(bf16, WS_YG)};
            pg8::gemm_phase<EpiSsmC, SsmOne>(ring, g, S, E); }
        }
        weight_copies(F, NITEMS_GLU, NITEMS_MID, NG * NB, F.G - NG * NB);
    } SEAM(2);
    if (IN(5)) {
        for (int u = gw; u < MS * NH; u += NGW) sb_sample_combine(F, u >> 3, u & 7);
        pg8::Gemm g{WSP(bf16, WS_YG), WSP(bf16, WS_WGLU), SBW, SBW, SBW}; pg8::GridOrder S; S.init(MPR / 256, 2, F.G, (int)blockIdx.x, 0, SBW, SBW);
        EpiGlu E{WSP(bf16, WS_YG), INF(23), WSP(bf16, WS_MIX), (float*)(F.ctl + CW_SSQB)};
        pg8::gemm_phase<EpiGlu, pg8::GridOrder>(ring, g, S, E);
        weight_copies(F, NITEMS_MID, NITEMS_ALL, 128, F.G - 128);
        __syncthreads();
        SkGlu E2{WSP(bf16, WS_YG), INF(23), WSP(bf16, WS_MIX), (float*)(F.ctl + CW_SSQB)};
        skinny_gemm(F, WSP(bf16, WS_YG) + (size_t)MPR * SBW, SBW, WSP(bf16, WS_WGLU), SBW, SBW, SBW, E2, ((int)blockIdx.x + F.G - 128) % F.G, F.G);
    } SEAM(5);
    if (IN(7)) {
        pg8::Gemm g{WSP(bf16, WS_MIX), WSP(bf16, WS_WOUT), D, D, D}; pg8::GridOrder S; S.init(MPR / 256, 4, F.G, (int)blockIdx.x, 0, D, D);
        EpiResidMix E{WSP(bf16, WS_XB), WSP(bf16, WS_X1B), (float*)(F.ctl + CW_SSQ1), (const float*)(F.ctl + CW_SSQA), (const float*)(F.ctl + CW_SSQB), (LAS float*)(F.lds + HALO_OFF_C)};
        pg8::gemm_phase<EpiResidMix, pg8::GridOrder>(ring, g, S, E);
        SkResidMix E2{WSP(bf16, WS_XB), WSP(bf16, WS_X1B), (float*)(F.ctl + CW_SSQ1), (const float*)(F.ctl + CW_SSQA), (const float*)(F.ctl + CW_SSQB)};
        skinny_gemm(F, WSP(bf16, WS_MIX) + (size_t)MPR * D, D, WSP(bf16, WS_WOUT), D, D, D, E2, (int)blockIdx.x, F.G);
    } SEAM(7);
    if (IN(8)) {
        pg8::Gemm g{WSP(bf16, WS_X1B), WSP(bf16, WS_WMQ), D, D, D}; pg8::GridOrder S; S.init(MPR / 256, 4, F.G, (int)blockIdx.x, 0, D, D);
        EpiScaleBf16 E{(const float*)(F.ctl + CW_SSQ1), CM, WSP(bf16, WS_QM)};
        pg8::gemm_phase<EpiScaleBf16, pg8::GridOrder>(ring, g, S, E);
#if MK_PROBE == 8
        pg8::gemm_phase<EpiScaleBf16, pg8::GridOrder>(ring, g, S, E);
#endif
        SkScale E2{(const float*)(F.ctl + CW_SSQ1), CM, WSP(bf16, WS_QM)};
        skinny_gemm(F, WSP(bf16, WS_X1B) + (size_t)MPR * D, D, WSP(bf16, WS_WMQ), D, D, D, E2, (int)blockIdx.x, F.G);
        if (IN(9) && F.vcu < 256) { __syncthreads(); xattn_prompt_kload(F, F.vcu >> 6, (F.vcu >> 4) & 3); }
    } SEAM(8);
    if (IN(9)) {
#if MK_XSTAG
        const bool sfirst = ((F.vcu >> 4) & 1) != 0;
#else
        const bool sfirst = false;
#endif
        if (sfirst) { for (int u = F.vcu; u < MS * MH; u += F.G) xattn_sample_unit(F, u >> 2, u & 3); __syncthreads(); }
        { bool have_k = IN(8); for (int u = F.vcu; u < 256; u += F.G) { xattn_prompt_unit(F, u >> 6, (u >> 4) & 3, u & 15, have_k); have_k = false; } }
        if (!sfirst) { for (int u = F.vcu; u < MS * MH; u += F.G) xattn_sample_unit(F, u >> 2, u & 3); }
    } SEAM(9);
    if (IN(10)) {
        pg8::Gemm g{WSP(bf16, WS_OMEM), WSP(bf16, WS_WMO), D, D, D}; pg8::GridOrder S; S.init(MPR / 256, 4, F.G, (int)blockIdx.x, 0, D, D);
        EpiResidB E{WSP(bf16, WS_X1B), nullptr, WSP(bf16, WS_X2B), (float*)(F.ctl + CW_SSQ2), (LAS float*)(F.lds + HALO_OFF_C)};
        pg8::gemm_phase<EpiResidB, pg8::GridOrder>(ring, g, S, E);
#if MK_PROBE == 10
        { EpiResidB Ed{WSP(bf16, WS_X1B), nullptr, WSP(bf16, WS_X2B), (float*)(F.ctl + CW_SSQD), (LAS float*)(F.lds + HALO_OFF_C)}; pg8::gemm_phase<EpiResidB, pg8::GridOrder>(ring, g, S, Ed); }
#endif
        SkResidB E2{WSP(bf16, WS_X1B), nullptr, WSP(bf16, WS_X2B), (float*)(F.ctl + CW_SSQ2)};
        skinny_gemm(F, WSP(bf16, WS_OMEM) + (size_t)MPR * D, D, WSP(bf16, WS_WMO), D, D, D, E2, (int)blockIdx.x, F.G);
    } SEAM(10);
    if (IN(11)) {
        pg8::Gemm g{WSP(bf16, WS_X2B), WSP(bf16, WS_WGU), D, D, D, FF}; PanelOrder254 S; S.Gd.init(65, 22, F.G, (int)blockIdx.x, 0, D, D);
        EpiGateUpConv E{(const float*)(F.ctl + CW_SSQ2), WSP(bf16, WS_UB), F.out, INF(36), INF(37), (LAS float*)(F.lds + HALO_OFF)};
        const int nheavy = 1430 - (1430 / F.G) * F.G; const bool heavy = (int)blockIdx.x < nheavy;
        SkGateUpConv E2{(const float*)(F.ctl + CW_SSQ2), WSP(bf16, WS_UB), F.out, INF(36), INF(37), INF(7)};
        const int su0 = ((int)blockIdx.x + F.G - nheavy) % F.G;
        if (heavy) { skinny_gemm(F, WSP(bf16, WS_X2B) + (size_t)MPR * D, D, WSP(bf16, WS_WGU), D, FF, D, E2, su0, F.G, 16, FF);
            asm volatile("s_waitcnt vmcnt(0)" ::: "memory"); __syncthreads();
            if (F.tid == 0) { __builtin_amdgcn_fence(__ATOMIC_RELEASE, "agent"); (void)xb_add(F.ctl + CW_SCNT, 1u); } }
        pg8::gemm_phase<EpiGateUpConv, PanelOrder254>(ring, g, S, E);
#if MK_PROBE == 11
        pg8::gemm_phase<EpiGateUpConv, PanelOrder254>(ring, g, S, E);
#endif
        if (!heavy) { skinny_gemm(F, WSP(bf16, WS_X2B) + (size_t)MPR * D, D, WSP(bf16, WS_WGU), D, FF, D, E2, su0, F.G, 16, FF);
            asm volatile("s_waitcnt vmcnt(0)" ::: "memory"); __syncthreads();
            if (F.tid == 0) { __builtin_amdgcn_fence(__ATOMIC_RELEASE, "agent"); (void)xb_add(F.ctl + CW_SCNT, 1u);
                XB_SPIN(xb_ld(F.ctl + CW_SCNT) < (unsigned)F.G, F.ctl + CW_BAR); __builtin_amdgcn_fence(__ATOMIC_ACQUIRE, "agent"); }
            __syncthreads();
            SkResidB E3{WSP(bf16, WS_X2B), nullptr, WSP(bf16, WS_X1B), (float*)(F.ctl + CW_SSQ3)};
            skinny_gemm(F, WSP(bf16, WS_UB) + (size_t)MPR * FF, FF, WSP(bf16, WS_WDN), FF, D, FF, E3, su0, F.G - nheavy); }
    } SEAM(11);
    if (IN(13)) {
        pg8::Gemm g{WSP(bf16, WS_UB), WSP(bf16, WS_WDN), FF, FF, FF}; pg8::GridOrder S; S.init(MPR / 256, 4, F.G, (int)blockIdx.x, 0, FF, FF);
        for (int m = MPR + gw; m < MALL; m += NGW) final_norm_row(F, m);
        EpiResidFinal E{WSP(bf16, WS_X2B), (float*)(F.ctl + CW_SSQ3), (LAS float*)(F.lds + HALO_OFF_C), F.ctl + CW_PCNT, F.ctl + CW_BAR, INF(39), F.out + O_YP};
        pg8::gemm_phase<EpiResidFinal, pg8::GridOrder>(ring, g, S, E);
#if MK_PROBE == 13
        { EpiResidB Ed{WSP(bf16, WS_X2B), nullptr, WSP(bf16, WS_X1B), (float*)(F.ctl + CW_SSQD), (LAS float*)(F.lds + HALO_OFF_C)}; pg8::gemm_phase<EpiResidB, pg8::GridOrder>(ring, g, S, Ed); }
#endif
    }
#if MK_PROBE == 20
    if (args.use_bar) { for (int i = 0; i < 10; ++i) xcd_barrier(bar); }
#endif
#if MK_PROBE >= 200
    TP_END(14);
    if (blockIdx.x == 0) { const unsigned long long t1 = __builtin_amdgcn_s_memrealtime(); while (__builtin_amdgcn_s_memrealtime() - t1 < tpd) __builtin_amdgcn_s_sleep(8); }
#endif
#undef IN
#undef SEAM
}
#ifndef MK_DEBUG
#define MK_DEBUG 0
#endif
#ifndef MK_ONE_LAUNCH
#define MK_ONE_LAUNCH 1
#endif
#if MK_DEBUG
struct Chk { const void* fast; const float* ref; long rows, cols, ldf, ldr; int isbf; float scale; };
__global__ void k_compare(Chk c, double* acc) {
    __shared__ double se[256], sr[256];
    double e = 0.0, r = 0.0; const long n = c.rows * c.cols;
    for (long i = (long)blockIdx.x * 256 + threadIdx.x; i < n; i += (long)gridDim.x * 256) { const long rr = i / c.cols, cc = i % c.cols;
        const float f = (c.isbf ? bf2f(((const unsigned short*)c.fast)[rr * c.ldf + cc]) : ((const float*)c.fast)[rr * c.ldf + cc]) * c.scale; const float g = c.ref[rr * c.ldr + cc];
        const double d = (double)f - (double)g; e += d * d; r += (double)g * (double)g; }
    se[threadIdx.x] = e; sr[threadIdx.x] = r; __syncthreads();
    for (int k = 128; k > 0; k >>= 1) { if ((int)threadIdx.x < k) { se[threadIdx.x] += se[threadIdx.x + k]; sr[threadIdx.x] += sr[threadIdx.x + k]; } __syncthreads(); }
    if (threadIdx.x == 0) { atomicAdd(acc, se[0]); atomicAdd(acc + 1, sr[0]); }
}
__global__ void k_compare_xh(const unsigned short* XH, const float* proj, const float* hs, int part, double* acc) {
    __shared__ double se[256], sr[256];
    double e = 0.0, r = 0.0; const int w = part ? 128 : 256; const long n = (long)1024 * NG * w;
    for (long i = (long)blockIdx.x * 256 + threadIdx.x; i < n; i += (long)gridDim.x * 256) { const int j = (int)(i % w); const long bcg = i / w; const int g = (int)(bcg % NG); const long bc = bcg / NG; const int b = (int)(bc / NCH), c = (int)(bc % NCH);
        const float f = bf2f(XH[bcg * XHP + (part ? 256 : 0) + j]); float gref;
        if (!part) { const int s = j >> 4, q = j & 15; gref = proj[((size_t)b * T + c * LC + s) * INW + 1536 + g * GP + q]; }
        else { const int nn = j >> 1, ri = j & 1; gref = (c == 0) ? 0.f : hs[((((size_t)b * T + c * LC - 1) * NG + g) * NST + nn) * 2 + ri]; }
        const double d = (double)f - (double)gref; e += d * d; r += (double)gref * (double)gref; }
    se[threadIdx.x] = e; sr[threadIdx.x] = r; __syncthreads();
    for (int k = 128; k > 0; k >>= 1) { if ((int)threadIdx.x < k) { se[threadIdx.x] += se[threadIdx.x + k]; sr[threadIdx.x] += sr[threadIdx.x + k]; } __syncthreads(); }
    if (threadIdx.x == 0) { atomicAdd(acc, se[0]); atomicAdd(acc + 1, sr[0]); }
}
__global__ void k_judge(const double* acc, int n, float tol, float* out) {
    if (threadIdx.x != 0 || blockIdx.x != 0) return;
    for (int k = 0; k < n; ++k) { const double rv = acc[2 * k] / acc[2 * k + 1];
        if (!(rv < (double)tol)) { int m = 5; if (rv != rv) m = 0; else if (rv >= 1.0) m = 9; else if (rv >= 0.1) m = 8; else if (rv >= 0.01) m = 7; else if (rv >= 0.001) m = 6;
            const int grp = k / 9, kk = k % 9 + 1; float code = (float)(10 * kk + m) * 100.f; for (int i = 0; i < grp; ++i) code *= 100.f; out[0] = code; return; } }
}
#endif

extern "C" void kernel_launch(void* const* d_in, const int* in_sizes, int n_in, void* d_out, int out_size, void* d_ws, size_t ws_size, hipStream_t stream) {
    static int grid = 0;
    if (grid == 0) {
        if (n_in != 40 || (size_t)out_size != O_END || ws_size < WS_FAST_END) { fprintf(stderr, "kernel_launch: unexpected shapes: n_in %d out %d ws %zu\n", n_in, out_size, ws_size); grid = -1; return; }
        int dev = 0, cus = 0, per_cu = 0;
        if (hipGetDevice(&dev) != hipSuccess || hipDeviceGetAttribute(&cus, hipDeviceAttributeMultiprocessorCount, dev) != hipSuccess) { grid = -1; return; }
        if (hipFuncSetAttribute((const void*)mk_fwd, hipFuncAttributeMaxDynamicSharedMemorySize, LDS_BYTES) != hipSuccess) { fprintf(stderr, "kernel_launch: hipFuncSetAttribute failed\n"); grid = -1; return; }
        if (hipOccupancyMaxActiveBlocksPerMultiprocessor(&per_cu, (const void*)mk_fwd, NTHR, LDS_BYTES) != hipSuccess || per_cu < 1) { fprintf(stderr, "kernel_launch: occupancy query says %d\n", per_cu); }
        (void)hipGetLastError();
        grid = cus;
        if (grid < 256) { fprintf(stderr, "kernel_launch: this kernel needs at least 256 CUs (found %d): the down projection's 256 units meet on per-panel counters and must all be resident at once\n", grid); grid = -1; return; }
    }
    if (grid < 0) return;
    (void)hipMemsetAsync((char*)d_ws + WS_CTL, 0, CTL_ZERO_BYTES, stream);
    Args a{};
    for (int i = 0; i < 40; ++i) a.in[i] = d_in[i];
    a.out = (float*)d_out; a.ws = (unsigned char*)d_ws;
#if MK_DEBUG
    const size_t fo_off = (WS_FAST_END + 4095) & ~(size_t)4095, nv_off = fo_off + (((size_t)O_END * 4 + 4095) & ~(size_t)4095), chk_off = nv_off + (((size_t)nv::WS_FLOATS * 4 + 4095) & ~(size_t)4095);
    if (ws_size < chk_off + 4096) { fprintf(stderr, "debug build: workspace too small (%zu < %zu)\n", ws_size, chk_off + 4096); return; }
    float* fast_out = (float*)((char*)d_ws + fo_off); float* nvws = (float*)((char*)d_ws + nv_off); double* chk = (double*)((char*)d_ws + chk_off);
    nv::forward(d_in, (float*)d_out, nvws, stream);
    a.out = fast_out;
    (void)hipMemsetAsync(chk, 0, 4096, stream);
#endif
#if MK_ONE_LAUNCH
    a.ph_lo = 0; a.ph_hi = N_PHASES; a.use_bar = 1;
    hipLaunchKernelGGL(mk_fwd, dim3(grid), dim3(NTHR), LDS_BYTES, stream, a);
#else
    for (int p = 0; p < N_PHASES; ++p) { a.ph_lo = p; a.ph_hi = p + 1; a.use_bar = 0; hipLaunchKernelGGL(mk_fwd, dim3(grid), dim3(NTHR), LDS_BYTES, stream, a); }
#endif
#if MK_DEBUG
    {
        const nv::Bufs B = nv::carve(nvws); unsigned char* ws = (unsigned char*)d_ws; int k = 0; const float* no = (const float*)d_out;
        auto cmp = [&](const void* fast, int isbf, long ldf, const float* ref, long ldr, long rows, long cols, float scale) {
            Chk c; memset(&c, 0, sizeof(c)); c.fast = fast; c.ref = ref; c.rows = rows; c.cols = cols; c.ldf = ldf; c.ldr = ldr; c.isbf = isbf; c.scale = scale; hipLaunchKernelGGL(k_compare, dim3(1024), dim3(256), 0, stream, c, chk + 2 * k); ++k; };
        cmp(ws + WS_KB, 1, SBW, B.PROJ + 512, INW, MPR, SBW, 1.f);
        cmp(ws + WS_VB, 1, SBW, B.PROJ + 1024, INW, MPR, SBW, 1.f);
        cmp(ws + WS_QB, 1, SBW, B.PROJ, INW, MPR, SBW, 1.f / C2);
        hipLaunchKernelGGL(k_compare_xh, dim3(1024), dim3(256), 0, stream, (const unsigned short*)(ws + WS_XH), B.PROJ, B.HS, 0, chk + 2 * k); ++k;
        cmp(ws + WS_MKB, 1, D, no + O_MKP, D, NB * MT, D, 1.f);
        cmp(ws + WS_MVB, 1, D, no + O_MVP, D, NB * MT, D, 1.f);
        cmp(ws + WS_MIX, 1, D, B.OSB, SBW, MPR, SBW, 1.f);
        cmp(ws + WS_MIX + (size_t)MPR * D * 2, 1, D, B.OSB + (size_t)MPR * SBW, SBW, MS, SBW, 1.f);
        hipLaunchKernelGGL(k_compare_xh, dim3(1024), dim3(256), 0, stream, (const unsigned short*)(ws + WS_XH), B.PROJ, B.HS, 1, chk + 2 * k); ++k;
        cmp(ws + WS_YG, 1, SBW, B.YG, SBW, MPR, SBW, 1.f);
        cmp(ws + WS_YG + (size_t)MPR * SBW * 2, 1, SBW, B.YG + (size_t)MPR * SBW, SBW, MS, SBW, 1.f);
        cmp(ws + WS_MIX + SBW * 2, 1, D, B.OSSM, SBW, MALL, SBW, 1.f);
        cmp(ws + WS_X1B, 1, D, B.X3, D, MALL, D, 1.f);
        cmp(ws + WS_QM, 1, D, B.Q, D, MALL, D, 1.f / CM);
        cmp(ws + WS_OMEM, 1, D, B.OM, D, MPR, D, 1.f);
        cmp(ws + WS_OMEM + (size_t)MPR * D * 2, 1, D, B.OM + (size_t)MPR * D, D, MS, D, 1.f);
        cmp(ws + WS_X2B, 1, D, B.X2, D, MALL, D, 1.f);
        cmp(ws + WS_X2B, 1, D, B.X2, D, MALL, D, 1.f);
        cmp(ws + WS_UB, 1, FF, B.ACT, FF, MALL, FF, 1.f);
        const size_t offs[15] = {O_YP, O_YS, O_KP, O_VP, O_REP, O_IMP, O_CVP, O_MKP, O_MVP, O_KS, O_VS, O_RES, O_IMS, O_CVS, O_END};
        for (int i = 0; i < 14; ++i) cmp(fast_out + offs[i], 0, 1, no + offs[i], 1, (long)(offs[i + 1] - offs[i]), 1, 1.f);
        hipLaunchKernelGGL(k_judge, dim3(1), dim3(64), 0, stream, (const double*)chk, k, 2e-3f, (float*)d_out);
    }
#endif
}
```

```cpp
#define MK_DEBUG 0
#define MK_ONE_LAUNCH 1
#define MK_PROBE 0
#define MK_STREAM_DIV 2
#define MK_XSTAG 1
#include <hip/hip_runtime.h>
#include <cstdio>
#include <cstdint>
#include <cmath>
#include <cstring>
namespace pg8 {
#define PG8_LAS __attribute__((address_space(3)))
typedef unsigned short bf16_t;
typedef short bf16x8 __attribute__((ext_vector_type(8)));
typedef float f32x4 __attribute__((ext_vector_type(4)));
typedef unsigned u32x4 __attribute__((ext_vector_type(4)));
constexpr int BM = 256, BK = 64, HALF = 128, HTB = HALF * BK * 2  , STAGE_BYTES = 8 * HTB, NXCD = 8, WGM = 8;

__host__ __device__ __forceinline__ int lds_byte(int r, int c) { const int st = (r >> 4) * 2 + (c >> 5), rr = r & 15, cc = c & 31, ob = rr * 64 + cc * 2; return st * 1024 + (ob ^ (((ob >> 9) & 1) << 5)); }
__host__ __device__ __forceinline__ void stage_rc(int b, int& R, int& C) { const int st = b / 1024, sb = b % 1024, swz = sb ^ (((sb >> 9) & 1) << 5); R = (st >> 1) * 16 + swz / 64; C = (st & 1) * 32 + (swz % 64) / 2; }
__host__ __device__ __forceinline__ int perm32(int rho) { const int n = rho >> 4, i = rho & 15; return 8 * (i >> 2) + 4 * n + (i & 3); }

struct Unit { int pm, pn; };
struct Gemm { const bf16_t* A; const bf16_t* Bt; int lda, ldb, K; int bhalf = HALF; };

struct GridOrder {
    int nM, nN, nwg, G, c; size_t astep, bstep;
    __device__ void init(int nM_, int nN_, int G_, int c_, int shift, int lda, int ldb) { nM = nM_; nN = nN_; nwg = nM * nN; G = G_; c = (c_ + G_ - (shift % G_)) % G_; astep = (size_t)BM * lda * 2; bstep = (size_t)BM * ldb * 2; }
    __device__ bool next(int i, Unit& u) const {
        const long L = (long)i * G + c; if (L >= nwg) return false;
        int wgid = (int)L; { const int q = nwg / NXCD, r = nwg % NXCD, xcd = wgid % NXCD, off = wgid / NXCD; wgid = (xcd < r ? xcd * (q + 1) : r * (q + 1) + (xcd - r) * q) + off; }
        const int nig = WGM * nN, gid = wgid / nig, fm = gid * WGM, gsz = (nM - fm) < WGM ? (nM - fm) : WGM;
        u.pm = fm + ((wgid % nig) % gsz); u.pn = (wgid % nig) / gsz; return true;
    }
    __device__ __forceinline__ size_t aoff(const Unit& u) const { return (size_t)u.pm * astep; }
    __device__ __forceinline__ size_t boff(const Unit& u) const { return (size_t)u.pn * bstep; }
};

__device__ __forceinline__ unsigned cvt_pk_bf16(float lo, float hi) { unsigned r; asm volatile("v_cvt_pk_bf16_f32 %0, %1, %2" : "=v"(r) : "v"(lo), "v"(hi)); return r; }

template <class Epi, class Sched, bool ALIGN_EPI = true, bool SP2 = true>
__device__ __forceinline__ void gemm_phase(PG8_LAS unsigned char* lds, const Gemm g, const Sched& S, const Epi& E) {
    const int tid = threadIdx.x, wid = __builtin_amdgcn_readfirstlane(tid >> 6), lane = tid & 63, wr = wid >> 2, wc = wid & 3, fr = lane & 15, fq = lane >> 4;
    const int K = g.K, nt = K / BK;
    unsigned voffA[2], voffB[2];
#pragma unroll
    for (int i = 0; i < 2; ++i) { int R, C; stage_rc(tid * 16 + i * 8192, R, C); const int Rb = (R & ~31) + perm32(R & 31);
        voffA[i] = (unsigned)(R * g.lda + C) * 2u; voffB[i] = (unsigned)(Rb * g.ldb + C) * 2u; }
    const size_t kstep = (size_t)(BK * 2);
    const size_t hstepA = (size_t)HALF * g.lda * 2, hstepB = (size_t)g.bhalf * g.ldb * 2;
    const unsigned ldsw = (unsigned)wid * 1024u;
    const int aoff = lds_byte(wr * 64 + fr, fq * 8), boff = lds_byte(wc * 32 + fr, fq * 8);
#define PG8_SA(b, h) (((b) * 2 + (h)) * HTB)
#define PG8_SB(b, h) ((4 + (b) * 2 + (h)) * HTB)
#define PG8_STAGE(bufoff, gbase, voff) do { _Pragma("unroll") for (int _i = 0; _i < 2; ++_i) \
        __builtin_amdgcn_global_load_lds((const unsigned*)((const char*)(gbase) + (voff)[_i]), (PG8_LAS unsigned*)(lds + (bufoff) + ldsw + _i * 8192), 16, 0, 0); } while (0)
#define PG8_LDA(dst, b, h) do { _Pragma("unroll") for (int m = 0; m < 4; ++m) _Pragma("unroll") for (int k = 0; k < 2; ++k) dst[m][k] = *(const PG8_LAS bf16x8*)(lds + PG8_SA(b, h) + aoff + m * 2048 + k * 1024); } while (0)
#define PG8_LDB(dst, b, h) do { _Pragma("unroll") for (int n = 0; n < 2; ++n) _Pragma("unroll") for (int k = 0; k < 2; ++k) dst[n][k] = *(const PG8_LAS bf16x8*)(lds + PG8_SB(b, h) + boff + n * 2048 + k * 1024); } while (0)
#define PG8_MMA(ai, bj, At, Bt) do { __builtin_amdgcn_s_setprio(1); _Pragma("unroll") for (int m = 0; m < 4; ++m) _Pragma("unroll") for (int n = 0; n < 2; ++n) _Pragma("unroll") for (int k = 0; k < 2; ++k) \
        acc[ai][bj][m][n] = __builtin_amdgcn_mfma_f32_16x16x32_bf16(Bt[n][k], At[m][k], acc[ai][bj][m][n], 0, 0, 0); __builtin_amdgcn_s_setprio(0); } while (0)
#define PG8_WAIT_V(n) asm volatile("s_waitcnt vmcnt(" #n ")" ::: "memory")
#define PG8_WAIT_L(n) asm volatile("s_waitcnt lgkmcnt(" #n ")" ::: "memory")
#define PG8_BAR __builtin_amdgcn_s_barrier()
#define PG8_SCHED __builtin_amdgcn_sched_barrier(0)
    Unit cur, nxt; int ui = 0;
    if (!S.next(0, cur)) return;
    f32x4 acc[2][2][4][2];
#pragma unroll
    for (int a = 0; a < 2; ++a)
#pragma unroll
        for (int b = 0; b < 2; ++b)
#pragma unroll
            for (int m = 0; m < 4; ++m)
#pragma unroll
                for (int n = 0; n < 2; ++n) acc[a][b][m][n] = (f32x4){0.f, 0.f, 0.f, 0.f};
    bf16x8 At[4][2], B0[2][2], B1[2][2];
    const char* cA = (const char*)g.A + S.aoff(cur); const char* cB = (const char*)g.Bt + S.boff(cur);
    static_assert(SP2, "only the SP2 loop is kept in this file");
    PG8_STAGE(PG8_SB(0, 0), cB, voffB); PG8_STAGE(PG8_SB(0, 1), cB + hstepB, voffB); PG8_STAGE(PG8_SA(0, 0), cA, voffA); PG8_STAGE(PG8_SA(0, 1), cA + hstepA, voffA);
    if (wr == 1) PG8_BAR;
    PG8_WAIT_V(2); PG8_BAR;
    PG8_STAGE(PG8_SB(1, 0), cB + kstep, voffB); PG8_STAGE(PG8_SA(1, 0), cA + kstep, voffA); PG8_STAGE(PG8_SB(1, 1), cB + hstepB + kstep, voffB);
    PG8_WAIT_V(6); PG8_BAR;
    for (;;) {
        const bool has_next = S.next(ui + 1, nxt);
        const char* nA = has_next ? (const char*)g.A + S.aoff(nxt) : cA; const char* nB = has_next ? (const char*)g.Bt + S.boff(nxt) : cB;
        for (int t = 0; t < nt; t += 2) {
            const bool last = (t == nt - 2);
            const char* a1 = cA + (size_t)(t + 1) * kstep;
            const char* a2 = last ? nA : cA + (size_t)(t + 2) * kstep; const char* b2 = last ? nB : cB + (size_t)(t + 2) * kstep;
            const char* a3 = a2 + kstep; const char* b3 = b2 + kstep;
            PG8_LDB(B0, 0, 0); PG8_LDB(B1, 0, 1); PG8_SCHED; PG8_LDA(At, 0, 0); PG8_STAGE(PG8_SA(1, 1), a1 + hstepA, voffA);
            PG8_WAIT_V(8); PG8_WAIT_L(0); PG8_BAR; PG8_MMA(0, 0, At, B0); PG8_MMA(0, 1, At, B1); PG8_BAR; PG8_SCHED;
            PG8_LDA(At, 0, 1); PG8_STAGE(PG8_SB(0, 0), b2, voffB); PG8_STAGE(PG8_SB(0, 1), b2 + hstepB, voffB); PG8_STAGE(PG8_SA(0, 0), a2, voffA);
            PG8_WAIT_V(8); PG8_WAIT_L(0); PG8_BAR; PG8_MMA(1, 0, At, B0); PG8_MMA(1, 1, At, B1); PG8_BAR; PG8_SCHED;
            PG8_LDB(B0, 1, 0); PG8_LDB(B1, 1, 1); PG8_SCHED; PG8_LDA(At, 1, 0); PG8_STAGE(PG8_SA(0, 1), a2 + hstepA, voffA);
            PG8_WAIT_V(8); PG8_WAIT_L(0); PG8_BAR; PG8_MMA(0, 0, At, B0); PG8_MMA(0, 1, At, B1); PG8_BAR; PG8_SCHED;
            PG8_LDA(At, 1, 1); PG8_STAGE(PG8_SB(1, 0), b3, voffB); PG8_STAGE(PG8_SB(1, 1), b3 + hstepB, voffB); PG8_STAGE(PG8_SA(1, 0), a3, voffA);
            PG8_WAIT_V(8); PG8_WAIT_L(0); PG8_BAR; PG8_MMA(1, 0, At, B0); PG8_MMA(1, 1, At, B1); PG8_BAR; PG8_SCHED;
            if constexpr (Epi::MIDK) { if (t + 2 == nt / 2) E.mid(acc, cur, wr, wc, fr, fq); }
        }
        if constexpr (ALIGN_EPI) { if (wr == 0) PG8_BAR; }
        E(acc, cur, wr, wc, fr, fq);
        if (!has_next) break;
#pragma unroll
        for (int a = 0; a < 2; ++a)
#pragma unroll
            for (int b = 0; b < 2; ++b)
#pragma unroll
                for (int m = 0; m < 4; ++m)
#pragma unroll
                    for (int n = 0; n < 2; ++n) acc[a][b][m][n] = (f32x4){0.f, 0.f, 0.f, 0.f};
        cur = nxt; cA = nA; cB = nB; ++ui;
        if constexpr (ALIGN_EPI) { if (wr == 1) PG8_BAR; }
    }
    PG8_WAIT_V(0);
    if constexpr (!ALIGN_EPI) { if (wr == 0) PG8_BAR; }
    PG8_BAR;
#undef PG8_SA
#undef PG8_SB
#undef PG8_STAGE
#undef PG8_LDA
#undef PG8_LDB
#undef PG8_MMA
#undef PG8_WAIT_V
#undef PG8_WAIT_L
#undef PG8_BAR
#undef PG8_SCHED
}
}
constexpr int NWAVES = 8, NTHR = 512;
constexpr int D = 1024, NB = 4, T = 4096, MPR = NB * T, MS = 128, MALL = MPR + MS, MPAD = 16640;
constexpr int SBW = 512, NH = 8, HD = 64, NG = 32, GP = 16, NST = 64, INW = 2048, FF = 2816, NFF2 = 2 * FF;
constexpr int MT = 256, MH = 4, MHD = 256, PAST = 2048, PAGE = 128, NPG = 16;
constexpr int LC = 16, NCH = T / LC, XHP = 384;
constexpr float EPS = 1e-6f, LOG2E = 1.4426950408889634f;
constexpr float C2 = 0.125f * LOG2E;
constexpr float CM = 0.0625f * LOG2E;

constexpr size_t O_YP = 0, O_YS = O_YP + (size_t)MPR * D, O_KP = O_YS + (size_t)MS * D, O_VP = O_KP + (size_t)MPR * SBW, O_REP = O_VP + (size_t)MPR * SBW,
    O_IMP = O_REP + NB * NG * NST, O_CVP = O_IMP + NB * NG * NST, O_MKP = O_CVP + (size_t)NB * 2 * FF, O_MVP = O_MKP + (size_t)NB * MT * D, O_KS = O_MVP + (size_t)NB * MT * D,
    O_VS = O_KS + (size_t)MS * SBW, O_RES = O_VS + (size_t)MS * SBW, O_IMS = O_RES + (size_t)MS * NG * NST, O_CVS = O_IMS + (size_t)MS * NG * NST, O_END = O_CVS + (size_t)MS * 2 * FF;

constexpr size_t MiB = 1u << 20;
constexpr size_t al(size_t x) { return (x + 4095) & ~(size_t)4095; }
constexpr size_t WS_CTL = 0, CTL_ZERO_BYTES = 1 * MiB;
constexpr size_t WS_WIN = 1 * MiB;
constexpr size_t WS_WMKV = WS_WIN + al((size_t)INW * D * 2);
constexpr size_t WS_WGLU = WS_WMKV + al((size_t)2048 * D * 2);
constexpr size_t WS_WOUT = WS_WGLU + al((size_t)SBW * SBW * 2);
constexpr size_t WS_WMQ = WS_WOUT + al((size_t)D * D * 2);
constexpr size_t WS_WMO = WS_WMQ + al((size_t)D * D * 2);
constexpr size_t WS_WGU = WS_WMO + al((size_t)D * D * 2);
constexpr size_t WS_WDN = WS_WGU + al((size_t)NFF2 * D * 2);
constexpr size_t WS_W1 = WS_WDN + al((size_t)D * FF * 2);
constexpr size_t WS_BTC = WS_W1 + al((size_t)33 * 128 * 256 * 2);
constexpr size_t WS_XB = WS_BTC + al((size_t)NG * 256 * XHP * 2);
constexpr size_t WS_RSTD0 = WS_XB + al((size_t)MPAD * D * 2);
constexpr size_t WS_MB = WS_RSTD0 + al((size_t)MPAD * 4);
constexpr size_t WS_RSTDM = WS_MB + al((size_t)1024 * D * 2);
constexpr size_t WS_QB = WS_RSTDM + al(4096);
constexpr size_t WS_KB = WS_QB + al((size_t)MPAD * SBW * 2);
constexpr size_t WS_VB = WS_KB + al((size_t)MPAD * SBW * 2);
constexpr size_t WS_QS = WS_VB + al((size_t)MPAD * SBW * 2);
constexpr size_t WS_US = WS_QS + al((size_t)MS * SBW * 4);
constexpr size_t WS_XH = WS_US + al((size_t)MS * SBW * 4);
constexpr size_t WS_SST = WS_XH + al((size_t)1024 * NG * XHP * 2 + 65536);
constexpr size_t WS_YG = WS_SST + al((size_t)1024 * NG * 128 * 4);
constexpr size_t WS_OSB = WS_YG + al((size_t)MPAD * SBW * 2);
constexpr size_t WS_OSSM = WS_OSB + al((size_t)MPAD * SBW * 2);
constexpr size_t WS_SBPO = WS_OSSM + al((size_t)MPAD * SBW * 2);
constexpr size_t WS_SBPL = WS_SBPO + al((size_t)MS * NPG * NH * HD * 4);
constexpr size_t WS_MIX = WS_SBPL + al((size_t)MS * NPG * NH * 4);
constexpr size_t WS_X1 = WS_MIX + al((size_t)MPAD * D * 2);
constexpr size_t WS_X1B = WS_X1 + al((size_t)MPAD * D * 4);
constexpr size_t WS_MKB = WS_X1B + al((size_t)MPAD * D * 2);
constexpr size_t WS_MVB = WS_MKB + al((size_t)1024 * D * 2);
constexpr size_t WS_QM = WS_MVB + al((size_t)1024 * D * 2);
constexpr size_t WS_OMEM = WS_QM + al((size_t)MPAD * D * 2);
constexpr size_t WS_X2 = WS_OMEM + al((size_t)MPAD * D * 2);
constexpr size_t WS_X2B = WS_X2 + al((size_t)MPAD * D * 4);
constexpr size_t WS_GB = WS_X2B + al((size_t)MPAD * D * 2);
constexpr size_t WS_UB = WS_GB + al((size_t)MPAD * FF * 2);
constexpr size_t WS_FAST_END = WS_UB + al((size_t)MPAD * FF * 2);
constexpr int CW_TMO = 0, CW_CODE = 1, CW_QA = 2048, CW_QM = 2112, CW_SCNT = 2240  , CW_PCNT = 2304  , CW_BAR = 4096;
constexpr int CW_SSQ1 = 16384, CW_SSQ2 = CW_SSQ1 + MPAD, CW_SSQ3 = CW_SSQ2 + MPAD, CW_SSQD = CW_SSQ3 + MPAD, CW_SSQA = CW_SSQD + MPAD, CW_SSQB = CW_SSQA + MPAD;
static_assert((CW_SSQB + MPAD) * 4 <= (int)CTL_ZERO_BYTES, "CTL words inside the memset region");

constexpr int RING_OFF = 0, RING_BYTES = 131072;
constexpr int LDSCTL_OFF = RING_BYTES, MISC_OFF = LDSCTL_OFF + 320;
constexpr int LDS_BYTES = 147456;
static_assert(MISC_OFF + 128 <= LDS_BYTES, "LDS map");

#define GAS __attribute__((address_space(1)))
#define LAS __attribute__((address_space(3)))
typedef unsigned short bf16;
typedef unsigned v4u __attribute__((ext_vector_type(4)));
typedef unsigned v2u __attribute__((ext_vector_type(2)));
typedef float f32x4 __attribute__((ext_vector_type(4)));
typedef float f32x2 __attribute__((ext_vector_type(2)));
typedef float f32x16 __attribute__((ext_vector_type(16)));
typedef short bf16x8 __attribute__((ext_vector_type(8)));
typedef short s16x4 __attribute__((ext_vector_type(4)));
typedef GAS unsigned gu32;
#define RLX_AGENT __ATOMIC_RELAXED, __HIP_MEMORY_SCOPE_AGENT
#define LDS_WAIT() asm volatile("s_waitcnt lgkmcnt(0)" ::: "memory")
#define VM_WAIT() asm volatile("s_waitcnt vmcnt(0)" ::: "memory")
__device__ __forceinline__ unsigned f2bf(float f) { unsigned u = __builtin_bit_cast(unsigned, f); return (u + 0x7fffu + ((u >> 16) & 1u)) >> 16; }
__device__ __forceinline__ unsigned pk2(float lo, float hi) { return f2bf(lo) | (f2bf(hi) << 16); }
__device__ __forceinline__ float bf2f(unsigned short h) { return __builtin_bit_cast(float, (unsigned)h << 16); }
__device__ __forceinline__ float bflo(unsigned w) { return __builtin_bit_cast(float, w << 16); }
__device__ __forceinline__ float bfhi(unsigned w) { return __builtin_bit_cast(float, w & 0xffff0000u); }
typedef float f32x2_c __attribute__((ext_vector_type(2))); typedef __bf16 bf16x2_c __attribute__((ext_vector_type(2)));
__device__ __forceinline__ unsigned cvtpk(float lo, float hi) { f32x2_c v = {lo, hi}; bf16x2_c r = __builtin_convertvector(v, bf16x2_c); return __builtin_bit_cast(unsigned, r); }
__device__ __forceinline__ float gelu_tanh_f(float x) {
    const float u2 = 2.f * 0.7978845608028654f * (x + 0.044715f * x * x * x);
    return x * __builtin_amdgcn_rcpf(1.f + __builtin_amdgcn_exp2f(-u2 * LOG2E));
}

__device__ __forceinline__ float swap16(float v) { auto rr = __builtin_amdgcn_permlane16_swap(__float_as_uint(v), __float_as_uint(v), false, false); return __uint_as_float((threadIdx.x & 16) ? rr[0] : rr[1]); }
__device__ __forceinline__ float swap_half(float v) { auto rr = __builtin_amdgcn_permlane32_swap(__float_as_uint(v), __float_as_uint(v), false, false); return __uint_as_float((threadIdx.x & 32) ? rr[0] : rr[1]); }
__device__ __forceinline__ float wave_sum(float x) {
    x += __builtin_bit_cast(float, __builtin_amdgcn_update_dpp(0, __builtin_bit_cast(int, x), 0xB1, 0xf, 0xf, true));
    x += __builtin_bit_cast(float, __builtin_amdgcn_update_dpp(0, __builtin_bit_cast(int, x), 0x4E, 0xf, 0xf, true));
    x += __builtin_bit_cast(float, __builtin_amdgcn_update_dpp(0, __builtin_bit_cast(int, x), 0x141, 0xf, 0xf, true));
    x += __builtin_bit_cast(float, __builtin_amdgcn_update_dpp(0, __builtin_bit_cast(int, x), 0x140, 0xf, 0xf, true));
    x += swap16(x); x += swap_half(x); return x;
}
#define XB_TMO      128
#define XB_XCNT(j)  (256  + 64 * (j))
#define XB_XSUB(j)  (1280 + 64 * (j))
#define XB_XGEN(j)  (2304 + 64 * (j))
#define XB_TOP      3328
#define XB_TOPGEN   3392
#define XCD_BAR_WORDS 3456
#define XB_SPIN_CAP (1u << 18)
__device__ __forceinline__ unsigned xb_ld(unsigned* p)              { return __hip_atomic_load(p, __ATOMIC_RELAXED, __HIP_MEMORY_SCOPE_AGENT); }
__device__ __forceinline__ unsigned xb_add(unsigned* p, unsigned v) { return __hip_atomic_fetch_add(p, v, __ATOMIC_RELAXED, __HIP_MEMORY_SCOPE_AGENT); }
__device__ __forceinline__ unsigned xb_xcc_id() { return (unsigned)__builtin_amdgcn_s_getreg((3 << 11) | 20) & 0xFu; }
#define XB_SPIN(cond, bar) do { unsigned _sp = 0; while (cond) { __builtin_amdgcn_s_sleep(1); \
    if ((++_sp & 255u) == 0u) { if (xb_ld(&(bar)[XB_TMO])) break; if (_sp > XB_SPIN_CAP) { atomicAdd(&(bar)[XB_TMO], 1u); break; } } } } while (0)
struct XcdBarrier { unsigned* bar; unsigned x; volatile LAS unsigned* st; };
__device__ __forceinline__ XcdBarrier xcd_barrier_post(unsigned* bar, volatile LAS unsigned* st) {
    XcdBarrier b; b.bar = bar; b.x = xb_xcc_id(); b.st = st;
    if (threadIdx.x == 0) (void)xb_add(&bar[XB_XCNT(b.x)], 1u);
    return b;
}
__device__ __forceinline__ void xcd_barrier_complete(unsigned* bar, unsigned x, unsigned& nloc, unsigned& nx) {
    const unsigned G = gridDim.x * gridDim.y * gridDim.z;
    unsigned sum, cnt, mine, sp = 0u;
    for (;;) {
        sum = 0u; cnt = 0u; mine = 0u;
#pragma unroll
        for (unsigned j = 0; j < 16; ++j) { const unsigned c = xb_ld(&bar[XB_XCNT(j)]); sum += c; cnt += (c > 0u) ? 1u : 0u; mine = (j == x) ? c : mine; }
        if (sum == G) break;
        __builtin_amdgcn_s_sleep(1);
        if ((++sp & 255u) == 0u) { if (xb_ld(&bar[XB_TMO])) break; if (sp > XB_SPIN_CAP) { atomicAdd(&bar[XB_TMO], 1u); break; } }
    }
    nloc = mine > 0u ? mine : 1u; nx = cnt > 0u ? cnt : 1u;
}
__device__ __forceinline__ void xcd_barrier(const XcdBarrier& b) {
    asm volatile("s_waitcnt vmcnt(0)" ::: "memory");
    __syncthreads();
    if (threadIdx.x == 0) {
        unsigned* bar = b.bar;
        __builtin_amdgcn_s_waitcnt(0);
        unsigned nloc = b.st[0], nx = b.st[1];
        if (nloc == 0u) { xcd_barrier_complete(bar, b.x, nloc, nx); b.st[0] = nloc; b.st[1] = nx; }
        const unsigned old = xb_add(&bar[XB_XSUB(b.x)], 1u);
        const unsigned gen = old / nloc;
        if (old + 1u == (gen + 1u) * nloc) {
            __builtin_amdgcn_fence(__ATOMIC_RELEASE, "agent");
            asm volatile("s_waitcnt vmcnt(0)" ::: "memory");
            const unsigned og = xb_add(&bar[XB_TOP], 1u);
            const unsigned tg = og / nx;
            if (og + 1u == (tg + 1u) * nx) xb_add(&bar[XB_TOPGEN], 1u);
            else XB_SPIN(xb_ld(&bar[XB_TOPGEN]) == tg, bar);
            __builtin_amdgcn_fence(__ATOMIC_ACQUIRE, "agent");
            xb_add(&bar[XB_XGEN(b.x)], 1u);
            asm volatile("s_waitcnt vmcnt(0)" ::: "memory");
        } else {
            XB_SPIN(xb_ld(&bar[XB_XGEN(b.x)]) == gen, bar);
            __builtin_amdgcn_fence(__ATOMIC_ACQUIRE, "agent");
            asm volatile("s_waitcnt vmcnt(0)" ::: "memory");
        }
    }
    __syncthreads();
}

struct Args { const void* in[40]; float* out; unsigned char* ws; int ph_lo, ph_hi, use_bar, pad; };
struct Frame {
    LAS unsigned char* lds; volatile LAS unsigned* MISC; unsigned* ctl;
    int tid, lane, wave, vcu, G;
    unsigned char* ws; float* out; const void* const* in;
};
#define INF(i) ((const float*)F.in[i])
#define WSP(T_, off) ((T_*)(F.ws + (off)))
struct TrItem { const float* W; const float* gain; bf16* WT; int K, N, row_off, k0, n0; };
__device__ __forceinline__ void tr_load(const TrItem& t, float (&wv)[32], int lane) {
#pragma unroll
    for (int i = 0; i < 32; ++i) wv[i] = t.W[(size_t)(t.k0 + 2 * i + (lane >> 5)) * t.N + t.n0 + (lane & 31)];
}
__device__ __forceinline__ void tr_finish(const TrItem& t, const float (&wv)[32], LAS float* scr, int lane) {
#pragma unroll
    for (int i = 0; i < 32; ++i) { const int kk = 2 * i + (lane >> 5); const float gv = t.gain ? t.gain[t.k0 + kk] : 1.f; scr[kk * 33 + (lane & 31)] = wv[i] * gv; }
    LDS_WAIT(); asm volatile("" ::: "memory");
    const int c = lane & 7;
#pragma unroll
    for (int j = 0; j < 4; ++j) { const int n = (lane >> 3) + 8 * j; const LAS float* s = scr + (8 * c) * 33 + n;
        v4u o; o.x = pk2(s[0 * 33], s[1 * 33]); o.y = pk2(s[2 * 33], s[3 * 33]); o.z = pk2(s[4 * 33], s[5 * 33]); o.w = pk2(s[6 * 33], s[7 * 33]);
        *(GAS v4u*)(t.WT + (size_t)(t.row_off + t.n0 + n) * t.K + t.k0 + 8 * c) = o; }
    LDS_WAIT(); asm volatile("" ::: "memory");
}
__device__ __forceinline__ void rows2_load(const float* xrow, f32x4 (&v)[2][4], int lane) {
#pragma unroll
    for (int r = 0; r < 2; ++r)
#pragma unroll
        for (int j = 0; j < 4; ++j) v[r][j] = ((const GAS f32x4*)(xrow + (size_t)r * D) + lane)[64 * j];
}
__device__ __forceinline__ void rows2_finish(const f32x4 (&v)[2][4], bf16* orow, float* rstd, int lane) {
    float s[2] = {0.f, 0.f};
#pragma unroll
    for (int r = 0; r < 2; ++r) {
#pragma unroll
        for (int j = 0; j < 4; ++j) s[r] += (v[r][j].x * v[r][j].x + v[r][j].y * v[r][j].y) + (v[r][j].z * v[r][j].z + v[r][j].w * v[r][j].w);
        GAS v2u* o8 = (GAS v2u*)(orow + (size_t)r * D) + lane;
#pragma unroll
        for (int j = 0; j < 4; ++j) { v2u w; w.x = pk2(v[r][j].x, v[r][j].y); w.y = pk2(v[r][j].z, v[r][j].w); o8[64 * j] = w; }
    }
    s[0] = wave_sum(s[0]); s[1] = wave_sum(s[1]);
    if (lane < 2) rstd[lane] = 1.f / sqrtf((lane ? s[1] : s[0]) * (1.f / D) + EPS);
}
__device__ __forceinline__ void lam_pow(float lr, float li, float logdt, int tau, float& pr, float& pi) {
    const double dt = exp((double)logdt);
    const double ang = (double)li * dt * (double)tau;
    const double k = rint(ang * 0.15915494309189535);
    double r = fma(-k, 6.283185307179586, ang); r = fma(-k, 2.4492935982947064e-16, r);
    const float rf = (float)r, mag = (float)exp((double)lr * dt * (double)tau);
    pr = mag * cosf(rf); pi = mag * sinf(rf);
}
__device__ __forceinline__ void lam_coef(float lr, float li, float logdt, float& cr, float& ci) {
    const double dt = exp((double)logdt);
    const double ang = (double)li * dt;
    const double k = rint(ang * 0.15915494309189535);
    double r = fma(-k, 6.283185307179586, ang); r = fma(-k, 2.4492935982947064e-16, r);
    const float th = (float)r, a = (float)((double)lr * dt);
    const float sh = sinf(0.5f * th);
    const float nr = expm1f(a) * cosf(th) - 2.f * sh * sh, ni = expf(a) * sinf(th);
    const float den = lr * lr + li * li;
    cr = (nr * lr + ni * li) / den; ci = (ni * lr - nr * li) / den;
}
__device__ __forceinline__ void ssm_table_unit(Frame& F, int g, int tau) {
    LAS float* Mr = (LAS float*)(F.lds + RING_OFF); LAS float* Mi = Mr + 1024; LAS float* Pr = Mi + 1024; LAS float* Pi = Pr + 64; LAS float* Cr = Pi + 64; LAS float* Ci = Cr + 64;
    LAS float* Kt = Ci + 64; LAS float* CRE = Kt + 256; LAS float* CIM = CRE + 1024; LAS float* Qr = CIM + 1024; LAS float* Qi = Qr + 64;
    const float* lam_re = INF(14); const float* lam_im = INF(15); const float* log_dt = INF(16); const float* b_re = INF(17); const float* b_im = INF(18);
    const float* c_re = INF(19); const float* c_im = INF(20); const float* d_skip = INF(21);
    bf16* W1 = WSP(bf16, WS_W1); bf16* BTC = WSP(bf16, WS_BTC);
    const int tid = F.tid; const float ldt = log_dt[g];
    __syncthreads();
    if (tid < 64) { float pr, pi, cr, ci; const float lr = lam_re[g * NST + tid], li = lam_im[g * NST + tid]; lam_pow(lr, li, ldt, tau, pr, pi); lam_coef(lr, li, ldt, cr, ci); Pr[tid] = pr; Pi[tid] = pi; Cr[tid] = cr; Ci[tid] = ci; lam_pow(lr, li, ldt, tau + 1, pr, pi); Qr[tid] = pr; Qi[tid] = pi; }
    for (int i = tid; i < 1024; i += NTHR) { CRE[i] = c_re[g * 1024 + i]; CIM[i] = c_im[g * 1024 + i]; }
    __syncthreads();
    for (int i = tid; i < 1024; i += NTHR) { const int n = i >> 4; const float cr = Cr[n], ci = Ci[n];
        const float br = b_re[g * 1024 + i], bi = b_im[g * 1024 + i]; const float bbr = cr * br - ci * bi, bbi = cr * bi + ci * br;
        const float pr = Pr[n], pi = Pi[n]; Mr[i] = pr * bbr - pi * bbi; Mi[i] = pr * bbi + pi * bbr; }
    __syncthreads();
    {
        const int s = 15 - tau;
        for (int i = tid; i < 2048; i += NTHR) { const int n = i >> 5, ri = (i >> 4) & 1, q = i & 15; const float v = ri ? Mi[n * 16 + q] : Mr[n * 16 + q];
            W1[((size_t)g * 128 + 2 * n + ri) * 256 + s * 16 + q] = (bf16)f2bf(v); }
        if (tid < 256) { const int p = tid >> 4, q = tid & 15; float acc = 0.f;
#pragma unroll 8
            for (int n = 0; n < NST; ++n) acc += CRE[p * NST + n] * Mr[n * 16 + q] - CIM[p * NST + n] * Mi[n * 16 + q];
            if (tau == 0 && p == q) acc += d_skip[g * GP + p];
            Kt[tid] = acc; }
        __syncthreads();
        for (int idx = tid; idx < (16 - tau) * 256; idx += NTHR) { const int blk = idx >> 8, e = idx & 255, p = e >> 4, q = e & 15; const int s2 = blk, t2 = s2 + tau;
            BTC[((size_t)g * 256 + t2 * 16 + p) * XHP + s2 * 16 + q] = (bf16)f2bf(Kt[e]);
            if (tau >= 1) BTC[((size_t)g * 256 + s2 * 16 + p) * XHP + t2 * 16 + q] = (bf16)0; }
    }
    {
        for (int idx = tid; idx < 1024; idx += NTHR) { const int p = idx >> 6, n = idx & 63; const float cr = CRE[idx], ci = CIM[idx], pr = Qr[n], pi = Qi[n];
            const unsigned w = pk2(cr * pr - ci * pi, -(cr * pi + ci * pr));
            *(GAS unsigned*)(BTC + ((size_t)g * 256 + tau * 16 + p) * XHP + 256 + 2 * n) = w; }
    }
    __syncthreads();
}
__device__ __forceinline__ TrItem tr_item(Frame& F, int it) {
    constexpr int I_IN = 16 * 64, I_MK = 16 * 32, I_GLU = 8 * 16, I_SQ = 16 * 32, I_G = 16 * 88;
    TrItem t; int r = it; t.row_off = 0; t.K = D;
    if (r < I_IN) { t.W = INF(12); t.N = INW; t.WT = WSP(bf16, WS_WIN); t.gain = INF(11); }
    else if ((r -= I_IN) < I_MK) { t.W = INF(30); t.N = D; t.WT = WSP(bf16, WS_WMKV); t.gain = INF(28); }
    else if ((r -= I_MK) < I_MK) { t.W = INF(31); t.N = D; t.WT = WSP(bf16, WS_WMKV); t.gain = INF(28); t.row_off = D; }
    else if ((r -= I_MK) < I_GLU) { t.W = INF(22); t.N = SBW; t.K = SBW; t.WT = WSP(bf16, WS_WGLU); t.gain = nullptr; }
    else if ((r -= I_GLU) < I_SQ) { t.W = INF(26); t.N = D; t.WT = WSP(bf16, WS_WOUT); t.gain = (r / (D / 32) < 8) ? INF(24) : INF(25) - SBW; }
    else if ((r -= I_SQ) < I_SQ) { t.W = INF(29); t.N = D; t.WT = WSP(bf16, WS_WMQ); t.gain = INF(27); }
    else if ((r -= I_SQ) < I_SQ) { t.W = INF(32); t.N = D; t.WT = WSP(bf16, WS_WMO); t.gain = nullptr; }
    else if ((r -= I_SQ) < I_G) { t.W = INF(34); t.N = FF; t.WT = WSP(bf16, WS_WGU); t.gain = INF(33); }
    else if ((r -= I_G) < I_G) { t.W = INF(35); t.N = FF; t.WT = WSP(bf16, WS_WGU); t.gain = INF(33); t.row_off = FF; }
    else { r -= I_G; t.W = INF(38); t.N = D; t.K = FF; t.WT = WSP(bf16, WS_WDN); t.gain = nullptr; }
    const int nblk = t.N / 32; t.k0 = 64 * (r / nblk); t.n0 = 32 * (r % nblk); return t;
}
constexpr int NITEMS_EARLY = 16 * 64 + 2 * 16 * 32, NITEMS_GLU = NITEMS_EARLY + 8 * 16, NITEMS_ALL = 16 * 64 + 2 * 16 * 32 + 8 * 16 + 3 * 16 * 32 + 2 * 16 * 88 + 44 * 32;
constexpr int NITEMS_MID = NITEMS_GLU + 3 * 16 * 32 + 16 * 88;
__device__ __forceinline__ void weight_copies(Frame& F, int lo, int hi, int cu0 = 0, int ncu = 0) {
    LAS float* scr = (LAS float*)(F.lds + RING_OFF + F.wave * 16384);
    if (ncu && ((int)blockIdx.x < cu0 || (int)blockIdx.x >= cu0 + ncu)) return;
    const int gw = (ncu ? (int)blockIdx.x - cu0 : F.vcu) * NWAVES + F.wave, NGW = (ncu ? ncu : F.G) * NWAVES;
    if (lo + gw < hi) {
        float wa[32], wb[32]; TrItem ta = tr_item(F, lo + gw), tb; tr_load(ta, wa, F.lane);
        for (int it = lo + gw; it < hi; it += NGW) {
            const bool more = it + NGW < hi;
            if (more) { tb = tr_item(F, it + NGW); tr_load(tb, wb, F.lane); }
            tr_finish(ta, wa, scr, F.lane);
            if (more) { ta = tb;
#pragma unroll
                for (int i = 0; i < 32; ++i) wa[i] = wb[i]; }
        }
    }
}
__device__ __forceinline__ void p0_prologue(Frame& F) {
    LAS float* scr = (LAS float*)(F.lds + RING_OFF + F.wave * 16384);
    const int gw = F.vcu * NWAVES + F.wave, NGW = F.G * NWAVES;
    weight_copies(F, 0, NITEMS_EARLY);
    {
        f32x4 va[2][4], vb[2][4];
        auto src = [&](int m) -> const float* { return (m < MPR) ? INF(0) + (size_t)m * D : (m < MALL) ? INF(1) + (size_t)(m - MPR) * D : INF(10) + (size_t)(m - MALL) * D; };
        constexpr int NR = MALL + NB * MT;
        int m = 2 * gw;
        if (m < NR) { rows2_load(src(m), va, F.lane);
            for (; m < NR; m += 2 * NGW) {
                const bool more = m + 2 * NGW < NR;
                if (more) rows2_load(src(m + 2 * NGW), vb, F.lane);
                if (m < MALL) rows2_finish(va, WSP(bf16, WS_XB) + (size_t)m * D, WSP(float, WS_RSTD0) + m, F.lane);
                else rows2_finish(va, WSP(bf16, WS_MB) + (size_t)(m - MALL) * D, WSP(float, WS_RSTDM) + (m - MALL), F.lane);
                if (more) {
#pragma unroll
                    for (int r = 0; r < 2; ++r)
#pragma unroll
                        for (int j = 0; j < 4; ++j) va[r][j] = vb[r][j]; }
            } }
    }
    for (int u = F.vcu; u < NG * 16; u += F.G) ssm_table_unit(F, u >> 4, u & 15);
    { bf16* W1 = WSP(bf16, WS_W1); for (int i = gw * 64 + F.lane; i < 128 * 256 / 8; i += NGW * 64) *(GAS v4u*)(W1 + (size_t)32 * 128 * 256 + (size_t)i * 8) = (v4u){0u, 0u, 0u, 0u}; }
}

constexpr int HALO_OFF_C = RING_BYTES + 1024;
#define EPI_LOOP_BEGIN \
    _Pragma("unroll") for (int ai = 0; ai < 2; ++ai) _Pragma("unroll") for (int m = 0; m < 4; ++m) { const int row = u.pm * 256 + ai * 128 + wr * 64 + m * 16 + fr; \
    _Pragma("unroll") for (int bj = 0; bj < 2; ++bj) { const int col = u.pn * 256 + bj * 128 + wc * 32 + 8 * fq; f32x4 v0 = acc[ai][bj][m][0], v1 = acc[ai][bj][m][1];
#define EPI_LOOP_END } }
__device__ __forceinline__ v4u pack8(f32x4 a, f32x4 b) { v4u w; w.x = cvtpk(a[0], a[1]); w.y = cvtpk(a[2], a[3]); w.z = cvtpk(b[0], b[1]); w.w = cvtpk(b[2], b[3]); return w; }

struct EpiInProj { static constexpr bool MIDK = false;
    const float* rstd; bf16 *QBp, *KBp, *VBp, *XHp; float *QSp, *USp, *out;
    __device__ __forceinline__ void operator()(const f32x4 (&acc)[2][2][4][2], const pg8::Unit& u, int wr, int wc, int fr_, int fq_) const { int fr = fr_, fq = fq_; asm volatile("" : "+v"(fr), "+v"(fq));
        const int sect = u.pn >> 1;
        EPI_LOOP_BEGIN
            if (row < MALL) {
                const float rs = rstd[row]; v0 = v0 * rs; v1 = v1 * rs;
                const int c = col - sect * SBW;
                if (sect == 0) { v0 = v0 * C2; v1 = v1 * C2; *(v4u*)(QBp + (size_t)row * SBW + c) = pack8(v0, v1);
                    if (row >= MPR) { float* q = QSp + (size_t)(row - MPR) * SBW + c; *(f32x4*)q = v0; *(f32x4*)(q + 4) = v1; } }
                else if (sect == 1 || sect == 2) { bf16* B = (sect == 1) ? KBp : VBp; *(v4u*)(B + (size_t)row * SBW + c) = pack8(v0, v1);
                    float* o = (row < MPR) ? out + (sect == 1 ? O_KP : O_VP) + (size_t)row * SBW + c : out + (sect == 1 ? O_KS : O_VS) + (size_t)(row - MPR) * SBW + c;
                    *(f32x4*)o = v0; *(f32x4*)(o + 4) = v1; }
                else { if (row < MPR) { const int b = row >> 12, t = row & 4095, ch = t >> 4, s = t & 15, g = c >> 4, q0 = c & 15;
                        *(v4u*)(XHp + ((size_t)(b * NCH + ch) * NG + g) * XHP + s * 16 + q0) = pack8(v0, v1); }
                    else { float* q = USp + (size_t)(row - MPR) * SBW + c; *(f32x4*)q = v0; *(f32x4*)(q + 4) = v1; } }
            }
        EPI_LOOP_END
    }
};
struct EpiMemKV { static constexpr bool MIDK = false;
    const float* rstd; bf16 *MKBp, *MVBp; float* out;
    __device__ __forceinline__ void operator()(const f32x4 (&acc)[2][2][4][2], const pg8::Unit& u, int wr, int wc, int fr_, int fq_) const { int fr = fr_, fq = fq_; asm volatile("" : "+v"(fr), "+v"(fq));
        const int sect = u.pn >> 2;
        EPI_LOOP_BEGIN
            const float rs = rstd[row]; v0 = v0 * rs; v1 = v1 * rs; const int c = col - sect * D;
            bf16* B = sect ? MVBp : MKBp; *(v4u*)(B + (size_t)row * D + c) = pack8(v0, v1);
            float* o = out + (sect ? O_MVP : O_MKP) + (size_t)row * D + c; *(f32x4*)o = v0; *(f32x4*)(o + 4) = v1;
        EPI_LOOP_END
    }
};
struct EpiSsmA { static constexpr bool MIDK = false;
    float* SST;
    __device__ __forceinline__ void operator()(const f32x4 (&acc)[2][2][4][2], const pg8::Unit& u, int wr, int wc, int fr_, int fq_) const { int fr = fr_, fq = fq_; asm volatile("" : "+v"(fr), "+v"(fq));
        _Pragma("unroll") for (int ai = 0; ai < 2; ++ai) _Pragma("unroll") for (int m = 0; m < 4; ++m) { const int row = u.pm * 256 + ai * 128 + wr * 64 + m * 16 + fr;
            const int col = wc * 32 + 8 * fq; float* o = SST + ((size_t)row * NG + u.pn) * 128 + col; *(f32x4*)o = acc[ai][0][m][0]; *(f32x4*)(o + 4) = acc[ai][0][m][1]; }
    }
};
struct EpiSsmC { static constexpr bool MIDK = false;
    bf16* YG;
    __device__ __forceinline__ void operator()(const f32x4 (&acc)[2][2][4][2], const pg8::Unit& u, int wr, int wc, int fr_, int fq_) const { int fr = fr_, fq = fq_; asm volatile("" : "+v"(fr), "+v"(fq));
        _Pragma("unroll") for (int ai = 0; ai < 2; ++ai) _Pragma("unroll") for (int m = 0; m < 4; ++m) { const int ch = ai * 128 + wr * 64 + m * 16 + fr;
            _Pragma("unroll") for (int bj = 0; bj < 2; ++bj) { const int col = bj * 128 + wc * 32 + 8 * fq, t = col >> 4, p0 = col & 15; f32x4 v0 = acc[ai][bj][m][0], v1 = acc[ai][bj][m][1];
                _Pragma("unroll") for (int e = 0; e < 4; ++e) { v0[e] = gelu_tanh_f(v0[e]); v1[e] = gelu_tanh_f(v1[e]); }
                *(v4u*)(YG + ((size_t)u.pm * T + ch * LC + t) * SBW + u.pn * GP + p0) = pack8(v0, v1); } }
    }
};
struct EpiGlu { static constexpr bool MIDK = false;
    const bf16* YG; const float* bglu; bf16* MIXU; float* ssq;
    __device__ __forceinline__ void operator()(const f32x4 (&acc)[2][2][4][2], const pg8::Unit& u, int wr, int wc, int fr_, int fq_) const { int fr = fr_, fq = fq_; asm volatile("" : "+v"(fr), "+v"(fq));
        _Pragma("unroll") for (int ai = 0; ai < 2; ++ai) _Pragma("unroll") for (int m = 0; m < 4; ++m) { const int row = u.pm * 256 + ai * 128 + wr * 64 + m * 16 + fr; float sq = 0.f;
            _Pragma("unroll") for (int bj = 0; bj < 2; ++bj) { const int col = u.pn * 256 + bj * 128 + wc * 32 + 8 * fq; f32x4 v0 = acc[ai][bj][m][0], v1 = acc[ai][bj][m][1];
                const v4u yw = *(const v4u*)(YG + (size_t)row * SBW + col); const f32x4 b0 = *(const f32x4*)(bglu + col), b1 = *(const f32x4*)(bglu + col + 4);
                const float y[8] = {bflo(yw.x), bfhi(yw.x), bflo(yw.y), bfhi(yw.y), bflo(yw.z), bfhi(yw.z), bflo(yw.w), bfhi(yw.w)};
                _Pragma("unroll") for (int e = 0; e < 4; ++e) { v0[e] = y[e] * __builtin_amdgcn_rcpf(1.f + __builtin_amdgcn_exp2f(-(v0[e] + b0[e]) * LOG2E));
                                                                 v1[e] = y[4 + e] * __builtin_amdgcn_rcpf(1.f + __builtin_amdgcn_exp2f(-(v1[e] + b1[e]) * LOG2E)); }
                *(v4u*)(MIXU + (size_t)row * D + SBW + col) = pack8(v0, v1);
                sq += (v0[0] * v0[0] + v0[1] * v0[1]) + (v0[2] * v0[2] + v0[3] * v0[3]) + (v1[0] * v1[0] + v1[1] * v1[1]) + (v1[2] * v1[2] + v1[3] * v1[3]); }
            sq += swap16(sq); sq += swap_half(sq);
            if (fq == 0) atomicAdd(ssq + row, sq); }
    }
};
struct EpiResid { static constexpr bool MIDK = false;
    const float* base0; const float* base1; float* xo; bf16* xb; float* ssq;
    __device__ __forceinline__ void operator()(const f32x4 (&acc)[2][2][4][2], const pg8::Unit& u, int wr, int wc, int fr_, int fq_) const { int fr = fr_, fq = fq_; asm volatile("" : "+v"(fr), "+v"(fq));
        _Pragma("unroll") for (int ai = 0; ai < 2; ++ai) _Pragma("unroll") for (int m = 0; m < 4; ++m) { const int row = u.pm * 256 + ai * 128 + wr * 64 + m * 16 + fr; float sq = 0.f;
            const bool ok = row < MALL; const float* bp = (row < MPR) ? base0 + (size_t)row * D : base1 + (size_t)(row - MPR) * D;
            _Pragma("unroll") for (int bj = 0; bj < 2; ++bj) { const int col = u.pn * 256 + bj * 128 + wc * 32 + 8 * fq; f32x4 v0 = acc[ai][bj][m][0], v1 = acc[ai][bj][m][1];
                if (ok) { v0 = v0 + *(const f32x4*)(bp + col); v1 = v1 + *(const f32x4*)(bp + col + 4);
                    if (xo) { float* o = xo + (size_t)row * D + col; *(f32x4*)o = v0; *(f32x4*)(o + 4) = v1; }
                    if (xb) *(v4u*)(xb + (size_t)row * D + col) = pack8(v0, v1);
                    sq += (v0[0] * v0[0] + v0[1] * v0[1]) + (v0[2] * v0[2] + v0[3] * v0[3]) + (v1[0] * v1[0] + v1[1] * v1[1]) + (v1[2] * v1[2] + v1[3] * v1[3]); } }
            sq += swap16(sq); sq += swap_half(sq);
            if (ok && fq == 0) atomicAdd(ssq + row, sq); }
    }
};
struct EpiScaleBf16 { static constexpr bool MIDK = false;
    const float* ssq; float scale; bf16* O;
    __device__ __forceinline__ void operator()(const f32x4 (&acc)[2][2][4][2], const pg8::Unit& u, int wr, int wc, int fr_, int fq_) const { int fr = fr_, fq = fq_; asm volatile("" : "+v"(fr), "+v"(fq));
        EPI_LOOP_BEGIN
            if (row < MALL) { const float rs = scale / sqrtf(ssq[row] * (1.f / D) + EPS); v0 = v0 * rs; v1 = v1 * rs; *(v4u*)(O + (size_t)row * D + col) = pack8(v0, v1); }
        EPI_LOOP_END
    }
};
struct EpiGateUp { static constexpr bool MIDK = false;
    const float* ssq; bf16 *GBp, *UBp; float* out;
    __device__ __forceinline__ void operator()(const f32x4 (&acc)[2][2][4][2], const pg8::Unit& u, int wr, int wc, int fr_, int fq_) const { int fr = fr_, fq = fq_; asm volatile("" : "+v"(fr), "+v"(fq));
        const bool up = u.pn >= 11;
        EPI_LOOP_BEGIN
            if (row < MALL) { const float rs = 1.f / sqrtf(ssq[row] * (1.f / D) + EPS); v0 = v0 * rs; v1 = v1 * rs;
                if (up) *(v4u*)(UBp + (size_t)row * FF + (col - FF)) = pack8(v0, v1);
                else { *(v4u*)(GBp + (size_t)row * FF + col) = pack8(v0, v1);
                    if (row >= MPR) { float* o = out + O_CVS + ((size_t)(row - MPR) * 2 + 1) * FF + col; *(f32x4*)o = v0; *(f32x4*)(o + 4) = v1; }
                    else { const int t = row & 4095; if (t >= T - 2) { float* o = out + O_CVP + ((size_t)(row >> 12) * 2 + (t - (T - 2))) * FF + col; *(f32x4*)o = v0; *(f32x4*)(o + 4) = v1; } } } }
        EPI_LOOP_END
    }
};
struct SsmOrder {
    int G, c; size_t bstride;
    __device__ bool next(int i, pg8::Unit& u) const { const int L = i * G + c; if (L >= NG * NB) return false; u.pn = L >> 2; u.pm = L & 3; return true; }
    __device__ __forceinline__ size_t aoff(const pg8::Unit& u) const { return ((size_t)u.pm * NCH * NG * XHP + (size_t)u.pn * XHP) * 2; }
    __device__ __forceinline__ size_t boff(const pg8::Unit& u) const { return (size_t)u.pn * bstride; }
};
template <class Epi>
__device__ __forceinline__ void skinny_gemm(Frame& F, const bf16* A, int lda, const bf16* Bt, int ldb, int N, int K, const Epi& E, int u0, int ustride, int ustep = 32, int nb1off = 16) {
    const int lane = F.lane, wid = F.wave; const int kw = K >> 3, nks = kw >> 5;
    LAS float* red = (LAS float*)(F.lds + RING_OFF);
    for (int u = u0; u < 2 * (N / ustep); u += ustride) {
        const int uc = u >> 1, rh = u & 1;
        f32x4 acc[2][4];
#pragma unroll
        for (int nb = 0; nb < 2; ++nb)
#pragma unroll
            for (int mb = 0; mb < 4; ++mb) acc[nb][mb] = (f32x4){0.f, 0.f, 0.f, 0.f};
        const bf16* wp = Bt + (size_t)(uc * ustep + (lane & 15)) * ldb + wid * kw + 8 * (lane >> 4);
        const bf16* ap = A + (size_t)(rh * 64 + (lane & 15)) * lda + wid * kw + 8 * (lane >> 4);
#pragma unroll 1
        for (int ks0 = 0; ks0 < nks; ks0 += 4) {
            bf16x8 wf[4][2], af[4][4];
#pragma unroll
            for (int j = 0; j < 4; ++j) { const int ks = (ks0 + j < nks) ? ks0 + j : nks - 1;
                wf[j][0] = *(const bf16x8*)(wp + ks * 32); wf[j][1] = *(const bf16x8*)(wp + (size_t)nb1off * ldb + ks * 32);
#pragma unroll
                for (int mb = 0; mb < 4; ++mb) af[j][mb] = *(const bf16x8*)(ap + (size_t)mb * 16 * lda + ks * 32); }
#pragma unroll
            for (int j = 0; j < 4; ++j) if (ks0 + j < nks) {
#pragma unroll
                for (int nb = 0; nb < 2; ++nb)
#pragma unroll
                    for (int mb = 0; mb < 4; ++mb) acc[nb][mb] = __builtin_amdgcn_mfma_f32_16x16x32_bf16(wf[j][nb], af[j][mb], acc[nb][mb], 0, 0, 0); }
        }
        __syncthreads();
#pragma unroll
        for (int nb = 0; nb < 2; ++nb)
#pragma unroll
            for (int mb = 0; mb < 4; ++mb) *(LAS f32x4*)(red + ((wid * 8 + nb * 4 + mb) * 64 + lane) * 4) = acc[nb][mb];
        __syncthreads();
        if constexpr (!Epi::PAIR) { const int blk = F.tid >> 6, l = F.tid & 63;
            f32x4 s = {0.f, 0.f, 0.f, 0.f}, s2 = {0.f, 0.f, 0.f, 0.f};
#pragma unroll
            for (int w = 0; w < 4; ++w) s = s + *(const LAS f32x4*)(red + ((w * 8 + blk) * 64 + l) * 4);
#pragma unroll
            for (int w = 4; w < 8; ++w) s2 = s2 + *(const LAS f32x4*)(red + ((w * 8 + blk) * 64 + l) * 4);
            const int em = rh * 64 + 16 * (blk & 3) + (l & 15), en = uc * 32 + 16 * (blk >> 2) + 4 * (l >> 4);
            if constexpr (Epi::STATS) {
                float sq; if constexpr (Epi::SPLIT2) sq = E(em, en, s, s2); else sq = E(em, en, s + s2);
                sq += swap16(sq); sq += swap_half(sq);
                LAS float* r2 = red + 8 * 8 * 64 * 4;
                if ((l >> 4) == 0) r2[blk * 16 + (l & 15)] = sq;
                __syncthreads();
                if (F.tid < 64) atomicAdd(E.ssq + MPR + rh * 64 + F.tid, r2[(F.tid >> 4) * 16 + (F.tid & 15)] + r2[(4 + (F.tid >> 4)) * 16 + (F.tid & 15)]);
            } else {
                if constexpr (Epi::SPLIT2) E(em, en, s, s2);
                else E(em, en, s + s2); } }
        else if (F.tid < 256) { const int mb = F.tid >> 6, l = F.tid & 63;
            f32x4 s0 = {0.f, 0.f, 0.f, 0.f}, s1 = {0.f, 0.f, 0.f, 0.f};
#pragma unroll
            for (int w = 0; w < 8; ++w) { s0 = s0 + *(const LAS f32x4*)(red + ((w * 8 + mb) * 64 + l) * 4); s1 = s1 + *(const LAS f32x4*)(red + ((w * 8 + 4 + mb) * 64 + l) * 4); }
            E(rh * 64 + 16 * mb + (l & 15), uc * 16 + 4 * (l >> 4), s0, s1); }
    }
    __syncthreads();
}
__device__ __forceinline__ v2u pack4(f32x4 a) { v2u w; w.x = cvtpk(a[0], a[1]); w.y = cvtpk(a[2], a[3]); return w; }
struct SkInProj { static constexpr bool STATS = false; static constexpr bool SPLIT2 = false; static constexpr bool PAIR = false;
    const float* rstd; bf16* QBp; float *QSp, *USp, *out;
    __device__ __forceinline__ void operator()(int m, int n, f32x4 v) const {
        v = v * rstd[MPR + m]; const int sect = n >> 9, c = n & 511;
        if (sect == 0) { v = v * C2; *(f32x4*)(QSp + (size_t)m * SBW + c) = v; }
        else if (sect == 1) *(f32x4*)(out + O_KS + (size_t)m * SBW + c) = v;
        else if (sect == 2) *(f32x4*)(out + O_VS + (size_t)m * SBW + c) = v;
        else *(f32x4*)(USp + (size_t)m * SBW + c) = v;
    }
};
struct SkGlu { static constexpr bool STATS = true; static constexpr bool SPLIT2 = false; static constexpr bool PAIR = false;
    const bf16* YG; const float* bglu; bf16* MIXU; float* ssq;
    __device__ __forceinline__ float operator()(int m, int n, f32x4 v) const {
        const v2u yw = *(const v2u*)(YG + (size_t)(MPR + m) * SBW + n); const f32x4 b = *(const f32x4*)(bglu + n);
        const float y[4] = {bflo(yw.x), bfhi(yw.x), bflo(yw.y), bfhi(yw.y)};
#pragma unroll
        for (int e = 0; e < 4; ++e) v[e] = y[e] * __builtin_amdgcn_rcpf(1.f + __builtin_amdgcn_exp2f(-(v[e] + b[e]) * LOG2E));
        *(v2u*)(MIXU + (size_t)(MPR + m) * D + SBW + n) = pack4(v);
        return (v[0] * v[0] + v[1] * v[1]) + (v[2] * v[2] + v[3] * v[3]);
    }
};
struct SkResid { static constexpr bool STATS = true; static constexpr bool SPLIT2 = false; static constexpr bool PAIR = false;
    const float* base; float* xo; bf16* xb; float* ssq;
    __device__ __forceinline__ float operator()(int m, int n, f32x4 v) const {
        v = v + *(const f32x4*)(base + (size_t)m * D + n); const size_t o = (size_t)(MPR + m) * D + n;
        if (xo) *(f32x4*)(xo + o) = v; if (xb) *(v2u*)(xb + o) = pack4(v);
        return (v[0] * v[0] + v[1] * v[1]) + (v[2] * v[2] + v[3] * v[3]);
    }
};
struct SkScale { static constexpr bool STATS = false; static constexpr bool SPLIT2 = false; static constexpr bool PAIR = false;
    const float* ssq; float scale; bf16* O;
    __device__ __forceinline__ void operator()(int m, int n, f32x4 v) const {
        const float rs = scale / sqrtf(ssq[MPR + m] * (1.f / D) + EPS); v = v * rs; *(v2u*)(O + (size_t)(MPR + m) * D + n) = pack4(v);
    }
};
struct SkGateUp { static constexpr bool STATS = false; static constexpr bool SPLIT2 = false; static constexpr bool PAIR = false;
    const float* ssq; bf16 *GBp, *UBp; float* out;
    __device__ __forceinline__ void operator()(int m, int n, f32x4 v) const {
        const float rs = 1.f / sqrtf(ssq[MPR + m] * (1.f / D) + EPS); v = v * rs;
        if (n >= FF) *(v2u*)(UBp + (size_t)(MPR + m) * FF + (n - FF)) = pack4(v);
        else { *(v2u*)(GBp + (size_t)(MPR + m) * FF + n) = pack4(v); *(f32x4*)(out + O_CVS + ((size_t)m * 2 + 1) * FF + n) = v; }
    }
};

constexpr int HALO_OFF = RING_BYTES + 1024;
__device__ __forceinline__ float dpp_ror1(float x) { return __builtin_bit_cast(float, __builtin_amdgcn_update_dpp(0, __builtin_bit_cast(int, x), 0x121, 0xf, 0xf, true)); }
__device__ __forceinline__ float dpp_ror2(float x) { return __builtin_bit_cast(float, __builtin_amdgcn_update_dpp(0, __builtin_bit_cast(int, x), 0x122, 0xf, 0xf, true)); }
struct EpiGateUpConv { static constexpr bool MIDK = false;
    const float* ssq; bf16* ACT; float* out; const float* cw; const float* cb; LAS float* halo;
    __device__ __forceinline__ void operator()(const f32x4 (&acc)[2][2][4][2], const pg8::Unit& u, int wr, int wc, int fr_, int fq_) const {
        int fr = fr_, fq = fq_; asm volatile("" : "+v"(fr), "+v"(fq));
        const int cl = wc * 32 + 8 * fq, col = u.pn * 128 + cl, prow0 = u.pm * 254;
        float rs[2][4];
#pragma unroll
        for (int ai = 0; ai < 2; ++ai)
#pragma unroll
            for (int m = 0; m < 4; ++m) { const int row = prow0 + ai * 128 + wr * 64 + m * 16 + fr; rs[ai][m] = (row < MPR) ? 1.f / sqrtf(ssq[row < MPR ? row : 0] * (1.f / D) + EPS) : 0.f; }
        if (fr >= 14) {
#pragma unroll
            for (int ai = 0; ai < 2; ++ai) { LAS float* hp = halo + (((2 * ai + wr) * 2 + (fr - 14)) * 128 + cl); *(LAS f32x4*)hp = acc[ai][0][3][0] * rs[ai][3]; *(LAS f32x4*)(hp + 4) = acc[ai][0][3][1] * rs[ai][3]; }
        }
        asm volatile("s_waitcnt lgkmcnt(0)\n\ts_barrier" ::: "memory");
        f32x4 w0[2], w1[2], w2[2], bb[2];
#pragma unroll
        for (int n = 0; n < 2; ++n) { w0[n] = *(const f32x4*)(cw + col + 4 * n); w1[n] = *(const f32x4*)(cw + FF + col + 4 * n); w2[n] = *(const f32x4*)(cw + 2 * FF + col + 4 * n); bb[n] = *(const f32x4*)(cb + col + 4 * n); }
#pragma unroll
        for (int ai = 0; ai < 2; ++ai) {
            const int blk = 2 * ai + wr;
            f32x4 r1p[2], r2p[2];
            if (blk == 0) { r1p[0] = r1p[1] = r2p[0] = r2p[1] = (f32x4){0.f, 0.f, 0.f, 0.f}; }
            else { const LAS float* hb = halo + ((blk - 1) * 2) * 128 + cl;
                const f32x4 a0 = *(const LAS f32x4*)hb, a1 = *(const LAS f32x4*)(hb + 4), b0 = *(const LAS f32x4*)(hb + 128), b1 = *(const LAS f32x4*)(hb + 132);
                r1p[0] = b0; r1p[1] = b1; r2p[0] = (fr == 0) ? a0 : b0; r2p[1] = (fr == 0) ? a1 : b1; }
#pragma unroll
            for (int m = 0; m < 4; ++m) {
                const int lr = ai * 128 + wr * 64 + m * 16 + fr, row = prow0 + lr, t = row & (T - 1); const float rsv = rs[ai][m];
                f32x4 g[2], up[2], R1[2], R2[2];
#pragma unroll
                for (int n = 0; n < 2; ++n) { g[n] = acc[ai][0][m][n] * rsv; up[n] = acc[ai][1][m][n] * rsv;
#pragma unroll
                    for (int e = 0; e < 4; ++e) { R1[n][e] = dpp_ror1(g[n][e]); R2[n][e] = dpp_ror2(g[n][e]); } }
                const bool valid = (row < MPR) && (lr >= 2 || u.pm == 0);
                f32x4 av[2];
#pragma unroll
                for (int n = 0; n < 2; ++n) { f32x4 g1 = (fr == 0) ? r1p[n] : R1[n], g2 = (fr < 2) ? r2p[n] : R2[n];
                    if (t < 1) g1 = (f32x4){0.f, 0.f, 0.f, 0.f}; if (t < 2) g2 = (f32x4){0.f, 0.f, 0.f, 0.f};
                    const f32x4 cv = bb[n] + w0[n] * g2 + w1[n] * g1 + w2[n] * g[n];
#pragma unroll
                    for (int e = 0; e < 4; ++e) av[n][e] = gelu_tanh_f(cv[e]) * up[n][e]; }
                if (valid) { *(v4u*)(ACT + (size_t)row * FF + col) = pack8(av[0], av[1]);
                    if (t >= T - 2) { float* o = out + O_CVP + ((size_t)(row >> 12) * 2 + (t - (T - 2))) * FF + col; *(f32x4*)o = g[0]; *(f32x4*)(o + 4) = g[1]; } }
                r1p[0] = R1[0]; r1p[1] = R1[1]; r2p[0] = R2[0]; r2p[1] = R2[1];
            }
        }
    }
};
struct PanelOrder254 {
    pg8::GridOrder Gd;
    __device__ bool next(int i, pg8::Unit& u) const { return Gd.next(i, u); }
    __device__ __forceinline__ size_t aoff(const pg8::Unit& u) const { return (size_t)u.pm * 254 * D * 2; }
    __device__ __forceinline__ size_t boff(const pg8::Unit& u) const { return (size_t)u.pn * 128 * D * 2; }
};
struct SkGateUpConv { static constexpr bool STATS = false; static constexpr bool SPLIT2 = false; static constexpr bool PAIR = true;
    const float* ssq; bf16* ACT; float* out; const float* cw; const float* cb; const float* sc;
    __device__ __forceinline__ void operator()(int m, int n, f32x4 g, f32x4 up) const {
        const float rs = 1.f / sqrtf(ssq[MPR + m] * (1.f / D) + EPS); g = g * rs; up = up * rs;
        const f32x4 s0 = *(const f32x4*)(sc + ((size_t)m * 2 + 0) * FF + n), s1 = *(const f32x4*)(sc + ((size_t)m * 2 + 1) * FF + n);
        *(f32x4*)(out + O_CVS + ((size_t)m * 2 + 0) * FF + n) = s1; *(f32x4*)(out + O_CVS + ((size_t)m * 2 + 1) * FF + n) = g;
        const f32x4 cv = *(const f32x4*)(cb + n) + *(const f32x4*)(cw + n) * s0 + *(const f32x4*)(cw + FF + n) * s1 + *(const f32x4*)(cw + 2 * FF + n) * g;
        f32x4 a;
#pragma unroll
        for (int e = 0; e < 4; ++e) a[e] = gelu_tanh_f(cv[e]) * up[e];
        *(v2u*)(ACT + (size_t)(MPR + m) * FF + n) = pack4(a);
    }
};

struct EpiResidB { static constexpr bool MIDK = false;
    const bf16* base; float* xo; bf16* xb; float* ssq; LAS float* rowpart;
    __device__ __forceinline__ void operator()(const f32x4 (&acc)[2][2][4][2], const pg8::Unit& u, int wr, int wc, int fr_, int fq_) const { int fr = fr_, fq = fq_; asm volatile("" : "+v"(fr), "+v"(fq));
        _Pragma("unroll") for (int ai = 0; ai < 2; ++ai) _Pragma("unroll") for (int m = 0; m < 4; ++m) { const int row = u.pm * 256 + ai * 128 + wr * 64 + m * 16 + fr; float sq = 0.f;
            _Pragma("unroll") for (int bj = 0; bj < 2; ++bj) { const int col = u.pn * 256 + bj * 128 + wc * 32 + 8 * fq; f32x4 v0 = acc[ai][bj][m][0], v1 = acc[ai][bj][m][1];
                const v4u bw = *(const v4u*)(base + (size_t)row * D + col);
                v0 = v0 + (f32x4){bflo(bw.x), bfhi(bw.x), bflo(bw.y), bfhi(bw.y)}; v1 = v1 + (f32x4){bflo(bw.z), bfhi(bw.z), bflo(bw.w), bfhi(bw.w)};
                if (xo) { float* o = xo + (size_t)row * D + col; *(f32x4*)o = v0; *(f32x4*)(o + 4) = v1; }
                if (xb) *(v4u*)(xb + (size_t)row * D + col) = pack8(v0, v1);
                sq += (v0[0] * v0[0] + v0[1] * v0[1]) + (v0[2] * v0[2] + v0[3] * v0[3]) + (v1[0] * v1[0] + v1[1] * v1[1]) + (v1[2] * v1[2] + v1[3] * v1[3]); }
            sq += swap16(sq); sq += swap_half(sq);
            if (fq == 0) rowpart[(ai * 128 + wr * 64 + m * 16 + fr) * 4 + wc] = sq; }
        asm volatile("s_waitcnt lgkmcnt(0)\n\ts_barrier" ::: "memory");
        if (threadIdx.x < 256) { const f32x4 pp = *(const LAS f32x4*)(rowpart + threadIdx.x * 4); atomicAdd(ssq + u.pm * 256 + threadIdx.x, (pp[0] + pp[1]) + (pp[2] + pp[3])); }
    }
};
struct EpiResidFinal { static constexpr bool MIDK = false;
    const bf16* base; float* ssq; LAS float* rowpart; unsigned* pcnt; unsigned* bar; const float* gain; float* y;
    __device__ __forceinline__ void operator()(const f32x4 (&acc)[2][2][4][2], const pg8::Unit& u, int wr, int wc, int fr_, int fq_) const { int fr = fr_, fq = fq_; asm volatile("" : "+v"(fr), "+v"(fq));
        _Pragma("unroll") for (int ai = 0; ai < 2; ++ai) _Pragma("unroll") for (int m = 0; m < 4; ++m) { const int row = u.pm * 256 + ai * 128 + wr * 64 + m * 16 + fr; float sq = 0.f;
            _Pragma("unroll") for (int bj = 0; bj < 2; ++bj) { const int col = u.pn * 256 + bj * 128 + wc * 32 + 8 * fq; f32x4 v0 = acc[ai][bj][m][0], v1 = acc[ai][bj][m][1];
                const v4u bw = *(const v4u*)(base + (size_t)row * D + col);
                v0 = v0 + (f32x4){bflo(bw.x), bfhi(bw.x), bflo(bw.y), bfhi(bw.y)}; v1 = v1 + (f32x4){bflo(bw.z), bfhi(bw.z), bflo(bw.w), bfhi(bw.w)};
                sq += (v0[0] * v0[0] + v0[1] * v0[1]) + (v0[2] * v0[2] + v0[3] * v0[3]) + (v1[0] * v1[0] + v1[1] * v1[1]) + (v1[2] * v1[2] + v1[3] * v1[3]); }
            sq += swap16(sq); sq += swap_half(sq);
            if (fq == 0) rowpart[(ai * 128 + wr * 64 + m * 16 + fr) * 4 + wc] = sq; }
        asm volatile("s_waitcnt lgkmcnt(0)\n\ts_barrier" ::: "memory");
        if (threadIdx.x < 256) { const f32x4 pp = *(const LAS f32x4*)(rowpart + threadIdx.x * 4); atomicAdd(ssq + u.pm * 256 + threadIdx.x, (pp[0] + pp[1]) + (pp[2] + pp[3])); }
        asm volatile("s_waitcnt vmcnt(0)" ::: "memory");
        __syncthreads();
        if (threadIdx.x == 0) {
            unsigned* pc = pcnt + u.pm * 16;
            (void)xb_add(pc, 1u);
            XB_SPIN(xb_ld(pc) < 4u, bar);
            __builtin_amdgcn_fence(__ATOMIC_ACQUIRE, "agent");
        }
        __syncthreads();
        if (threadIdx.x < 256) { const unsigned tb = __hip_atomic_load((const unsigned*)ssq + u.pm * 256 + threadIdx.x, __ATOMIC_RELAXED, __HIP_MEMORY_SCOPE_AGENT);
            rowpart[threadIdx.x * 4] = 1.f / sqrtf(__builtin_bit_cast(float, tb) * (1.f / D) + EPS); }
        asm volatile("s_waitcnt lgkmcnt(0)\n\ts_barrier" ::: "memory");
        int fr2 = fr_, fq2 = fq_; asm volatile("" : "+v"(fr2), "+v"(fq2));
        _Pragma("unroll") for (int ai = 0; ai < 2; ++ai) _Pragma("unroll") for (int m = 0; m < 4; ++m) { const int rl = ai * 128 + wr * 64 + m * 16 + fr2; const int row = u.pm * 256 + rl; const float rs = rowpart[rl * 4];
            _Pragma("unroll") for (int bj = 0; bj < 2; ++bj) { const int col = u.pn * 256 + bj * 128 + wc * 32 + 8 * fq2; f32x4 v0 = acc[ai][bj][m][0], v1 = acc[ai][bj][m][1];
                const v4u bw = *(const v4u*)(base + (size_t)row * D + col); const f32x4 g0 = *(const f32x4*)(gain + col), g1 = *(const f32x4*)(gain + col + 4);
                v0 = (v0 + (f32x4){bflo(bw.x), bfhi(bw.x), bflo(bw.y), bfhi(bw.y)}) * rs * g0; v1 = (v1 + (f32x4){bflo(bw.z), bfhi(bw.z), bflo(bw.w), bfhi(bw.w)}) * rs * g1;
                float* o = y + (size_t)row * D + col; *(f32x4*)o = v0; *(f32x4*)(o + 4) = v1; } }
    }
};
struct SkResidB { static constexpr bool STATS = true; static constexpr bool SPLIT2 = false; static constexpr bool PAIR = false;
    const bf16* base; float* xo; bf16* xb; float* ssq;
    __device__ __forceinline__ float operator()(int m, int n, f32x4 v) const {
        const size_t o = (size_t)(MPR + m) * D + n; const v2u bw = *(const v2u*)(base + o);
        v = v + (f32x4){bflo(bw.x), bfhi(bw.x), bflo(bw.y), bfhi(bw.y)};
        if (xo) *(f32x4*)(xo + o) = v; if (xb) *(v2u*)(xb + o) = pack4(v);
        return (v[0] * v[0] + v[1] * v[1]) + (v[2] * v[2] + v[3] * v[3]);
    }
};

struct InProjOrder {
    int c;
    __device__ __forceinline__ bool next(int i, pg8::Unit& u) const { if (i >= 2 || c >= 256) return false;
        const int wgid = (c % pg8::NXCD) * (256 / pg8::NXCD) + c / pg8::NXCD, j = wgid & 3; u.pm = wgid >> 2; u.pn = (i == 0) ? 2 + j : (j < 2 ? j : 4 + j); return true; }
    __device__ __forceinline__ size_t aoff(const pg8::Unit& u) const { return (size_t)u.pm * ((size_t)pg8::BM * D * 2); }
    __device__ __forceinline__ size_t boff(const pg8::Unit& u) const { return (size_t)u.pn * ((size_t)pg8::BM * D * 2); }
};
struct SsmOne {
    int b, g; size_t bstride; int cnt;
    __device__ bool next(int i, pg8::Unit& u) const { if (i >= cnt) return false; u.pm = b; u.pn = g; return true; }
    __device__ __forceinline__ size_t aoff(const pg8::Unit& u) const { return ((size_t)u.pm * NCH * NG * XHP + (size_t)u.pn * XHP) * 2; }
    __device__ __forceinline__ size_t boff(const pg8::Unit& u) const { return (size_t)u.pn * bstride; }
};

struct EpiResidMix { static constexpr bool MIDK = true;
    const bf16* base; bf16* xb; float* ssq; const float* ssqA; const float* ssqB; LAS float* rowpart;
    __device__ __forceinline__ void mid(f32x4 (&acc)[2][2][4][2], const pg8::Unit& u, int wr, int wc, int fr_, int fq_) const { int fr = fr_; asm volatile("" : "+v"(fr));
        _Pragma("unroll") for (int ai = 0; ai < 2; ++ai) _Pragma("unroll") for (int m = 0; m < 4; ++m) { const int row = u.pm * 256 + ai * 128 + wr * 64 + m * 16 + fr;
            const float ratio = sqrtf((ssqB[row] * (1.f / SBW) + EPS) / (ssqA[row] * (1.f / SBW) + EPS));
            _Pragma("unroll") for (int bj = 0; bj < 2; ++bj) _Pragma("unroll") for (int n = 0; n < 2; ++n) acc[ai][bj][m][n] = acc[ai][bj][m][n] * ratio; }
    }
    __device__ __forceinline__ void operator()(const f32x4 (&acc)[2][2][4][2], const pg8::Unit& u, int wr, int wc, int fr_, int fq_) const { int fr = fr_, fq = fq_; asm volatile("" : "+v"(fr), "+v"(fq));
        _Pragma("unroll") for (int ai = 0; ai < 2; ++ai) _Pragma("unroll") for (int m = 0; m < 4; ++m) { const int row = u.pm * 256 + ai * 128 + wr * 64 + m * 16 + fr; float sq = 0.f;
            const float rsB = 1.f / sqrtf(ssqB[row] * (1.f / SBW) + EPS);
            _Pragma("unroll") for (int bj = 0; bj < 2; ++bj) { const int col = u.pn * 256 + bj * 128 + wc * 32 + 8 * fq; f32x4 v0 = acc[ai][bj][m][0] * rsB, v1 = acc[ai][bj][m][1] * rsB;
                const v4u bw = *(const v4u*)(base + (size_t)row * D + col);
                v0 = v0 + (f32x4){bflo(bw.x), bfhi(bw.x), bflo(bw.y), bfhi(bw.y)}; v1 = v1 + (f32x4){bflo(bw.z), bfhi(bw.z), bflo(bw.w), bfhi(bw.w)};
                *(v4u*)(xb + (size_t)row * D + col) = pack8(v0, v1);
                sq += (v0[0] * v0[0] + v0[1] * v0[1]) + (v0[2] * v0[2] + v0[3] * v0[3]) + (v1[0] * v1[0] + v1[1] * v1[1]) + (v1[2] * v1[2] + v1[3] * v1[3]); }
            sq += swap16(sq); sq += swap_half(sq);
            if (fq == 0) rowpart[(ai * 128 + wr * 64 + m * 16 + fr) * 4 + wc] = sq; }
        asm volatile("s_waitcnt lgkmcnt(0)\n\ts_barrier" ::: "memory");
        if (threadIdx.x < 256) { const f32x4 pp = *(const LAS f32x4*)(rowpart + threadIdx.x * 4); atomicAdd(ssq + u.pm * 256 + threadIdx.x, (pp[0] + pp[1]) + (pp[2] + pp[3])); }
    }
};
struct SkResidMix { static constexpr bool STATS = true; static constexpr bool SPLIT2 = true; static constexpr bool PAIR = false;
    const bf16* base; bf16* xb; float* ssq; const float* ssqA; const float* ssqB;
    __device__ __forceinline__ float operator()(int m, int n, f32x4 sA, f32x4 sB) const {
        const float rsA = 1.f / sqrtf(ssqA[MPR + m] * (1.f / SBW) + EPS), rsB = 1.f / sqrtf(ssqB[MPR + m] * (1.f / SBW) + EPS);
        const size_t o = (size_t)(MPR + m) * D + n; const v2u bw = *(const v2u*)(base + o);
        const f32x4 v = sA * rsA + sB * rsB + (f32x4){bflo(bw.x), bfhi(bw.x), bflo(bw.y), bfhi(bw.y)};
        *(v2u*)(xb + o) = pack4(v);
        return (v[0] * v[0] + v[1] * v[1]) + (v[2] * v[2] + v[3] * v[3]);
    }
};
__device__ __forceinline__ int crow(int r, int hi) { return (r & 3) + 8 * (r >> 2) + 4 * hi; }
__device__ __forceinline__ void glds16(const void* gsrc, unsigned lds_dst) { unsigned keep;
    asm volatile("s_mov_b32 %0, m0\n\ts_mov_b32 m0, %2\n\ts_nop 0\n\tglobal_load_lds_dwordx4 %1, off\n\ts_mov_b32 m0, %0" : "=&s"(keep) : "v"(gsrc), "s"(lds_dst) : "memory"); }
#define WAIT_BAR(N) asm volatile("s_waitcnt vmcnt(" #N ") lgkmcnt(0)\n\ts_barrier" ::: "memory")
typedef LAS const char* lds_cptr;
typedef short v4i16_t __attribute__((ext_vector_type(4)));
__device__ __forceinline__ s16x4 vtr(lds_cptr p) { return __builtin_bit_cast(s16x4, __builtin_amdgcn_ds_read_tr16_b64_v4i16((LAS v4i16_t*)p)); }
__device__ __forceinline__ bf16x8 ldsq(lds_cptr p) { return *(const LAS bf16x8*)p; }
#define MFMA32(a, b, c) __builtin_amdgcn_mfma_f32_32x32x16_bf16((a), (b), (c), 0, 0, 0)
typedef float f32x2_t __attribute__((ext_vector_type(2))); typedef __bf16 bf16x2_t __attribute__((ext_vector_type(2)));
__device__ __forceinline__ unsigned cvtpk_s(float lo, float hi) { f32x2_t v = {lo, hi}; bf16x2_t b = __builtin_convertvector(v, bf16x2_t); return __builtin_bit_cast(unsigned, b); }
__device__ __forceinline__ bf16x8 pack_bf8(const f32x16& p, int base) {
    v4u w; w.x = cvtpk_s(p[base], p[base + 1]); w.y = cvtpk_s(p[base + 2], p[base + 3]); w.z = cvtpk_s(p[base + 4], p[base + 5]); w.w = cvtpk_s(p[base + 6], p[base + 7]); return __builtin_bit_cast(bf16x8, w);
}
template <int CTRL> __device__ __forceinline__ float dppf(float x) { return __builtin_bit_cast(float, __builtin_amdgcn_update_dpp(0, __builtin_bit_cast(int, x), CTRL, 0xf, 0xf, true)); }

constexpr int SBA_K = 0, SBA_V = 24576, SBA_OST = 49152;
__device__ __forceinline__ void sb_attn_unit(Frame& F, int b, int h, int qb, float b2) {
    int lane = F.lane; asm volatile("" : "+v"(lane));
    const int r32 = lane & 31, hi = lane >> 5, wid = F.wave;
    const bf16* QBp = WSP(bf16, WS_QB); const bf16* KBp = WSP(bf16, WS_KB); const bf16* VBp = WSP(bf16, WS_VB); bf16* MIXU = WSP(bf16, WS_MIX); float* SSQA = (float*)(F.ctl + CW_SSQA);
    const long rowbase = (long)b * T; const int q0 = qb * 256;
    const bf16* Qw = QBp + (rowbase + q0 + wid * 32) * SBW + h * HD;
    const bf16* Kh = KBp + rowbase * SBW + h * HD; const bf16* Vh = VBp + rowbase * SBW + h * HD;
    const unsigned lds0 = (unsigned)(uintptr_t)(F.lds + RING_OFF);
    const bf16* ksrc = Kh + (long)lane * SBW + wid * 8;
    const bf16* vsrc = Vh + (long)(16 * (wid & 3) + (lane >> 2)) * SBW + (wid >> 2) * 32 + (lane & 3) * 8;
    const unsigned kdst = lds0 + SBA_K + wid * 1024, vdst = lds0 + SBA_V + wid * 1024;
    const lds_cptr base3 = (lds_cptr)(F.lds + RING_OFF);
    const lds_cptr kp0 = base3 + SBA_K + hi * 1024 + r32 * 16;
    const lds_cptr vp0 = base3 + SBA_V + ((lane >> 4) & 1) * 32 + (lane & 3) * 8 + (4 * hi + ((lane & 15) >> 2)) * 64;
    const int NT = (q0 + 256) / 64;
#define DMA_KV(t, slot) do { glds16(ksrc + (long)(t) * 64 * SBW, (unsigned)__builtin_amdgcn_readfirstlane(kdst + (slot) * 8192)); glds16(vsrc + (long)(t) * 64 * SBW, (unsigned)__builtin_amdgcn_readfirstlane(vdst + (slot) * 8192)); } while (0)
    DMA_KV(NT - 1, 0); DMA_KV(NT - 2, 1);
    bf16x8 qr[4];
#pragma unroll
    for (int d0 = 0; d0 < 4; ++d0) qr[d0] = *reinterpret_cast<const bf16x8*>(&Qw[(long)r32 * SBW + d0 * 16 + hi * 8]);
    asm volatile("" : "+v"(qr[0]), "+v"(qr[1]), "+v"(qr[2]), "+v"(qr[3]));
    bf16x8 A0, A1, AN;
#pragma unroll
    for (int j = 0; j < 8; ++j) { const int kv = crow(j, hi); A0[j] = (short)((kv >= r32) ? 0xBF80 : 0); A1[j] = (short)((kv + 16 >= r32) ? 0xBF80 : 0); AN[j] = (short)0xBF80; }
    f32x16 o0 = {}, o1 = {}, racc, bt;
#pragma unroll
    for (int r = 0; r < 16; ++r) { bt[r] = b2; racc[r] = b2; }
    const int qrel = wid * 32 + r32;
    for (int it = 0; it < NT; ++it) {
        const int t = NT - 1 - it, cur = it % 3;
        if (it + 1 < NT) { WAIT_BAR(2); } else { WAIT_BAR(0); }
        if (it + 2 < NT) DMA_KV(t - 2, (it + 2) % 3);
        const int jb = t - (NT - 4);
        if (jb <= (wid >> 1)) {
            int so = cur * 8192; asm volatile("" : "+s"(so));
            const lds_cptr kp = kp0 + so; const lds_cptr vp = vp0 + so;
            f32x16 p0 = bt, p1 = bt, d0 = racc, d1 = racc;
#pragma unroll
            for (int dd = 0; dd < 4; ++dd) { const bf16x8 k0 = ldsq(kp + dd * 2048), k1 = ldsq(kp + dd * 2048 + 512);
                p0 = MFMA32(k0, qr[dd], p0); p1 = MFMA32(k1, qr[dd], p1); d0 = MFMA32(k0, qr[dd], d0); d1 = MFMA32(k1, qr[dd], d1); }
            const bool diag = (jb == (wid >> 1));
            if (diag) {
                const float NEG = -INFINITY; const int kb = 64 * jb + 4 * hi;
#pragma unroll
                for (int r = 0; r < 16; ++r) { const int kv = kb + (r & 3) + 8 * (r >> 2); if (kv >= qrel) p0[r] = NEG; if (kv + 32 >= qrel) p1[r] = NEG; }
            }
            f32x16 s0, s1;
#pragma unroll
            for (int r = 0; r < 16; ++r) { s0[r] = __builtin_amdgcn_logf(1.f + __builtin_amdgcn_exp2f(p0[r])); s1[r] = __builtin_amdgcn_logf(1.f + __builtin_amdgcn_exp2f(p1[r])); }
            const bf16x8 sb0 = pack_bf8(s0, 0), sb1 = pack_bf8(s0, 8), sb2 = pack_bf8(s1, 0), sb3 = pack_bf8(s1, 8);
            d1 = MFMA32(A0, sb2, d1); d1 = MFMA32(A1, sb3, d1);
            d0 = MFMA32(A0, sb0, d0); d0 = MFMA32(A1, sb1, d0); d0 = MFMA32(AN, sb2, d0); d0 = MFMA32(AN, sb3, d0);
            racc = MFMA32(AN, sb0, racc); racc = MFMA32(AN, sb1, racc); racc = MFMA32(AN, sb2, racc); racc = MFMA32(AN, sb3, racc);
            if (diag) { const float NEG = -INFINITY; const int kb = 64 * jb + 4 * hi;
#pragma unroll
                for (int r = 0; r < 16; ++r) { const int kv = kb + (r & 3) + 8 * (r >> 2); if (kv >= qrel) d0[r] = NEG; if (kv + 32 >= qrel) d1[r] = NEG; } }
#pragma unroll
            for (int r = 0; r < 16; ++r) { p0[r] = __builtin_amdgcn_exp2f(d0[r]); p1[r] = __builtin_amdgcn_exp2f(d1[r]); }
            const bf16x8 pa0 = pack_bf8(p0, 0), pa1 = pack_bf8(p0, 8), pa2 = pack_bf8(p1, 0), pa3 = pack_bf8(p1, 8);
#pragma unroll
            for (int dh = 0; dh < 2; ++dh) {
                f32x16& o = dh ? o1 : o0;
#pragma unroll
                for (int rg = 0; rg < 4; ++rg) { const s16x4 lo = vtr(vp + dh * 4096 + rg * 1024), hh = vtr(vp + dh * 4096 + rg * 1024 + 512);
                    const bf16x8 vf = (bf16x8){lo[0], lo[1], lo[2], lo[3], hh[0], hh[1], hh[2], hh[3]};
                    o = MFMA32(rg == 0 ? pa0 : rg == 1 ? pa1 : rg == 2 ? pa2 : pa3, vf, o); }
            }
        }
    }
#undef DMA_KV
    { int l2 = lane; asm volatile("" : "+v"(l2)); const int e32 = l2 & 31, ehi = l2 >> 5;
      LAS bf16* stg = (LAS bf16*)(F.lds + RING_OFF + SBA_OST) + wid * 2048; LAS bf16* sb = stg + (4 * ehi) * 64 + e32;
#pragma unroll
      for (int r = 0; r < 16; ++r) { sb[((r & 3) + 8 * (r >> 2)) * 64] = (bf16)f2bf(o0[r]); sb[((r & 3) + 8 * (r >> 2)) * 64 + 32] = (bf16)f2bf(o1[r]); }
      LDS_WAIT();
      const long orow = rowbase + q0 + wid * 32 + (l2 >> 3);
      bf16* Ow = MIXU + orow * D + h * HD + (l2 & 7) * 8; const LAS bf16* sr = stg + (l2 >> 3) * 64 + (l2 & 7) * 8;
#pragma unroll
      for (int i = 0; i < 4; ++i) { const v4u v = *(const LAS v4u*)(sr + i * 512); *(v4u*)(Ow + (long)i * 8 * D) = v;
          float sq = (bflo(v.x) * bflo(v.x) + bfhi(v.x) * bfhi(v.x)) + (bflo(v.y) * bflo(v.y) + bfhi(v.y) * bfhi(v.y)) + (bflo(v.z) * bflo(v.z) + bfhi(v.z) * bfhi(v.z)) + (bflo(v.w) * bflo(v.w) + bfhi(v.w) * bfhi(v.w));
          sq += dppf<0xB1>(sq); sq += dppf<0x4E>(sq); sq += dppf<0x141>(sq);
          if ((l2 & 7) == 0) atomicAdd(SSQA + orow + i * 8, sq); } }
    asm volatile("s_waitcnt vmcnt(0) lgkmcnt(0)\n\ts_barrier" ::: "memory");
}

__device__ __forceinline__ float dpp_sum16(float x) {
    x += __builtin_bit_cast(float, __builtin_amdgcn_update_dpp(0, __builtin_bit_cast(int, x), 0xB1, 0xf, 0xf, true));
    x += __builtin_bit_cast(float, __builtin_amdgcn_update_dpp(0, __builtin_bit_cast(int, x), 0x4E, 0xf, 0xf, true));
    x += __builtin_bit_cast(float, __builtin_amdgcn_update_dpp(0, __builtin_bit_cast(int, x), 0x141, 0xf, 0xf, true));
    x += __builtin_bit_cast(float, __builtin_amdgcn_update_dpp(0, __builtin_bit_cast(int, x), 0x140, 0xf, 0xf, true));
    return x;
}
__device__ __forceinline__ float wave_sum_fast(float x) { x = dpp_sum16(x); x += swap16(x); x += swap_half(x); return x; }
__device__ __forceinline__ float swz_xor4(float x) { return __builtin_bit_cast(float, __builtin_amdgcn_ds_swizzle(__builtin_bit_cast(int, x), 0x101F)); }
__device__ __forceinline__ void sb_sample_unit(Frame& F, int b, int pg) {
    int lane = F.lane; asm volatile("" : "+v"(lane));
    const int h = F.wave, ts = lane >> 4, d4 = lane & 15;
    const float* QS = WSP(float, WS_QS); const float* ck = INF(2); const float* cv = INF(3); const int* pt = (const int*)F.in[4];
    const float bl2 = INF(13)[h] * LOG2E;
    const f32x4 q4 = *(const f32x4*)(QS + (size_t)b * SBW + h * HD + 4 * d4);
    const int page = pt[b * NPG + pg];
    const float* kb = ck + ((size_t)page * PAGE + ts) * (NH * HD) + h * HD + 4 * d4;
    const float* vb = cv + ((size_t)page * PAGE + ts) * (NH * HD) + h * HD + 4 * d4;
    float p[32];
    { f32x4 kk[32];
#pragma unroll
      for (int i = 0; i < 32; ++i) kk[i] = __builtin_nontemporal_load((const f32x4*)(kb + (size_t)i * 4 * NH * HD));
#pragma unroll
      for (int i = 0; i < 32; ++i) p[i] = (q4[0] * kk[i][0] + q4[1] * kk[i][1]) + (q4[2] * kk[i][2] + q4[3] * kk[i][3]); }
    f32x4 vv[32];
#pragma unroll
    for (int i = 0; i < 32; ++i) vv[i] = __builtin_nontemporal_load((const f32x4*)(vb + (size_t)i * 4 * NH * HD));
    const bool c0 = d4 & 1, c1 = d4 & 2, c2 = d4 & 4, c3 = d4 & 8;
    float v1[16], v2[8], v3[4], zz[2];
#pragma unroll
    for (int k = 0; k < 16; ++k) { const float keep = c0 ? p[2 * k + 1] : p[2 * k], send = c0 ? p[2 * k] : p[2 * k + 1]; v1[k] = keep + dppf<0xB1>(send); }
#pragma unroll
    for (int k = 0; k < 8; ++k) { const float keep = c1 ? v1[2 * k + 1] : v1[2 * k], send = c1 ? v1[2 * k] : v1[2 * k + 1]; v2[k] = keep + dppf<0x4E>(send); }
#pragma unroll
    for (int k = 0; k < 4; ++k) { const float keep = c2 ? v2[2 * k + 1] : v2[2 * k], send = c2 ? v2[2 * k] : v2[2 * k + 1]; v3[k] = keep + swz_xor4(send); }
#pragma unroll
    for (int k = 0; k < 2; ++k) { const float keep = c3 ? v3[2 * k + 1] : v3[2 * k], send = c3 ? v3[2 * k] : v3[2 * k + 1]; zz[k] = keep + dppf<0x128>(send) + bl2; }
    float sp[2], aft[2], G[2], sfx[2];
#pragma unroll
    for (int k = 0; k < 2; ++k) {
        sp[k] = __builtin_amdgcn_logf(1.f + __builtin_amdgcn_exp2f(zz[k]));
        const float nb = swap16(sp[k]), w1 = sp[k] + nb, po = swap_half(w1);
        aft[k] = ((ts & 1) ? 0.f : nb) + ((ts & 2) ? 0.f : po); G[k] = w1 + po;
        float s2 = G[k]; s2 += dppf<0x101>(s2); s2 += dppf<0x102>(s2); s2 += dppf<0x104>(s2); s2 += dppf<0x108>(s2); sfx[k] = s2;
    }
    const float tot1 = __builtin_bit_cast(float, __builtin_amdgcn_readlane(__builtin_bit_cast(int, sfx[1]), 0)), tot0 = __builtin_bit_cast(float, __builtin_amdgcn_readlane(__builtin_bit_cast(int, sfx[0]), 0));
    const float a1 = __builtin_amdgcn_exp2f(zz[1] - sp[1] - (aft[1] + (sfx[1] - G[1])));
    const float a0 = __builtin_amdgcn_exp2f(zz[0] - sp[0] - (aft[0] + (sfx[0] - G[0]) + tot1));
    LAS float* aw = (LAS float*)(F.lds + RING_OFF) + h * 128 + ts * 32;
    aw[d4] = a0; aw[d4 + 16] = a1;
    LDS_WAIT(); asm volatile("" ::: "memory");
    f32x4 acc = {0.f, 0.f, 0.f, 0.f};
#pragma unroll
    for (int i4 = 0; i4 < 8; ++i4) { const f32x4 a4 = *(const LAS f32x4*)(aw + 4 * i4);
#pragma unroll
        for (int e2 = 0; e2 < 4; ++e2) acc = acc + vv[4 * i4 + e2] * a4[e2]; }
    LDS_WAIT(); asm volatile("" ::: "memory");
#pragma unroll
    for (int e2 = 0; e2 < 4; ++e2) { acc[e2] += swap16(acc[e2]); acc[e2] += swap_half(acc[e2]); }
    if (ts == 0) *(f32x4*)(WSP(float, WS_SBPO) + (((size_t)b * NPG + pg) * NH + h) * HD + 4 * d4) = acc;
    if (lane == 0) WSP(float, WS_SBPL)[((size_t)b * NPG + pg) * NH + h] = -(tot0 + tot1);
}
__device__ __forceinline__ void sb_sample_combine(Frame& F, int b, int h) {
    const float* PO = WSP(float, WS_SBPO); const float* PL = WSP(float, WS_SBPL); float o = 0.f, run = 0.f;
#pragma unroll
    for (int pg = NPG - 1; pg >= 0; --pg) { o += __builtin_amdgcn_exp2f(run) * PO[(((size_t)b * NPG + pg) * NH + h) * HD + F.lane]; run += PL[((size_t)b * NPG + pg) * NH + h]; }
    const unsigned ob = f2bf(o); const float orr = bf2f((unsigned short)ob);
    WSP(bf16, WS_MIX)[(size_t)(MPR + b) * D + h * HD + F.lane] = (bf16)ob;
    const float sq = wave_sum_fast(orr * orr);
    if (F.lane == 0) atomicAdd((float*)(F.ctl + CW_SSQA) + MPR + b, sq);
}
__device__ __forceinline__ void ssm_sample_unit(Frame& F, int b, int g) {
    const int n = F.lane;
    const float lr = INF(14)[g * NST + n], li = INF(15)[g * NST + n], ldt = INF(16)[g];
    float lbr, lbi, cr, ci; lam_pow(lr, li, ldt, 1, lbr, lbi); lam_coef(lr, li, ldt, cr, ci);
    const float* u = WSP(float, WS_US) + (size_t)b * SBW + g * GP;
    float br = 0.f, bi = 0.f;
#pragma unroll
    for (int p = 0; p < 16; ++p) { const float bre = INF(17)[(g * NST + n) * GP + p], bim = INF(18)[(g * NST + n) * GP + p]; const float uv = u[p]; br += (cr * bre - ci * bim) * uv; bi += (cr * bim + ci * bre) * uv; }
    const float h0r = INF(5)[(b * NG + g) * NST + n], h0i = INF(6)[(b * NG + g) * NST + n];
    const float hr = lbr * h0r - lbi * h0i + br, hi = lbr * h0i + lbi * h0r + bi;
    F.out[O_RES + (size_t)(b * NG + g) * NST + n] = hr; F.out[O_IMS + (size_t)(b * NG + g) * NST + n] = hi;
    float y = 0.f;
#pragma unroll
    for (int p = 0; p < 16; ++p) { const float v = wave_sum(INF(19)[(g * GP + p) * NST + n] * hr - INF(20)[(g * GP + p) * NST + n] * hi); if (n == p) y = v; }
    if (n < 16) { y += INF(21)[g * GP + n] * u[n]; WSP(bf16, WS_YG)[(size_t)(MPR + b) * SBW + g * GP + n] = (bf16)f2bf(gelu_tanh_f(y)); }
}
__device__ __forceinline__ void ssm_scan_bg(Frame& F, int b, int g) {
    const int n = F.tid & 63, seg = F.tid >> 6;
    LAS float* tot = (LAS float*)(F.lds + RING_OFF);
    const float lr = INF(14)[g * NST + n], li = INF(15)[g * NST + n], ldt = INF(16)[g];
    float Lr, Li, Sr, Si; lam_pow(lr, li, ldt, LC, Lr, Li); lam_pow(lr, li, ldt, LC * 32, Sr, Si);
    const float* SST = WSP(float, WS_SST); bf16* XH = WSP(bf16, WS_XH);
    f32x2 s[32];
#pragma unroll
    for (int k = 0; k < 32; ++k) s[k] = *(const f32x2*)(SST + ((size_t)(b * NCH + seg * 32 + k) * NG + g) * 128 + 2 * n);
    float pr = 0.f, pi = 0.f;
#pragma unroll
    for (int k = 0; k < 32; ++k) { const float nr = Lr * pr - Li * pi + s[k].x, ni = Lr * pi + Li * pr + s[k].y; pr = nr; pi = ni; s[k].x = pr; s[k].y = pi; }
    tot[(seg * 64 + n) * 2] = pr; tot[(seg * 64 + n) * 2 + 1] = pi;
    __syncthreads();
    float cr = 0.f, ci = 0.f;
    for (int s2 = 0; s2 < seg; ++s2) { const float tr = tot[(s2 * 64 + n) * 2], ti = tot[(s2 * 64 + n) * 2 + 1]; const float nr = Sr * cr - Si * ci + tr, ni = Sr * ci + Si * cr + ti; cr = nr; ci = ni; }
    if (seg == 0) *(GAS unsigned*)(XH + ((size_t)(b * NCH) * NG + g) * XHP + 256 + 2 * n) = 0u;
    float wr_ = Lr, wi_ = Li;
#pragma unroll
    for (int k = 0; k < 32; ++k) {
        const float hr = wr_ * cr - wi_ * ci + s[k].x, hi = wr_ * ci + wi_ * cr + s[k].y;
        const int c = seg * 32 + k;
        if (c + 1 < NCH) *(GAS unsigned*)(XH + ((size_t)(b * NCH + c + 1) * NG + g) * XHP + 256 + 2 * n) = pk2(hr, hi);
        else { F.out[O_REP + (size_t)(b * NG + g) * NST + n] = hr; F.out[O_IMP + (size_t)(b * NG + g) * NST + n] = hi; }
        const float nr = wr_ * Lr - wi_ * Li, ni = wr_ * Li + wi_ * Lr; wr_ = nr; wi_ = ni;
    }
}
__device__ __forceinline__ void xattn_prompt_kload(Frame& F, int b, int h) {
    const int lane = F.lane, wid = F.wave; const bf16* MKB = WSP(bf16, WS_MKB);
    const unsigned lds0 = (unsigned)(uintptr_t)(F.lds + RING_OFF);
#pragma unroll
    for (int t = 0; t < 4; ++t)
#pragma unroll
        for (int j = 0; j < 4; ++j) { const int c = wid + 8 * j;
            glds16(MKB + ((long)b * MT + t * 64 + lane) * D + h * MHD + c * 8, (unsigned)__builtin_amdgcn_readfirstlane(lds0 + t * 32768 + c * 1024)); }
}
__device__ __forceinline__ void xattn_prompt_unit(Frame& F, int b, int h, int qb, bool have_k) {
    const int lane = F.lane, r32 = lane & 31, hi = lane >> 5, wid = F.wave;
    const bf16* QM = WSP(bf16, WS_QM); const bf16* MVB = WSP(bf16, WS_MVB); bf16* OM = WSP(bf16, WS_OMEM);
    const unsigned lds0 = (unsigned)(uintptr_t)(F.lds + RING_OFF); const lds_cptr base3 = (lds_cptr)(F.lds + RING_OFF);
    const long qrow0 = (long)b * T + qb * 256 + wid * 32;
    if (!have_k) xattn_prompt_kload(F, b, h);
    bf16x8 qr[16];
#pragma unroll
    for (int ks = 0; ks < 16; ++ks) qr[ks] = *reinterpret_cast<const bf16x8*>(QM + (qrow0 + r32) * D + h * MHD + ks * 16 + hi * 8);
    WAIT_BAR(0);
    f32x16 S[8];
#pragma unroll
    for (int t = 0; t < 4; ++t)
#pragma unroll
        for (int blk = 0; blk < 2; ++blk) { f32x16 p = {};
#pragma unroll
            for (int ks = 0; ks < 16; ++ks) p = MFMA32(ldsq(base3 + t * 32768 + (2 * ks + hi) * 1024 + (32 * blk + r32) * 16), qr[ks], p);
            S[t * 2 + blk] = p; }
    WAIT_BAR(0);
#pragma unroll
    for (int t = 0; t < 4; ++t)
#pragma unroll
        for (int j = 0; j < 4; ++j) { const int p = wid + 8 * j, dblk = p >> 2, rg = p & 3;
            glds16(MVB + ((long)b * MT + t * 64 + 16 * rg + (lane >> 2)) * D + h * MHD + dblk * 32 + (lane & 3) * 8, (unsigned)__builtin_amdgcn_readfirstlane(lds0 + t * 32768 + p * 1024)); }
    float mx = -INFINITY;
#pragma unroll
    for (int i = 0; i < 8; ++i)
#pragma unroll
        for (int r = 0; r < 16; ++r) mx = fmaxf(mx, S[i][r]);
    mx = fmaxf(mx, swap_half(mx));
    float l = 0.f;
#pragma unroll
    for (int i = 0; i < 8; ++i)
#pragma unroll
        for (int r = 0; r < 16; ++r) { S[i][r] = __builtin_amdgcn_exp2f(S[i][r] - mx); l += S[i][r]; }
    l += swap_half(l);
    bf16x8 pa[16];
#pragma unroll
    for (int i = 0; i < 8; ++i) { pa[2 * i] = pack_bf8(S[i], 0); pa[2 * i + 1] = pack_bf8(S[i], 8); }
    WAIT_BAR(0);
    f32x16 o[8];
#pragma unroll
    for (int dblk = 0; dblk < 8; ++dblk) o[dblk] = (f32x16){};
    const lds_cptr vp0 = base3 + ((lane >> 4) & 1) * 32 + (lane & 3) * 8 + (4 * hi + ((lane & 15) >> 2)) * 64;
#pragma unroll
    for (int t = 0; t < 4; ++t)
#pragma unroll
        for (int dblk = 0; dblk < 8; ++dblk)
#pragma unroll
            for (int rg = 0; rg < 4; ++rg) { const s16x4 lo = vtr(vp0 + t * 32768 + dblk * 4096 + rg * 1024), hh = vtr(vp0 + t * 32768 + dblk * 4096 + rg * 1024 + 512);
                const bf16x8 vf = (bf16x8){lo[0], lo[1], lo[2], lo[3], hh[0], hh[1], hh[2], hh[3]};
                o[dblk] = MFMA32(pa[t * 4 + rg], vf, o[dblk]); }
    WAIT_BAR(0);
    int l2 = lane; asm volatile("" : "+v"(l2));
    const int e32 = l2 & 31, ehi = l2 >> 5;
    LAS bf16* stg = (LAS bf16*)(F.lds + RING_OFF) + wid * 8192;
    LAS float* lsw = (LAS float*)stg;
    if (ehi == 0) lsw[e32] = l;
    LDS_WAIT();
    float rli[16];
    { const LAS float* lb = lsw + 4 * ehi;
#pragma unroll
      for (int r = 0; r < 16; ++r) rli[r] = __builtin_amdgcn_rcpf(lb[(r & 3) + 8 * (r >> 2)]); }
    LDS_WAIT(); asm volatile("" ::: "memory");
    { LAS bf16* sb = stg + (4 * ehi) * 256 + e32;
#pragma unroll
      for (int dblk = 0; dblk < 8; ++dblk)
#pragma unroll
        for (int r = 0; r < 16; ++r) sb[((r & 3) + 8 * (r >> 2)) * 256 + dblk * 32] = (bf16)f2bf(o[dblk][r] * rli[r]); }
    LDS_WAIT();
    { bf16* Ow = OM + (qrow0 + (l2 >> 5)) * D + h * MHD + (l2 & 31) * 8; const LAS bf16* sr = stg + (l2 >> 5) * 256 + (l2 & 31) * 8;
#pragma unroll
      for (int i = 0; i < 16; ++i) { const v4u v = *(const LAS v4u*)(sr + i * 512); *(v4u*)(Ow + (long)i * 2 * D) = v; } }
    asm volatile("s_waitcnt vmcnt(0) lgkmcnt(0)\n\ts_barrier" ::: "memory");
}
__device__ __forceinline__ void xattn_sample_unit(Frame& F, int b, int h) {
    const int lane = F.lane, wid = F.wave;
    const bf16* QM = WSP(bf16, WS_QM); const float* ck = INF(8); const float* cv = INF(9);
    LAS float* xm = (LAS float*)(F.lds + HALO_OFF);
    const v2u qw = *(const v2u*)(QM + (size_t)(MPR + b) * D + h * MHD + 4 * lane);
    const f32x4 q4 = {bflo(qw.x), bfhi(qw.x), bflo(qw.y), bfhi(qw.y)};
    const float* kb = ck + (((size_t)b * MT + wid * 32) * MH + h) * MHD + 4 * lane;
    const float* vb = cv + (((size_t)b * MT + wid * 32) * MH + h) * MHD + 4 * lane;
    float s[32];
    f32x4 kk[32], vv[32];
#pragma unroll
    for (int i = 0; i < 32; ++i) kk[i] = __builtin_nontemporal_load((const f32x4*)(kb + (size_t)i * MH * MHD));
#pragma unroll
    for (int i0 = 0; i0 < 32; i0 += 16) {
#pragma unroll
        for (int i = 0; i < 16; ++i) s[i0 + i] = wave_sum_fast((q4[0] * kk[i0 + i][0] + q4[1] * kk[i0 + i][1]) + (q4[2] * kk[i0 + i][2] + q4[3] * kk[i0 + i][3]));
#pragma unroll
        for (int i = 0; i < 16; ++i) vv[i0 + i] = __builtin_nontemporal_load((const f32x4*)(vb + (size_t)(i0 + i) * MH * MHD));
        __builtin_amdgcn_sched_barrier(0);
    }
    float mx = s[0];
#pragma unroll
    for (int i = 1; i < 32; ++i) mx = fmaxf(mx, s[i]);
    float l = 0.f;
#pragma unroll
    for (int i = 0; i < 32; ++i) { s[i] = __builtin_amdgcn_exp2f(s[i] - mx); l += s[i]; }
    f32x4 acc = {0.f, 0.f, 0.f, 0.f};
#pragma unroll
    for (int i = 0; i < 32; ++i) acc = acc + vv[i] * s[i];
    WAIT_BAR(0);
    if (lane == 0) { xm[wid] = mx; xm[8 + wid] = l; }
    *(LAS f32x4*)(xm + 64 + wid * 256 + 4 * lane) = acc;
    WAIT_BAR(0);
    if (F.tid < 256) { float gm = xm[0];
#pragma unroll
        for (int w = 1; w < 8; ++w) gm = fmaxf(gm, xm[w]);
        float lt = 0.f, ov = 0.f;
#pragma unroll
        for (int w = 0; w < 8; ++w) { const float f = __builtin_amdgcn_exp2f(xm[w] - gm); lt += xm[8 + w] * f; ov += xm[64 + w * 256 + F.tid] * f; }
        WSP(bf16, WS_OMEM)[(size_t)(MPR + b) * D + h * MHD + F.tid] = (bf16)f2bf(ov / lt); }
}
__device__ __forceinline__ void mix_row(Frame& F, int row) {
    const int lane = F.lane;
#pragma unroll
    for (int half = 0; half < 2; ++half) {
        const bf16* src = (half ? WSP(bf16, WS_OSSM) : WSP(bf16, WS_OSB)) + (size_t)row * SBW + 8 * lane;
        const v4u w = *(const v4u*)src; float v[8] = {bflo(w.x), bfhi(w.x), bflo(w.y), bfhi(w.y), bflo(w.z), bfhi(w.z), bflo(w.w), bfhi(w.w)};
        float s = 0.f;
#pragma unroll
        for (int e = 0; e < 8; ++e) s += v[e] * v[e];
        s = wave_sum(s); const float rs = 1.f / sqrtf(s * (1.f / SBW) + EPS);
        v4u o; o.x = pk2(v[0] * rs, v[1] * rs); o.y = pk2(v[2] * rs, v[3] * rs); o.z = pk2(v[4] * rs, v[5] * rs); o.w = pk2(v[6] * rs, v[7] * rs);
        *(v4u*)(WSP(bf16, WS_MIX) + (size_t)row * D + half * SBW + 8 * lane) = o;
    }
}
__device__ __forceinline__ void conv_act_item(Frame& F, long item) {
    const int row = (int)(item / (FF / 8)), j = (int)(item % (FF / 8)) * 8;
    const bf16* GB = WSP(bf16, WS_GB); bf16* UB = WSP(bf16, WS_UB);
    const float* cw = INF(36); const float* cb = INF(37); const float* sc = INF(7);
    float g0[8], g1[8], g2[8], uu[8];
    { const v4u w = *(const v4u*)(GB + (size_t)row * FF + j); g0[0] = bflo(w.x); g0[1] = bfhi(w.x); g0[2] = bflo(w.y); g0[3] = bfhi(w.y); g0[4] = bflo(w.z); g0[5] = bfhi(w.z); g0[6] = bflo(w.w); g0[7] = bfhi(w.w); }
    { const v4u w = *(const v4u*)(UB + (size_t)row * FF + j); uu[0] = bflo(w.x); uu[1] = bfhi(w.x); uu[2] = bflo(w.y); uu[3] = bfhi(w.y); uu[4] = bflo(w.z); uu[5] = bfhi(w.z); uu[6] = bflo(w.w); uu[7] = bfhi(w.w); }
    if (row < MPR) { const int t = row & 4095;
        if (t >= 1) { const v4u w = *(const v4u*)(GB + (size_t)(row - 1) * FF + j); g1[0] = bflo(w.x); g1[1] = bfhi(w.x); g1[2] = bflo(w.y); g1[3] = bfhi(w.y); g1[4] = bflo(w.z); g1[5] = bfhi(w.z); g1[6] = bflo(w.w); g1[7] = bfhi(w.w); }
        else { _Pragma("unroll") for (int e = 0; e < 8; ++e) g1[e] = 0.f; }
        if (t >= 2) { const v4u w = *(const v4u*)(GB + (size_t)(row - 2) * FF + j); g2[0] = bflo(w.x); g2[1] = bfhi(w.x); g2[2] = bflo(w.y); g2[3] = bfhi(w.y); g2[4] = bflo(w.z); g2[5] = bfhi(w.z); g2[6] = bflo(w.w); g2[7] = bfhi(w.w); }
        else { _Pragma("unroll") for (int e = 0; e < 8; ++e) g2[e] = 0.f; }
    } else { const int b = row - MPR;
        _Pragma("unroll") for (int e = 0; e < 8; ++e) { g2[e] = sc[((size_t)b * 2 + 0) * FF + j + e]; g1[e] = sc[((size_t)b * 2 + 1) * FF + j + e]; F.out[O_CVS + ((size_t)b * 2 + 0) * FF + j + e] = g1[e]; } }
    float r[8];
#pragma unroll
    for (int e = 0; e < 8; ++e) { const float c = cb[j + e] + cw[j + e] * g2[e] + cw[FF + j + e] * g1[e] + cw[2 * FF + j + e] * g0[e]; r[e] = gelu_tanh_f(c) * uu[e]; }
    v4u o; o.x = pk2(r[0], r[1]); o.y = pk2(r[2], r[3]); o.z = pk2(r[4], r[5]); o.w = pk2(r[6], r[7]);
    *(v4u*)(UB + (size_t)row * FF + j) = o;
}
__device__ __forceinline__ void final_norm_row(Frame& F, int row) {
    const float rs = 1.f / sqrtf(((const float*)(F.ctl + CW_SSQ3))[row] * (1.f / D) + EPS);
    float* y = F.out + O_YP + (size_t)row * D; const float* g = INF(39); const bf16* x3 = WSP(bf16, WS_X1B) + (size_t)row * D;
#pragma unroll
    for (int j = 0; j < 2; ++j) { const int c = 8 * F.lane + 512 * j; const v4u w = *(const v4u*)(x3 + c); const f32x4 g0 = *(const f32x4*)(g + c), g1 = *(const f32x4*)(g + c + 4);
        const f32x4 v0 = (f32x4){bflo(w.x), bfhi(w.x), bflo(w.y), bfhi(w.y)} * rs * g0, v1 = (f32x4){bflo(w.z), bfhi(w.z), bflo(w.w), bfhi(w.w)} * rs * g1;
        *(f32x4*)(y + c) = v0; *(f32x4*)(y + c + 4) = v1; }
}
constexpr int N_PHASES = 15;
__global__ void __launch_bounds__(NTHR, 2) mk_fwd(Args args) {
    extern __shared__ __attribute__((aligned(16))) unsigned char lds[];
    Frame F;
    F.lds = (LAS unsigned char*)lds; F.MISC = (volatile LAS unsigned*)(F.lds + MISC_OFF);
    F.tid = threadIdx.x; F.lane = F.tid & 63; F.wave = __builtin_amdgcn_readfirstlane(F.tid >> 6);
    F.G = gridDim.x; { const int bx = blockIdx.x; F.vcu = (F.G % 8 == 0) ? (bx % 8) * (F.G / 8) + bx / 8 : bx; }
    F.ws = args.ws; F.out = args.out; F.in = args.in; F.ctl = (unsigned*)(args.ws + WS_CTL);
    for (int u = F.tid; u < (LDS_BYTES - LDSCTL_OFF) / 4; u += NTHR) ((LAS unsigned*)(F.lds + LDSCTL_OFF))[u] = 0u;
    __syncthreads();
    XcdBarrier bar; bar.bar = F.ctl + CW_BAR; bar.x = 0; bar.st = nullptr;
    if (args.use_bar) bar = xcd_barrier_post(F.ctl + CW_BAR, F.MISC + 8);
    const int lo = args.ph_lo, hi = args.ph_hi;
#define IN(k) (lo <= (k) && (k) < hi)
#if MK_PROBE >= 200
    unsigned long long tp0 = 0, tpd = 0;
#define TP_BEGIN(k) do { if ((k) == MK_PROBE - 200) tp0 = __builtin_amdgcn_s_memrealtime(); } while (0)
#define TP_END(k) do { if ((k) == MK_PROBE - 200) tpd = __builtin_amdgcn_s_memrealtime() - tp0; } while (0)
#else
#define TP_BEGIN(k) do {} while (0)
#define TP_END(k) do {} while (0)
#endif
#define SEAM(k) do { if (IN(k) && IN((k) + 1)) xcd_barrier(bar); TP_END(k); TP_BEGIN((k) + 1); TP_BEGIN((k) + 2); TP_BEGIN((k) + 3); } while (0)
    const int gw = F.vcu * NWAVES + F.wave, NGW = F.G * NWAVES;
    LAS unsigned char* ring = F.lds + RING_OFF;

    TP_BEGIN(0);
    if (IN(0)) { p0_prologue(F);
#if MK_PROBE == 100
        __syncthreads(); p0_prologue(F);
#endif
    } SEAM(0);
    if (IN(1)) {
        { pg8::Gemm g{WSP(bf16, WS_XB), WSP(bf16, WS_WIN), D, D, D}; InProjOrder S{(int)blockIdx.x};
          EpiInProj E{WSP(float, WS_RSTD0), WSP(bf16, WS_QB), WSP(bf16, WS_KB), WSP(bf16, WS_VB), WSP(bf16, WS_XH), WSP(float, WS_QS), WSP(float, WS_US), F.out};
          pg8::gemm_phase<EpiInProj, InProjOrder>(ring, g, S, E);
#if MK_PROBE == 1
          pg8::gemm_phase<EpiInProj, InProjOrder>(ring, g, S, E);
#endif
        }
        { SkInProj E{WSP(float, WS_RSTD0), WSP(bf16, WS_QB), WSP(float, WS_QS), WSP(float, WS_US), F.out};
          skinny_gemm(F, WSP(bf16, WS_XB) + (size_t)MPR * D, D, WSP(bf16, WS_WIN), D, INW, D, E, (int)blockIdx.x, F.G); }
    } SEAM(1);
    if (IN(2)) {
        if ((int)blockIdx.x < NG * NB) { const int u = (int)blockIdx.x; const int sb_ = u & 3, sg_ = u >> 2; int one = 1; asm volatile("" : "+s"(one));
          { pg8::Gemm g{WSP(bf16, WS_XH), WSP(bf16, WS_W1), NG * XHP, 256, 256}; SsmOne S{sb_, sg_, (size_t)128 * 256 * 2, one};
            EpiSsmA E{WSP(float, WS_SST)};
            pg8::gemm_phase<EpiSsmA, SsmOne>(ring, g, S, E); }
          VM_WAIT(); __syncthreads();
          ssm_scan_bg(F, sb_, sg_);
          VM_WAIT(); __syncthreads();
        }
        { pg8::Gemm g{WSP(bf16, WS_MB), WSP(bf16, WS_WMKV), D, D, D}; pg8::GridOrder S; S.init(4, 8, F.G, (int)blockIdx.x, 128, D, D);
          EpiMemKV E{WSP(float, WS_RSTDM), WSP(bf16, WS_MKB), WSP(bf16, WS_MVB), F.out};
          pg8::gemm_phase<EpiMemKV, pg8::GridOrder>(ring, g, S, E); }
        for (int u = gw; u < MS * NG; u += NGW) ssm_sample_unit(F, u >> 5, u & 31);
        weight_copies(F, NITEMS_EARLY, NITEMS_GLU);
        __syncthreads();
        { int mode = (MK_STREAM_DIV > 0 ? (F.vcu % MK_STREAM_DIV == MK_STREAM_DIV - 1) : (F.vcu % (-MK_STREAM_DIV) != 0)) ? 1 : 0; bool adone = false, mdone = false;
          while (!(adone && mdone)) {
              if (mode == 0 && adone) mode = 1; else if (mode == 1 && mdone) mode = 0;
              __syncthreads();
              if (F.tid == 0) F.MISC[16] = __hip_atomic_fetch_add(F.ctl + (mode ? CW_QM : CW_QA), 1u, __ATOMIC_RELAXED, __HIP_MEMORY_SCOPE_AGENT);
              __syncthreads();
              const int idx = (int)F.MISC[16];
              if (mode == 0) { if (idx >= 512) { adone = true; continue; }
                  const int qb = 15 - (idx >> 5), bh = idx & 31; sb_attn_unit(F, bh >> 3, bh & 7, qb, INF(13)[bh & 7] * LOG2E); }
              else { if (idx >= MS * NPG) { mdone = true; continue; }
                  sb_sample_unit(F, idx >> 4, idx & 15); }
          } }
#if MK_PROBE == 22
        if (args.use_bar) { xcd_barrier(bar); if (blockIdx.x == 0 && F.tid == 0) { __hip_atomic_store(F.ctl + CW_QA, 0u, __ATOMIC_RELAXED, __HIP_MEMORY_SCOPE_AGENT); __hip_atomic_store(F.ctl + CW_QM, 0u, __ATOMIC_RELAXED, __HIP_MEMORY_SCOPE_AGENT); } xcd_barrier(bar);
        { int mode = (MK_STREAM_DIV > 0 ? (F.vcu % MK_STREAM_DIV == MK_STREAM_DIV - 1) : (F.vcu % (-MK_STREAM_DIV) != 0)) ? 1 : 0; bool adone = false, mdone = false;
          while (!(adone && mdone)) {
              if (mode == 0 && adone) mode = 1; else if (mode == 1 && mdone) mode = 0;
              __syncthreads();
              if (F.tid == 0) F.MISC[16] = __hip_atomic_fetch_add(F.ctl + (mode ? CW_QM : CW_QA), 1u, __ATOMIC_RELAXED, __HIP_MEMORY_SCOPE_AGENT);
              __syncthreads();
              const int idx = (int)F.MISC[16];
              if (mode == 0) { if (idx >= 512) { adone = true; continue; }
                  const int qb = 15 - (idx >> 5), bh = idx & 31; sb_attn_unit(F, bh >> 3, bh & 7, qb, INF(13)[bh & 7] * LOG2E); }
              else { if (idx >= MS * NPG) { mdone = true; continue; }
                  sb_sample_unit(F, idx >> 4, idx & 15); }
          } }
        }
#endif
        __syncthreads();
        if ((int)blockIdx.x < NG * NB) { const int u = (int)blockIdx.x; const int sb_ = u & 3, sg_ = u >> 2; int one = 1; asm volatile("" : "+s"(one));
          { pg8::Gemm g{WSP(bf16, WS_XH), WSP(bf16, WS_BTC), NG * XHP, XHP, XHP}; SsmOne S{sb_, sg_, (size_t)256 * XHP * 2, one};
            EpiSsmC E{WSP(bf16, WS_YG)};
            pg8::gemm_phase<EpiSsmC, SsmOne>(ring, g, S, E); }
        }
        weight_copies(F, NITEMS_GLU, NITEMS_MID, NG * NB, F.G - NG * NB);
    } SEAM(2);
    if (IN(5)) {
        for (int u = gw; u < MS * NH; u += NGW) sb_sample_combine(F, u >> 3, u & 7);
        pg8::Gemm g{WSP(bf16, WS_YG), WSP(bf16, WS_WGLU), SBW, SBW, SBW}; pg8::GridOrder S; S.init(MPR / 256, 2, F.G, (int)blockIdx.x, 0, SBW, SBW);
        EpiGlu E{WSP(bf16, WS_YG), INF(23), WSP(bf16, WS_MIX), (float*)(F.ctl + CW_SSQB)};
        pg8::gemm_phase<EpiGlu, pg8::GridOrder>(ring, g, S, E);
        weight_copies(F, NITEMS_MID, NITEMS_ALL, 128, F.G - 128);
        __syncthreads();
        SkGlu E2{WSP(bf16, WS_YG), INF(23), WSP(bf16, WS_MIX), (float*)(F.ctl + CW_SSQB)};
        skinny_gemm(F, WSP(bf16, WS_YG) + (size_t)MPR * SBW, SBW, WSP(bf16, WS_WGLU), SBW, SBW, SBW, E2, ((int)blockIdx.x + F.G - 128) % F.G, F.G);
    } SEAM(5);
    if (IN(7)) {
        pg8::Gemm g{WSP(bf16, WS_MIX), WSP(bf16, WS_WOUT), D, D, D}; pg8::GridOrder S; S.init(MPR / 256, 4, F.G, (int)blockIdx.x, 0, D, D);
        EpiResidMix E{WSP(bf16, WS_XB), WSP(bf16, WS_X1B), (float*)(F.ctl + CW_SSQ1), (const float*)(F.ctl + CW_SSQA), (const float*)(F.ctl + CW_SSQB), (LAS float*)(F.lds + HALO_OFF_C)};
        pg8::gemm_phase<EpiResidMix, pg8::GridOrder>(ring, g, S, E);
        SkResidMix E2{WSP(bf16, WS_XB), WSP(bf16, WS_X1B), (float*)(F.ctl + CW_SSQ1), (const float*)(F.ctl + CW_SSQA), (const float*)(F.ctl + CW_SSQB)};
        skinny_gemm(F, WSP(bf16, WS_MIX) + (size_t)MPR * D, D, WSP(bf16, WS_WOUT), D, D, D, E2, (int)blockIdx.x, F.G);
    } SEAM(7);
    if (IN(8)) {
        pg8::Gemm g{WSP(bf16, WS_X1B), WSP(bf16, WS_WMQ), D, D, D}; pg8::GridOrder S; S.init(MPR / 256, 4, F.G, (int)blockIdx.x, 0, D, D);
        EpiScaleBf16 E{(const float*)(F.ctl + CW_SSQ1), CM, WSP(bf16, WS_QM)};
        pg8::gemm_phase<EpiScaleBf16, pg8::GridOrder>(ring, g, S, E);
#if MK_PROBE == 8
        pg8::gemm_phase<EpiScaleBf16, pg8::GridOrder>(ring, g, S, E);
#endif
        SkScale E2{(const float*)(F.ctl + CW_SSQ1), CM, WSP(bf16, WS_QM)};
        skinny_gemm(F, WSP(bf16, WS_X1B) + (size_t)MPR * D, D, WSP(bf16, WS_WMQ), D, D, D, E2, (int)blockIdx.x, F.G);
        if (IN(9) && F.vcu < 256) { __syncthreads(); xattn_prompt_kload(F, F.vcu >> 6, (F.vcu >> 4) & 3); }
    } SEAM(8);
    if (IN(9)) {
#if MK_XSTAG
        const bool sfirst = ((F.vcu >> 4) & 1) != 0;
#else
        const bool sfirst = false;
#endif
        if (sfirst) { for (int u = F.vcu; u < MS * MH; u += F.G) xattn_sample_unit(F, u >> 2, u & 3); __syncthreads(); }
        { bool have_k = IN(8); for (int u = F.vcu; u < 256; u += F.G) { xattn_prompt_unit(F, u >> 6, (u >> 4) & 3, u & 15, have_k); have_k = false; } }
        if (!sfirst) { for (int u = F.vcu; u < MS * MH; u += F.G) xattn_sample_unit(F, u >> 2, u & 3); }
    } SEAM(9);
    if (IN(10)) {
        pg8::Gemm g{WSP(bf16, WS_OMEM), WSP(bf16, WS_WMO), D, D, D}; pg8::GridOrder S; S.init(MPR / 256, 4, F.G, (int)blockIdx.x, 0, D, D);
        EpiResidB E{WSP(bf16, WS_X1B), nullptr, WSP(bf16, WS_X2B), (float*)(F.ctl + CW_SSQ2), (LAS float*)(F.lds + HALO_OFF_C)};
        pg8::gemm_phase<EpiResidB, pg8::GridOrder>(ring, g, S, E);
#if MK_PROBE == 10
        { EpiResidB Ed{WSP(bf16, WS_X1B), nullptr, WSP(bf16, WS_X2B), (float*)(F.ctl + CW_SSQD), (LAS float*)(F.lds + HALO_OFF_C)}; pg8::gemm_phase<EpiResidB, pg8::GridOrder>(ring, g, S, Ed); }
#endif
        SkResidB E2{WSP(bf16, WS_X1B), nullptr, WSP(bf16, WS_X2B), (float*)(F.ctl + CW_SSQ2)};
        skinny_gemm(F, WSP(bf16, WS_OMEM) + (size_t)MPR * D, D, WSP(bf16, WS_WMO), D, D, D, E2, (int)blockIdx.x, F.G);
    } SEAM(10);
    if (IN(11)) {
        pg8::Gemm g{WSP(bf16, WS_X2B), WSP(bf16, WS_WGU), D, D, D, FF}; PanelOrder254 S; S.Gd.init(65, 22, F.G, (int)blockIdx.x, 0, D, D);
        EpiGateUpConv E{(const float*)(F.ctl + CW_SSQ2), WSP(bf16, WS_UB), F.out, INF(36), INF(37), (LAS float*)(F.lds + HALO_OFF)};
        const int nheavy = 1430 - (1430 / F.G) * F.G; const bool heavy = (int)blockIdx.x < nheavy;
        SkGateUpConv E2{(const float*)(F.ctl + CW_SSQ2), WSP(bf16, WS_UB), F.out, INF(36), INF(37), INF(7)};
        const int su0 = ((int)blockIdx.x + F.G - nheavy) % F.G;
        if (heavy) { skinny_gemm(F, WSP(bf16, WS_X2B) + (size_t)MPR * D, D, WSP(bf16, WS_WGU), D, FF, D, E2, su0, F.G, 16, FF);
            asm volatile("s_waitcnt vmcnt(0)" ::: "memory"); __syncthreads();
            if (F.tid == 0) { __builtin_amdgcn_fence(__ATOMIC_RELEASE, "agent"); (void)xb_add(F.ctl + CW_SCNT, 1u); } }
        pg8::gemm_phase<EpiGateUpConv, PanelOrder254>(ring, g, S, E);
#if MK_PROBE == 11
        pg8::gemm_phase<EpiGateUpConv, PanelOrder254>(ring, g, S, E);
#endif
        if (!heavy) { skinny_gemm(F, WSP(bf16, WS_X2B) + (size_t)MPR * D, D, WSP(bf16, WS_WGU), D, FF, D, E2, su0, F.G, 16, FF);
            asm volatile("s_waitcnt vmcnt(0)" ::: "memory"); __syncthreads();
            if (F.tid == 0) { __builtin_amdgcn_fence(__ATOMIC_RELEASE, "agent"); (void)xb_add(F.ctl + CW_SCNT, 1u);
                XB_SPIN(xb_ld(F.ctl + CW_SCNT) < (unsigned)F.G, F.ctl + CW_BAR); __builtin_amdgcn_fence(__ATOMIC_ACQUIRE, "agent"); }
            __syncthreads();
            SkResidB E3{WSP(bf16, WS_X2B), nullptr, WSP(bf16, WS_X1B), (float*)(F.ctl + CW_SSQ3)};
            skinny_gemm(F, WSP(bf16, WS_UB) + (size_t)MPR * FF, FF, WSP(bf16, WS_WDN), FF, D, FF, E3, su0, F.G - nheavy); }
    } SEAM(11);
    if (IN(13)) {
        pg8::Gemm g{WSP(bf16, WS_UB), WSP(bf16, WS_WDN), FF, FF, FF}; pg8::GridOrder S; S.init(MPR / 256, 4, F.G, (int)blockIdx.x, 0, FF, FF);
        for (int m = MPR + gw; m < MALL; m += NGW) final_norm_row(F, m);
        EpiResidFinal E{WSP(bf16, WS_X2B), (float*)(F.ctl + CW_SSQ3), (LAS float*)(F.lds + HALO_OFF_C), F.ctl + CW_PCNT, F.ctl + CW_BAR, INF(39), F.out + O_YP};
        pg8::gemm_phase<EpiResidFinal, pg8::GridOrder>(ring, g, S, E);
#if MK_PROBE == 13
        { EpiResidB Ed{WSP(bf16, WS_X2B), nullptr, WSP(bf16, WS_X1B), (float*)(F.ctl + CW_SSQD), (LAS float*)(F.lds + HALO_OFF_C)}; pg8::gemm_phase<EpiResidB, pg8::GridOrder>(ring, g, S, Ed); }
#endif
    }
#if MK_PROBE == 20
    if (args.use_bar) { for (int i = 0; i < 10; ++i) xcd_barrier(bar); }
#endif
#if MK_PROBE >= 200
    TP_END(14);
    if (blockIdx.x == 0) { const unsigned long long t1 = __builtin_amdgcn_s_memrealtime(); while (__builtin_amdgcn_s_memrealtime() - t1 < tpd) __builtin_amdgcn_s_sleep(8); }
#endif
#undef IN
#undef SEAM
}
#ifndef MK_DEBUG
#define MK_DEBUG 0
#endif
#ifndef MK_ONE_LAUNCH
#define MK_ONE_LAUNCH 1
#endif
#if MK_DEBUG
struct Chk { const void* fast; const float* ref; long rows, cols, ldf, ldr; int isbf; float scale; };
__global__ void k_compare(Chk c, double* acc) {
    __shared__ double se[256], sr[256];
    double e = 0.0, r = 0.0; const long n = c.rows * c.cols;
    for (long i = (long)blockIdx.x * 256 + threadIdx.x; i < n; i += (long)gridDim.x * 256) { const long rr = i / c.cols, cc = i % c.cols;
        const float f = (c.isbf ? bf2f(((const unsigned short*)c.fast)[rr * c.ldf + cc]) : ((const float*)c.fast)[rr * c.ldf + cc]) * c.scale; const float g = c.ref[rr * c.ldr + cc];
        const double d = (double)f - (double)g; e += d * d; r += (double)g * (double)g; }
    se[threadIdx.x] = e; sr[threadIdx.x] = r; __syncthreads();
    for (int k = 128; k > 0; k >>= 1) { if ((int)threadIdx.x < k) { se[threadIdx.x] += se[threadIdx.x + k]; sr[threadIdx.x] += sr[threadIdx.x + k]; } __syncthreads(); }
    if (threadIdx.x == 0) { atomicAdd(acc, se[0]); atomicAdd(acc + 1, sr[0]); }
}
__global__ void k_compare_xh(const unsigned short* XH, const float* proj, const float* hs, int part, double* acc) {
    __shared__ double se[256], sr[256];
    double e = 0.0, r = 0.0; const int w = part ? 128 : 256; const long n = (long)1024 * NG * w;
    for (long i = (long)blockIdx.x * 256 + threadIdx.x; i < n; i += (long)gridDim.x * 256) { const int j = (int)(i % w); const long bcg = i / w; const int g = (int)(bcg % NG); const long bc = bcg / NG; const int b = (int)(bc / NCH), c = (int)(bc % NCH);
        const float f = bf2f(XH[bcg * XHP + (part ? 256 : 0) + j]); float gref;
        if (!part) { const int s = j >> 4, q = j & 15; gref = proj[((size_t)b * T + c * LC + s) * INW + 1536 + g * GP + q]; }
        else { const int nn = j >> 1, ri = j & 1; gref = (c == 0) ? 0.f : hs[((((size_t)b * T + c * LC - 1) * NG + g) * NST + nn) * 2 + ri]; }
        const double d = (double)f - (double)gref; e += d * d; r += (double)gref * (double)gref; }
    se[threadIdx.x] = e; sr[threadIdx.x] = r; __syncthreads();
    for (int k = 128; k > 0; k >>= 1) { if ((int)threadIdx.x < k) { se[threadIdx.x] += se[threadIdx.x + k]; sr[threadIdx.x] += sr[threadIdx.x + k]; } __syncthreads(); }
    if (threadIdx.x == 0) { atomicAdd(acc, se[0]); atomicAdd(acc + 1, sr[0]); }
}
__global__ void k_judge(const double* acc, int n, float tol, float* out) {
    if (threadIdx.x != 0 || blockIdx.x != 0) return;
    for (int k = 0; k < n; ++k) { const double rv = acc[2 * k] / acc[2 * k + 1];
        if (!(rv < (double)tol)) { int m = 5; if (rv != rv) m = 0; else if (rv >= 1.0) m = 9; else if (rv >= 0.1) m = 8; else if (rv >= 0.01) m = 7; else if (rv >= 0.001) m = 6;
            const int grp = k / 9, kk = k % 9 + 1; float code = (float)(10 * kk + m) * 100.f; for (int i = 0; i < grp; ++i) code *= 100.f; out[0] = code; return; } }
}
#endif

extern "C" void kernel_launch(void* const* d_in, const int* in_sizes, int n_in, void* d_out, int out_size, void* d_ws, size_t ws_size, hipStream_t stream) {
    static int grid = 0;
    if (grid == 0) {
        if (n_in != 40 || (size_t)out_size != O_END || ws_size < WS_FAST_END) { fprintf(stderr, "kernel_launch: unexpected shapes: n_in %d out %d ws %zu\n", n_in, out_size, ws_size); grid = -1; return; }
        int dev = 0, cus = 0, per_cu = 0;
        if (hipGetDevice(&dev) != hipSuccess || hipDeviceGetAttribute(&cus, hipDeviceAttributeMultiprocessorCount, dev) != hipSuccess) { grid = -1; return; }
        if (hipFuncSetAttribute((const void*)mk_fwd, hipFuncAttributeMaxDynamicSharedMemorySize, LDS_BYTES) != hipSuccess) { fprintf(stderr, "kernel_launch: hipFuncSetAttribute failed\n"); grid = -1; return; }
        if (hipOccupancyMaxActiveBlocksPerMultiprocessor(&per_cu, (const void*)mk_fwd, NTHR, LDS_BYTES) != hipSuccess || per_cu < 1) { fprintf(stderr, "kernel_launch: occupancy query says %d\n", per_cu); }
        (void)hipGetLastError();
        grid = cus;
        if (grid < 256) { fprintf(stderr, "kernel_launch: this kernel needs at least 256 CUs (found %d): the down projection's 256 units meet on per-panel counters and must all be resident at once\n", grid); grid = -1; return; }
    }
    if (grid < 0) return;
    (void)hipMemsetAsync((char*)d_ws + WS_CTL, 0, CTL_ZERO_BYTES, stream);
    Args a{};
    for (int i = 0; i < 40; ++i) a.in[i] = d_in[i];
    a.out = (float*)d_out; a.ws = (unsigned char*)d_ws;
#if MK_DEBUG
    const size_t fo_off = (WS_FAST_END + 4095) & ~(size_t)4095, nv_off = fo_off + (((size_t)O_END * 4 + 4095) & ~(size_t)4095), chk_off = nv_off + (((size_t)nv::WS_FLOATS * 4 + 4095) & ~(size_t)4095);
    if (ws_size < chk_off + 4096) { fprintf(stderr, "debug build: workspace too small (%zu < %zu)\n", ws_size, chk_off + 4096); return; }
    float* fast_out = (float*)((char*)d_ws + fo_off); float* nvws = (float*)((char*)d_ws + nv_off); double* chk = (double*)((char*)d_ws + chk_off);
    nv::forward(d_in, (float*)d_out, nvws, stream);
    a.out = fast_out;
    (void)hipMemsetAsync(chk, 0, 4096, stream);
#endif
#if MK_ONE_LAUNCH
    a.ph_lo = 0; a.ph_hi = N_PHASES; a.use_bar = 1;
    hipLaunchKernelGGL(mk_fwd, dim3(grid), dim3(NTHR), LDS_BYTES, stream, a);
#else
    for (int p = 0; p < N_PHASES; ++p) { a.ph_lo = p; a.ph_hi = p + 1; a.use_bar = 0; hipLaunchKernelGGL(mk_fwd, dim3(grid), dim3(NTHR), LDS_BYTES, stream, a); }
#endif
#if MK_DEBUG
    {
        const nv::Bufs B = nv::carve(nvws); unsigned char* ws = (unsigned char*)d_ws; int k = 0; const float* no = (const float*)d_out;
        auto cmp = [&](const void* fast, int isbf, long ldf, const float* ref, long ldr, long rows, long cols, float scale) {
            Chk c; memset(&c, 0, sizeof(c)); c.fast = fast; c.ref = ref; c.rows = rows; c.cols = cols; c.ldf = ldf; c.ldr = ldr; c.isbf = isbf; c.scale = scale; hipLaunchKernelGGL(k_compare, dim3(1024), dim3(256), 0, stream, c, chk + 2 * k); ++k; };
        cmp(ws + WS_KB, 1, SBW, B.PROJ + 512, INW, MPR, SBW, 1.f);
        cmp(ws + WS_VB, 1, SBW, B.PROJ + 1024, INW, MPR, SBW, 1.f);
        cmp(ws + WS_QB, 1, SBW, B.PROJ, INW, MPR, SBW, 1.f / C2);
        hipLaunchKernelGGL(k_compare_xh, dim3(1024), dim3(256), 0, stream, (const unsigned short*)(ws + WS_XH), B.PROJ, B.HS, 0, chk + 2 * k); ++k;
        cmp(ws + WS_MKB, 1, D, no + O_MKP, D, NB * MT, D, 1.f);
        cmp(ws + WS_MVB, 1, D, no + O_MVP, D, NB * MT, D, 1.f);
        cmp(ws + WS_MIX, 1, D, B.OSB, SBW, MPR, SBW, 1.f);
        cmp(ws + WS_MIX + (size_t)MPR * D * 2, 1, D, B.OSB + (size_t)MPR * SBW, SBW, MS, SBW, 1.f);
        hipLaunchKernelGGL(k_compare_xh, dim3(1024), dim3(256), 0, stream, (const unsigned short*)(ws + WS_XH), B.PROJ, B.HS, 1, chk + 2 * k); ++k;
        cmp(ws + WS_YG, 1, SBW, B.YG, SBW, MPR, SBW, 1.f);
        cmp(ws + WS_YG + (size_t)MPR * SBW * 2, 1, SBW, B.YG + (size_t)MPR * SBW, SBW, MS, SBW, 1.f);
        cmp(ws + WS_MIX + SBW * 2, 1, D, B.OSSM, SBW, MALL, SBW, 1.f);
        cmp(ws + WS_X1B, 1, D, B.X3, D, MALL, D, 1.f);
        cmp(ws + WS_QM, 1, D, B.Q, D, MALL, D, 1.f / CM);
        cmp(ws + WS_OMEM, 1, D, B.OM, D, MPR, D, 1.f);
        cmp(ws + WS_OMEM + (size_t)MPR * D * 2, 1, D, B.OM + (size_t)MPR * D, D, MS, D, 1.f);
        cmp(ws + WS_X2B, 1, D, B.X2, D, MALL, D, 1.f);
        cmp(ws + WS_X2B, 1, D, B.X2, D, MALL, D, 1.f);
        cmp(ws + WS_UB, 1, FF, B.ACT, FF, MALL, FF, 1.f);
        const size_t offs[15] = {O_YP, O_YS, O_KP, O_VP, O_REP, O_IMP, O_CVP, O_MKP, O_MVP, O_KS, O_VS, O_RES, O_IMS, O_CVS, O_END};
        for (int i = 0; i < 14; ++i) cmp(fast_out + offs[i], 0, 1, no + offs[i], 1, (long)(offs[i + 1] - offs[i]), 1, 1.f);
        hipLaunchKernelGGL(k_judge, dim3(1), dim3(64), 0, stream, (const double*)chk, k, 2e-3f, (float*)d_out);
    }
#endif
}
```

```cpp
#define MK_DEBUG 0
#define MK_ONE_LAUNCH 1
#define MK_PROBE 0
#define MK_STREAM_DIV 2
#define MK_XSTAG 1
#include <hip/hip_runtime.h>
#include <cstdio>
#include <cstdint>
#include <cmath>
#include <cstring>
namespace pg8 {
#define PG8_LAS __attribute__((address_space(3)))
typedef unsigned short bf16_t;
typedef short bf16x8 __attribute__((ext_vector_type(8)));
typedef float f32x4 __attribute__((ext_vector_type(4)));
typedef unsigned u32x4 __attribute__((ext_vector_type(4)));
constexpr int BM = 256, BK = 64, HALF = 128, HTB = HALF * BK * 2  , STAGE_BYTES = 8 * HTB, NXCD = 8, WGM = 8;

__host__ __device__ __forceinline__ int lds_byte(int r, int c) { const int st = (r >> 4) * 2 + (c >> 5), rr = r & 15, cc = c & 31, ob = rr * 64 + cc * 2; return st * 1024 + (ob ^ (((ob >> 9) & 1) << 5)); }
__host__ __device__ __forceinline__ void stage_rc(int b, int& R, int& C) { const int st = b / 1024, sb = b % 1024, swz = sb ^ (((sb >> 9) & 1) << 5); R = (st >> 1) * 16 + swz / 64; C = (st & 1) * 32 + (swz % 64) / 2; }
__host__ __device__ __forceinline__ int perm32(int rho) { const int n = rho >> 4, i = rho & 15; return 8 * (i >> 2) + 4 * n + (i & 3); }

struct Unit { int pm, pn; };
struct Gemm { const bf16_t* A; const bf16_t* Bt; int lda, ldb, K; int bhalf = HALF; };

struct GridOrder {
    int nM, nN, nwg, G, c; size_t astep, bstep;
    __device__ void init(int nM_, int nN_, int G_, int c_, int shift, int lda, int ldb) { nM = nM_; nN = nN_; nwg = nM * nN; G = G_; c = (c_ + G_ - (shift % G_)) % G_; astep = (size_t)BM * lda * 2; bstep = (size_t)BM * ldb * 2; }
    __device__ bool next(int i, Unit& u) const {
        const long L = (long)i * G + c; if (L >= nwg) return false;
        int wgid = (int)L; { const int q = nwg / NXCD, r = nwg % NXCD, xcd = wgid % NXCD, off = wgid / NXCD; wgid = (xcd < r ? xcd * (q + 1) : r * (q + 1) + (xcd - r) * q) + off; }
        const int nig = WGM * nN, gid = wgid / nig, fm = gid * WGM, gsz = (nM - fm) < WGM ? (nM - fm) : WGM;
        u.pm = fm + ((wgid % nig) % gsz); u.pn = (wgid % nig) / gsz; return true;
    }
    __device__ __forceinline__ size_t aoff(const Unit& u) const { return (size_t)u.pm * astep; }
    __device__ __forceinline__ size_t boff(const Unit& u) const { return (size_t)u.pn * bstep; }
};

__device__ __forceinline__ unsigned cvt_pk_bf16(float lo, float hi) { unsigned r; asm volatile("v_cvt_pk_bf16_f32 %0, %1, %2" : "=v"(r) : "v"(lo), "v"(hi)); return r; }

template <class Epi, class Sched, bool ALIGN_EPI = true, bool SP2 = true>
__device__ __forceinline__ void gemm_phase(PG8_LAS unsigned char* lds, const Gemm g, const Sched& S, const Epi& E) {
    const int tid = threadIdx.x, wid = __builtin_amdgcn_readfirstlane(tid >> 6), lane = tid & 63, wr = wid >> 2, wc = wid & 3, fr = lane & 15, fq = lane >> 4;
    const int K = g.K, nt = K / BK;
    unsigned voffA[2], voffB[2];
#pragma unroll
    for (int i = 0; i < 2; ++i) { int R, C; stage_rc(tid * 16 + i * 8192, R, C); const int Rb = (R & ~31) + perm32(R & 31);
        voffA[i] = (unsigned)(R * g.lda + C) * 2u; voffB[i] = (unsigned)(Rb * g.ldb + C) * 2u; }
    const size_t kstep = (size_t)(BK * 2);
    const size_t hstepA = (size_t)HALF * g.lda * 2, hstepB = (size_t)g.bhalf * g.ldb * 2;
    const unsigned ldsw = (unsigned)wid * 1024u;
    const int aoff = lds_byte(wr * 64 + fr, fq * 8), boff = lds_byte(wc * 32 + fr, fq * 8);
#define PG8_SA(b, h) (((b) * 2 + (h)) * HTB)
#define PG8_SB(b, h) ((4 + (b) * 2 + (h)) * HTB)
#define PG8_STAGE(bufoff, gbase, voff) do { _Pragma("unroll") for (int _i = 0; _i < 2; ++_i) \
        __builtin_amdgcn_global_load_lds((const unsigned*)((const char*)(gbase) + (voff)[_i]), (PG8_LAS unsigned*)(lds + (bufoff) + ldsw + _i * 8192), 16, 0, 0); } while (0)
#define PG8_LDA(dst, b, h) do { _Pragma("unroll") for (int m = 0; m < 4; ++m) _Pragma("unroll") for (int k = 0; k < 2; ++k) dst[m][k] = *(const PG8_LAS bf16x8*)(lds + PG8_SA(b, h) + aoff + m * 2048 + k * 1024); } while (0)
#define PG8_LDB(dst, b, h) do { _Pragma("unroll") for (int n = 0; n < 2; ++n) _Pragma("unroll") for (int k = 0; k < 2; ++k) dst[n][k] = *(const PG8_LAS bf16x8*)(lds + PG8_SB(b, h) + boff + n * 2048 + k * 1024); } while (0)
#define PG8_MMA(ai, bj, At, Bt) do { __builtin_amdgcn_s_setprio(1); _Pragma("unroll") for (int m = 0; m < 4; ++m) _Pragma("unroll") for (int n = 0; n < 2; ++n) _Pragma("unroll") for (int k = 0; k < 2; ++k) \
        acc[ai][bj][m][n] = __builtin_amdgcn_mfma_f32_16x16x32_bf16(Bt[n][k], At[m][k], acc[ai][bj][m][n], 0, 0, 0); __builtin_amdgcn_s_setprio(0); } while (0)
#define PG8_WAIT_V(n) asm volatile("s_waitcnt vmcnt(" #n ")" ::: "memory")
#define PG8_WAIT_L(n) asm volatile("s_waitcnt lgkmcnt(" #n ")" ::: "memory")
#define PG8_BAR __builtin_amdgcn_s_barrier()
#define PG8_SCHED __builtin_amdgcn_sched_barrier(0)
    Unit cur, nxt; int ui = 0;
    if (!S.next(0, cur)) return;
    f32x4 acc[2][2][4][2];
#pragma unroll
    for (int a = 0; a < 2; ++a)
#pragma unroll
        for (int b = 0; b < 2; ++b)
#pragma unroll
            for (int m = 0; m < 4; ++m)
#pragma unroll
                for (int n = 0; n < 2; ++n) acc[a][b][m][n] = (f32x4){0.f, 0.f, 0.f, 0.f};
    bf16x8 At[4][2], B0[2][2], B1[2][2];
    const char* cA = (const char*)g.A + S.aoff(cur); const char* cB = (const char*)g.Bt + S.boff(cur);
    static_assert(SP2, "only the SP2 loop is kept in this file");
    PG8_STAGE(PG8_SB(0, 0), cB, voffB); PG8_STAGE(PG8_SB(0, 1), cB + hstepB, voffB); PG8_STAGE(PG8_SA(0, 0), cA, voffA); PG8_STAGE(PG8_SA(0, 1), cA + hstepA, voffA);
    if (wr == 1) PG8_BAR;
    PG8_WAIT_V(2); PG8_BAR;
    PG8_STAGE(PG8_SB(1, 0), cB + kstep, voffB); PG8_STAGE(PG8_SA(1, 0), cA + kstep, voffA); PG8_STAGE(PG8_SB(1, 1), cB + hstepB + kstep, voffB);
    PG8_WAIT_V(6); PG8_BAR;
    for (;;) {
        const bool has_next = S.next(ui + 1, nxt);
        const char* nA = has_next ? (const char*)g.A + S.aoff(nxt) : cA; const char* nB = has_next ? (const char*)g.Bt + S.boff(nxt) : cB;
        for (int t = 0; t < nt; t += 2) {
            const bool last = (t == nt - 2);
            const char* a1 = cA + (size_t)(t + 1) * kstep;
            const char* a2 = last ? nA : cA + (size_t)(t + 2) * kstep; const char* b2 = last ? nB : cB + (size_t)(t + 2) * kstep;
            const char* a3 = a2 + kstep; const char* b3 = b2 + kstep;
            PG8_LDB(B0, 0, 0); PG8_LDB(B1, 0, 1); PG8_SCHED; PG8_LDA(At, 0, 0); PG8_STAGE(PG8_SA(1, 1), a1 + hstepA, voffA);
            PG8_WAIT_V(8); PG8_WAIT_L(0); PG8_BAR; PG8_MMA(0, 0, At, B0); PG8_MMA(0, 1, At, B1); PG8_BAR; PG8_SCHED;
            PG8_LDA(At, 0, 1); PG8_STAGE(PG8_SB(0, 0), b2, voffB); PG8_STAGE(PG8_SB(0, 1), b2 + hstepB, voffB); PG8_STAGE(PG8_SA(0, 0), a2, voffA);
            PG8_WAIT_V(8); PG8_WAIT_L(0); PG8_BAR; PG8_MMA(1, 0, At, B0); PG8_MMA(1, 1, At, B1); PG8_BAR; PG8_SCHED;
            PG8_LDB(B0, 1, 0); PG8_LDB(B1, 1, 1); PG8_SCHED; PG8_LDA(At, 1, 0); PG8_STAGE(PG8_SA(0, 1), a2 + hstepA, voffA);
            PG8_WAIT_V(8); PG8_WAIT_L(0); PG8_BAR; PG8_MMA(0, 0, At, B0); PG8_MMA(0, 1, At, B1); PG8_BAR; PG8_SCHED;
            PG8_LDA(At, 1, 1); PG8_STAGE(PG8_SB(1, 0), b3, voffB); PG8_STAGE(PG8_SB(1, 1), b3 + hstepB, voffB); PG8_STAGE(PG8_SA(1, 0), a3, voffA);
            PG8_WAIT_V(8); PG8_WAIT_L(0); PG8_BAR; PG8_MMA(1, 0, At, B0); PG8_MMA(1, 1, At, B1); PG8_BAR; PG8_SCHED;
            if constexpr (Epi::MIDK) { if (t + 2 == nt / 2) E.mid(acc, cur, wr, wc, fr, fq); }
        }
        if constexpr (ALIGN_EPI) { if (wr == 0) PG8_BAR; }
        E(acc, cur, wr, wc, fr, fq);
        if (!has_next) break;
#pragma unroll
        for (int a = 0; a < 2; ++a)
#pragma unroll
            for (int b = 0; b < 2; ++b)
#pragma unroll
                for (int m = 0; m < 4; ++m)
#pragma unroll
                    for (int n = 0; n < 2; ++n) acc[a][b][m][n] = (f32x4){0.f, 0.f, 0.f, 0.f};
        cur = nxt; cA = nA; cB = nB; ++ui;
        if constexpr (ALIGN_EPI) { if (wr == 1) PG8_BAR; }
    }
    PG8_WAIT_V(0);
    if constexpr (!ALIGN_EPI) { if (wr == 0) PG8_BAR; }
    PG8_BAR;
#undef PG8_SA
#undef PG8_SB
#undef PG8_STAGE
#undef PG8_LDA
#undef PG8_LDB
#undef PG8_MMA
#undef PG8_WAIT_V
#undef PG8_WAIT_L
#undef PG8_BAR
#undef PG8_SCHED
}
}
constexpr int NWAVES = 8, NTHR = 512;
constexpr int D = 1024, NB = 4, T = 4096, MPR = NB * T, MS = 128, MALL = MPR + MS, MPAD = 16640;
constexpr int SBW = 512, NH = 8, HD = 64, NG = 32, GP = 16, NST = 64, INW = 2048, FF = 2816, NFF2 = 2 * FF;
constexpr int MT = 256, MH = 4, MHD = 256, PAST = 2048, PAGE = 128, NPG = 16;
constexpr int LC = 16, NCH = T / LC, XHP = 384;
constexpr float EPS = 1e-6f, LOG2E = 1.4426950408889634f;
constexpr float C2 = 0.125f * LOG2E;
constexpr float CM = 0.0625f * LOG2E;

constexpr size_t O_YP = 0, O_YS = O_YP + (size_t)MPR * D, O_KP = O_YS + (size_t)MS * D, O_VP = O_KP + (size_t)MPR * SBW, O_REP = O_VP + (size_t)MPR * SBW,
    O_IMP = O_REP + NB * NG * NST, O_CVP = O_IMP + NB * NG * NST, O_MKP = O_CVP + (size_t)NB * 2 * FF, O_MVP = O_MKP + (size_t)NB * MT * D, O_KS = O_MVP + (size_t)NB * MT * D,
    O_VS = O_KS + (size_t)MS * SBW, O_RES = O_VS + (size_t)MS * SBW, O_IMS = O_RES + (size_t)MS * NG * NST, O_CVS = O_IMS + (size_t)MS * NG * NST, O_END = O_CVS + (size_t)MS * 2 * FF;

constexpr size_t MiB = 1u << 20;
constexpr size_t al(size_t x) { return (x + 4095) & ~(size_t)4095; }
constexpr size_t WS_CTL = 0, CTL_ZERO_BYTES = 1 * MiB;
constexpr size_t WS_WIN = 1 * MiB;
constexpr size_t WS_WMKV = WS_WIN + al((size_t)INW * D * 2);
constexpr size_t WS_WGLU = WS_WMKV + al((size_t)2048 * D * 2);
constexpr size_t WS_WOUT = WS_WGLU + al((size_t)SBW * SBW * 2);
constexpr size_t WS_WMQ = WS_WOUT + al((size_t)D * D * 2);
constexpr size_t WS_WMO = WS_WMQ + al((size_t)D * D * 2);
constexpr size_t WS_WGU = WS_WMO + al((size_t)D * D * 2);
constexpr size_t WS_WDN = WS_WGU + al((size_t)NFF2 * D * 2);
constexpr size_t WS_W1 = WS_WDN + al((size_t)D * FF * 2);
constexpr size_t WS_BTC = WS_W1 + al((size_t)33 * 128 * 256 * 2);
constexpr size_t WS_XB = WS_BTC + al((size_t)NG * 256 * XHP * 2);
constexpr size_t WS_RSTD0 = WS_XB + al((size_t)MPAD * D * 2);
constexpr size_t WS_MB = WS_RSTD0 + al((size_t)MPAD * 4);
constexpr size_t WS_RSTDM = WS_MB + al((size_t)1024 * D * 2);
constexpr size_t WS_QB = WS_RSTDM + al(4096);
constexpr size_t WS_KB = WS_QB + al((size_t)MPAD * SBW * 2);
constexpr size_t WS_VB = WS_KB + al((size_t)MPAD * SBW * 2);
constexpr size_t WS_QS = WS_VB + al((size_t)MPAD * SBW * 2);
constexpr size_t WS_US = WS_QS + al((size_t)MS * SBW * 4);
constexpr size_t WS_XH = WS_US + al((size_t)MS * SBW * 4);
constexpr size_t WS_SST = WS_XH + al((size_t)1024 * NG * XHP * 2 + 65536);
constexpr size_t WS_YG = WS_SST + al((size_t)1024 * NG * 128 * 4);
constexpr size_t WS_OSB = WS_YG + al((size_t)MPAD * SBW * 2);
constexpr size_t WS_OSSM = WS_OSB + al((size_t)MPAD * SBW * 2);
constexpr size_t WS_SBPO = WS_OSSM + al((size_t)MPAD * SBW * 2);
constexpr size_t WS_SBPL = WS_SBPO + al((size_t)MS * NPG * NH * HD * 4);
constexpr size_t WS_MIX = WS_SBPL + al((size_t)MS * NPG * NH * 4);
constexpr size_t WS_X1 = WS_MIX + al((size_t)MPAD * D * 2);
constexpr size_t WS_X1B = WS_X1 + al((size_t)MPAD * D * 4);
constexpr size_t WS_MKB = WS_X1B + al((size_t)MPAD * D * 2);
constexpr size_t WS_MVB = WS_MKB + al((size_t)1024 * D * 2);
constexpr size_t WS_QM = WS_MVB + al((size_t)1024 * D * 2);
constexpr size_t WS_OMEM = WS_QM + al((size_t)MPAD * D * 2);
constexpr size_t WS_X2 = WS_OMEM + al((size_t)MPAD * D * 2);
constexpr size_t WS_X2B = WS_X2 + al((size_t)MPAD * D * 4);
constexpr size_t WS_GB = WS_X2B + al((size_t)MPAD * D * 2);
constexpr size_t WS_UB = WS_GB + al((size_t)MPAD * FF * 2);
constexpr size_t WS_FAST_END = WS_UB + al((size_t)MPAD * FF * 2);
constexpr int CW_TMO = 0, CW_CODE = 1, CW_QA = 2048, CW_QM = 2112, CW_SCNT = 2240  , CW_PCNT = 2304  , CW_BAR = 4096;
constexpr int CW_SSQ1 = 16384, CW_SSQ2 = CW_SSQ1 + MPAD, CW_SSQ3 = CW_SSQ2 + MPAD, CW_SSQD = CW_SSQ3 + MPAD, CW_SSQA = CW_SSQD + MPAD, CW_SSQB = CW_SSQA + MPAD;
static_assert((CW_SSQB + MPAD) * 4 <= (int)CTL_ZERO_BYTES, "CTL words inside the memset region");

constexpr int RING_OFF = 0, RING_BYTES = 131072;
constexpr int LDSCTL_OFF = RING_BYTES, MISC_OFF = LDSCTL_OFF + 320;
constexpr int LDS_BYTES = 147456;
static_assert(MISC_OFF + 128 <= LDS_BYTES, "LDS map");

#define GAS __attribute__((address_space(1)))
#define LAS __attribute__((address_space(3)))
typedef unsigned short bf16;
typedef unsigned v4u __attribute__((ext_vector_type(4)));
typedef unsigned v2u __attribute__((ext_vector_type(2)));
typedef float f32x4 __attribute__((ext_vector_type(4)));
typedef float f32x2 __attribute__((ext_vector_type(2)));
typedef float f32x16 __attribute__((ext_vector_type(16)));
typedef short bf16x8 __attribute__((ext_vector_type(8)));
typedef short s16x4 __attribute__((ext_vector_type(4)));
typedef GAS unsigned gu32;
#define RLX_AGENT __ATOMIC_RELAXED, __HIP_MEMORY_SCOPE_AGENT
#define LDS_WAIT() asm volatile("s_waitcnt lgkmcnt(0)" ::: "memory")
#define VM_WAIT() asm volatile("s_waitcnt vmcnt(0)" ::: "memory")
__device__ __forceinline__ unsigned f2bf(float f) { unsigned u = __builtin_bit_cast(unsigned, f); return (u + 0x7fffu + ((u >> 16) & 1u)) >> 16; }
__device__ __forceinline__ unsigned pk2(float lo, float hi) { return f2bf(lo) | (f2bf(hi) << 16); }
__device__ __forceinline__ float bf2f(unsigned short h) { return __builtin_bit_cast(float, (unsigned)h << 16); }
__device__ __forceinline__ float bflo(unsigned w) { return __builtin_bit_cast(float, w << 16); }
__device__ __forceinline__ float bfhi(unsigned w) { return __builtin_bit_cast(float, w & 0xffff0000u); }
typedef float f32x2_c __attribute__((ext_vector_type(2))); typedef __bf16 bf16x2_c __attribute__((ext_vector_type(2)));
__device__ __forceinline__ unsigned cvtpk(float lo, float hi) { f32x2_c v = {lo, hi}; bf16x2_c r = __builtin_convertvector(v, bf16x2_c); return __builtin_bit_cast(unsigned, r); }
__device__ __forceinline__ float gelu_tanh_f(float x) {
    const float u2 = 2.f * 0.7978845608028654f * (x + 0.044715f * x * x * x);
    return x * __builtin_amdgcn_rcpf(1.f + __builtin_amdgcn_exp2f(-u2 * LOG2E));
}

__device__ __forceinline__ float swap16(float v) { auto rr = __builtin_amdgcn_permlane16_swap(__float_as_uint(v), __float_as_uint(v), false, false); return __uint_as_float((threadIdx.x & 16) ? rr[0] : rr[1]); }
__device__ __forceinline__ float swap_half(float v) { auto rr = __builtin_amdgcn_permlane32_swap(__float_as_uint(v), __float_as_uint(v), false, false); return __uint_as_float((threadIdx.x & 32) ? rr[0] : rr[1]); }
__device__ __forceinline__ float wave_sum(float x) {
    x += __builtin_bit_cast(float, __builtin_amdgcn_update_dpp(0, __builtin_bit_cast(int, x), 0xB1, 0xf, 0xf, true));
    x += __builtin_bit_cast(float, __builtin_amdgcn_update_dpp(0, __builtin_bit_cast(int, x), 0x4E, 0xf, 0xf, true));
    x += __builtin_bit_cast(float, __builtin_amdgcn_update_dpp(0, __builtin_bit_cast(int, x), 0x141, 0xf, 0xf, true));
    x += __builtin_bit_cast(float, __builtin_amdgcn_update_dpp(0, __builtin_bit_cast(int, x), 0x140, 0xf, 0xf, true));
    x += swap16(x); x += swap_half(x); return x;
}
#define XB_TMO      128
#define XB_XCNT(j)  (256  + 64 * (j))
#define XB_XSUB(j)  (1280 + 64 * (j))
#define XB_XGEN(j)  (2304 + 64 * (j))
#define XB_TOP      3328
#define XB_TOPGEN   3392
#define XCD_BAR_WORDS 3456
#define XB_SPIN_CAP (1u << 18)
__device__ __forceinline__ unsigned xb_ld(unsigned* p)              { return __hip_atomic_load(p, __ATOMIC_RELAXED, __HIP_MEMORY_SCOPE_AGENT); }
__device__ __forceinline__ unsigned xb_add(unsigned* p, unsigned v) { return __hip_atomic_fetch_add(p, v, __ATOMIC_RELAXED, __HIP_MEMORY_SCOPE_AGENT); }
__device__ __forceinline__ unsigned xb_xcc_id() { return (unsigned)__builtin_amdgcn_s_getreg((3 << 11) | 20) & 0xFu; }
#define XB_SPIN(cond, bar) do { unsigned _sp = 0; while (cond) { __builtin_amdgcn_s_sleep(1); \
    if ((++_sp & 255u) == 0u) { if (xb_ld(&(bar)[XB_TMO])) break; if (_sp > XB_SPIN_CAP) { atomicAdd(&(bar)[XB_TMO], 1u); break; } } } } while (0)
struct XcdBarrier { unsigned* bar; unsigned x; volatile LAS unsigned* st; };
__device__ __forceinline__ XcdBarrier xcd_barrier_post(unsigned* bar, volatile LAS unsigned* st) {
    XcdBarrier b; b.bar = bar; b.x = xb_xcc_id(); b.st = st;
    if (threadIdx.x == 0) (void)xb_add(&bar[XB_XCNT(b.x)], 1u);
    return b;
}
__device__ __forceinline__ void xcd_barrier_complete(unsigned* bar, unsigned x, unsigned& nloc, unsigned& nx) {
    const unsigned G = gridDim.x * gridDim.y * gridDim.z;
    unsigned sum, cnt, mine, sp = 0u;
    for (;;) {
        sum = 0u; cnt = 0u; mine = 0u;
#pragma unroll
        for (unsigned j = 0; j < 16; ++j) { const unsigned c = xb_ld(&bar[XB_XCNT(j)]); sum += c; cnt += (c > 0u) ? 1u : 0u; mine = (j == x) ? c : mine; }
        if (sum == G) break;
        __builtin_amdgcn_s_sleep(1);
        if ((++sp & 255u) == 0u) { if (xb_ld(&bar[XB_TMO])) break; if (sp > XB_SPIN_CAP) { atomicAdd(&bar[XB_TMO], 1u); break; } }
    }
    nloc = mine > 0u ? mine : 1u; nx = cnt > 0u ? cnt : 1u;
}
__device__ __forceinline__ void xcd_barrier(const XcdBarrier& b) {
    asm volatile("s_waitcnt vmcnt(0)" ::: "memory");
    __syncthreads();
    if (threadIdx.x == 0) {
        unsigned* bar = b.bar;
        __builtin_amdgcn_s_waitcnt(0);
        unsigned nloc = b.st[0], nx = b.st[1];
        if (nloc == 0u) { xcd_barrier_complete(bar, b.x, nloc, nx); b.st[0] = nloc; b.st[1] = nx; }
        const unsigned old = xb_add(&bar[XB_XSUB(b.x)], 1u);
        const unsigned gen = old / nloc;
        if (old + 1u == (gen + 1u) * nloc) {
            __builtin_amdgcn_fence(__ATOMIC_RELEASE, "agent");
            asm volatile("s_waitcnt vmcnt(0)" ::: "memory");
            const unsigned og = xb_add(&bar[XB_TOP], 1u);
            const unsigned tg = og / nx;
            if (og + 1u == (tg + 1u) * nx) xb_add(&bar[XB_TOPGEN], 1u);
            else XB_SPIN(xb_ld(&bar[XB_TOPGEN]) == tg, bar);
            __builtin_amdgcn_fence(__ATOMIC_ACQUIRE, "agent");
            xb_add(&bar[XB_XGEN(b.x)], 1u);
            asm volatile("s_waitcnt vmcnt(0)" ::: "memory");
        } else {
            XB_SPIN(xb_ld(&bar[XB_XGEN(b.x)]) == gen, bar);
            __builtin_amdgcn_fence(__ATOMIC_ACQUIRE, "agent");
            asm volatile("s_waitcnt vmcnt(0)" ::: "memory");
        }
    }
    __syncthreads();
}

struct Args { const void* in[40]; float* out; unsigned char* ws; int ph_lo, ph_hi, use_bar, pad; };
struct Frame {
    LAS unsigned char* lds; volatile LAS unsigned* MISC; unsigned* ctl;
    int tid, lane, wave, vcu, G;
    unsigned char* ws; float* out; const void* const* in;
};
#define INF(i) ((const float*)F.in[i])
#define WSP(T_, off) ((T_*)(F.ws + (off)))
struct TrItem { const float* W; const float* gain; bf16* WT; int K, N, row_off, k0, n0; };
__device__ __forceinline__ void tr_load(const TrItem& t, float (&wv)[32], int lane) {
#pragma unroll
    for (int i = 0; i < 32; ++i) wv[i] = t.W[(size_t)(t.k0 + 2 * i + (lane >> 5)) * t.N + t.n0 + (lane & 31)];
}
__device__ __forceinline__ void tr_finish(const TrItem& t, const float (&wv)[32], LAS float* scr, int lane) {
#pragma unroll
    for (int i = 0; i < 32; ++i) { const int kk = 2 * i + (lane >> 5); const float gv = t.gain ? t.gain[t.k0 + kk] : 1.f; scr[kk * 33 + (lane & 31)] = wv[i] * gv; }
    LDS_WAIT(); asm volatile("" ::: "memory");
    const int c = lane & 7;
#pragma unroll
    for (int j = 0; j < 4; ++j) { const int n = (lane >> 3) + 8 * j; const LAS float* s = scr + (8 * c) * 33 + n;
        v4u o; o.x = pk2(s[0 * 33], s[1 * 33]); o.y = pk2(s[2 * 33], s[3 * 33]); o.z = pk2(s[4 * 33], s[5 * 33]); o.w = pk2(s[6 * 33], s[7 * 33]);
        *(GAS v4u*)(t.WT + (size_t)(t.row_off + t.n0 + n) * t.K + t.k0 + 8 * c) = o; }
    LDS_WAIT(); asm volatile("" ::: "memory");
}
__device__ __forceinline__ void rows2_load(const float* xrow, f32x4 (&v)[2][4], int lane) {
#pragma unroll
    for (int r = 0; r < 2; ++r)
#pragma unroll
        for (int j = 0; j < 4; ++j) v[r][j] = ((const GAS f32x4*)(xrow + (size_t)r * D) + lane)[64 * j];
}
__device__ __forceinline__ void rows2_finish(const f32x4 (&v)[2][4], bf16* orow, float* rstd, int lane) {
    float s[2] = {0.f, 0.f};
#pragma unroll
    for (int r = 0; r < 2; ++r) {
#pragma unroll
        for (int j = 0; j < 4; ++j) s[r] += (v[r][j].x * v[r][j].x + v[r][j].y * v[r][j].y) + (v[r][j].z * v[r][j].z + v[r][j].w * v[r][j].w);
        GAS v2u* o8 = (GAS v2u*)(orow + (size_t)r * D) + lane;
#pragma unroll
        for (int j = 0; j < 4; ++j) { v2u w; w.x = pk2(v[r][j].x, v[r][j].y); w.y = pk2(v[r][j].z, v[r][j].w); o8[64 * j] = w; }
    }
    s[0] = wave_sum(s[0]); s[1] = wave_sum(s[1]);
    if (lane < 2) rstd[lane] = 1.f / sqrtf((lane ? s[1] : s[0]) * (1.f / D) + EPS);
}
__device__ __forceinline__ void lam_pow(float lr, float li, float logdt, int tau, float& pr, float& pi) {
    const double dt = exp((double)logdt);
    const double ang = (double)li * dt * (double)tau;
    const double k = rint(ang * 0.15915494309189535);
    double r = fma(-k, 6.283185307179586, ang); r = fma(-k, 2.4492935982947064e-16, r);
    const float rf = (float)r, mag = (float)exp((double)lr * dt * (double)tau);
    pr = mag * cosf(rf); pi = mag * sinf(rf);
}
__device__ __forceinline__ void lam_coef(float lr, float li, float logdt, float& cr, float& ci) {
    const double dt = exp((double)logdt);
    const double ang = (double)li * dt;
    const double k = rint(ang * 0.15915494309189535);
    double r = fma(-k, 6.283185307179586, ang); r = fma(-k, 2.4492935982947064e-16, r);
    const float th = (float)r, a = (float)((double)lr * dt);
    const float sh = sinf(0.5f * th);
    const float nr = expm1f(a) * cosf(th) - 2.f * sh * sh, ni = expf(a) * sinf(th);
    const float den = lr * lr + li * li;
    cr = (nr * lr + ni * li) / den; ci = (ni * lr - nr * li) / den;
}
__device__ __forceinline__ void ssm_table_unit(Frame& F, int g, int tau) {
    LAS float* Mr = (LAS float*)(F.lds + RING_OFF); LAS float* Mi = Mr + 1024; LAS float* Pr = Mi + 1024; LAS float* Pi = Pr + 64; LAS float* Cr = Pi + 64; LAS float* Ci = Cr + 64;
    LAS float* Kt = Ci + 64; LAS float* CRE = Kt + 256; LAS float* CIM = CRE + 1024; LAS float* Qr = CIM + 1024; LAS float* Qi = Qr + 64;
    const float* lam_re = INF(14); const float* lam_im = INF(15); const float* log_dt = INF(16); const float* b_re = INF(17); const float* b_im = INF(18);
    const float* c_re = INF(19); const float* c_im = INF(20); const float* d_skip = INF(21);
    bf16* W1 = WSP(bf16, WS_W1); bf16* BTC = WSP(bf16, WS_BTC);
    const int tid = F.tid; const float ldt = log_dt[g];
    __syncthreads();
    if (tid < 64) { float pr, pi, cr, ci; const float lr = lam_re[g * NST + tid], li = lam_im[g * NST + tid]; lam_pow(lr, li, ldt, tau, pr, pi); lam_coef(lr, li, ldt, cr, ci); Pr[tid] = pr; Pi[tid] = pi; Cr[tid] = cr; Ci[tid] = ci; lam_pow(lr, li, ldt, tau + 1, pr, pi); Qr[tid] = pr; Qi[tid] = pi; }
    for (int i = tid; i < 1024; i += NTHR) { CRE[i] = c_re[g * 1024 + i]; CIM[i] = c_im[g * 1024 + i]; }
    __syncthreads();
    for (int i = tid; i < 1024; i += NTHR) { const int n = i >> 4; const float cr = Cr[n], ci = Ci[n];
        const float br = b_re[g * 1024 + i], bi = b_im[g * 1024 + i]; const float bbr = cr * br - ci * bi, bbi = cr * bi + ci * br;
        const float pr = Pr[n], pi = Pi[n]; Mr[i] = pr * bbr - pi * bbi; Mi[i] = pr * bbi + pi * bbr; }
    __syncthreads();
    {
        const int s = 15 - tau;
        for (int i = tid; i < 2048; i += NTHR) { const int n = i >> 5, ri = (i >> 4) & 1, q = i & 15; const float v = ri ? Mi[n * 16 + q] : Mr[n * 16 + q];
            W1[((size_t)g * 128 + 2 * n + ri) * 256 + s * 16 + q] = (bf16)f2bf(v); }
        if (tid < 256) { const int p = tid >> 4, q = tid & 15; float acc = 0.f;
#pragma unroll 8
            for (int n = 0; n < NST; ++n) acc += CRE[p * NST + n] * Mr[n * 16 + q] - CIM[p * NST + n] * Mi[n * 16 + q];
            if (tau == 0 && p == q) acc += d_skip[g * GP + p];
            Kt[tid] = acc; }
        __syncthreads();
        for (int idx = tid; idx < (16 - tau) * 256; idx += NTHR) { const int blk = idx >> 8, e = idx & 255, p = e >> 4, q = e & 15; const int s2 = blk, t2 = s2 + tau;
            BTC[((size_t)g * 256 + t2 * 16 + p) * XHP + s2 * 16 + q] = (bf16)f2bf(Kt[e]);
            if (tau >= 1) BTC[((size_t)g * 256 + s2 * 16 + p) * XHP + t2 * 16 + q] = (bf16)0; }
    }
    {
        for (int idx = tid; idx < 1024; idx += NTHR) { const int p = idx >> 6, n = idx & 63; const float cr = CRE[idx], ci = CIM[idx], pr = Qr[n], pi = Qi[n];
            const unsigned w = pk2(cr * pr - ci * pi, -(cr * pi + ci * pr));
            *(GAS unsigned*)(BTC + ((size_t)g * 256 + tau * 16 + p) * XHP + 256 + 2 * n) = w; }
    }
    __syncthreads();
}
__device__ __forceinline__ TrItem tr_item(Frame& F, int it) {
    constexpr int I_IN = 16 * 64, I_MK = 16 * 32, I_GLU = 8 * 16, I_SQ = 16 * 32, I_G = 16 * 88;
    TrItem t; int r = it; t.row_off = 0; t.K = D;
    if (r < I_IN) { t.W = INF(12); t.N = INW; t.WT = WSP(bf16, WS_WIN); t.gain = INF(11); }
    else if ((r -= I_IN) < I_MK) { t.W = INF(30); t.N = D; t.WT = WSP(bf16, WS_WMKV); t.gain = INF(28); }
    else if ((r -= I_MK) < I_MK) { t.W = INF(31); t.N = D; t.WT = WSP(bf16, WS_WMKV); t.gain = INF(28); t.row_off = D; }
    else if ((r -= I_MK) < I_GLU) { t.W = INF(22); t.N = SBW; t.K = SBW; t.WT = WSP(bf16, WS_WGLU); t.gain = nullptr; }
    else if ((r -= I_GLU) < I_SQ) { t.W = INF(26); t.N = D; t.WT = WSP(bf16, WS_WOUT); t.gain = (r / (D / 32) < 8) ? INF(24) : INF(25) - SBW; }
    else if ((r -= I_SQ) < I_SQ) { t.W = INF(29); t.N = D; t.WT = WSP(bf16, WS_WMQ); t.gain = INF(27); }
    else if ((r -= I_SQ) < I_SQ) { t.W = INF(32); t.N = D; t.WT = WSP(bf16, WS_WMO); t.gain = nullptr; }
    else if ((r -= I_SQ) < I_G) { t.W = INF(34); t.N = FF; t.WT = WSP(bf16, WS_WGU); t.gain = INF(33); }
    else if ((r -= I_G) < I_G) { t.W = INF(35); t.N = FF; t.WT = WSP(bf16, WS_WGU); t.gain = INF(33); t.row_off = FF; }
    else { r -= I_G; t.W = INF(38); t.N = D; t.K = FF; t.WT = WSP(bf16, WS_WDN); t.gain = nullptr; }
    const int nblk = t.N / 32; t.k0 = 64 * (r / nblk); t.n0 = 32 * (r % nblk); return t;
}
constexpr int NITEMS_EARLY = 16 * 64 + 2 * 16 * 32, NITEMS_GLU = NITEMS_EARLY + 8 * 16, NITEMS_ALL = 16 * 64 + 2 * 16 * 32 + 8 * 16 + 3 * 16 * 32 + 2 * 16 * 88 + 44 * 32;
constexpr int NITEMS_MID = NITEMS_GLU + 3 * 16 * 32 + 16 * 88;
__device__ __forceinline__ void weight_copies(Frame& F, int lo, int hi, int cu0 = 0, int ncu = 0) {
    LAS float* scr = (LAS float*)(F.lds + RING_OFF + F.wave * 16384);
    if (ncu && ((int)blockIdx.x < cu0 || (int)blockIdx.x >= cu0 + ncu)) return;
    const int gw = (ncu ? (int)blockIdx.x - cu0 : F.vcu) * NWAVES + F.wave, NGW = (ncu ? ncu : F.G) * NWAVES;
    if (lo + gw < hi) {
        float wa[32], wb[32]; TrItem ta = tr_item(F, lo + gw), tb; tr_load(ta, wa, F.lane);
        for (int it = lo + gw; it < hi; it += NGW) {
            const bool more = it + NGW < hi;
            if (more) { tb = tr_item(F, it + NGW); tr_load(tb, wb, F.lane); }
            tr_finish(ta, wa, scr, F.lane);
            if (more) { ta = tb;
#pragma unroll
                for (int i = 0; i < 32; ++i) wa[i] = wb[i]; }
        }
    }
}
__device__ __forceinline__ void p0_prologue(Frame& F) {
    LAS float* scr = (LAS float*)(F.lds + RING_OFF + F.wave * 16384);
    const int gw = F.vcu * NWAVES + F.wave, NGW = F.G * NWAVES;
    weight_copies(F, 0, NITEMS_EARLY);
    {
        f32x4 va[2][4], vb[2][4];
        auto src = [&](int m) -> const float* { return (m < MPR) ? INF(0) + (size_t)m * D : (m < MALL) ? INF(1) + (size_t)(m - MPR) * D : INF(10) + (size_t)(m - MALL) * D; };
        constexpr int NR = MALL + NB * MT;
        int m = 2 * gw;
        if (m < NR) { rows2_load(src(m), va, F.lane);
            for (; m < NR; m += 2 * NGW) {
                const bool more = m + 2 * NGW < NR;
                if (more) rows2_load(src(m + 2 * NGW), vb, F.lane);
                if (m < MALL) rows2_finish(va, WSP(bf16, WS_XB) + (size_t)m * D, WSP(float, WS_RSTD0) + m, F.lane);
                else rows2_finish(va, WSP(bf16, WS_MB) + (size_t)(m - MALL) * D, WSP(float, WS_RSTDM) + (m - MALL), F.lane);
                if (more) {
#pragma unroll
                    for (int r = 0; r < 2; ++r)
#pragma unroll
                        for (int j = 0; j < 4; ++j) va[r][j] = vb[r][j]; }
            } }
    }
    for (int u = F.vcu; u < NG * 16; u += F.G) ssm_table_unit(F, u >> 4, u & 15);
    { bf16* W1 = WSP(bf16, WS_W1); for (int i = gw * 64 + F.lane; i < 128 * 256 / 8; i += NGW * 64) *(GAS v4u*)(W1 + (size_t)32 * 128 * 256 + (size_t)i * 8) = (v4u){0u, 0u, 0u, 0u}; }
}

constexpr int HALO_OFF_C = RING_BYTES + 1024;
#define EPI_LOOP_BEGIN \
    _Pragma("unroll") for (int ai = 0; ai < 2; ++ai) _Pragma("unroll") for (int m = 0; m < 4; ++m) { const int row = u.pm * 256 + ai * 128 + wr * 64 + m * 16 + fr; \
    _Pragma("unroll") for (int bj = 0; bj < 2; ++bj) { const int col = u.pn * 256 + bj * 128 + wc * 32 + 8 * fq; f32x4 v0 = acc[ai][bj][m][0], v1 = acc[ai][bj][m][1];
#define EPI_LOOP_END } }
__device__ __forceinline__ v4u pack8(f32x4 a, f32x4 b) { v4u w; w.x = cvtpk(a[0], a[1]); w.y = cvtpk(a[2], a[3]); w.z = cvtpk(b[0], b[1]); w.w = cvtpk(b[2], b[3]); return w; }

struct EpiInProj { static constexpr bool MIDK = false;
    const float* rstd; bf16 *QBp, *KBp, *VBp, *XHp; float *QSp, *USp, *out;
    __device__ __forceinline__ void operator()(const f32x4 (&acc)[2][2][4][2], const pg8::Unit& u, int wr, int wc, int fr_, int fq_) const { int fr = fr_, fq = fq_; asm volatile("" : "+v"(fr), "+v"(fq));
        const int sect = u.pn >> 1;
        EPI_LOOP_BEGIN
            if (row < MALL) {
                const float rs = rstd[row]; v0 = v0 * rs; v1 = v1 * rs;
                const int c = col - sect * SBW;
                if (sect == 0) { v0 = v0 * C2; v1 = v1 * C2; *(v4u*)(QBp + (size_t)row * SBW + c) = pack8(v0, v1);
                    if (row >= MPR) { float* q = QSp + (size_t)(row - MPR) * SBW + c; *(f32x4*)q = v0; *(f32x4*)(q + 4) = v1; } }
                else if (sect == 1 || sect == 2) { bf16* B = (sect == 1) ? KBp : VBp; *(v4u*)(B + (size_t)row * SBW + c) = pack8(v0, v1);
                    float* o = (row < MPR) ? out + (sect == 1 ? O_KP : O_VP) + (size_t)row * SBW + c : out + (sect == 1 ? O_KS : O_VS) + (size_t)(row - MPR) * SBW + c;
                    *(f32x4*)o = v0; *(f32x4*)(o + 4) = v1; }
                else { if (row < MPR) { const int b = row >> 12, t = row & 4095, ch = t >> 4, s = t & 15, g = c >> 4, q0 = c & 15;
                        *(v4u*)(XHp + ((size_t)(b * NCH + ch) * NG + g) * XHP + s * 16 + q0) = pack8(v0, v1); }
                    else { float* q = USp + (size_t)(row - MPR) * SBW + c; *(f32x4*)q = v0; *(f32x4*)(q + 4) = v1; } }
            }
        EPI_LOOP_END
    }
};
struct EpiMemKV { static constexpr bool MIDK = false;
    const float* rstd; bf16 *MKBp, *MVBp; float* out;
    __device__ __forceinline__ void operator()(const f32x4 (&acc)[2][2][4][2], const pg8::Unit& u, int wr, int wc, int fr_, int fq_) const { int fr = fr_, fq = fq_; asm volatile("" : "+v"(fr), "+v"(fq));
        const int sect = u.pn >> 2;
        EPI_LOOP_BEGIN
            const float rs = rstd[row]; v0 = v0 * rs; v1 = v1 * rs; const int c = col - sect * D;
            bf16* B = sect ? MVBp : MKBp; *(v4u*)(B + (size_t)row * D + c) = pack8(v0, v1);
            float* o = out + (sect ? O_MVP : O_MKP) + (size_t)row * D + c; *(f32x4*)o = v0; *(f32x4*)(o + 4) = v1;
        EPI_LOOP_END
    }
};
struct EpiSsmA { static constexpr bool MIDK = false;
    float* SST;
    __device__ __forceinline__ void operator()(const f32x4 (&acc)[2][2][4][2], const pg8::Unit& u, int wr, int wc, int fr_, int fq_) const { int fr = fr_, fq = fq_; asm volatile("" : "+v"(fr), "+v"(fq));
        _Pragma("unroll") for (int ai = 0; ai < 2; ++ai) _Pragma("unroll") for (int m = 0; m < 4; ++m) { const int row = u.pm * 256 + ai * 128 + wr * 64 + m * 16 + fr;
            const int col = wc * 32 + 8 * fq; float* o = SST + ((size_t)row * NG + u.pn) * 128 + col; *(f32x4*)o = acc[ai][0][m][0]; *(f32x4*)(o + 4) = acc[ai][0][m][1]; }
    }
};
struct EpiSsmC { static constexpr bool MIDK = false;
    bf16* YG;
    __device__ __forceinline__ void operator()(const f32x4 (&acc)[2][2][4][2], const pg8::Unit& u, int wr, int wc, int fr_, int fq_) const { int fr = fr_, fq = fq_; asm volatile("" : "+v"(fr), "+v"(fq));
        _Pragma("unroll") for (int ai = 0; ai < 2; ++ai) _Pragma("unroll") for (int m = 0; m < 4; ++m) { const int ch = ai * 128 + wr * 64 + m * 16 + fr;
            _Pragma("unroll") for (int bj = 0; bj < 2; ++bj) { const int col = bj * 128 + wc * 32 + 8 * fq, t = col >> 4, p0 = col & 15; f32x4 v0 = acc[ai][bj][m][0], v1 = acc[ai][bj][m][1];
                _Pragma("unroll") for (int e = 0; e < 4; ++e) { v0[e] = gelu_tanh_f(v0[e]); v1[e] = gelu_tanh_f(v1[e]); }
                *(v4u*)(YG + ((size_t)u.pm * T + ch * LC + t) * SBW + u.pn * GP + p0) = pack8(v0, v1); } }
    }
};
struct EpiGlu { static constexpr bool MIDK = false;
    const bf16* YG; const float* bglu; bf16* MIXU; float* ssq;
    __device__ __forceinline__ void operator()(const f32x4 (&acc)[2][2][4][2], const pg8::Unit& u, int wr, int wc, int fr_, int fq_) const { int fr = fr_, fq = fq_; asm volatile("" : "+v"(fr), "+v"(fq));
        _Pragma("unroll") for (int ai = 0; ai < 2; ++ai) _Pragma("unroll") for (int m = 0; m < 4; ++m) { const int row = u.pm * 256 + ai * 128 + wr * 64 + m * 16 + fr; float sq = 0.f;
            _Pragma("unroll") for (int bj = 0; bj < 2; ++bj) { const int col = u.pn * 256 + bj * 128 + wc * 32 + 8 * fq; f32x4 v0 = acc[ai][bj][m][0], v1 = acc[ai][bj][m][1];
                const v4u yw = *(const v4u*)(YG + (size_t)row * SBW + col); const f32x4 b0 = *(const f32x4*)(bglu + col), b1 = *(const f32x4*)(bglu + col + 4);
                const float y[8] = {bflo(yw.x), bfhi(yw.x), bflo(yw.y), bfhi(yw.y), bflo(yw.z), bfhi(yw.z), bflo(yw.w), bfhi(yw.w)};
                _Pragma("unroll") for (int e = 0; e < 4; ++e) { v0[e] = y[e] * __builtin_amdgcn_rcpf(1.f + __builtin_amdgcn_exp2f(-(v0[e] + b0[e]) * LOG2E));
                                                                 v1[e] = y[4 + e] * __builtin_amdgcn_rcpf(1.f + __builtin_amdgcn_exp2f(-(v1[e] + b1[e]) * LOG2E)); }
                *(v4u*)(MIXU + (size_t)row * D + SBW + col) = pack8(v0, v1);
                sq += (v0[0] * v0[0] + v0[1] * v0[1]) + (v0[2] * v0[2] + v0[3] * v0[3]) + (v1[0] * v1[0] + v1[1] * v1[1]) + (v1[2] * v1[2] + v1[3] * v1[3]); }
            sq += swap16(sq); sq += swap_half(sq);
            if (fq == 0) atomicAdd(ssq + row, sq); }
    }
};
struct EpiResid { static constexpr bool MIDK = false;
    const float* base0; const float* base1; float* xo; bf16* xb; float* ssq;
    __device__ __forceinline__ void operator()(const f32x4 (&acc)[2][2][4][2], const pg8::Unit& u, int wr, int wc, int fr_, int fq_) const { int fr = fr_, fq = fq_; asm volatile("" : "+v"(fr), "+v"(fq));
        _Pragma("unroll") for (int ai = 0; ai < 2; ++ai) _Pragma("unroll") for (int m = 0; m < 4; ++m) { const int row = u.pm * 256 + ai * 128 + wr * 64 + m * 16 + fr; float sq = 0.f;
            const bool ok = row < MALL; const float* bp = (row < MPR) ? base0 + (size_t)row * D : base1 + (size_t)(row - MPR) * D;
            _Pragma("unroll") for (int bj = 0; bj < 2; ++bj) { const int col = u.pn * 256 + bj * 128 + wc * 32 + 8 * fq; f32x4 v0 = acc[ai][bj][m][0], v1 = acc[ai][bj][m][1];
                if (ok) { v0 = v0 + *(const f32x4*)(bp + col); v1 = v1 + *(const f32x4*)(bp + col + 4);
                    if (xo) { float* o = xo + (size_t)row * D + col; *(f32x4*)o = v0; *(f32x4*)(o + 4) = v1; }
                    if (xb) *(v4u*)(xb + (size_t)row * D + col) = pack8(v0, v1);
                    sq += (v0[0] * v0[0] + v0[1] * v0[1]) + (v0[2] * v0[2] + v0[3] * v0[3]) + (v1[0] * v1[0] + v1[1] * v1[1]) + (v1[2] * v1[2] + v1[3] * v1[3]); } }
            sq += swap16(sq); sq += swap_half(sq);
            if (ok && fq == 0) atomicAdd(ssq + row, sq); }
    }
};
struct EpiScaleBf16 { static constexpr bool MIDK = false;
    const float* ssq; float scale; bf16* O;
    __device__ __forceinline__ void operator()(const f32x4 (&acc)[2][2][4][2], const pg8::Unit& u, int wr, int wc, int fr_, int fq_) const { int fr = fr_, fq = fq_; asm volatile("" : "+v"(fr), "+v"(fq));
        EPI_LOOP_BEGIN
            if (row < MALL) { const float rs = scale / sqrtf(ssq[row] * (1.f / D) + EPS); v0 = v0 * rs; v1 = v1 * rs; *(v4u*)(O + (size_t)row * D + col) = pack8(v0, v1); }
        EPI_LOOP_END
    }
};
struct EpiGateUp { static constexpr bool MIDK = false;
    const float* ssq; bf16 *GBp, *UBp; float* out;
    __device__ __forceinline__ void operator()(const f32x4 (&acc)[2][2][4][2], const pg8::Unit& u, int wr, int wc, int fr_, int fq_) const { int fr = fr_, fq = fq_; asm volatile("" : "+v"(fr), "+v"(fq));
        const bool up = u.pn >= 11;
        EPI_LOOP_BEGIN
            if (row < MALL) { const float rs = 1.f / sqrtf(ssq[row] * (1.f / D) + EPS); v0 = v0 * rs; v1 = v1 * rs;
                if (up) *(v4u*)(UBp + (size_t)row * FF + (col - FF)) = pack8(v0, v1);
                else { *(v4u*)(GBp + (size_t)row * FF + col) = pack8(v0, v1);
                    if (row >= MPR) { float* o = out + O_CVS + ((size_t)(row - MPR) * 2 + 1) * FF + col; *(f32x4*)o = v0; *(f32x4*)(o + 4) = v1; }
                    else { const int t = row & 4095; if (t >= T - 2) { float* o = out + O_CVP + ((size_t)(row >> 12) * 2 + (t - (T - 2))) * FF + col; *(f32x4*)o = v0; *(f32x4*)(o + 4) = v1; } } } }
        EPI_LOOP_END
    }
};
struct SsmOrder {
    int G, c; size_t bstride;
    __device__ bool next(int i, pg8::Unit& u) const { const int L = i * G + c; if (L >= NG * NB) return false; u.pn = L >> 2; u.pm = L & 3; return true; }
    __device__ __forceinline__ size_t aoff(const pg8::Unit& u) const { return ((size_t)u.pm * NCH * NG * XHP + (size_t)u.pn * XHP) * 2; }
    __device__ __forceinline__ size_t boff(const pg8::Unit& u) const { return (size_t)u.pn * bstride; }
};
template <class Epi>
__device__ __forceinline__ void skinny_gemm(Frame& F, const bf16* A, int lda, const bf16* Bt, int ldb, int N, int K, const Epi& E, int u0, int ustride, int ustep = 32, int nb1off = 16) {
    const int lane = F.lane, wid = F.wave; const int kw = K >> 3, nks = kw >> 5;
    LAS float* red = (LAS float*)(F.lds + RING_OFF);
    for (int u = u0; u < 2 * (N / ustep); u += ustride) {
        const int uc = u >> 1, rh = u & 1;
        f32x4 acc[2][4];
#pragma unroll
        for (int nb = 0; nb < 2; ++nb)
#pragma unroll
            for (int mb = 0; mb < 4; ++mb) acc[nb][mb] = (f32x4){0.f, 0.f, 0.f, 0.f};
        const bf16* wp = Bt + (size_t)(uc * ustep + (lane & 15)) * ldb + wid * kw + 8 * (lane >> 4);
        const bf16* ap = A + (size_t)(rh * 64 + (lane & 15)) * lda + wid * kw + 8 * (lane >> 4);
#pragma unroll 1
        for (int ks0 = 0; ks0 < nks; ks0 += 4) {
            bf16x8 wf[4][2], af[4][4];
#pragma unroll
            for (int j = 0; j < 4; ++j) { const int ks = (ks0 + j < nks) ? ks0 + j : nks - 1;
                wf[j][0] = *(const bf16x8*)(wp + ks * 32); wf[j][1] = *(const bf16x8*)(wp + (size_t)nb1off * ldb + ks * 32);
#pragma unroll
                for (int mb = 0; mb < 4; ++mb) af[j][mb] = *(const bf16x8*)(ap + (size_t)mb * 16 * lda + ks * 32); }
#pragma unroll
            for (int j = 0; j < 4; ++j) if (ks0 + j < nks) {
#pragma unroll
                for (int nb = 0; nb < 2; ++nb)
#pragma unroll
                    for (int mb = 0; mb < 4; ++mb) acc[nb][mb] = __builtin_amdgcn_mfma_f32_16x16x32_bf16(wf[j][nb], af[j][mb], acc[nb][mb], 0, 0, 0); }
        }
        __syncthreads();
#pragma unroll
        for (int nb = 0; nb < 2; ++nb)
#pragma unroll
            for (int mb = 0; mb < 4; ++mb) *(LAS f32x4*)(red + ((wid * 8 + nb * 4 + mb) * 64 + lane) * 4) = acc[nb][mb];
        __syncthreads();
        if constexpr (!Epi::PAIR) { const int blk = F.tid >> 6, l = F.tid & 63;
            f32x4 s = {0.f, 0.f, 0.f, 0.f}, s2 = {0.f, 0.f, 0.f, 0.f};
#pragma unroll
            for (int w = 0; w < 4; ++w) s = s + *(const LAS f32x4*)(red + ((w * 8 + blk) * 64 + l) * 4);
#pragma unroll
            for (int w = 4; w < 8; ++w) s2 = s2 + *(const LAS f32x4*)(red + ((w * 8 + blk) * 64 + l) * 4);
            const int em = rh * 64 + 16 * (blk & 3) + (l & 15), en = uc * 32 + 16 * (blk >> 2) + 4 * (l >> 4);
            if constexpr (Epi::STATS) {
                float sq; if constexpr (Epi::SPLIT2) sq = E(em, en, s, s2); else sq = E(em, en, s + s2);
                sq += swap16(sq); sq += swap_half(sq);
                LAS float* r2 = red + 8 * 8 * 64 * 4;
                if ((l >> 4) == 0) r2[blk * 16 + (l & 15)] = sq;
                __syncthreads();
                if (F.tid < 64) atomicAdd(E.ssq + MPR + rh * 64 + F.tid, r2[(F.tid >> 4) * 16 + (F.tid & 15)] + r2[(4 + (F.tid >> 4)) * 16 + (F.tid & 15)]);
            } else {
                if constexpr (Epi::SPLIT2) E(em, en, s, s2);
                else E(em, en, s + s2); } }
        else if (F.tid < 256) { const int mb = F.tid >> 6, l = F.tid & 63;
            f32x4 s0 = {0.f, 0.f, 0.f, 0.f}, s1 = {0.f, 0.f, 0.f, 0.f};
#pragma unroll
            for (int w = 0; w < 8; ++w) { s0 = s0 + *(const LAS f32x4*)(red + ((w * 8 + mb) * 64 + l) * 4); s1 = s1 + *(const LAS f32x4*)(red + ((w * 8 + 4 + mb) * 64 + l) * 4); }
            E(rh * 64 + 16 * mb + (l & 15), uc * 16 + 4 * (l >> 4), s0, s1); }
    }
    __syncthreads();
}
__device__ __forceinline__ v2u pack4(f32x4 a) { v2u w; w.x = cvtpk(a[0], a[1]); w.y = cvtpk(a[2], a[3]); return w; }
struct SkInProj { static constexpr bool STATS = false; static constexpr bool SPLIT2 = false; static constexpr bool PAIR = false;
    const float* rstd; bf16* QBp; float *QSp, *USp, *out;
    __device__ __forceinline__ void operator()(int m, int n, f32x4 v) const {
        v = v * rstd[MPR + m]; const int sect = n >> 9, c = n & 511;
        if (sect == 0) { v = v * C2; *(f32x4*)(QSp + (size_t)m * SBW + c) = v; }
        else if (sect == 1) *(f32x4*)(out + O_KS + (size_t)m * SBW + c) = v;
        else if (sect == 2) *(f32x4*)(out + O_VS + (size_t)m * SBW + c) = v;
        else *(f32x4*)(USp + (size_t)m * SBW + c) = v;
    }
};
struct SkGlu { static constexpr bool STATS = true; static constexpr bool SPLIT2 = false; static constexpr bool PAIR = false;
    const bf16* YG; const float* bglu; bf16* MIXU; float* ssq;
    __device__ __forceinline__ float operator()(int m, int n, f32x4 v) const {
        const v2u yw = *(const v2u*)(YG + (size_t)(MPR + m) * SBW + n); const f32x4 b = *(const f32x4*)(bglu + n);
        const float y[4] = {bflo(yw.x), bfhi(yw.x), bflo(yw.y), bfhi(yw.y)};
#pragma unroll
        for (int e = 0; e < 4; ++e) v[e] = y[e] * __builtin_amdgcn_rcpf(1.f + __builtin_amdgcn_exp2f(-(v[e] + b[e]) * LOG2E));
        *(v2u*)(MIXU + (size_t)(MPR + m) * D + SBW + n) = pack4(v);
        return (v[0] * v[0] + v[1] * v[1]) + (v[2] * v[2] + v[3] * v[3]);
    }
};
struct SkResid { static constexpr bool STATS = true; static constexpr bool SPLIT2 = false; static constexpr bool PAIR = false;
    const float* base; float* xo; bf16* xb; float* ssq;
    __device__ __forceinline__ float operator()(int m, int n, f32x4 v) const {
        v = v + *(const f32x4*)(base + (size_t)m * D + n); const size_t o = (size_t)(MPR + m) * D + n;
        if (xo) *(f32x4*)(xo + o) = v; if (xb) *(v2u*)(xb + o) = pack4(v);
        return (v[0] * v[0] + v[1] * v[1]) + (v[2] * v[2] + v[3] * v[3]);
    }
};
struct SkScale { static constexpr bool STATS = false; static constexpr bool SPLIT2 = false; static constexpr bool PAIR = false;
    const float* ssq; float scale; bf16* O;
    __device__ __forceinline__ void operator()(int m, int n, f32x4 v) const {
        const float rs = scale / sqrtf(ssq[MPR + m] * (1.f / D) + EPS); v = v * rs; *(v2u*)(O + (size_t)(MPR + m) * D + n) = pack4(v);
    }
};
struct SkGateUp { static constexpr bool STATS = false; static constexpr bool SPLIT2 = false; static constexpr bool PAIR = false;
    const float* ssq; bf16 *GBp, *UBp; float* out;
    __device__ __forceinline__ void operator()(int m, int n, f32x4 v) const {
        const float rs = 1.f / sqrtf(ssq[MPR + m] * (1.f / D) + EPS); v = v * rs;
        if (n >= FF) *(v2u*)(UBp + (size_t)(MPR + m) * FF + (n - FF)) = pack4(v);
        else { *(v2u*)(GBp + (size_t)(MPR + m) * FF + n) = pack4(v); *(f32x4*)(out + O_CVS + ((size_t)m * 2 + 1) * FF + n) = v; }
    }
};

constexpr int HALO_OFF = RING_BYTES + 1024;
__device__ __forceinline__ float dpp_ror1(float x) { return __builtin_bit_cast(float, __builtin_amdgcn_update_dpp(0, __builtin_bit_cast(int, x), 0x121, 0xf, 0xf, true)); }
__device__ __forceinline__ float dpp_ror2(float x) { return __builtin_bit_cast(float, __builtin_amdgcn_update_dpp(0, __builtin_bit_cast(int, x), 0x122, 0xf, 0xf, true)); }
struct EpiGateUpConv { static constexpr bool MIDK = false;
    const float* ssq; bf16* ACT; float* out; const float* cw; const float* cb; LAS float* halo;
    __device__ __forceinline__ void operator()(const f32x4 (&acc)[2][2][4][2], const pg8::Unit& u, int wr, int wc, int fr_, int fq_) const {
        int fr = fr_, fq = fq_; asm volatile("" : "+v"(fr), "+v"(fq));
        const int cl = wc * 32 + 8 * fq, col = u.pn * 128 + cl, prow0 = u.pm * 254;
        float rs[2][4];
#pragma unroll
        for (int ai = 0; ai < 2; ++ai)
#pragma unroll
            for (int m = 0; m < 4; ++m) { const int row = prow0 + ai * 128 + wr * 64 + m * 16 + fr; rs[ai][m] = (row < MPR) ? 1.f / sqrtf(ssq[row < MPR ? row : 0] * (1.f / D) + EPS) : 0.f; }
        if (fr >= 14) {
#pragma unroll
            for (int ai = 0; ai < 2; ++ai) { LAS float* hp = halo + (((2 * ai + wr) * 2 + (fr - 14)) * 128 + cl); *(LAS f32x4*)hp = acc[ai][0][3][0] * rs[ai][3]; *(LAS f32x4*)(hp + 4) = acc[ai][0][3][1] * rs[ai][3]; }
        }
        asm volatile("s_waitcnt lgkmcnt(0)\n\ts_barrier" ::: "memory");
        f32x4 w0[2], w1[2], w2[2], bb[2];
#pragma unroll
        for (int n = 0; n < 2; ++n) { w0[n] = *(const f32x4*)(cw + col + 4 * n); w1[n] = *(const f32x4*)(cw + FF + col + 4 * n); w2[n] = *(const f32x4*)(cw + 2 * FF + col + 4 * n); bb[n] = *(const f32x4*)(cb + col + 4 * n); }
#pragma unroll
        for (int ai = 0; ai < 2; ++ai) {
            const int blk = 2 * ai + wr;
            f32x4 r1p[2], r2p[2];
            if (blk == 0) { r1p[0] = r1p[1] = r2p[0] = r2p[1] = (f32x4){0.f, 0.f, 0.f, 0.f}; }
            else { const LAS float* hb = halo + ((blk - 1) * 2) * 128 + cl;
                const f32x4 a0 = *(const LAS f32x4*)hb, a1 = *(const LAS f32x4*)(hb + 4), b0 = *(const LAS f32x4*)(hb + 128), b1 = *(const LAS f32x4*)(hb + 132);
                r1p[0] = b0; r1p[1] = b1; r2p[0] = (fr == 0) ? a0 : b0; r2p[1] = (fr == 0) ? a1 : b1; }
#pragma unroll
            for (int m = 0; m < 4; ++m) {
                const int lr = ai * 128 + wr * 64 + m * 16 + fr, row = prow0 + lr, t = row & (T - 1); const float rsv = rs[ai][m];
                f32x4 g[2], up[2], R1[2], R2[2];
#pragma unroll
                for (int n = 0; n < 2; ++n) { g[n] = acc[ai][0][m][n] * rsv; up[n] = acc[ai][1][m][n] * rsv;
#pragma unroll
                    for (int e = 0; e < 4; ++e) { R1[n][e] = dpp_ror1(g[n][e]); R2[n][e] = dpp_ror2(g[n][e]); } }
                const bool valid = (row < MPR) && (lr >= 2 || u.pm == 0);
                f32x4 av[2];
#pragma unroll
                for (int n = 0; n < 2; ++n) { f32x4 g1 = (fr == 0) ? r1p[n] : R1[n], g2 = (fr < 2) ? r2p[n] : R2[n];
                    if (t < 1) g1 = (f32x4){0.f, 0.f, 0.f, 0.f}; if (t < 2) g2 = (f32x4){0.f, 0.f, 0.f, 0.f};
                    const f32x4 cv = bb[n] + w0[n] * g2 + w1[n] * g1 + w2[n] * g[n];
#pragma unroll
                    for (int e = 0; e < 4; ++e) av[n][e] = gelu_tanh_f(cv[e]) * up[n][e]; }
                if (valid) { *(v4u*)(ACT + (size_t)row * FF + col) = pack8(av[0], av[1]);
                    if (t >= T - 2) { float* o = out + O_CVP + ((size_t)(row >> 12) * 2 + (t - (T - 2))) * FF + col; *(f32x4*)o = g[0]; *(f32x4*)(o + 4) = g[1]; } }
                r1p[0] = R1[0]; r1p[1] = R1[1]; r2p[0] = R2[0]; r2p[1] = R2[1];
            }
        }
    }
};
struct PanelOrder254 {
    pg8::GridOrder Gd;
    __device__ bool next(int i, pg8::Unit& u) const { return Gd.next(i, u); }
    __device__ __forceinline__ size_t aoff(const pg8::Unit& u) const { return (size_t)u.pm * 254 * D * 2; }
    __device__ __forceinline__ size_t boff(const pg8::Unit& u) const { return (size_t)u.pn * 128 * D * 2; }
};
struct SkGateUpConv { static constexpr bool STATS = false; static constexpr bool SPLIT2 = false; static constexpr bool PAIR = true;
    const float* ssq; bf16* ACT; float* out; const float* cw; const float* cb; const float* sc;
    __device__ __forceinline__ void operator()(int m, int n, f32x4 g, f32x4 up) const {
        const float rs = 1.f / sqrtf(ssq[MPR + m] * (1.f / D) + EPS); g = g * rs; up = up * rs;
        const f32x4 s0 = *(const f32x4*)(sc + ((size_t)m * 2 + 0) * FF + n), s1 = *(const f32x4*)(sc + ((size_t)m * 2 + 1) * FF + n);
        *(f32x4*)(out + O_CVS + ((size_t)m * 2 + 0) * FF + n) = s1; *(f32x4*)(out + O_CVS + ((size_t)m * 2 + 1) * FF + n) = g;
        const f32x4 cv = *(const f32x4*)(cb + n) + *(const f32x4*)(cw + n) * s0 + *(const f32x4*)(cw + FF + n) * s1 + *(const f32x4*)(cw + 2 * FF + n) * g;
        f32x4 a;
#pragma unroll
        for (int e = 0; e < 4; ++e) a[e] = gelu_tanh_f(cv[e]) * up[e];
        *(v2u*)(ACT + (size_t)(MPR + m) * FF + n) = pack4(a);
    }
};

struct EpiResidB { static constexpr bool MIDK = false;
    const bf16* base; float* xo; bf16* xb; float* ssq; LAS float* rowpart;
    __device__ __forceinline__ void operator()(const f32x4 (&acc)[2][2][4][2], const pg8::Unit& u, int wr, int wc, int fr_, int fq_) const { int fr = fr_, fq = fq_; asm volatile("" : "+v"(fr), "+v"(fq));
        _Pragma("unroll") for (int ai = 0; ai < 2; ++ai) _Pragma("unroll") for (int m = 0; m < 4; ++m) { const int row = u.pm * 256 + ai * 128 + wr * 64 + m * 16 + fr; float sq = 0.f;
            _Pragma("unroll") for (int bj = 0; bj < 2; ++bj) { const int col = u.pn * 256 + bj * 128 + wc * 32 + 8 * fq; f32x4 v0 = acc[ai][bj][m][0], v1 = acc[ai][bj][m][1];
                const v4u bw = *(const v4u*)(base + (size_t)row * D + col);
                v0 = v0 + (f32x4){bflo(bw.x), bfhi(bw.x), bflo(bw.y), bfhi(bw.y)}; v1 = v1 + (f32x4){bflo(bw.z), bfhi(bw.z), bflo(bw.w), bfhi(bw.w)};
                if (xo) { float* o = xo + (size_t)row * D + col; *(f32x4*)o = v0; *(f32x4*)(o + 4) = v1; }
                if (xb) *(v4u*)(xb + (size_t)row * D + col) = pack8(v0, v1);
                sq += (v0[0] * v0[0] + v0[1] * v0[1]) + (v0[2] * v0[2] + v0[3] * v0[3]) + (v1[0] * v1[0] + v1[1] * v1[1]) + (v1[2] * v1[2] + v1[3] * v1[3]); }
            sq += swap16(sq); sq += swap_half(sq);
            if (fq == 0) rowpart[(ai * 128 + wr * 64 + m * 16 + fr) * 4 + wc] = sq; }
        asm volatile("s_waitcnt lgkmcnt(0)\n\ts_barrier" ::: "memory");
        if (threadIdx.x < 256) { const f32x4 pp = *(const LAS f32x4*)(rowpart + threadIdx.x * 4); atomicAdd(ssq + u.pm * 256 + threadIdx.x, (pp[0] + pp[1]) + (pp[2] + pp[3])); }
    }
};
struct EpiResidFinal { static constexpr bool MIDK = false;
    const bf16* base; float* ssq; LAS float* rowpart; unsigned* pcnt; unsigned* bar; const float* gain; float* y; const bf16* xs;
    __device__ __forceinline__ void operator()(const f32x4 (&acc)[2][2][4][2], const pg8::Unit& u, int wr, int wc, int fr_, int fq_) const { int fr = fr_, fq = fq_; asm volatile("" : "+v"(fr), "+v"(fq));
        _Pragma("unroll") for (int ai = 0; ai < 2; ++ai) _Pragma("unroll") for (int m = 0; m < 4; ++m) { const int row = u.pm * 256 + ai * 128 + wr * 64 + m * 16 + fr; float sq = 0.f;
            _Pragma("unroll") for (int bj = 0; bj < 2; ++bj) { const int col = u.pn * 256 + bj * 128 + wc * 32 + 8 * fq; f32x4 v0 = acc[ai][bj][m][0], v1 = acc[ai][bj][m][1];
                const v4u bw = *(const v4u*)(base + (size_t)row * D + col);
                v0 = v0 + (f32x4){bflo(bw.x), bfhi(bw.x), bflo(bw.y), bfhi(bw.y)}; v1 = v1 + (f32x4){bflo(bw.z), bfhi(bw.z), bflo(bw.w), bfhi(bw.w)};
                sq += (v0[0] * v0[0] + v0[1] * v0[1]) + (v0[2] * v0[2] + v0[3] * v0[3]) + (v1[0] * v1[0] + v1[1] * v1[1]) + (v1[2] * v1[2] + v1[3] * v1[3]); }
            sq += swap16(sq); sq += swap_half(sq);
            if (fq == 0) rowpart[(ai * 128 + wr * 64 + m * 16 + fr) * 4 + wc] = sq; }
        asm volatile("s_waitcnt lgkmcnt(0)\n\ts_barrier" ::: "memory");
        if (threadIdx.x < 256) { const f32x4 pp = *(const LAS f32x4*)(rowpart + threadIdx.x * 4); atomicAdd(ssq + u.pm * 256 + threadIdx.x, (pp[0] + pp[1]) + (pp[2] + pp[3])); }
        asm volatile("s_waitcnt vmcnt(0)" ::: "memory");
        __syncthreads();
        if (threadIdx.x == 0) {
            unsigned* pc = pcnt + u.pm * 16;
            (void)xb_add(pc, 1u);
        }
        if ((threadIdx.x >> 6) == 1 && (int)blockIdx.x < MS) { const int row = MPR + (int)blockIdx.x, lane = threadIdx.x & 63;
            const float rs = 1.f / sqrtf(ssq[row] * (1.f / D) + EPS); float* yr = y + (size_t)row * D; const bf16* x3 = xs + (size_t)row * D;
            _Pragma("unroll") for (int j = 0; j < 2; ++j) { const int c = 8 * lane + 512 * j; const v4u w = *(const v4u*)(x3 + c); const f32x4 g0 = *(const f32x4*)(gain + c), g1 = *(const f32x4*)(gain + c + 4);
                *(f32x4*)(yr + c) = (f32x4){bflo(w.x), bfhi(w.x), bflo(w.y), bfhi(w.y)} * rs * g0; *(f32x4*)(yr + c + 4) = (f32x4){bflo(w.z), bfhi(w.z), bflo(w.w), bfhi(w.w)} * rs * g1; } }
        if (threadIdx.x == 0) {
            unsigned* pc = pcnt + u.pm * 16;
            XB_SPIN(xb_ld(pc) < 4u, bar);
            __builtin_amdgcn_fence(__ATOMIC_ACQUIRE, "agent");
        }
        __syncthreads();
        if (threadIdx.x < 256) { const unsigned tb = __hip_atomic_load((const unsigned*)ssq + u.pm * 256 + threadIdx.x, __ATOMIC_RELAXED, __HIP_MEMORY_SCOPE_AGENT);
            rowpart[threadIdx.x * 4] = 1.f / sqrtf(__builtin_bit_cast(float, tb) * (1.f / D) + EPS); }
        asm volatile("s_waitcnt lgkmcnt(0)\n\ts_barrier" ::: "memory");
        int fr2 = fr_, fq2 = fq_; asm volatile("" : "+v"(fr2), "+v"(fq2));
        _Pragma("unroll") for (int ai = 0; ai < 2; ++ai) _Pragma("unroll") for (int m = 0; m < 4; ++m) { const int rl = ai * 128 + wr * 64 + m * 16 + fr2; const int row = u.pm * 256 + rl; const float rs = rowpart[rl * 4];
            _Pragma("unroll") for (int bj = 0; bj < 2; ++bj) { const int col = u.pn * 256 + bj * 128 + wc * 32 + 8 * fq2; f32x4 v0 = acc[ai][bj][m][0], v1 = acc[ai][bj][m][1];
                const v4u bw = *(const v4u*)(base + (size_t)row * D + col); const f32x4 g0 = *(const f32x4*)(gain + col), g1 = *(const f32x4*)(gain + col + 4);
                v0 = (v0 + (f32x4){bflo(bw.x), bfhi(bw.x), bflo(bw.y), bfhi(bw.y)}) * rs * g0; v1 = (v1 + (f32x4){bflo(bw.z), bfhi(bw.z), bflo(bw.w), bfhi(bw.w)}) * rs * g1;
                float* o = y + (size_t)row * D + col; *(f32x4*)o = v0; *(f32x4*)(o + 4) = v1; } }
    }
};
struct SkResidB { static constexpr bool STATS = true; static constexpr bool SPLIT2 = false; static constexpr bool PAIR = false;
    const bf16* base; float* xo; bf16* xb; float* ssq;
    __device__ __forceinline__ float operator()(int m, int n, f32x4 v) const {
        const size_t o = (size_t)(MPR + m) * D + n; const v2u bw = *(const v2u*)(base + o);
        v = v + (f32x4){bflo(bw.x), bfhi(bw.x), bflo(bw.y), bfhi(bw.y)};
        if (xo) *(f32x4*)(xo + o) = v; if (xb) *(v2u*)(xb + o) = pack4(v);
        return (v[0] * v[0] + v[1] * v[1]) + (v[2] * v[2] + v[3] * v[3]);
    }
};

struct InProjOrder {
    int c;
    __device__ __forceinline__ bool next(int i, pg8::Unit& u) const { if (i >= 2 || c >= 256) return false;
        const int wgid = (c % pg8::NXCD) * (256 / pg8::NXCD) + c / pg8::NXCD, j = wgid & 3; u.pm = wgid >> 2; u.pn = (i == 0) ? 2 + j : (j < 2 ? j : 4 + j); return true; }
    __device__ __forceinline__ size_t aoff(const pg8::Unit& u) const { return (size_t)u.pm * ((size_t)pg8::BM * D * 2); }
    __device__ __forceinline__ size_t boff(const pg8::Unit& u) const { return (size_t)u.pn * ((size_t)pg8::BM * D * 2); }
};
struct SsmOne {
    int b, g; size_t bstride; int cnt;
    __device__ bool next(int i, pg8::Unit& u) const { if (i >= cnt) return false; u.pm = b; u.pn = g; return true; }
    __device__ __forceinline__ size_t aoff(const pg8::Unit& u) const { return ((size_t)u.pm * NCH * NG * XHP + (size_t)u.pn * XHP) * 2; }
    __device__ __forceinline__ size_t boff(const pg8::Unit& u) const { return (size_t)u.pn * bstride; }
};

struct EpiResidMix { static constexpr bool MIDK = true;
    const bf16* base; bf16* xb; float* ssq; const float* ssqA; const float* ssqB; LAS float* rowpart;
    __device__ __forceinline__ void mid(f32x4 (&acc)[2][2][4][2], const pg8::Unit& u, int wr, int wc, int fr_, int fq_) const { int fr = fr_; asm volatile("" : "+v"(fr));
        _Pragma("unroll") for (int ai = 0; ai < 2; ++ai) _Pragma("unroll") for (int m = 0; m < 4; ++m) { const int row = u.pm * 256 + ai * 128 + wr * 64 + m * 16 + fr;
            const float ratio = sqrtf((ssqB[row] * (1.f / SBW) + EPS) / (ssqA[row] * (1.f / SBW) + EPS));
            _Pragma("unroll") for (int bj = 0; bj < 2; ++bj) _Pragma("unroll") for (int n = 0; n < 2; ++n) acc[ai][bj][m][n] = acc[ai][bj][m][n] * ratio; }
    }
    __device__ __forceinline__ void operator()(const f32x4 (&acc)[2][2][4][2], const pg8::Unit& u, int wr, int wc, int fr_, int fq_) const { int fr = fr_, fq = fq_; asm volatile("" : "+v"(fr), "+v"(fq));
        _Pragma("unroll") for (int ai = 0; ai < 2; ++ai) _Pragma("unroll") for (int m = 0; m < 4; ++m) { const int row = u.pm * 256 + ai * 128 + wr * 64 + m * 16 + fr; float sq = 0.f;
            const float rsB = 1.f / sqrtf(ssqB[row] * (1.f / SBW) + EPS);
            _Pragma("unroll") for (int bj = 0; bj < 2; ++bj) { const int col = u.pn * 256 + bj * 128 + wc * 32 + 8 * fq; f32x4 v0 = acc[ai][bj][m][0] * rsB, v1 = acc[ai][bj][m][1] * rsB;
                const v4u bw = *(const v4u*)(base + (size_t)row * D + col);
                v0 = v0 + (f32x4){bflo(bw.x), bfhi(bw.x), bflo(bw.y), bfhi(bw.y)}; v1 = v1 + (f32x4){bflo(bw.z), bfhi(bw.z), bflo(bw.w), bfhi(bw.w)};
                *(v4u*)(xb + (size_t)row * D + col) = pack8(v0, v1);
                sq += (v0[0] * v0[0] + v0[1] * v0[1]) + (v0[2] * v0[2] + v0[3] * v0[3]) + (v1[0] * v1[0] + v1[1] * v1[1]) + (v1[2] * v1[2] + v1[3] * v1[3]); }
            sq += swap16(sq); sq += swap_half(sq);
            if (fq == 0) rowpart[(ai * 128 + wr * 64 + m * 16 + fr) * 4 + wc] = sq; }
        asm volatile("s_waitcnt lgkmcnt(0)\n\ts_barrier" ::: "memory");
        if (threadIdx.x < 256) { const f32x4 pp = *(const LAS f32x4*)(rowpart + threadIdx.x * 4); atomicAdd(ssq + u.pm * 256 + threadIdx.x, (pp[0] + pp[1]) + (pp[2] + pp[3])); }
    }
};
struct SkResidMix { static constexpr bool STATS = true; static constexpr bool SPLIT2 = true; static constexpr bool PAIR = false;
    const bf16* base; bf16* xb; float* ssq; const float* ssqA; const float* ssqB;
    __device__ __forceinline__ float operator()(int m, int n, f32x4 sA, f32x4 sB) const {
        const float rsA = 1.f / sqrtf(ssqA[MPR + m] * (1.f / SBW) + EPS), rsB = 1.f / sqrtf(ssqB[MPR + m] * (1.f / SBW) + EPS);
        const size_t o = (size_t)(MPR + m) * D + n; const v2u bw = *(const v2u*)(base + o);
        const f32x4 v = sA * rsA + sB * rsB + (f32x4){bflo(bw.x), bfhi(bw.x), bflo(bw.y), bfhi(bw.y)};
        *(v2u*)(xb + o) = pack4(v);
        return (v[0] * v[0] + v[1] * v[1]) + (v[2] * v[2] + v[3] * v[3]);
    }
};
__device__ __forceinline__ int crow(int r, int hi) { return (r & 3) + 8 * (r >> 2) + 4 * hi; }
__device__ __forceinline__ void glds16(const void* gsrc, unsigned lds_dst) { unsigned keep;
    asm volatile("s_mov_b32 %0, m0\n\ts_mov_b32 m0, %2\n\ts_nop 0\n\tglobal_load_lds_dwordx4 %1, off\n\ts_mov_b32 m0, %0" : "=&s"(keep) : "v"(gsrc), "s"(lds_dst) : "memory"); }
#define WAIT_BAR(N) asm volatile("s_waitcnt vmcnt(" #N ") lgkmcnt(0)\n\ts_barrier" ::: "memory")
typedef LAS const char* lds_cptr;
typedef short v4i16_t __attribute__((ext_vector_type(4)));
__device__ __forceinline__ s16x4 vtr(lds_cptr p) { return __builtin_bit_cast(s16x4, __builtin_amdgcn_ds_read_tr16_b64_v4i16((LAS v4i16_t*)p)); }
__device__ __forceinline__ bf16x8 ldsq(lds_cptr p) { return *(const LAS bf16x8*)p; }
#define MFMA32(a, b, c) __builtin_amdgcn_mfma_f32_32x32x16_bf16((a), (b), (c), 0, 0, 0)
typedef float f32x2_t __attribute__((ext_vector_type(2))); typedef __bf16 bf16x2_t __attribute__((ext_vector_type(2)));
__device__ __forceinline__ unsigned cvtpk_s(float lo, float hi) { f32x2_t v = {lo, hi}; bf16x2_t b = __builtin_convertvector(v, bf16x2_t); return __builtin_bit_cast(unsigned, b); }
__device__ __forceinline__ bf16x8 pack_bf8(const f32x16& p, int base) {
    v4u w; w.x = cvtpk_s(p[base], p[base + 1]); w.y = cvtpk_s(p[base + 2], p[base + 3]); w.z = cvtpk_s(p[base + 4], p[base + 5]); w.w = cvtpk_s(p[base + 6], p[base + 7]); return __builtin_bit_cast(bf16x8, w);
}
template <int CTRL> __device__ __forceinline__ float dppf(float x) { return __builtin_bit_cast(float, __builtin_amdgcn_update_dpp(0, __builtin_bit_cast(int, x), CTRL, 0xf, 0xf, true)); }

constexpr int SBA_K = 0, SBA_V = 24576, SBA_OST = 49152;
__device__ __forceinline__ void sb_attn_unit(Frame& F, int b, int h, int qb, float b2) {
    int lane = F.lane; asm volatile("" : "+v"(lane));
    const int r32 = lane & 31, hi = lane >> 5, wid = F.wave;
    const bf16* QBp = WSP(bf16, WS_QB); const bf16* KBp = WSP(bf16, WS_KB); const bf16* VBp = WSP(bf16, WS_VB); bf16* MIXU = WSP(bf16, WS_MIX); float* SSQA = (float*)(F.ctl + CW_SSQA);
    const long rowbase = (long)b * T; const int q0 = qb * 256;
    const bf16* Qw = QBp + (rowbase + q0 + wid * 32) * SBW + h * HD;
    const bf16* Kh = KBp + rowbase * SBW + h * HD; const bf16* Vh = VBp + rowbase * SBW + h * HD;
    const unsigned lds0 = (unsigned)(uintptr_t)(F.lds + RING_OFF);
    const bf16* ksrc = Kh + (long)lane * SBW + wid * 8;
    const bf16* vsrc = Vh + (long)(16 * (wid & 3) + (lane >> 2)) * SBW + (wid >> 2) * 32 + (lane & 3) * 8;
    const unsigned kdst = lds0 + SBA_K + wid * 1024, vdst = lds0 + SBA_V + wid * 1024;
    const lds_cptr base3 = (lds_cptr)(F.lds + RING_OFF);
    const lds_cptr kp0 = base3 + SBA_K + hi * 1024 + r32 * 16;
    const lds_cptr vp0 = base3 + SBA_V + ((lane >> 4) & 1) * 32 + (lane & 3) * 8 + (4 * hi + ((lane & 15) >> 2)) * 64;
    const int NT = (q0 + 256) / 64;
#define DMA_KV(t, slot) do { glds16(ksrc + (long)(t) * 64 * SBW, (unsigned)__builtin_amdgcn_readfirstlane(kdst + (slot) * 8192)); glds16(vsrc + (long)(t) * 64 * SBW, (unsigned)__builtin_amdgcn_readfirstlane(vdst + (slot) * 8192)); } while (0)
    DMA_KV(NT - 1, 0); DMA_KV(NT - 2, 1);
    bf16x8 qr[4];
#pragma unroll
    for (int d0 = 0; d0 < 4; ++d0) qr[d0] = *reinterpret_cast<const bf16x8*>(&Qw[(long)r32 * SBW + d0 * 16 + hi * 8]);
    asm volatile("" : "+v"(qr[0]), "+v"(qr[1]), "+v"(qr[2]), "+v"(qr[3]));
    bf16x8 A0, A1, AN;
#pragma unroll
    for (int j = 0; j < 8; ++j) { const int kv = crow(j, hi); A0[j] = (short)((kv >= r32) ? 0xBF80 : 0); A1[j] = (short)((kv + 16 >= r32) ? 0xBF80 : 0); AN[j] = (short)0xBF80; }
    f32x16 o0 = {}, o1 = {}, racc, bt;
#pragma unroll
    for (int r = 0; r < 16; ++r) { bt[r] = b2; racc[r] = b2; }
    const int qrel = wid * 32 + r32;
    for (int it = 0; it < NT; ++it) {
        const int t = NT - 1 - it, cur = it % 3;
        if (it + 1 < NT) { WAIT_BAR(2); } else { WAIT_BAR(0); }
        if (it + 2 < NT) DMA_KV(t - 2, (it + 2) % 3);
        const int jb = t - (NT - 4);
        if (jb <= (wid >> 1)) {
            int so = cur * 8192; asm volatile("" : "+s"(so));
            const lds_cptr kp = kp0 + so; const lds_cptr vp = vp0 + so;
            f32x16 p0 = bt, p1 = bt, d0 = racc, d1 = racc;
#pragma unroll
            for (int dd = 0; dd < 4; ++dd) { const bf16x8 k0 = ldsq(kp + dd * 2048), k1 = ldsq(kp + dd * 2048 + 512);
                p0 = MFMA32(k0, qr[dd], p0); p1 = MFMA32(k1, qr[dd], p1); d0 = MFMA32(k0, qr[dd], d0); d1 = MFMA32(k1, qr[dd], d1); }
            const bool diag = (jb == (wid >> 1));
            if (diag) {
                const float NEG = -INFINITY; const int kb = 64 * jb + 4 * hi;
#pragma unroll
                for (int r = 0; r < 16; ++r) { const int kv = kb + (r & 3) + 8 * (r >> 2); if (kv >= qrel) p0[r] = NEG; if (kv + 32 >= qrel) p1[r] = NEG; }
            }
            f32x16 s0, s1;
#pragma unroll
            for (int r = 0; r < 16; ++r) { s0[r] = __builtin_amdgcn_logf(1.f + __builtin_amdgcn_exp2f(p0[r])); s1[r] = __builtin_amdgcn_logf(1.f + __builtin_amdgcn_exp2f(p1[r])); }
            const bf16x8 sb0 = pack_bf8(s0, 0), sb1 = pack_bf8(s0, 8), sb2 = pack_bf8(s1, 0), sb3 = pack_bf8(s1, 8);
            d1 = MFMA32(A0, sb2, d1); d1 = MFMA32(A1, sb3, d1);
            d0 = MFMA32(A0, sb0, d0); d0 = MFMA32(A1, sb1, d0); d0 = MFMA32(AN, sb2, d0); d0 = MFMA32(AN, sb3, d0);
            racc = MFMA32(AN, sb0, racc); racc = MFMA32(AN, sb1, racc); racc = MFMA32(AN, sb2, racc); racc = MFMA32(AN, sb3, racc);
            if (diag) { const float NEG = -INFINITY; const int kb = 64 * jb + 4 * hi;
#pragma unroll
                for (int r = 0; r < 16; ++r) { const int kv = kb + (r & 3) + 8 * (r >> 2); if (kv >= qrel) d0[r] = NEG; if (kv + 32 >= qrel) d1[r] = NEG; } }
#pragma unroll
            for (int r = 0; r < 16; ++r) { p0[r] = __builtin_amdgcn_exp2f(d0[r]); p1[r] = __builtin_amdgcn_exp2f(d1[r]); }
            const bf16x8 pa0 = pack_bf8(p0, 0), pa1 = pack_bf8(p0, 8), pa2 = pack_bf8(p1, 0), pa3 = pack_bf8(p1, 8);
#pragma unroll
            for (int dh = 0; dh < 2; ++dh) {
                f32x16& o = dh ? o1 : o0;
#pragma unroll
                for (int rg = 0; rg < 4; ++rg) { const s16x4 lo = vtr(vp + dh * 4096 + rg * 1024), hh = vtr(vp + dh * 4096 + rg * 1024 + 512);
                    const bf16x8 vf = (bf16x8){lo[0], lo[1], lo[2], lo[3], hh[0], hh[1], hh[2], hh[3]};
                    o = MFMA32(rg == 0 ? pa0 : rg == 1 ? pa1 : rg == 2 ? pa2 : pa3, vf, o); }
            }
        }
    }
#undef DMA_KV
    { int l2 = lane; asm volatile("" : "+v"(l2)); const int e32 = l2 & 31, ehi = l2 >> 5;
      LAS bf16* stg = (LAS bf16*)(F.lds + RING_OFF + SBA_OST) + wid * 2048; LAS bf16* sb = stg + (4 * ehi) * 64 + e32;
#pragma unroll
      for (int r = 0; r < 16; ++r) { sb[((r & 3) + 8 * (r >> 2)) * 64] = (bf16)f2bf(o0[r]); sb[((r & 3) + 8 * (r >> 2)) * 64 + 32] = (bf16)f2bf(o1[r]); }
      LDS_WAIT();
      const long orow = rowbase + q0 + wid * 32 + (l2 >> 3);
      bf16* Ow = MIXU + orow * D + h * HD + (l2 & 7) * 8; const LAS bf16* sr = stg + (l2 >> 3) * 64 + (l2 & 7) * 8;
#pragma unroll
      for (int i = 0; i < 4; ++i) { const v4u v = *(const LAS v4u*)(sr + i * 512); *(v4u*)(Ow + (long)i * 8 * D) = v;
          float sq = (bflo(v.x) * bflo(v.x) + bfhi(v.x) * bfhi(v.x)) + (bflo(v.y) * bflo(v.y) + bfhi(v.y) * bfhi(v.y)) + (bflo(v.z) * bflo(v.z) + bfhi(v.z) * bfhi(v.z)) + (bflo(v.w) * bflo(v.w) + bfhi(v.w) * bfhi(v.w));
          sq += dppf<0xB1>(sq); sq += dppf<0x4E>(sq); sq += dppf<0x141>(sq);
          if ((l2 & 7) == 0) atomicAdd(SSQA + orow + i * 8, sq); } }
    asm volatile("s_waitcnt vmcnt(0) lgkmcnt(0)\n\ts_barrier" ::: "memory");
}

__device__ __forceinline__ float dpp_sum16(float x) {
    x += __builtin_bit_cast(float, __builtin_amdgcn_update_dpp(0, __builtin_bit_cast(int, x), 0xB1, 0xf, 0xf, true));
    x += __builtin_bit_cast(float, __builtin_amdgcn_update_dpp(0, __builtin_bit_cast(int, x), 0x4E, 0xf, 0xf, true));
    x += __builtin_bit_cast(float, __builtin_amdgcn_update_dpp(0, __builtin_bit_cast(int, x), 0x141, 0xf, 0xf, true));
    x += __builtin_bit_cast(float, __builtin_amdgcn_update_dpp(0, __builtin_bit_cast(int, x), 0x140, 0xf, 0xf, true));
    return x;
}
__device__ __forceinline__ float wave_sum_fast(float x) { x = dpp_sum16(x); x += swap16(x); x += swap_half(x); return x; }
__device__ __forceinline__ float swz_xor4(float x) { return __builtin_bit_cast(float, __builtin_amdgcn_ds_swizzle(__builtin_bit_cast(int, x), 0x101F)); }
__device__ __forceinline__ void sb_sample_unit(Frame& F, int b, int pg) {
    int lane = F.lane; asm volatile("" : "+v"(lane));
    const int h = F.wave, ts = lane >> 4, d4 = lane & 15;
    const float* QS = WSP(float, WS_QS); const float* ck = INF(2); const float* cv = INF(3); const int* pt = (const int*)F.in[4];
    const float bl2 = INF(13)[h] * LOG2E;
    const f32x4 q4 = *(const f32x4*)(QS + (size_t)b * SBW + h * HD + 4 * d4);
    const int page = pt[b * NPG + pg];
    const float* kb = ck + ((size_t)page * PAGE + ts) * (NH * HD) + h * HD + 4 * d4;
    const float* vb = cv + ((size_t)page * PAGE + ts) * (NH * HD) + h * HD + 4 * d4;
    float p[32];
    { f32x4 kk[32];
#pragma unroll
      for (int i = 0; i < 32; ++i) kk[i] = __builtin_nontemporal_load((const f32x4*)(kb + (size_t)i * 4 * NH * HD));
#pragma unroll
      for (int i = 0; i < 32; ++i) p[i] = (q4[0] * kk[i][0] + q4[1] * kk[i][1]) + (q4[2] * kk[i][2] + q4[3] * kk[i][3]); }
    f32x4 vv[32];
#pragma unroll
    for (int i = 0; i < 32; ++i) vv[i] = __builtin_nontemporal_load((const f32x4*)(vb + (size_t)i * 4 * NH * HD));
    const bool c0 = d4 & 1, c1 = d4 & 2, c2 = d4 & 4, c3 = d4 & 8;
    float v1[16], v2[8], v3[4], zz[2];
#pragma unroll
    for (int k = 0; k < 16; ++k) { const float keep = c0 ? p[2 * k + 1] : p[2 * k], send = c0 ? p[2 * k] : p[2 * k + 1]; v1[k] = keep + dppf<0xB1>(send); }
#pragma unroll
    for (int k = 0; k < 8; ++k) { const float keep = c1 ? v1[2 * k + 1] : v1[2 * k], send = c1 ? v1[2 * k] : v1[2 * k + 1]; v2[k] = keep + dppf<0x4E>(send); }
#pragma unroll
    for (int k = 0; k < 4; ++k) { const float keep = c2 ? v2[2 * k + 1] : v2[2 * k], send = c2 ? v2[2 * k] : v2[2 * k + 1]; v3[k] = keep + swz_xor4(send); }
#pragma unroll
    for (int k = 0; k < 2; ++k) { const float keep = c3 ? v3[2 * k + 1] : v3[2 * k], send = c3 ? v3[2 * k] : v3[2 * k + 1]; zz[k] = keep + dppf<0x128>(send) + bl2; }
    float sp[2], aft[2], G[2], sfx[2];
#pragma unroll
    for (int k = 0; k < 2; ++k) {
        sp[k] = __builtin_amdgcn_logf(1.f + __builtin_amdgcn_exp2f(zz[k]));
        const float nb = swap16(sp[k]), w1 = sp[k] + nb, po = swap_half(w1);
        aft[k] = ((ts & 1) ? 0.f : nb) + ((ts & 2) ? 0.f : po); G[k] = w1 + po;
        float s2 = G[k]; s2 += dppf<0x101>(s2); s2 += dppf<0x102>(s2); s2 += dppf<0x104>(s2); s2 += dppf<0x108>(s2); sfx[k] = s2;
    }
    const float tot1 = __builtin_bit_cast(float, __builtin_amdgcn_readlane(__builtin_bit_cast(int, sfx[1]), 0)), tot0 = __builtin_bit_cast(float, __builtin_amdgcn_readlane(__builtin_bit_cast(int, sfx[0]), 0));
    const float a1 = __builtin_amdgcn_exp2f(zz[1] - sp[1] - (aft[1] + (sfx[1] - G[1])));
    const float a0 = __builtin_amdgcn_exp2f(zz[0] - sp[0] - (aft[0] + (sfx[0] - G[0]) + tot1));
    LAS float* aw = (LAS float*)(F.lds + RING_OFF) + h * 128 + ts * 32;
    aw[d4] = a0; aw[d4 + 16] = a1;
    LDS_WAIT(); asm volatile("" ::: "memory");
    f32x4 acc = {0.f, 0.f, 0.f, 0.f};
#pragma unroll
    for (int i4 = 0; i4 < 8; ++i4) { const f32x4 a4 = *(const LAS f32x4*)(aw + 4 * i4);
#pragma unroll
        for (int e2 = 0; e2 < 4; ++e2) acc = acc + vv[4 * i4 + e2] * a4[e2]; }
    LDS_WAIT(); asm volatile("" ::: "memory");
#pragma unroll
    for (int e2 = 0; e2 < 4; ++e2) { acc[e2] += swap16(acc[e2]); acc[e2] += swap_half(acc[e2]); }
    if (ts == 0) *(f32x4*)(WSP(float, WS_SBPO) + (((size_t)b * NPG + pg) * NH + h) * HD + 4 * d4) = acc;
    if (lane == 0) WSP(float, WS_SBPL)[((size_t)b * NPG + pg) * NH + h] = -(tot0 + tot1);
}
__device__ __forceinline__ void sb_sample_combine(Frame& F, int b, int h) {
    const float* PO = WSP(float, WS_SBPO); const float* PL = WSP(float, WS_SBPL); float o = 0.f, run = 0.f;
#pragma unroll
    for (int pg = NPG - 1; pg >= 0; --pg) { o += __builtin_amdgcn_exp2f(run) * PO[(((size_t)b * NPG + pg) * NH + h) * HD + F.lane]; run += PL[((size_t)b * NPG + pg) * NH + h]; }
    const unsigned ob = f2bf(o); const float orr = bf2f((unsigned short)ob);
    WSP(bf16, WS_MIX)[(size_t)(MPR + b) * D + h * HD + F.lane] = (bf16)ob;
    const float sq = wave_sum_fast(orr * orr);
    if (F.lane == 0) atomicAdd((float*)(F.ctl + CW_SSQA) + MPR + b, sq);
}
__device__ __forceinline__ void ssm_sample_unit(Frame& F, int b, int g) {
    const int n = F.lane;
    const float lr = INF(14)[g * NST + n], li = INF(15)[g * NST + n], ldt = INF(16)[g];
    float lbr, lbi, cr, ci; lam_pow(lr, li, ldt, 1, lbr, lbi); lam_coef(lr, li, ldt, cr, ci);
    const float* u = WSP(float, WS_US) + (size_t)b * SBW + g * GP;
    float br = 0.f, bi = 0.f;
#pragma unroll
    for (int p = 0; p < 16; ++p) { const float bre = INF(17)[(g * NST + n) * GP + p], bim = INF(18)[(g * NST + n) * GP + p]; const float uv = u[p]; br += (cr * bre - ci * bim) * uv; bi += (cr * bim + ci * bre) * uv; }
    const float h0r = INF(5)[(b * NG + g) * NST + n], h0i = INF(6)[(b * NG + g) * NST + n];
    const float hr = lbr * h0r - lbi * h0i + br, hi = lbr * h0i + lbi * h0r + bi;
    F.out[O_RES + (size_t)(b * NG + g) * NST + n] = hr; F.out[O_IMS + (size_t)(b * NG + g) * NST + n] = hi;
    float y = 0.f;
#pragma unroll
    for (int p = 0; p < 16; ++p) { const float v = wave_sum(INF(19)[(g * GP + p) * NST + n] * hr - INF(20)[(g * GP + p) * NST + n] * hi); if (n == p) y = v; }
    if (n < 16) { y += INF(21)[g * GP + n] * u[n]; WSP(bf16, WS_YG)[(size_t)(MPR + b) * SBW + g * GP + n] = (bf16)f2bf(gelu_tanh_f(y)); }
}
__device__ __forceinline__ void ssm_scan_bg(Frame& F, int b, int g) {
    const int n = F.tid & 63, seg = F.tid >> 6;
    LAS float* tot = (LAS float*)(F.lds + RING_OFF);
    const float lr = INF(14)[g * NST + n], li = INF(15)[g * NST + n], ldt = INF(16)[g];
    float Lr, Li, Sr, Si; lam_pow(lr, li, ldt, LC, Lr, Li); lam_pow(lr, li, ldt, LC * 32, Sr, Si);
    const float* SST = WSP(float, WS_SST); bf16* XH = WSP(bf16, WS_XH);
    f32x2 s[32];
#pragma unroll
    for (int k = 0; k < 32; ++k) s[k] = *(const f32x2*)(SST + ((size_t)(b * NCH + seg * 32 + k) * NG + g) * 128 + 2 * n);
    float pr = 0.f, pi = 0.f;
#pragma unroll
    for (int k = 0; k < 32; ++k) { const float nr = Lr * pr - Li * pi + s[k].x, ni = Lr * pi + Li * pr + s[k].y; pr = nr; pi = ni; s[k].x = pr; s[k].y = pi; }
    tot[(seg * 64 + n) * 2] = pr; tot[(seg * 64 + n) * 2 + 1] = pi;
    __syncthreads();
    float cr = 0.f, ci = 0.f;
    for (int s2 = 0; s2 < seg; ++s2) { const float tr = tot[(s2 * 64 + n) * 2], ti = tot[(s2 * 64 + n) * 2 + 1]; const float nr = Sr * cr - Si * ci + tr, ni = Sr * ci + Si * cr + ti; cr = nr; ci = ni; }
    if (seg == 0) *(GAS unsigned*)(XH + ((size_t)(b * NCH) * NG + g) * XHP + 256 + 2 * n) = 0u;
    float wr_ = Lr, wi_ = Li;
#pragma unroll
    for (int k = 0; k < 32; ++k) {
        const float hr = wr_ * cr - wi_ * ci + s[k].x, hi = wr_ * ci + wi_ * cr + s[k].y;
        const int c = seg * 32 + k;
        if (c + 1 < NCH) *(GAS unsigned*)(XH + ((size_t)(b * NCH + c + 1) * NG + g) * XHP + 256 + 2 * n) = pk2(hr, hi);
        else { F.out[O_REP + (size_t)(b * NG + g) * NST + n] = hr; F.out[O_IMP + (size_t)(b * NG + g) * NST + n] = hi; }
        const float nr = wr_ * Lr - wi_ * Li, ni = wr_ * Li + wi_ * Lr; wr_ = nr; wi_ = ni;
    }
}
__device__ __forceinline__ void xattn_prompt_kload(Frame& F, int b, int h) {
    const int lane = F.lane, wid = F.wave; const bf16* MKB = WSP(bf16, WS_MKB);
    const unsigned lds0 = (unsigned)(uintptr_t)(F.lds + RING_OFF);
#pragma unroll
    for (int t = 0; t < 4; ++t)
#pragma unroll
        for (int j = 0; j < 4; ++j) { const int c = wid + 8 * j;
            glds16(MKB + ((long)b * MT + t * 64 + lane) * D + h * MHD + c * 8, (unsigned)__builtin_amdgcn_readfirstlane(lds0 + t * 32768 + c * 1024)); }
}
__device__ __forceinline__ void xattn_prompt_unit(Frame& F, int b, int h, int qb, bool have_k) {
    const int lane = F.lane, r32 = lane & 31, hi = lane >> 5, wid = F.wave;
    const bf16* QM = WSP(bf16, WS_QM); const bf16* MVB = WSP(bf16, WS_MVB); bf16* OM = WSP(bf16, WS_OMEM);
    const unsigned lds0 = (unsigned)(uintptr_t)(F.lds + RING_OFF); const lds_cptr base3 = (lds_cptr)(F.lds + RING_OFF);
    const long qrow0 = (long)b * T + qb * 256 + wid * 32;
    if (!have_k) xattn_prompt_kload(F, b, h);
    bf16x8 qr[16];
#pragma unroll
    for (int ks = 0; ks < 16; ++ks) qr[ks] = *reinterpret_cast<const bf16x8*>(QM + (qrow0 + r32) * D + h * MHD + ks * 16 + hi * 8);
    WAIT_BAR(0);
    f32x16 S[8];
#pragma unroll
    for (int t = 0; t < 4; ++t)
#pragma unroll
        for (int blk = 0; blk < 2; ++blk) { f32x16 p = {};
#pragma unroll
            for (int ks = 0; ks < 16; ++ks) p = MFMA32(ldsq(base3 + t * 32768 + (2 * ks + hi) * 1024 + (32 * blk + r32) * 16), qr[ks], p);
            S[t * 2 + blk] = p; }
    WAIT_BAR(0);
#pragma unroll
    for (int t = 0; t < 4; ++t)
#pragma unroll
        for (int j = 0; j < 4; ++j) { const int p = wid + 8 * j, dblk = p >> 2, rg = p & 3;
            glds16(MVB + ((long)b * MT + t * 64 + 16 * rg + (lane >> 2)) * D + h * MHD + dblk * 32 + (lane & 3) * 8, (unsigned)__builtin_amdgcn_readfirstlane(lds0 + t * 32768 + p * 1024)); }
    float mx = -INFINITY;
#pragma unroll
    for (int i = 0; i < 8; ++i)
#pragma unroll
        for (int r = 0; r < 16; ++r) mx = fmaxf(mx, S[i][r]);
    mx = fmaxf(mx, swap_half(mx));
    float l = 0.f;
#pragma unroll
    for (int i = 0; i < 8; ++i)
#pragma unroll
        for (int r = 0; r < 16; ++r) { S[i][r] = __builtin_amdgcn_exp2f(S[i][r] - mx); l += S[i][r]; }
    l += swap_half(l);
    bf16x8 pa[16];
#pragma unroll
    for (int i = 0; i < 8; ++i) { pa[2 * i] = pack_bf8(S[i], 0); pa[2 * i + 1] = pack_bf8(S[i], 8); }
    WAIT_BAR(0);
    f32x16 o[8];
#pragma unroll
    for (int dblk = 0; dblk < 8; ++dblk) o[dblk] = (f32x16){};
    const lds_cptr vp0 = base3 + ((lane >> 4) & 1) * 32 + (lane & 3) * 8 + (4 * hi + ((lane & 15) >> 2)) * 64;
#pragma unroll
    for (int t = 0; t < 4; ++t)
#pragma unroll
        for (int dblk = 0; dblk < 8; ++dblk)
#pragma unroll
            for (int rg = 0; rg < 4; ++rg) { const s16x4 lo = vtr(vp0 + t * 32768 + dblk * 4096 + rg * 1024), hh = vtr(vp0 + t * 32768 + dblk * 4096 + rg * 1024 + 512);
                const bf16x8 vf = (bf16x8){lo[0], lo[1], lo[2], lo[3], hh[0], hh[1], hh[2], hh[3]};
                o[dblk] = MFMA32(pa[t * 4 + rg], vf, o[dblk]); }
    WAIT_BAR(0);
    int l2 = lane; asm volatile("" : "+v"(l2));
    const int e32 = l2 & 31, ehi = l2 >> 5;
    LAS bf16* stg = (LAS bf16*)(F.lds + RING_OFF) + wid * 8192;
    LAS float* lsw = (LAS float*)stg;
    if (ehi == 0) lsw[e32] = l;
    LDS_WAIT();
    float rli[16];
    { const LAS float* lb = lsw + 4 * ehi;
#pragma unroll
      for (int r = 0; r < 16; ++r) rli[r] = __builtin_amdgcn_rcpf(lb[(r & 3) + 8 * (r >> 2)]); }
    LDS_WAIT(); asm volatile("" ::: "memory");
    { LAS bf16* sb = stg + (4 * ehi) * 256 + e32;
#pragma unroll
      for (int dblk = 0; dblk < 8; ++dblk)
#pragma unroll
        for (int r = 0; r < 16; ++r) sb[((r & 3) + 8 * (r >> 2)) * 256 + dblk * 32] = (bf16)f2bf(o[dblk][r] * rli[r]); }
    LDS_WAIT();
    { bf16* Ow = OM + (qrow0 + (l2 >> 5)) * D + h * MHD + (l2 & 31) * 8; const LAS bf16* sr = stg + (l2 >> 5) * 256 + (l2 & 31) * 8;
#pragma unroll
      for (int i = 0; i < 16; ++i) { const v4u v = *(const LAS v4u*)(sr + i * 512); *(v4u*)(Ow + (long)i * 2 * D) = v; } }
    asm volatile("s_waitcnt vmcnt(0) lgkmcnt(0)\n\ts_barrier" ::: "memory");
}
__device__ __forceinline__ void xattn_sample_unit(Frame& F, int b, int h) {
    const int lane = F.lane, wid = F.wave;
    const bf16* QM = WSP(bf16, WS_QM); const float* ck = INF(8); const float* cv = INF(9);
    LAS float* xm = (LAS float*)(F.lds + HALO_OFF);
    const v2u qw = *(const v2u*)(QM + (size_t)(MPR + b) * D + h * MHD + 4 * lane);
    const f32x4 q4 = {bflo(qw.x), bfhi(qw.x), bflo(qw.y), bfhi(qw.y)};
    const float* kb = ck + (((size_t)b * MT + wid * 32) * MH + h) * MHD + 4 * lane;
    const float* vb = cv + (((size_t)b * MT + wid * 32) * MH + h) * MHD + 4 * lane;
    float s[32];
    f32x4 kk[32], vv[32];
#pragma unroll
    for (int i = 0; i < 32; ++i) kk[i] = __builtin_nontemporal_load((const f32x4*)(kb + (size_t)i * MH * MHD));
#pragma unroll
    for (int i0 = 0; i0 < 32; i0 += 16) {
#pragma unroll
        for (int i = 0; i < 16; ++i) s[i0 + i] = wave_sum_fast((q4[0] * kk[i0 + i][0] + q4[1] * kk[i0 + i][1]) + (q4[2] * kk[i0 + i][2] + q4[3] * kk[i0 + i][3]));
#pragma unroll
        for (int i = 0; i < 16; ++i) vv[i0 + i] = __builtin_nontemporal_load((const f32x4*)(vb + (size_t)(i0 + i) * MH * MHD));
        __builtin_amdgcn_sched_barrier(0);
    }
    float mx = s[0];
#pragma unroll
    for (int i = 1; i < 32; ++i) mx = fmaxf(mx, s[i]);
    float l = 0.f;
#pragma unroll
    for (int i = 0; i < 32; ++i) { s[i] = __builtin_amdgcn_exp2f(s[i] - mx); l += s[i]; }
    f32x4 acc = {0.f, 0.f, 0.f, 0.f};
#pragma unroll
    for (int i = 0; i < 32; ++i) acc = acc + vv[i] * s[i];
    WAIT_BAR(0);
    if (lane == 0) { xm[wid] = mx; xm[8 + wid] = l; }
    *(LAS f32x4*)(xm + 64 + wid * 256 + 4 * lane) = acc;
    WAIT_BAR(0);
    if (F.tid < 256) { float gm = xm[0];
#pragma unroll
        for (int w = 1; w < 8; ++w) gm = fmaxf(gm, xm[w]);
        float lt = 0.f, ov = 0.f;
#pragma unroll
        for (int w = 0; w < 8; ++w) { const float f = __builtin_amdgcn_exp2f(xm[w] - gm); lt += xm[8 + w] * f; ov += xm[64 + w * 256 + F.tid] * f; }
        WSP(bf16, WS_OMEM)[(size_t)(MPR + b) * D + h * MHD + F.tid] = (bf16)f2bf(ov / lt); }
}
__device__ __forceinline__ void mix_row(Frame& F, int row) {
    const int lane = F.lane;
#pragma unroll
    for (int half = 0; half < 2; ++half) {
        const bf16* src = (half ? WSP(bf16, WS_OSSM) : WSP(bf16, WS_OSB)) + (size_t)row * SBW + 8 * lane;
        const v4u w = *(const v4u*)src; float v[8] = {bflo(w.x), bfhi(w.x), bflo(w.y), bfhi(w.y), bflo(w.z), bfhi(w.z), bflo(w.w), bfhi(w.w)};
        float s = 0.f;
#pragma unroll
        for (int e = 0; e < 8; ++e) s += v[e] * v[e];
        s = wave_sum(s); const float rs = 1.f / sqrtf(s * (1.f / SBW) + EPS);
        v4u o; o.x = pk2(v[0] * rs, v[1] * rs); o.y = pk2(v[2] * rs, v[3] * rs); o.z = pk2(v[4] * rs, v[5] * rs); o.w = pk2(v[6] * rs, v[7] * rs);
        *(v4u*)(WSP(bf16, WS_MIX) + (size_t)row * D + half * SBW + 8 * lane) = o;
    }
}
__device__ __forceinline__ void conv_act_item(Frame& F, long item) {
    const int row = (int)(item / (FF / 8)), j = (int)(item % (FF / 8)) * 8;
    const bf16* GB = WSP(bf16, WS_GB); bf16* UB = WSP(bf16, WS_UB);
    const float* cw = INF(36); const float* cb = INF(37); const float* sc = INF(7);
    float g0[8], g1[8], g2[8], uu[8];
    { const v4u w = *(const v4u*)(GB + (size_t)row * FF + j); g0[0] = bflo(w.x); g0[1] = bfhi(w.x); g0[2] = bflo(w.y); g0[3] = bfhi(w.y); g0[4] = bflo(w.z); g0[5] = bfhi(w.z); g0[6] = bflo(w.w); g0[7] = bfhi(w.w); }
    { const v4u w = *(const v4u*)(UB + (size_t)row * FF + j); uu[0] = bflo(w.x); uu[1] = bfhi(w.x); uu[2] = bflo(w.y); uu[3] = bfhi(w.y); uu[4] = bflo(w.z); uu[5] = bfhi(w.z); uu[6] = bflo(w.w); uu[7] = bfhi(w.w); }
    if (row < MPR) { const int t = row & 4095;
        if (t >= 1) { const v4u w = *(const v4u*)(GB + (size_t)(row - 1) * FF + j); g1[0] = bflo(w.x); g1[1] = bfhi(w.x); g1[2] = bflo(w.y); g1[3] = bfhi(w.y); g1[4] = bflo(w.z); g1[5] = bfhi(w.z); g1[6] = bflo(w.w); g1[7] = bfhi(w.w); }
        else { _Pragma("unroll") for (int e = 0; e < 8; ++e) g1[e] = 0.f; }
        if (t >= 2) { const v4u w = *(const v4u*)(GB + (size_t)(row - 2) * FF + j); g2[0] = bflo(w.x); g2[1] = bfhi(w.x); g2[2] = bflo(w.y); g2[3] = bfhi(w.y); g2[4] = bflo(w.z); g2[5] = bfhi(w.z); g2[6] = bflo(w.w); g2[7] = bfhi(w.w); }
        else { _Pragma("unroll") for (int e = 0; e < 8; ++e) g2[e] = 0.f; }
    } else { const int b = row - MPR;
        _Pragma("unroll") for (int e = 0; e < 8; ++e) { g2[e] = sc[((size_t)b * 2 + 0) * FF + j + e]; g1[e] = sc[((size_t)b * 2 + 1) * FF + j + e]; F.out[O_CVS + ((size_t)b * 2 + 0) * FF + j + e] = g1[e]; } }
    float r[8];
#pragma unroll
    for (int e = 0; e < 8; ++e) { const float c = cb[j + e] + cw[j + e] * g2[e] + cw[FF + j + e] * g1[e] + cw[2 * FF + j + e] * g0[e]; r[e] = gelu_tanh_f(c) * uu[e]; }
    v4u o; o.x = pk2(r[0], r[1]); o.y = pk2(r[2], r[3]); o.z = pk2(r[4], r[5]); o.w = pk2(r[6], r[7]);
    *(v4u*)(UB + (size_t)row * FF + j) = o;
}
__device__ __forceinline__ void final_norm_row(Frame& F, int row) {
    const float rs = 1.f / sqrtf(((const float*)(F.ctl + CW_SSQ3))[row] * (1.f / D) + EPS);
    float* y = F.out + O_YP + (size_t)row * D; const float* g = INF(39); const bf16* x3 = WSP(bf16, WS_X1B) + (size_t)row * D;
#pragma unroll
    for (int j = 0; j < 2; ++j) { const int c = 8 * F.lane + 512 * j; const v4u w = *(const v4u*)(x3 + c); const f32x4 g0 = *(const f32x4*)(g + c), g1 = *(const f32x4*)(g + c + 4);
        const f32x4 v0 = (f32x4){bflo(w.x), bfhi(w.x), bflo(w.y), bfhi(w.y)} * rs * g0, v1 = (f32x4){bflo(w.z), bfhi(w.z), bflo(w.w), bfhi(w.w)} * rs * g1;
        *(f32x4*)(y + c) = v0; *(f32x4*)(y + c + 4) = v1; }
}
constexpr int N_PHASES = 15;
__global__ void __launch_bounds__(NTHR, 2) mk_fwd(Args args) {
    extern __shared__ __attribute__((aligned(16))) unsigned char lds[];
    Frame F;
    F.lds = (LAS unsigned char*)lds; F.MISC = (volatile LAS unsigned*)(F.lds + MISC_OFF);
    F.tid = threadIdx.x; F.lane = F.tid & 63; F.wave = __builtin_amdgcn_readfirstlane(F.tid >> 6);
    F.G = gridDim.x; { const int bx = blockIdx.x; F.vcu = (F.G % 8 == 0) ? (bx % 8) * (F.G / 8) + bx / 8 : bx; }
    F.ws = args.ws; F.out = args.out; F.in = args.in; F.ctl = (unsigned*)(args.ws + WS_CTL);
    for (int u = F.tid; u < (LDS_BYTES - LDSCTL_OFF) / 4; u += NTHR) ((LAS unsigned*)(F.lds + LDSCTL_OFF))[u] = 0u;
    __syncthreads();
    XcdBarrier bar; bar.bar = F.ctl + CW_BAR; bar.x = 0; bar.st = nullptr;
    if (args.use_bar) bar = xcd_barrier_post(F.ctl + CW_BAR, F.MISC + 8);
    const int lo = args.ph_lo, hi = args.ph_hi;
#define IN(k) (lo <= (k) && (k) < hi)
#if MK_PROBE >= 200
    unsigned long long tp0 = 0, tpd = 0;
#define TP_BEGIN(k) do { if ((k) == MK_PROBE - 200) tp0 = __builtin_amdgcn_s_memrealtime(); } while (0)
#define TP_END(k) do { if ((k) == MK_PROBE - 200) tpd = __builtin_amdgcn_s_memrealtime() - tp0; } while (0)
#else
#define TP_BEGIN(k) do {} while (0)
#define TP_END(k) do {} while (0)
#endif
#define SEAM(k) do { if (IN(k) && IN((k) + 1)) xcd_barrier(bar); TP_END(k); TP_BEGIN((k) + 1); TP_BEGIN((k) + 2); TP_BEGIN((k) + 3); } while (0)
    const int gw = F.vcu * NWAVES + F.wave, NGW = F.G * NWAVES;
    LAS unsigned char* ring = F.lds + RING_OFF;

    TP_BEGIN(0);
    if (IN(0)) { p0_prologue(F);
#if MK_PROBE == 100
        __syncthreads(); p0_prologue(F);
#endif
    } SEAM(0);
    if (IN(1)) {
        { pg8::Gemm g{WSP(bf16, WS_XB), WSP(bf16, WS_WIN), D, D, D}; InProjOrder S{(int)blockIdx.x};
          EpiInProj E{WSP(float, WS_RSTD0), WSP(bf16, WS_QB), WSP(bf16, WS_KB), WSP(bf16, WS_VB), WSP(bf16, WS_XH), WSP(float, WS_QS), WSP(float, WS_US), F.out};
          pg8::gemm_phase<EpiInProj, InProjOrder>(ring, g, S, E);
#if MK_PROBE == 1
          pg8::gemm_phase<EpiInProj, InProjOrder>(ring, g, S, E);
#endif
        }
        { SkInProj E{WSP(float, WS_RSTD0), WSP(bf16, WS_QB), WSP(float, WS_QS), WSP(float, WS_US), F.out};
          skinny_gemm(F, WSP(bf16, WS_XB) + (size_t)MPR * D, D, WSP(bf16, WS_WIN), D, INW, D, E, (int)blockIdx.x, F.G); }
    } SEAM(1);
    if (IN(2)) {
        if ((int)blockIdx.x < NG * NB) { const int u = (int)blockIdx.x; const int sb_ = u & 3, sg_ = u >> 2; int one = 1; asm volatile("" : "+s"(one));
          { pg8::Gemm g{WSP(bf16, WS_XH), WSP(bf16, WS_W1), NG * XHP, 256, 256}; SsmOne S{sb_, sg_, (size_t)128 * 256 * 2, one};
            EpiSsmA E{WSP(float, WS_SST)};
            pg8::gemm_phase<EpiSsmA, SsmOne>(ring, g, S, E); }
          VM_WAIT(); __syncthreads();
          ssm_scan_bg(F, sb_, sg_);
          VM_WAIT(); __syncthreads();
        }
        { pg8::Gemm g{WSP(bf16, WS_MB), WSP(bf16, WS_WMKV), D, D, D}; pg8::GridOrder S; S.init(4, 8, F.G, (int)blockIdx.x, 128, D, D);
          EpiMemKV E{WSP(float, WS_RSTDM), WSP(bf16, WS_MKB), WSP(bf16, WS_MVB), F.out};
          pg8::gemm_phase<EpiMemKV, pg8::GridOrder>(ring, g, S, E); }
        for (int u = gw; u < MS * NG; u += NGW) ssm_sample_unit(F, u >> 5, u & 31);
        weight_copies(F, NITEMS_EARLY, NITEMS_GLU);
        __syncthreads();
        { int mode = (MK_STREAM_DIV > 0 ? (F.vcu % MK_STREAM_DIV == MK_STREAM_DIV - 1) : (F.vcu % (-MK_STREAM_DIV) != 0)) ? 1 : 0; bool adone = false, mdone = false;
          while (!(adone && mdone)) {
              if (mode == 0 && adone) mode = 1; else if (mode == 1 && mdone) mode = 0;
              __syncthreads();
              if (F.tid == 0) F.MISC[16] = __hip_atomic_fetch_add(F.ctl + (mode ? CW_QM : CW_QA), 1u, __ATOMIC_RELAXED, __HIP_MEMORY_SCOPE_AGENT);
              __syncthreads();
              const int idx = (int)F.MISC[16];
              if (mode == 0) { if (idx >= 512) { adone = true; continue; }
                  const int qb = 15 - (idx >> 5), bh = idx & 31; sb_attn_unit(F, bh >> 3, bh & 7, qb, INF(13)[bh & 7] * LOG2E); }
              else { if (idx >= MS * NPG) { mdone = true; continue; }
                  sb_sample_unit(F, idx >> 4, idx & 15); }
          } }
#if MK_PROBE == 22
        if (args.use_bar) { xcd_barrier(bar); if (blockIdx.x == 0 && F.tid == 0) { __hip_atomic_store(F.ctl + CW_QA, 0u, __ATOMIC_RELAXED, __HIP_MEMORY_SCOPE_AGENT); __hip_atomic_store(F.ctl + CW_QM, 0u, __ATOMIC_RELAXED, __HIP_MEMORY_SCOPE_AGENT); } xcd_barrier(bar);
        { int mode = (MK_STREAM_DIV > 0 ? (F.vcu % MK_STREAM_DIV == MK_STREAM_DIV - 1) : (F.vcu % (-MK_STREAM_DIV) != 0)) ? 1 : 0; bool adone = false, mdone = false;
          while (!(adone && mdone)) {
              if (mode == 0 && adone) mode = 1; else if (mode == 1 && mdone) mode = 0;
              __syncthreads();
              if (F.tid == 0) F.MISC[16] = __hip_atomic_fetch_add(F.ctl + (mode ? CW_QM : CW_QA), 1u, __ATOMIC_RELAXED, __HIP_MEMORY_SCOPE_AGENT);
              __syncthreads();
              const int idx = (int)F.MISC[16];
              if (mode == 0) { if (idx >= 512) { adone = true; continue; }
                  const int qb = 15 - (idx >> 5), bh = idx & 31; sb_attn_unit(F, bh >> 3, bh & 7, qb, INF(13)[bh & 7] * LOG2E); }
              else { if (idx >= MS * NPG) { mdone = true; continue; }
                  sb_sample_unit(F, idx >> 4, idx & 15); }
          } }
        }
#endif
        __syncthreads();
        if ((int)blockIdx.x < NG * NB) { const int u = (int)blockIdx.x; const int sb_ = u & 3, sg_ = u >> 2; int one = 1; asm volatile("" : "+s"(one));
          { pg8::Gemm g{WSP(bf16, WS_XH), WSP(bf16, WS_BTC), NG * XHP, XHP, XHP}; SsmOne S{sb_, sg_, (size_t)256 * XHP * 2, one};
            EpiSsmC E{WSP(bf16, WS_YG)};
            pg8::gemm_phase<EpiSsmC, SsmOne>(ring, g, S, E); }
        }
        weight_copies(F, NITEMS_GLU, NITEMS_MID, NG * NB, F.G - NG * NB);
    } SEAM(2);
    if (IN(5)) {
        for (int u = gw; u < MS * NH; u += NGW) sb_sample_combine(F, u >> 3, u & 7);
        pg8::Gemm g{WSP(bf16, WS_YG), WSP(bf16, WS_WGLU), SBW, SBW, SBW}; pg8::GridOrder S; S.init(MPR / 256, 2, F.G, (int)blockIdx.x, 0, SBW, SBW);
        EpiGlu E{WSP(bf16, WS_YG), INF(23), WSP(bf16, WS_MIX), (float*)(F.ctl + CW_SSQB)};
        pg8::gemm_phase<EpiGlu, pg8::GridOrder>(ring, g, S, E);
        weight_copies(F, NITEMS_MID, NITEMS_ALL, 128, F.G - 128);
        __syncthreads();
        SkGlu E2{WSP(bf16, WS_YG), INF(23), WSP(bf16, WS_MIX), (float*)(F.ctl + CW_SSQB)};
        skinny_gemm(F, WSP(bf16, WS_YG) + (size_t)MPR * SBW, SBW, WSP(bf16, WS_WGLU), SBW, SBW, SBW, E2, ((int)blockIdx.x + F.G - 128) % F.G, F.G);
    } SEAM(5);
    if (IN(7)) {
        pg8::Gemm g{WSP(bf16, WS_MIX), WSP(bf16, WS_WOUT), D, D, D}; pg8::GridOrder S; S.init(MPR / 256, 4, F.G, (int)blockIdx.x, 0, D, D);
        EpiResidMix E{WSP(bf16, WS_XB), WSP(bf16, WS_X1B), (float*)(F.ctl + CW_SSQ1), (const float*)(F.ctl + CW_SSQA), (const float*)(F.ctl + CW_SSQB), (LAS float*)(F.lds + HALO_OFF_C)};
        pg8::gemm_phase<EpiResidMix, pg8::GridOrder>(ring, g, S, E);
        SkResidMix E2{WSP(bf16, WS_XB), WSP(bf16, WS_X1B), (float*)(F.ctl + CW_SSQ1), (const float*)(F.ctl + CW_SSQA), (const float*)(F.ctl + CW_SSQB)};
        skinny_gemm(F, WSP(bf16, WS_MIX) + (size_t)MPR * D, D, WSP(bf16, WS_WOUT), D, D, D, E2, (int)blockIdx.x, F.G);
    } SEAM(7);
    if (IN(8)) {
        pg8::Gemm g{WSP(bf16, WS_X1B), WSP(bf16, WS_WMQ), D, D, D}; pg8::GridOrder S; S.init(MPR / 256, 4, F.G, (int)blockIdx.x, 0, D, D);
        EpiScaleBf16 E{(const float*)(F.ctl + CW_SSQ1), CM, WSP(bf16, WS_QM)};
        pg8::gemm_phase<EpiScaleBf16, pg8::GridOrder>(ring, g, S, E);
#if MK_PROBE == 8
        pg8::gemm_phase<EpiScaleBf16, pg8::GridOrder>(ring, g, S, E);
#endif
        SkScale E2{(const float*)(F.ctl + CW_SSQ1), CM, WSP(bf16, WS_QM)};
        skinny_gemm(F, WSP(bf16, WS_X1B) + (size_t)MPR * D, D, WSP(bf16, WS_WMQ), D, D, D, E2, (int)blockIdx.x, F.G);
        if (IN(9) && F.vcu < 256) { __syncthreads(); xattn_prompt_kload(F, F.vcu >> 6, (F.vcu >> 4) & 3); }
    } SEAM(8);
    if (IN(9)) {
#if MK_XSTAG
        const bool sfirst = ((F.vcu >> 4) & 1) != 0;
#else
        const bool sfirst = false;
#endif
        if (sfirst) { for (int u = F.vcu; u < MS * MH; u += F.G) xattn_sample_unit(F, u >> 2, u & 3); __syncthreads(); }
        { bool have_k = IN(8); for (int u = F.vcu; u < 256; u += F.G) { xattn_prompt_unit(F, u >> 6, (u >> 4) & 3, u & 15, have_k); have_k = false; } }
        if (!sfirst) { for (int u = F.vcu; u < MS * MH; u += F.G) xattn_sample_unit(F, u >> 2, u & 3); }
    } SEAM(9);
    if (IN(10)) {
        pg8::Gemm g{WSP(bf16, WS_OMEM), WSP(bf16, WS_WMO), D, D, D}; pg8::GridOrder S; S.init(MPR / 256, 4, F.G, (int)blockIdx.x, 0, D, D);
        EpiResidB E{WSP(bf16, WS_X1B), nullptr, WSP(bf16, WS_X2B), (float*)(F.ctl + CW_SSQ2), (LAS float*)(F.lds + HALO_OFF_C)};
        pg8::gemm_phase<EpiResidB, pg8::GridOrder>(ring, g, S, E);
#if MK_PROBE == 10
        { EpiResidB Ed{WSP(bf16, WS_X1B), nullptr, WSP(bf16, WS_X2B), (float*)(F.ctl + CW_SSQD), (LAS float*)(F.lds + HALO_OFF_C)}; pg8::gemm_phase<EpiResidB, pg8::GridOrder>(ring, g, S, Ed); }
#endif
        SkResidB E2{WSP(bf16, WS_X1B), nullptr, WSP(bf16, WS_X2B), (float*)(F.ctl + CW_SSQ2)};
        skinny_gemm(F, WSP(bf16, WS_OMEM) + (size_t)MPR * D, D, WSP(bf16, WS_WMO), D, D, D, E2, (int)blockIdx.x, F.G);
    } SEAM(10);
    if (IN(11)) {
        pg8::Gemm g{WSP(bf16, WS_X2B), WSP(bf16, WS_WGU), D, D, D, FF}; PanelOrder254 S; S.Gd.init(65, 22, F.G, (int)blockIdx.x, 0, D, D);
        EpiGateUpConv E{(const float*)(F.ctl + CW_SSQ2), WSP(bf16, WS_UB), F.out, INF(36), INF(37), (LAS float*)(F.lds + HALO_OFF)};
        const int nheavy = 1430 - (1430 / F.G) * F.G; const bool heavy = (int)blockIdx.x < nheavy;
        SkGateUpConv E2{(const float*)(F.ctl + CW_SSQ2), WSP(bf16, WS_UB), F.out, INF(36), INF(37), INF(7)};
        const int su0 = ((int)blockIdx.x + F.G - nheavy) % F.G;
        if (heavy) { skinny_gemm(F, WSP(bf16, WS_X2B) + (size_t)MPR * D, D, WSP(bf16, WS_WGU), D, FF, D, E2, su0, F.G, 16, FF);
            asm volatile("s_waitcnt vmcnt(0)" ::: "memory"); __syncthreads();
            if (F.tid == 0) { __builtin_amdgcn_fence(__ATOMIC_RELEASE, "agent"); (void)xb_add(F.ctl + CW_SCNT, 1u); } }
        pg8::gemm_phase<EpiGateUpConv, PanelOrder254>(ring, g, S, E);
#if MK_PROBE == 11
        pg8::gemm_phase<EpiGateUpConv, PanelOrder254>(ring, g, S, E);
#endif
        if (!heavy) { skinny_gemm(F, WSP(bf16, WS_X2B) + (size_t)MPR * D, D, WSP(bf16, WS_WGU), D, FF, D, E2, su0, F.G, 16, FF);
            asm volatile("s_waitcnt vmcnt(0)" ::: "memory"); __syncthreads();
            if (F.tid == 0) { __builtin_amdgcn_fence(__ATOMIC_RELEASE, "agent"); (void)xb_add(F.ctl + CW_SCNT, 1u);
                XB_SPIN(xb_ld(F.ctl + CW_SCNT) < (unsigned)F.G, F.ctl + CW_BAR); __builtin_amdgcn_fence(__ATOMIC_ACQUIRE, "agent"); }
            __syncthreads();
            SkResidB E3{WSP(bf16, WS_X2B), nullptr, WSP(bf16, WS_X1B), (float*)(F.ctl + CW_SSQ3)};
            skinny_gemm(F, WSP(bf16, WS_UB) + (size_t)MPR * FF, FF, WSP(bf16, WS_WDN), FF, D, FF, E3, su0, F.G - nheavy); }
    } SEAM(11);
    if (IN(13)) {
        pg8::Gemm g{WSP(bf16, WS_UB), WSP(bf16, WS_WDN), FF, FF, FF}; pg8::GridOrder S; S.init(MPR / 256, 4, F.G, (int)blockIdx.x, 0, FF, FF);
        EpiResidFinal E{WSP(bf16, WS_X2B), (float*)(F.ctl + CW_SSQ3), (LAS float*)(F.lds + HALO_OFF_C), F.ctl + CW_PCNT, F.ctl + CW_BAR, INF(39), F.out + O_YP, WSP(bf16, WS_X1B)};
        pg8::gemm_phase<EpiResidFinal, pg8::GridOrder>(ring, g, S, E);
#if MK_PROBE == 13
        { EpiResidB Ed{WSP(bf16, WS_X2B), nullptr, WSP(bf16, WS_X1B), (float*)(F.ctl + CW_SSQD), (LAS float*)(F.lds + HALO_OFF_C)}; pg8::gemm_phase<EpiResidB, pg8::GridOrder>(ring, g, S, Ed); }
#endif
    }
#if MK_PROBE == 20
    if (args.use_bar) { for (int i = 0; i < 10; ++i) xcd_barrier(bar); }
#endif
#if MK_PROBE >= 200
    TP_END(14);
    if (blockIdx.x == 0) { const unsigned long long t1 = __builtin_amdgcn_s_memrealtime(); while (__builtin_amdgcn_s_memrealtime() - t1 < tpd) __builtin_amdgcn_s_sleep(8); }
#endif
#undef IN
#undef SEAM
}
#ifndef MK_DEBUG
#define MK_DEBUG 0
#endif
#ifndef MK_ONE_LAUNCH
#define MK_ONE_LAUNCH 1
#endif
#if MK_DEBUG
struct Chk { const void* fast; const float* ref; long rows, cols, ldf, ldr; int isbf; float scale; };
__global__ void k_compare(Chk c, double* acc) {
    __shared__ double se[256], sr[256];
    double e = 0.0, r = 0.0; const long n = c.rows * c.cols;
    for (long i = (long)blockIdx.x * 256 + threadIdx.x; i < n; i += (long)gridDim.x * 256) { const long rr = i / c.cols, cc = i % c.cols;
        const float f = (c.isbf ? bf2f(((const unsigned short*)c.fast)[rr * c.ldf + cc]) : ((const float*)c.fast)[rr * c.ldf + cc]) * c.scale; const float g = c.ref[rr * c.ldr + cc];
        const double d = (double)f - (double)g; e += d * d; r += (double)g * (double)g; }
    se[threadIdx.x] = e; sr[threadIdx.x] = r; __syncthreads();
    for (int k = 128; k > 0; k >>= 1) { if ((int)threadIdx.x < k) { se[threadIdx.x] += se[threadIdx.x + k]; sr[threadIdx.x] += sr[threadIdx.x + k]; } __syncthreads(); }
    if (threadIdx.x == 0) { atomicAdd(acc, se[0]); atomicAdd(acc + 1, sr[0]); }
}
__global__ void k_compare_xh(const unsigned short* XH, const float* proj, const float* hs, int part, double* acc) {
    __shared__ double se[256], sr[256];
    double e = 0.0, r = 0.0; const int w = part ? 128 : 256; const long n = (long)1024 * NG * w;
    for (long i = (long)blockIdx.x * 256 + threadIdx.x; i < n; i += (long)gridDim.x * 256) { const int j = (int)(i % w); const long bcg = i / w; const int g = (int)(bcg % NG); const long bc = bcg / NG; const int b = (int)(bc / NCH), c = (int)(bc % NCH);
        const float f = bf2f(XH[bcg * XHP + (part ? 256 : 0) + j]); float gref;
        if (!part) { const int s = j >> 4, q = j & 15; gref = proj[((size_t)b * T + c * LC + s) * INW + 1536 + g * GP + q]; }
        else { const int nn = j >> 1, ri = j & 1; gref = (c == 0) ? 0.f : hs[((((size_t)b * T + c * LC - 1) * NG + g) * NST + nn) * 2 + ri]; }
        const double d = (double)f - (double)gref; e += d * d; r += (double)gref * (double)gref; }
    se[threadIdx.x] = e; sr[threadIdx.x] = r; __syncthreads();
    for (int k = 128; k > 0; k >>= 1) { if ((int)threadIdx.x < k) { se[threadIdx.x] += se[threadIdx.x + k]; sr[threadIdx.x] += sr[threadIdx.x + k]; } __syncthreads(); }
    if (threadIdx.x == 0) { atomicAdd(acc, se[0]); atomicAdd(acc + 1, sr[0]); }
}
__global__ void k_judge(const double* acc, int n, float tol, float* out) {
    if (threadIdx.x != 0 || blockIdx.x != 0) return;
    for (int k = 0; k < n; ++k) { const double rv = acc[2 * k] / acc[2 * k + 1];
        if (!(rv < (double)tol)) { int m = 5; if (rv != rv) m = 0; else if (rv >= 1.0) m = 9; else if (rv >= 0.1) m = 8; else if (rv >= 0.01) m = 7; else if (rv >= 0.001) m = 6;
            const int grp = k / 9, kk = k % 9 + 1; float code = (float)(10 * kk + m) * 100.f; for (int i = 0; i < grp; ++i) code *= 100.f; out[0] = code; return; } }
}
#endif

extern "C" void kernel_launch(void* const* d_in, const int* in_sizes, int n_in, void* d_out, int out_size, void* d_ws, size_t ws_size, hipStream_t stream) {
    static int grid = 0;
    if (grid == 0) {
        if (n_in != 40 || (size_t)out_size != O_END || ws_size < WS_FAST_END) { fprintf(stderr, "kernel_launch: unexpected shapes: n_in %d out %d ws %zu\n", n_in, out_size, ws_size); grid = -1; return; }
        int dev = 0, cus = 0, per_cu = 0;
        if (hipGetDevice(&dev) != hipSuccess || hipDeviceGetAttribute(&cus, hipDeviceAttributeMultiprocessorCount, dev) != hipSuccess) { grid = -1; return; }
        if (hipFuncSetAttribute((const void*)mk_fwd, hipFuncAttributeMaxDynamicSharedMemorySize, LDS_BYTES) != hipSuccess) { fprintf(stderr, "kernel_launch: hipFuncSetAttribute failed\n"); grid = -1; return; }
        if (hipOccupancyMaxActiveBlocksPerMultiprocessor(&per_cu, (const void*)mk_fwd, NTHR, LDS_BYTES) != hipSuccess || per_cu < 1) { fprintf(stderr, "kernel_launch: occupancy query says %d\n", per_cu); }
        (void)hipGetLastError();
        grid = cus;
        if (grid < 256) { fprintf(stderr, "kernel_launch: this kernel needs at least 256 CUs (found %d): the down projection's 256 units meet on per-panel counters and must all be resident at once\n", grid); grid = -1; return; }
    }
    if (grid < 0) return;
    (void)hipMemsetAsync((char*)d_ws + WS_CTL, 0, CTL_ZERO_BYTES, stream);
    Args a{};
    for (int i = 0; i < 40; ++i) a.in[i] = d_in[i];
    a.out = (float*)d_out; a.ws = (unsigned char*)d_ws;
#if MK_DEBUG
    const size_t fo_off = (WS_FAST_END + 4095) & ~(size_t)4095, nv_off = fo_off + (((size_t)O_END * 4 + 4095) & ~(size_t)4095), chk_off = nv_off + (((size_t)nv::WS_FLOATS * 4 + 4095) & ~(size_t)4095);
    if (ws_size < chk_off + 4096) { fprintf(stderr, "debug build: workspace too small (%zu < %zu)\n", ws_size, chk_off + 4096); return; }
    float* fast_out = (float*)((char*)d_ws + fo_off); float* nvws = (float*)((char*)d_ws + nv_off); double* chk = (double*)((char*)d_ws + chk_off);
    nv::forward(d_in, (float*)d_out, nvws, stream);
    a.out = fast_out;
    (void)hipMemsetAsync(chk, 0, 4096, stream);
#endif
#if MK_ONE_LAUNCH
    a.ph_lo = 0; a.ph_hi = N_PHASES; a.use_bar = 1;
    hipLaunchKernelGGL(mk_fwd, dim3(grid), dim3(NTHR), LDS_BYTES, stream, a);
#else
    for (int p = 0; p < N_PHASES; ++p) { a.ph_lo = p; a.ph_hi = p + 1; a.use_bar = 0; hipLaunchKernelGGL(mk_fwd, dim3(grid), dim3(NTHR), LDS_BYTES, stream, a); }
#endif
#if MK_DEBUG
    {
        const nv::Bufs B = nv::carve(nvws); unsigned char* ws = (unsigned char*)d_ws; int k = 0; const float* no = (const float*)d_out;
        auto cmp = [&](const void* fast, int isbf, long ldf, const float* ref, long ldr, long rows, long cols, float scale) {
            Chk c; memset(&c, 0, sizeof(c)); c.fast = fast; c.ref = ref; c.rows = rows; c.cols = cols; c.ldf = ldf; c.ldr = ldr; c.isbf = isbf; c.scale = scale; hipLaunchKernelGGL(k_compare, dim3(1024), dim3(256), 0, stream, c, chk + 2 * k); ++k; };
        cmp(ws + WS_KB, 1, SBW, B.PROJ + 512, INW, MPR, SBW, 1.f);
        cmp(ws + WS_VB, 1, SBW, B.PROJ + 1024, INW, MPR, SBW, 1.f);
        cmp(ws + WS_QB, 1, SBW, B.PROJ, INW, MPR, SBW, 1.f / C2);
        hipLaunchKernelGGL(k_compare_xh, dim3(1024), dim3(256), 0, stream, (const unsigned short*)(ws + WS_XH), B.PROJ, B.HS, 0, chk + 2 * k); ++k;
        cmp(ws + WS_MKB, 1, D, no + O_MKP, D, NB * MT, D, 1.f);
        cmp(ws + WS_MVB, 1, D, no + O_MVP, D, NB * MT, D, 1.f);
        cmp(ws + WS_MIX, 1, D, B.OSB, SBW, MPR, SBW, 1.f);
        cmp(ws + WS_MIX + (size_t)MPR * D * 2, 1, D, B.OSB + (size_t)MPR * SBW, SBW, MS, SBW, 1.f);
        hipLaunchKernelGGL(k_compare_xh, dim3(1024), dim3(256), 0, stream, (const unsigned short*)(ws + WS_XH), B.PROJ, B.HS, 1, chk + 2 * k); ++k;
        cmp(ws + WS_YG, 1, SBW, B.YG, SBW, MPR, SBW, 1.f);
        cmp(ws + WS_YG + (size_t)MPR * SBW * 2, 1, SBW, B.YG + (size_t)MPR * SBW, SBW, MS, SBW, 1.f);
        cmp(ws + WS_MIX + SBW * 2, 1, D, B.OSSM, SBW, MALL, SBW, 1.f);
        cmp(ws + WS_X1B, 1, D, B.X3, D, MALL, D, 1.f);
        cmp(ws + WS_QM, 1, D, B.Q, D, MALL, D, 1.f / CM);
        cmp(ws + WS_OMEM, 1, D, B.OM, D, MPR, D, 1.f);
        cmp(ws + WS_OMEM + (size_t)MPR * D * 2, 1, D, B.OM + (size_t)MPR * D, D, MS, D, 1.f);
        cmp(ws + WS_X2B, 1, D, B.X2, D, MALL, D, 1.f);
        cmp(ws + WS_X2B, 1, D, B.X2, D, MALL, D, 1.f);
        cmp(ws + WS_UB, 1, FF, B.ACT, FF, MALL, FF, 1.f);
        const size_t offs[15] = {O_YP, O_YS, O_KP, O_VP, O_REP, O_IMP, O_CVP, O_MKP, O_MVP, O_KS, O_VS, O_RES, O_IMS, O_CVS, O_END};
        for (int i = 0; i < 14; ++i) cmp(fast_out + offs[i], 0, 1, no + offs[i], 1, (long)(offs[i + 1] - offs[i]), 1, 1.f);
        hipLaunchKernelGGL(k_judge, dim3(1), dim3(64), 0, stream, (const double*)chk, k, 2e-3f, (float*)d_out);
    }
#endif
}
```

```cpp
#define MK_DEBUG 0
#define MK_ONE_LAUNCH 1
#define MK_PROBE 0
#define MK_STREAM_DIV 2
#define MK_XSTAG 1
#include <hip/hip_runtime.h>
#include <cstdio>
#include <cstdint>
#include <cmath>
#include <cstring>
namespace pg8 {
#define PG8_LAS __attribute__((address_space(3)))
typedef unsigned short bf16_t;
typedef short bf16x8 __attribute__((ext_vector_type(8)));
typedef float f32x4 __attribute__((ext_vector_type(4)));
typedef unsigned u32x4 __attribute__((ext_vector_type(4)));
constexpr int BM = 256, BK = 64, HALF = 128, HTB = HALF * BK * 2  , STAGE_BYTES = 8 * HTB, NXCD = 8, WGM = 8;

__host__ __device__ __forceinline__ int lds_byte(int r, int c) { const int st = (r >> 4) * 2 + (c >> 5), rr = r & 15, cc = c & 31, ob = rr * 64 + cc * 2; return st * 1024 + (ob ^ (((ob >> 9) & 1) << 5)); }
__host__ __device__ __forceinline__ void stage_rc(int b, int& R, int& C) { const int st = b / 1024, sb = b % 1024, swz = sb ^ (((sb >> 9) & 1) << 5); R = (st >> 1) * 16 + swz / 64; C = (st & 1) * 32 + (swz % 64) / 2; }
__host__ __device__ __forceinline__ int perm32(int rho) { const int n = rho >> 4, i = rho & 15; return 8 * (i >> 2) + 4 * n + (i & 3); }

struct Unit { int pm, pn; };
struct Gemm { const bf16_t* A; const bf16_t* Bt; int lda, ldb, K; int bhalf = HALF; };

struct GridOrder {
    int nM, nN, nwg, G, c; size_t astep, bstep;
    __device__ void init(int nM_, int nN_, int G_, int c_, int shift, int lda, int ldb) { nM = nM_; nN = nN_; nwg = nM * nN; G = G_; c = (c_ + G_ - (shift % G_)) % G_; astep = (size_t)BM * lda * 2; bstep = (size_t)BM * ldb * 2; }
    __device__ bool next(int i, Unit& u) const {
        const long L = (long)i * G + c; if (L >= nwg) return false;
        int wgid = (int)L; { const int q = nwg / NXCD, r = nwg % NXCD, xcd = wgid % NXCD, off = wgid / NXCD; wgid = (xcd < r ? xcd * (q + 1) : r * (q + 1) + (xcd - r) * q) + off; }
        const int nig = WGM * nN, gid = wgid / nig, fm = gid * WGM, gsz = (nM - fm) < WGM ? (nM - fm) : WGM;
        u.pm = fm + ((wgid % nig) % gsz); u.pn = (wgid % nig) / gsz; return true;
    }
    __device__ __forceinline__ size_t aoff(const Unit& u) const { return (size_t)u.pm * astep; }
    __device__ __forceinline__ size_t boff(const Unit& u) const { return (size_t)u.pn * bstep; }
};

__device__ __forceinline__ unsigned cvt_pk_bf16(float lo, float hi) { unsigned r; asm volatile("v_cvt_pk_bf16_f32 %0, %1, %2" : "=v"(r) : "v"(lo), "v"(hi)); return r; }

template <class Epi, class Sched, bool ALIGN_EPI = true, bool SP2 = true>
__device__ __forceinline__ void gemm_phase(PG8_LAS unsigned char* lds, const Gemm g, const Sched& S, const Epi& E) {
    const int tid = threadIdx.x, wid = __builtin_amdgcn_readfirstlane(tid >> 6), lane = tid & 63, wr = wid >> 2, wc = wid & 3, fr = lane & 15, fq = lane >> 4;
    const int K = g.K, nt = K / BK;
    unsigned voffA[2], voffB[2];
#pragma unroll
    for (int i = 0; i < 2; ++i) { int R, C; stage_rc(tid * 16 + i * 8192, R, C); const int Rb = (R & ~31) + perm32(R & 31);
        voffA[i] = (unsigned)(R * g.lda + C) * 2u; voffB[i] = (unsigned)(Rb * g.ldb + C) * 2u; }
    const size_t kstep = (size_t)(BK * 2);
    const size_t hstepA = (size_t)HALF * g.lda * 2, hstepB = (size_t)g.bhalf * g.ldb * 2;
    const unsigned ldsw = (unsigned)wid * 1024u;
    const int aoff = lds_byte(wr * 64 + fr, fq * 8), boff = lds_byte(wc * 32 + fr, fq * 8);
#define PG8_SA(b, h) (((b) * 2 + (h)) * HTB)
#define PG8_SB(b, h) ((4 + (b) * 2 + (h)) * HTB)
#define PG8_STAGE(bufoff, gbase, voff) do { _Pragma("unroll") for (int _i = 0; _i < 2; ++_i) \
        __builtin_amdgcn_global_load_lds((const unsigned*)((const char*)(gbase) + (voff)[_i]), (PG8_LAS unsigned*)(lds + (bufoff) + ldsw + _i * 8192), 16, 0, 0); } while (0)
#define PG8_LDA(dst, b, h) do { _Pragma("unroll") for (int m = 0; m < 4; ++m) _Pragma("unroll") for (int k = 0; k < 2; ++k) dst[m][k] = *(const PG8_LAS bf16x8*)(lds + PG8_SA(b, h) + aoff + m * 2048 + k * 1024); } while (0)
#define PG8_LDB(dst, b, h) do { _Pragma("unroll") for (int n = 0; n < 2; ++n) _Pragma("unroll") for (int k = 0; k < 2; ++k) dst[n][k] = *(const PG8_LAS bf16x8*)(lds + PG8_SB(b, h) + boff + n * 2048 + k * 1024); } while (0)
#define PG8_MMA(ai, bj, At, Bt) do { __builtin_amdgcn_s_setprio(1); _Pragma("unroll") for (int m = 0; m < 4; ++m) _Pragma("unroll") for (int n = 0; n < 2; ++n) _Pragma("unroll") for (int k = 0; k < 2; ++k) \
        acc[ai][bj][m][n] = __builtin_amdgcn_mfma_f32_16x16x32_bf16(Bt[n][k], At[m][k], acc[ai][bj][m][n], 0, 0, 0); __builtin_amdgcn_s_setprio(0); } while (0)
#define PG8_WAIT_V(n) asm volatile("s_waitcnt vmcnt(" #n ")" ::: "memory")
#define PG8_WAIT_L(n) asm volatile("s_waitcnt lgkmcnt(" #n ")" ::: "memory")
#define PG8_BAR __builtin_amdgcn_s_barrier()
#define PG8_SCHED __builtin_amdgcn_sched_barrier(0)
    Unit cur, nxt; int ui = 0;
    if (!S.next(0, cur)) return;
    f32x4 acc[2][2][4][2];
#pragma unroll
    for (int a = 0; a < 2; ++a)
#pragma unroll
        for (int b = 0; b < 2; ++b)
#pragma unroll
            for (int m = 0; m < 4; ++m)
#pragma unroll
                for (int n = 0; n < 2; ++n) acc[a][b][m][n] = (f32x4){0.f, 0.f, 0.f, 0.f};
    bf16x8 At[4][2], B0[2][2], B1[2][2];
    const char* cA = (const char*)g.A + S.aoff(cur); const char* cB = (const char*)g.Bt + S.boff(cur);
    static_assert(SP2, "only the SP2 loop is kept in this file");
    PG8_STAGE(PG8_SB(0, 0), cB, voffB); PG8_STAGE(PG8_SB(0, 1), cB + hstepB, voffB); PG8_STAGE(PG8_SA(0, 0), cA, voffA); PG8_STAGE(PG8_SA(0, 1), cA + hstepA, voffA);
    if (wr == 1) PG8_BAR;
    PG8_WAIT_V(2); PG8_BAR;
    PG8_STAGE(PG8_SB(1, 0), cB + kstep, voffB); PG8_STAGE(PG8_SA(1, 0), cA + kstep, voffA); PG8_STAGE(PG8_SB(1, 1), cB + hstepB + kstep, voffB);
    PG8_WAIT_V(6); PG8_BAR;
    for (;;) {
        const bool has_next = S.next(ui + 1, nxt);
        const char* nA = has_next ? (const char*)g.A + S.aoff(nxt) : cA; const char* nB = has_next ? (const char*)g.Bt + S.boff(nxt) : cB;
        for (int t = 0; t < nt; t += 2) {
            const bool last = (t == nt - 2);
            const char* a1 = cA + (size_t)(t + 1) * kstep;
            const char* a2 = last ? nA : cA + (size_t)(t + 2) * kstep; const char* b2 = last ? nB : cB + (size_t)(t + 2) * kstep;
            const char* a3 = a2 + kstep; const char* b3 = b2 + kstep;
            PG8_LDB(B0, 0, 0); PG8_LDB(B1, 0, 1); PG8_SCHED; PG8_LDA(At, 0, 0); PG8_STAGE(PG8_SA(1, 1), a1 + hstepA, voffA);
            PG8_WAIT_V(8); PG8_WAIT_L(0); PG8_BAR; PG8_MMA(0, 0, At, B0); PG8_MMA(0, 1, At, B1); PG8_BAR; PG8_SCHED;
            PG8_LDA(At, 0, 1); PG8_STAGE(PG8_SB(0, 0), b2, voffB); PG8_STAGE(PG8_SB(0, 1), b2 + hstepB, voffB); PG8_STAGE(PG8_SA(0, 0), a2, voffA);
            PG8_WAIT_V(8); PG8_WAIT_L(0); PG8_BAR; PG8_MMA(1, 0, At, B0); PG8_MMA(1, 1, At, B1); PG8_BAR; PG8_SCHED;
            PG8_LDB(B0, 1, 0); PG8_LDB(B1, 1, 1); PG8_SCHED; PG8_LDA(At, 1, 0); PG8_STAGE(PG8_SA(0, 1), a2 + hstepA, voffA);
            PG8_WAIT_V(8); PG8_WAIT_L(0); PG8_BAR; PG8_MMA(0, 0, At, B0); PG8_MMA(0, 1, At, B1); PG8_BAR; PG8_SCHED;
            PG8_LDA(At, 1, 1); PG8_STAGE(PG8_SB(1, 0), b3, voffB); PG8_STAGE(PG8_SB(1, 1), b3 + hstepB, voffB); PG8_STAGE(PG8_SA(1, 0), a3, voffA);
            PG8_WAIT_V(8); PG8_WAIT_L(0); PG8_BAR; PG8_MMA(1, 0, At, B0); PG8_MMA(1, 1, At, B1); PG8_BAR; PG8_SCHED;
            if constexpr (Epi::MIDK) { if (t + 2 == nt / 2) E.mid(acc, cur, wr, wc, fr, fq); }
        }
        if constexpr (ALIGN_EPI) { if (wr == 0) PG8_BAR; }
        E(acc, cur, wr, wc, fr, fq);
        if (!has_next) break;
#pragma unroll
        for (int a = 0; a < 2; ++a)
#pragma unroll
            for (int b = 0; b < 2; ++b)
#pragma unroll
                for (int m = 0; m < 4; ++m)
#pragma unroll
                    for (int n = 0; n < 2; ++n) acc[a][b][m][n] = (f32x4){0.f, 0.f, 0.f, 0.f};
        cur = nxt; cA = nA; cB = nB; ++ui;
        if constexpr (ALIGN_EPI) { if (wr == 1) PG8_BAR; }
    }
    PG8_WAIT_V(0);
    if constexpr (!ALIGN_EPI) { if (wr == 0) PG8_BAR; }
    PG8_BAR;
#undef PG8_SA
#undef PG8_SB
#undef PG8_STAGE
#undef PG8_LDA
#undef PG8_LDB
#undef PG8_MMA
#undef PG8_WAIT_V
#undef PG8_WAIT_L
#undef PG8_BAR
#undef PG8_SCHED
}
}
constexpr int NWAVES = 8, NTHR = 512;
constexpr int D = 1024, NB = 4, T = 4096, MPR = NB * T, MS = 128, MALL = MPR + MS, MPAD = 16640;
constexpr int SBW = 512, NH = 8, HD = 64, NG = 32, GP = 16, NST = 64, INW = 2048, FF = 2816, NFF2 = 2 * FF;
constexpr int MT = 256, MH = 4, MHD = 256, PAST = 2048, PAGE = 128, NPG = 16;
constexpr int LC = 16, NCH = T / LC, XHP = 384;
constexpr float EPS = 1e-6f, LOG2E = 1.4426950408889634f;
constexpr float C2 = 0.125f * LOG2E;
constexpr float CM = 0.0625f * LOG2E;

constexpr size_t O_YP = 0, O_YS = O_YP + (size_t)MPR * D, O_KP = O_YS + (size_t)MS * D, O_VP = O_KP + (size_t)MPR * SBW, O_REP = O_VP + (size_t)MPR * SBW,
    O_IMP = O_REP + NB * NG * NST, O_CVP = O_IMP + NB * NG * NST, O_MKP = O_CVP + (size_t)NB * 2 * FF, O_MVP = O_MKP + (size_t)NB * MT * D, O_KS = O_MVP + (size_t)NB * MT * D,
    O_VS = O_KS + (size_t)MS * SBW, O_RES = O_VS + (size_t)MS * SBW, O_IMS = O_RES + (size_t)MS * NG * NST, O_CVS = O_IMS + (size_t)MS * NG * NST, O_END = O_CVS + (size_t)MS * 2 * FF;

constexpr size_t MiB = 1u << 20;
constexpr size_t al(size_t x) { return (x + 4095) & ~(size_t)4095; }
constexpr size_t WS_CTL = 0, CTL_ZERO_BYTES = 1 * MiB;
constexpr size_t WS_WIN = 1 * MiB;
constexpr size_t WS_WMKV = WS_WIN + al((size_t)INW * D * 2);
constexpr size_t WS_WGLU = WS_WMKV + al((size_t)2048 * D * 2);
constexpr size_t WS_WOUT = WS_WGLU + al((size_t)SBW * SBW * 2);
constexpr size_t WS_WMQ = WS_WOUT + al((size_t)D * D * 2);
constexpr size_t WS_WMO = WS_WMQ + al((size_t)D * D * 2);
constexpr size_t WS_WGU = WS_WMO + al((size_t)D * D * 2);
constexpr size_t WS_WDN = WS_WGU + al((size_t)NFF2 * D * 2);
constexpr size_t WS_W1 = WS_WDN + al((size_t)D * FF * 2);
constexpr size_t WS_BTC = WS_W1 + al((size_t)33 * 128 * 256 * 2);
constexpr size_t WS_XB = WS_BTC + al((size_t)NG * 256 * XHP * 2);
constexpr size_t WS_RSTD0 = WS_XB + al((size_t)MPAD * D * 2);
constexpr size_t WS_MB = WS_RSTD0 + al((size_t)MPAD * 4);
constexpr size_t WS_RSTDM = WS_MB + al((size_t)1024 * D * 2);
constexpr size_t WS_QB = WS_RSTDM + al(4096);
constexpr size_t WS_KB = WS_QB + al((size_t)MPAD * SBW * 2);
constexpr size_t WS_VB = WS_KB + al((size_t)MPAD * SBW * 2);
constexpr size_t WS_QS = WS_VB + al((size_t)MPAD * SBW * 2);
constexpr size_t WS_US = WS_QS + al((size_t)MS * SBW * 4);
constexpr size_t WS_XH = WS_US + al((size_t)MS * SBW * 4);
constexpr size_t WS_SST = WS_XH + al((size_t)1024 * NG * XHP * 2 + 65536);
constexpr size_t WS_YG = WS_SST + al((size_t)1024 * NG * 128 * 4);
constexpr size_t WS_OSB = WS_YG + al((size_t)MPAD * SBW * 2);
constexpr size_t WS_OSSM = WS_OSB + al((size_t)MPAD * SBW * 2);
constexpr size_t WS_SBPO = WS_OSSM + al((size_t)MPAD * SBW * 2);
constexpr size_t WS_SBPL = WS_SBPO + al((size_t)MS * NPG * NH * HD * 4);
constexpr size_t WS_MIX = WS_SBPL + al((size_t)MS * NPG * NH * 4);
constexpr size_t WS_X1 = WS_MIX + al((size_t)MPAD * D * 2);
constexpr size_t WS_X1B = WS_X1 + al((size_t)MPAD * D * 4);
constexpr size_t WS_MKB = WS_X1B + al((size_t)MPAD * D * 2);
constexpr size_t WS_MVB = WS_MKB + al((size_t)1024 * D * 2);
constexpr size_t WS_QM = WS_MVB + al((size_t)1024 * D * 2);
constexpr size_t WS_OMEM = WS_QM + al((size_t)MPAD * D * 2);
constexpr size_t WS_X2 = WS_OMEM + al((size_t)MPAD * D * 2);
constexpr size_t WS_X2B = WS_X2 + al((size_t)MPAD * D * 4);
constexpr size_t WS_GB = WS_X2B + al((size_t)MPAD * D * 2);
constexpr size_t WS_UB = WS_GB + al((size_t)MPAD * FF * 2);
constexpr size_t WS_FAST_END = WS_UB + al((size_t)MPAD * FF * 2);
constexpr int CW_TMO = 0, CW_CODE = 1, CW_QA = 2048, CW_QM = 2112, CW_SCNT = 2240  , CW_PCNT = 2304  , CW_BAR = 4096;
constexpr int CW_SSQ1 = 16384, CW_SSQ2 = CW_SSQ1 + MPAD, CW_SSQ3 = CW_SSQ2 + MPAD, CW_SSQD = CW_SSQ3 + MPAD, CW_SSQA = CW_SSQD + MPAD, CW_SSQB = CW_SSQA + MPAD;
static_assert((CW_SSQB + MPAD) * 4 <= (int)CTL_ZERO_BYTES, "CTL words inside the memset region");

constexpr int RING_OFF = 0, RING_BYTES = 131072;
constexpr int LDSCTL_OFF = RING_BYTES, MISC_OFF = LDSCTL_OFF + 320;
constexpr int LDS_BYTES = 147456;
static_assert(MISC_OFF + 128 <= LDS_BYTES, "LDS map");

#define GAS __attribute__((address_space(1)))
#define LAS __attribute__((address_space(3)))
typedef unsigned short bf16;
typedef unsigned v4u __attribute__((ext_vector_type(4)));
typedef unsigned v2u __attribute__((ext_vector_type(2)));
typedef float f32x4 __attribute__((ext_vector_type(4)));
typedef float f32x2 __attribute__((ext_vector_type(2)));
typedef float f32x16 __attribute__((ext_vector_type(16)));
typedef short bf16x8 __attribute__((ext_vector_type(8)));
typedef short s16x4 __attribute__((ext_vector_type(4)));
typedef GAS unsigned gu32;
#define RLX_AGENT __ATOMIC_RELAXED, __HIP_MEMORY_SCOPE_AGENT
#define LDS_WAIT() asm volatile("s_waitcnt lgkmcnt(0)" ::: "memory")
#define VM_WAIT() asm volatile("s_waitcnt vmcnt(0)" ::: "memory")
__device__ __forceinline__ unsigned f2bf(float f) { unsigned u = __builtin_bit_cast(unsigned, f); return (u + 0x7fffu + ((u >> 16) & 1u)) >> 16; }
__device__ __forceinline__ unsigned pk2(float lo, float hi) { return f2bf(lo) | (f2bf(hi) << 16); }
__device__ __forceinline__ float bf2f(unsigned short h) { return __builtin_bit_cast(float, (unsigned)h << 16); }
__device__ __forceinline__ float bflo(unsigned w) { return __builtin_bit_cast(float, w << 16); }
__device__ __forceinline__ float bfhi(unsigned w) { return __builtin_bit_cast(float, w & 0xffff0000u); }
typedef float f32x2_c __attribute__((ext_vector_type(2))); typedef __bf16 bf16x2_c __attribute__((ext_vector_type(2)));
__device__ __forceinline__ unsigned cvtpk(float lo, float hi) { f32x2_c v = {lo, hi}; bf16x2_c r = __builtin_convertvector(v, bf16x2_c); return __builtin_bit_cast(unsigned, r); }
__device__ __forceinline__ float gelu_tanh_f(float x) {
    const float u2 = 2.f * 0.7978845608028654f * (x + 0.044715f * x * x * x);
    return x * __builtin_amdgcn_rcpf(1.f + __builtin_amdgcn_exp2f(-u2 * LOG2E));
}

__device__ __forceinline__ float swap16(float v) { auto rr = __builtin_amdgcn_permlane16_swap(__float_as_uint(v), __float_as_uint(v), false, false); return __uint_as_float((threadIdx.x & 16) ? rr[0] : rr[1]); }
__device__ __forceinline__ float swap_half(float v) { auto rr = __builtin_amdgcn_permlane32_swap(__float_as_uint(v), __float_as_uint(v), false, false); return __uint_as_float((threadIdx.x & 32) ? rr[0] : rr[1]); }
__device__ __forceinline__ float wave_sum(float x) {
    x += __builtin_bit_cast(float, __builtin_amdgcn_update_dpp(0, __builtin_bit_cast(int, x), 0xB1, 0xf, 0xf, true));
    x += __builtin_bit_cast(float, __builtin_amdgcn_update_dpp(0, __builtin_bit_cast(int, x), 0x4E, 0xf, 0xf, true));
    x += __builtin_bit_cast(float, __builtin_amdgcn_update_dpp(0, __builtin_bit_cast(int, x), 0x141, 0xf, 0xf, true));
    x += __builtin_bit_cast(float, __builtin_amdgcn_update_dpp(0, __builtin_bit_cast(int, x), 0x140, 0xf, 0xf, true));
    x += swap16(x); x += swap_half(x); return x;
}
#define XB_TMO      128
#define XB_XCNT(j)  (256  + 64 * (j))
#define XB_XSUB(j)  (1280 + 64 * (j))
#define XB_XGEN(j)  (2304 + 64 * (j))
#define XB_TOP      3328
#define XB_TOPGEN   3392
#define XCD_BAR_WORDS 3456
#define XB_SPIN_CAP (1u << 18)
__device__ __forceinline__ unsigned xb_ld(unsigned* p)              { return __hip_atomic_load(p, __ATOMIC_RELAXED, __HIP_MEMORY_SCOPE_AGENT); }
__device__ __forceinline__ unsigned xb_add(unsigned* p, unsigned v) { return __hip_atomic_fetch_add(p, v, __ATOMIC_RELAXED, __HIP_MEMORY_SCOPE_AGENT); }
__device__ __forceinline__ unsigned xb_xcc_id() { return (unsigned)__builtin_amdgcn_s_getreg((3 << 11) | 20) & 0xFu; }
#define XB_SPIN(cond, bar) do { unsigned _sp = 0; while (cond) { __builtin_amdgcn_s_sleep(1); \
    if ((++_sp & 255u) == 0u) { if (xb_ld(&(bar)[XB_TMO])) break; if (_sp > XB_SPIN_CAP) { atomicAdd(&(bar)[XB_TMO], 1u); break; } } } } while (0)
struct XcdBarrier { unsigned* bar; unsigned x; volatile LAS unsigned* st; };
__device__ __forceinline__ XcdBarrier xcd_barrier_post(unsigned* bar, volatile LAS unsigned* st) {
    XcdBarrier b; b.bar = bar; b.x = xb_xcc_id(); b.st = st;
    if (threadIdx.x == 0) (void)xb_add(&bar[XB_XCNT(b.x)], 1u);
    return b;
}
__device__ __forceinline__ void xcd_barrier_complete(unsigned* bar, unsigned x, unsigned& nloc, unsigned& nx) {
    const unsigned G = gridDim.x * gridDim.y * gridDim.z;
    unsigned sum, cnt, mine, sp = 0u;
    for (;;) {
        sum = 0u; cnt = 0u; mine = 0u;
#pragma unroll
        for (unsigned j = 0; j < 16; ++j) { const unsigned c = xb_ld(&bar[XB_XCNT(j)]); sum += c; cnt += (c > 0u) ? 1u : 0u; mine = (j == x) ? c : mine; }
        if (sum == G) break;
        __builtin_amdgcn_s_sleep(1);
        if ((++sp & 255u) == 0u) { if (xb_ld(&bar[XB_TMO])) break; if (sp > XB_SPIN_CAP) { atomicAdd(&bar[XB_TMO], 1u); break; } }
    }
    nloc = mine > 0u ? mine : 1u; nx = cnt > 0u ? cnt : 1u;
}
__device__ __forceinline__ void xcd_barrier(const XcdBarrier& b) {
    asm volatile("s_waitcnt vmcnt(0)" ::: "memory");
    __syncthreads();
    if (threadIdx.x == 0) {
        unsigned* bar = b.bar;
        __builtin_amdgcn_s_waitcnt(0);
        unsigned nloc = b.st[0], nx = b.st[1];
        if (nloc == 0u) { xcd_barrier_complete(bar, b.x, nloc, nx); b.st[0] = nloc; b.st[1] = nx; }
        const unsigned old = xb_add(&bar[XB_XSUB(b.x)], 1u);
        const unsigned gen = old / nloc;
        if (old + 1u == (gen + 1u) * nloc) {
            __builtin_amdgcn_fence(__ATOMIC_RELEASE, "agent");
            asm volatile("s_waitcnt vmcnt(0)" ::: "memory");
            const unsigned og = xb_add(&bar[XB_TOP], 1u);
            const unsigned tg = og / nx;
            if (og + 1u == (tg + 1u) * nx) xb_add(&bar[XB_TOPGEN], 1u);
            else XB_SPIN(xb_ld(&bar[XB_TOPGEN]) == tg, bar);
            __builtin_amdgcn_fence(__ATOMIC_ACQUIRE, "agent");
            xb_add(&bar[XB_XGEN(b.x)], 1u);
            asm volatile("s_waitcnt vmcnt(0)" ::: "memory");
        } else {
            XB_SPIN(xb_ld(&bar[XB_XGEN(b.x)]) == gen, bar);
            __builtin_amdgcn_fence(__ATOMIC_ACQUIRE, "agent");
            asm volatile("s_waitcnt vmcnt(0)" ::: "memory");
        }
    }
    __syncthreads();
}

struct Args { const void* in[40]; float* out; unsigned char* ws; int ph_lo, ph_hi, use_bar, pad; };
struct Frame {
    LAS unsigned char* lds; volatile LAS unsigned* MISC; unsigned* ctl;
    int tid, lane, wave, vcu, G;
    unsigned char* ws; float* out; const void* const* in;
};
#define INF(i) ((const float*)F.in[i])
#define WSP(T_, off) ((T_*)(F.ws + (off)))
struct TrItem { const float* W; const float* gain; bf16* WT; int K, N, row_off, k0, n0; };
__device__ __forceinline__ void tr_load(const TrItem& t, float (&wv)[32], int lane) {
#pragma unroll
    for (int i = 0; i < 32; ++i) wv[i] = t.W[(size_t)(t.k0 + 2 * i + (lane >> 5)) * t.N + t.n0 + (lane & 31)];
}
__device__ __forceinline__ void tr_finish(const TrItem& t, const float (&wv)[32], LAS float* scr, int lane) {
#pragma unroll
    for (int i = 0; i < 32; ++i) { const int kk = 2 * i + (lane >> 5); const float gv = t.gain ? t.gain[t.k0 + kk] : 1.f; scr[kk * 33 + (lane & 31)] = wv[i] * gv; }
    LDS_WAIT(); asm volatile("" ::: "memory");
    const int c = lane & 7;
#pragma unroll
    for (int j = 0; j < 4; ++j) { const int n = (lane >> 3) + 8 * j; const LAS float* s = scr + (8 * c) * 33 + n;
        v4u o; o.x = pk2(s[0 * 33], s[1 * 33]); o.y = pk2(s[2 * 33], s[3 * 33]); o.z = pk2(s[4 * 33], s[5 * 33]); o.w = pk2(s[6 * 33], s[7 * 33]);
        *(GAS v4u*)(t.WT + (size_t)(t.row_off + t.n0 + n) * t.K + t.k0 + 8 * c) = o; }
    LDS_WAIT(); asm volatile("" ::: "memory");
}
__device__ __forceinline__ void rows2_load(const float* xrow, f32x4 (&v)[2][4], int lane) {
#pragma unroll
    for (int r = 0; r < 2; ++r)
#pragma unroll
        for (int j = 0; j < 4; ++j) v[r][j] = ((const GAS f32x4*)(xrow + (size_t)r * D) + lane)[64 * j];
}
__device__ __forceinline__ void rows2_finish(const f32x4 (&v)[2][4], bf16* orow, float* rstd, int lane) {
    float s[2] = {0.f, 0.f};
#pragma unroll
    for (int r = 0; r < 2; ++r) {
#pragma unroll
        for (int j = 0; j < 4; ++j) s[r] += (v[r][j].x * v[r][j].x + v[r][j].y * v[r][j].y) + (v[r][j].z * v[r][j].z + v[r][j].w * v[r][j].w);
        GAS v2u* o8 = (GAS v2u*)(orow + (size_t)r * D) + lane;
#pragma unroll
        for (int j = 0; j < 4; ++j) { v2u w; w.x = pk2(v[r][j].x, v[r][j].y); w.y = pk2(v[r][j].z, v[r][j].w); o8[64 * j] = w; }
    }
    s[0] = wave_sum(s[0]); s[1] = wave_sum(s[1]);
    if (lane < 2) rstd[lane] = 1.f / sqrtf((lane ? s[1] : s[0]) * (1.f / D) + EPS);
}
__device__ __forceinline__ void lam_pow(float lr, float li, float logdt, int tau, float& pr, float& pi) {
    const double dt = exp((double)logdt);
    const double ang = (double)li * dt * (double)tau;
    const double k = rint(ang * 0.15915494309189535);
    double r = fma(-k, 6.283185307179586, ang); r = fma(-k, 2.4492935982947064e-16, r);
    const float rf = (float)r, mag = (float)exp((double)lr * dt * (double)tau);
    pr = mag * cosf(rf); pi = mag * sinf(rf);
}
__device__ __forceinline__ void lam_coef(float lr, float li, float logdt, float& cr, float& ci) {
    const double dt = exp((double)logdt);
    const double ang = (double)li * dt;
    const double k = rint(ang * 0.15915494309189535);
    double r = fma(-k, 6.283185307179586, ang); r = fma(-k, 2.4492935982947064e-16, r);
    const float th = (float)r, a = (float)((double)lr * dt);
    const float sh = sinf(0.5f * th);
    const float nr = expm1f(a) * cosf(th) - 2.f * sh * sh, ni = expf(a) * sinf(th);
    const float den = lr * lr + li * li;
    cr = (nr * lr + ni * li) / den; ci = (ni * lr - nr * li) / den;
}
__device__ __forceinline__ void ssm_table_unit(Frame& F, int g, int tau) {
    LAS float* Mr = (LAS float*)(F.lds + RING_OFF); LAS float* Mi = Mr + 1024; LAS float* Pr = Mi + 1024; LAS float* Pi = Pr + 64; LAS float* Cr = Pi + 64; LAS float* Ci = Cr + 64;
    LAS float* Kt = Ci + 64; LAS float* CRE = Kt + 256; LAS float* CIM = CRE + 1024; LAS float* Qr = CIM + 1024; LAS float* Qi = Qr + 64;
    const float* lam_re = INF(14); const float* lam_im = INF(15); const float* log_dt = INF(16); const float* b_re = INF(17); const float* b_im = INF(18);
    const float* c_re = INF(19); const float* c_im = INF(20); const float* d_skip = INF(21);
    bf16* W1 = WSP(bf16, WS_W1); bf16* BTC = WSP(bf16, WS_BTC);
    const int tid = F.tid; const float ldt = log_dt[g];
    __syncthreads();
    if (tid < 64) { float pr, pi, cr, ci; const float lr = lam_re[g * NST + tid], li = lam_im[g * NST + tid]; lam_pow(lr, li, ldt, tau, pr, pi); lam_coef(lr, li, ldt, cr, ci); Pr[tid] = pr; Pi[tid] = pi; Cr[tid] = cr; Ci[tid] = ci; lam_pow(lr, li, ldt, tau + 1, pr, pi); Qr[tid] = pr; Qi[tid] = pi; }
    float brv[2], biv[2];
#pragma unroll
    for (int j = 0; j < 2; ++j) { brv[j] = b_re[g * 1024 + tid + j * NTHR]; biv[j] = b_im[g * 1024 + tid + j * NTHR]; }
    for (int i = tid; i < 1024; i += NTHR) { CRE[i] = c_re[g * 1024 + i]; CIM[i] = c_im[g * 1024 + i]; }
    __syncthreads();
#pragma unroll
    for (int j = 0; j < 2; ++j) { const int i = tid + j * NTHR; const int n = i >> 4; const float cr = Cr[n], ci = Ci[n];
        const float br = brv[j], bi = biv[j]; const float bbr = cr * br - ci * bi, bbi = cr * bi + ci * br;
        const float pr = Pr[n], pi = Pi[n]; Mr[i] = pr * bbr - pi * bbi; Mi[i] = pr * bbi + pi * bbr; }
    __syncthreads();
    {
        const int s = 15 - tau;
        for (int i = tid; i < 2048; i += NTHR) { const int n = i >> 5, ri = (i >> 4) & 1, q = i & 15; const float v = ri ? Mi[n * 16 + q] : Mr[n * 16 + q];
            W1[((size_t)g * 128 + 2 * n + ri) * 256 + s * 16 + q] = (bf16)f2bf(v); }
        if (tid < 256) { const int p = tid >> 4, q = tid & 15; float acc = 0.f;
#pragma unroll 8
            for (int n = 0; n < NST; ++n) acc += CRE[p * NST + n] * Mr[n * 16 + q] - CIM[p * NST + n] * Mi[n * 16 + q];
            if (tau == 0 && p == q) acc += d_skip[g * GP + p];
            Kt[tid] = acc; }
        __syncthreads();
        for (int idx = tid; idx < (16 - tau) * 256; idx += NTHR) { const int blk = idx >> 8, e = idx & 255, p = e >> 4, q = e & 15; const int s2 = blk, t2 = s2 + tau;
            BTC[((size_t)g * 256 + t2 * 16 + p) * XHP + s2 * 16 + q] = (bf16)f2bf(Kt[e]);
            if (tau >= 1) BTC[((size_t)g * 256 + s2 * 16 + p) * XHP + t2 * 16 + q] = (bf16)0; }
    }
    {
        for (int idx = tid; idx < 1024; idx += NTHR) { const int p = idx >> 6, n = idx & 63; const float cr = CRE[idx], ci = CIM[idx], pr = Qr[n], pi = Qi[n];
            const unsigned w = pk2(cr * pr - ci * pi, -(cr * pi + ci * pr));
            *(GAS unsigned*)(BTC + ((size_t)g * 256 + tau * 16 + p) * XHP + 256 + 2 * n) = w; }
    }
    __syncthreads();
}
__device__ __forceinline__ TrItem tr_item(Frame& F, int it) {
    constexpr int I_IN = 16 * 64, I_MK = 16 * 32, I_GLU = 8 * 16, I_SQ = 16 * 32, I_G = 16 * 88;
    TrItem t; int r = it; t.row_off = 0; t.K = D;
    if (r < I_IN) { t.W = INF(12); t.N = INW; t.WT = WSP(bf16, WS_WIN); t.gain = INF(11); }
    else if ((r -= I_IN) < I_MK) { t.W = INF(30); t.N = D; t.WT = WSP(bf16, WS_WMKV); t.gain = INF(28); }
    else if ((r -= I_MK) < I_MK) { t.W = INF(31); t.N = D; t.WT = WSP(bf16, WS_WMKV); t.gain = INF(28); t.row_off = D; }
    else if ((r -= I_MK) < I_GLU) { t.W = INF(22); t.N = SBW; t.K = SBW; t.WT = WSP(bf16, WS_WGLU); t.gain = nullptr; }
    else if ((r -= I_GLU) < I_SQ) { t.W = INF(26); t.N = D; t.WT = WSP(bf16, WS_WOUT); t.gain = (r / (D / 32) < 8) ? INF(24) : INF(25) - SBW; }
    else if ((r -= I_SQ) < I_SQ) { t.W = INF(29); t.N = D; t.WT = WSP(bf16, WS_WMQ); t.gain = INF(27); }
    else if ((r -= I_SQ) < I_SQ) { t.W = INF(32); t.N = D; t.WT = WSP(bf16, WS_WMO); t.gain = nullptr; }
    else if ((r -= I_SQ) < I_G) { t.W = INF(34); t.N = FF; t.WT = WSP(bf16, WS_WGU); t.gain = INF(33); }
    else if ((r -= I_G) < I_G) { t.W = INF(35); t.N = FF; t.WT = WSP(bf16, WS_WGU); t.gain = INF(33); t.row_off = FF; }
    else { r -= I_G; t.W = INF(38); t.N = D; t.K = FF; t.WT = WSP(bf16, WS_WDN); t.gain = nullptr; }
    const int nblk = t.N / 32; t.k0 = 64 * (r / nblk); t.n0 = 32 * (r % nblk); return t;
}
constexpr int NITEMS_EARLY = 16 * 64 + 2 * 16 * 32, NITEMS_GLU = NITEMS_EARLY + 8 * 16, NITEMS_ALL = 16 * 64 + 2 * 16 * 32 + 8 * 16 + 3 * 16 * 32 + 2 * 16 * 88 + 44 * 32;
constexpr int NITEMS_MID = NITEMS_GLU + 3 * 16 * 32 + 16 * 88;
__device__ __forceinline__ void weight_copies(Frame& F, int lo, int hi, int cu0 = 0, int ncu = 0) {
    LAS float* scr = (LAS float*)(F.lds + RING_OFF + F.wave * 16384);
    if (ncu && ((int)blockIdx.x < cu0 || (int)blockIdx.x >= cu0 + ncu)) return;
    const int gw = (ncu ? (int)blockIdx.x - cu0 : F.vcu) * NWAVES + F.wave, NGW = (ncu ? ncu : F.G) * NWAVES;
    if (lo + gw < hi) {
        float wa[32], wb[32]; TrItem ta = tr_item(F, lo + gw), tb; tr_load(ta, wa, F.lane);
        for (int it = lo + gw; it < hi; it += NGW) {
            const bool more = it + NGW < hi;
            if (more) { tb = tr_item(F, it + NGW); tr_load(tb, wb, F.lane); }
            tr_finish(ta, wa, scr, F.lane);
            if (more) { ta = tb;
#pragma unroll
                for (int i = 0; i < 32; ++i) wa[i] = wb[i]; }
        }
    }
}
__device__ __forceinline__ void p0_prologue(Frame& F) {
    LAS float* scr = (LAS float*)(F.lds + RING_OFF + F.wave * 16384);
    const int gw = F.vcu * NWAVES + F.wave, NGW = F.G * NWAVES;
    weight_copies(F, 0, NITEMS_EARLY);
    {
        f32x4 va[2][4], vb[2][4];
        auto src = [&](int m) -> const float* { return (m < MPR) ? INF(0) + (size_t)m * D : (m < MALL) ? INF(1) + (size_t)(m - MPR) * D : INF(10) + (size_t)(m - MALL) * D; };
        constexpr int NR = MALL + NB * MT;
        int m = 2 * gw;
        if (m < NR) { rows2_load(src(m), va, F.lane);
            for (; m < NR; m += 2 * NGW) {
                const bool more = m + 2 * NGW < NR;
                if (more) rows2_load(src(m + 2 * NGW), vb, F.lane);
                if (m < MALL) rows2_finish(va, WSP(bf16, WS_XB) + (size_t)m * D, WSP(float, WS_RSTD0) + m, F.lane);
                else rows2_finish(va, WSP(bf16, WS_MB) + (size_t)(m - MALL) * D, WSP(float, WS_RSTDM) + (m - MALL), F.lane);
                if (more) {
#pragma unroll
                    for (int r = 0; r < 2; ++r)
#pragma unroll
                        for (int j = 0; j < 4; ++j) va[r][j] = vb[r][j]; }
            } }
    }
    for (int u = F.vcu; u < NG * 16; u += F.G) ssm_table_unit(F, u >> 4, u & 15);
    { bf16* W1 = WSP(bf16, WS_W1); for (int i = gw * 64 + F.lane; i < 128 * 256 / 8; i += NGW * 64) *(GAS v4u*)(W1 + (size_t)32 * 128 * 256 + (size_t)i * 8) = (v4u){0u, 0u, 0u, 0u}; }
}

constexpr int HALO_OFF_C = RING_BYTES + 1024;
#define EPI_LOOP_BEGIN \
    _Pragma("unroll") for (int ai = 0; ai < 2; ++ai) _Pragma("unroll") for (int m = 0; m < 4; ++m) { const int row = u.pm * 256 + ai * 128 + wr * 64 + m * 16 + fr; \
    _Pragma("unroll") for (int bj = 0; bj < 2; ++bj) { const int col = u.pn * 256 + bj * 128 + wc * 32 + 8 * fq; f32x4 v0 = acc[ai][bj][m][0], v1 = acc[ai][bj][m][1];
#define EPI_LOOP_END } }
__device__ __forceinline__ v4u pack8(f32x4 a, f32x4 b) { v4u w; w.x = cvtpk(a[0], a[1]); w.y = cvtpk(a[2], a[3]); w.z = cvtpk(b[0], b[1]); w.w = cvtpk(b[2], b[3]); return w; }

struct EpiInProj { static constexpr bool MIDK = false;
    const float* rstd; bf16 *QBp, *KBp, *VBp, *XHp; float *QSp, *USp, *out;
    __device__ __forceinline__ void operator()(const f32x4 (&acc)[2][2][4][2], const pg8::Unit& u, int wr, int wc, int fr_, int fq_) const { int fr = fr_, fq = fq_; asm volatile("" : "+v"(fr), "+v"(fq));
        const int sect = u.pn >> 1;
        EPI_LOOP_BEGIN
            if (row < MALL) {
                const float rs = rstd[row]; v0 = v0 * rs; v1 = v1 * rs;
                const int c = col - sect * SBW;
                if (sect == 0) { v0 = v0 * C2; v1 = v1 * C2; *(v4u*)(QBp + (size_t)row * SBW + c) = pack8(v0, v1);
                    if (row >= MPR) { float* q = QSp + (size_t)(row - MPR) * SBW + c; *(f32x4*)q = v0; *(f32x4*)(q + 4) = v1; } }
                else if (sect == 1 || sect == 2) { bf16* B = (sect == 1) ? KBp : VBp; *(v4u*)(B + (size_t)row * SBW + c) = pack8(v0, v1);
                    float* o = (row < MPR) ? out + (sect == 1 ? O_KP : O_VP) + (size_t)row * SBW + c : out + (sect == 1 ? O_KS : O_VS) + (size_t)(row - MPR) * SBW + c;
                    *(f32x4*)o = v0; *(f32x4*)(o + 4) = v1; }
                else { if (row < MPR) { const int b = row >> 12, t = row & 4095, ch = t >> 4, s = t & 15, g = c >> 4, q0 = c & 15;
                        *(v4u*)(XHp + ((size_t)(b * NCH + ch) * NG + g) * XHP + s * 16 + q0) = pack8(v0, v1); }
                    else { float* q = USp + (size_t)(row - MPR) * SBW + c; *(f32x4*)q = v0; *(f32x4*)(q + 4) = v1; } }
            }
        EPI_LOOP_END
    }
};
struct EpiMemKV { static constexpr bool MIDK = false;
    const float* rstd; bf16 *MKBp, *MVBp; float* out;
    __device__ __forceinline__ void operator()(const f32x4 (&acc)[2][2][4][2], const pg8::Unit& u, int wr, int wc, int fr_, int fq_) const { int fr = fr_, fq = fq_; asm volatile("" : "+v"(fr), "+v"(fq));
        const int sect = u.pn >> 2;
        EPI_LOOP_BEGIN
            const float rs = rstd[row]; v0 = v0 * rs; v1 = v1 * rs; const int c = col - sect * D;
            bf16* B = sect ? MVBp : MKBp; *(v4u*)(B + (size_t)row * D + c) = pack8(v0, v1);
            float* o = out + (sect ? O_MVP : O_MKP) + (size_t)row * D + c; *(f32x4*)o = v0; *(f32x4*)(o + 4) = v1;
        EPI_LOOP_END
    }
};
struct EpiSsmA { static constexpr bool MIDK = false;
    float* SST;
    __device__ __forceinline__ void operator()(const f32x4 (&acc)[2][2][4][2], const pg8::Unit& u, int wr, int wc, int fr_, int fq_) const { int fr = fr_, fq = fq_; asm volatile("" : "+v"(fr), "+v"(fq));
        _Pragma("unroll") for (int ai = 0; ai < 2; ++ai) _Pragma("unroll") for (int m = 0; m < 4; ++m) { const int row = u.pm * 256 + ai * 128 + wr * 64 + m * 16 + fr;
            const int col = wc * 32 + 8 * fq; float* o = SST + ((size_t)row * NG + u.pn) * 128 + col; *(f32x4*)o = acc[ai][0][m][0]; *(f32x4*)(o + 4) = acc[ai][0][m][1]; }
    }
};
struct EpiSsmC { static constexpr bool MIDK = false;
    bf16* YG;
    __device__ __forceinline__ void operator()(const f32x4 (&acc)[2][2][4][2], const pg8::Unit& u, int wr, int wc, int fr_, int fq_) const { int fr = fr_, fq = fq_; asm volatile("" : "+v"(fr), "+v"(fq));
        _Pragma("unroll") for (int ai = 0; ai < 2; ++ai) _Pragma("unroll") for (int m = 0; m < 4; ++m) { const int ch = ai * 128 + wr * 64 + m * 16 + fr;
            _Pragma("unroll") for (int bj = 0; bj < 2; ++bj) { const int col = bj * 128 + wc * 32 + 8 * fq, t = col >> 4, p0 = col & 15; f32x4 v0 = acc[ai][bj][m][0], v1 = acc[ai][bj][m][1];
                _Pragma("unroll") for (int e = 0; e < 4; ++e) { v0[e] = gelu_tanh_f(v0[e]); v1[e] = gelu_tanh_f(v1[e]); }
                *(v4u*)(YG + ((size_t)u.pm * T + ch * LC + t) * SBW + u.pn * GP + p0) = pack8(v0, v1); } }
    }
};
struct EpiGlu { static constexpr bool MIDK = false;
    const bf16* YG; const float* bglu; bf16* MIXU; float* ssq;
    __device__ __forceinline__ void operator()(const f32x4 (&acc)[2][2][4][2], const pg8::Unit& u, int wr, int wc, int fr_, int fq_) const { int fr = fr_, fq = fq_; asm volatile("" : "+v"(fr), "+v"(fq));
        _Pragma("unroll") for (int ai = 0; ai < 2; ++ai) _Pragma("unroll") for (int m = 0; m < 4; ++m) { const int row = u.pm * 256 + ai * 128 + wr * 64 + m * 16 + fr; float sq = 0.f;
            _Pragma("unroll") for (int bj = 0; bj < 2; ++bj) { const int col = u.pn * 256 + bj * 128 + wc * 32 + 8 * fq; f32x4 v0 = acc[ai][bj][m][0], v1 = acc[ai][bj][m][1];
                const v4u yw = *(const v4u*)(YG + (size_t)row * SBW + col); const f32x4 b0 = *(const f32x4*)(bglu + col), b1 = *(const f32x4*)(bglu + col + 4);
                const float y[8] = {bflo(yw.x), bfhi(yw.x), bflo(yw.y), bfhi(yw.y), bflo(yw.z), bfhi(yw.z), bflo(yw.w), bfhi(yw.w)};
                _Pragma("unroll") for (int e = 0; e < 4; ++e) { v0[e] = y[e] * __builtin_amdgcn_rcpf(1.f + __builtin_amdgcn_exp2f(-(v0[e] + b0[e]) * LOG2E));
                                                                 v1[e] = y[4 + e] * __builtin_amdgcn_rcpf(1.f + __builtin_amdgcn_exp2f(-(v1[e] + b1[e]) * LOG2E)); }
                *(v4u*)(MIXU + (size_t)row * D + SBW + col) = pack8(v0, v1);
                sq += (v0[0] * v0[0] + v0[1] * v0[1]) + (v0[2] * v0[2] + v0[3] * v0[3]) + (v1[0] * v1[0] + v1[1] * v1[1]) + (v1[2] * v1[2] + v1[3] * v1[3]); }
            sq += swap16(sq); sq += swap_half(sq);
            if (fq == 0) atomicAdd(ssq + row, sq); }
    }
};
struct EpiResid { static constexpr bool MIDK = false;
    const float* base0; const float* base1; float* xo; bf16* xb; float* ssq;
    __device__ __forceinline__ void operator()(const f32x4 (&acc)[2][2][4][2], const pg8::Unit& u, int wr, int wc, int fr_, int fq_) const { int fr = fr_, fq = fq_; asm volatile("" : "+v"(fr), "+v"(fq));
        _Pragma("unroll") for (int ai = 0; ai < 2; ++ai) _Pragma("unroll") for (int m = 0; m < 4; ++m) { const int row = u.pm * 256 + ai * 128 + wr * 64 + m * 16 + fr; float sq = 0.f;
            const bool ok = row < MALL; const float* bp = (row < MPR) ? base0 + (size_t)row * D : base1 + (size_t)(row - MPR) * D;
            _Pragma("unroll") for (int bj = 0; bj < 2; ++bj) { const int col = u.pn * 256 + bj * 128 + wc * 32 + 8 * fq; f32x4 v0 = acc[ai][bj][m][0], v1 = acc[ai][bj][m][1];
                if (ok) { v0 = v0 + *(const f32x4*)(bp + col); v1 = v1 + *(const f32x4*)(bp + col + 4);
                    if (xo) { float* o = xo + (size_t)row * D + col; *(f32x4*)o = v0; *(f32x4*)(o + 4) = v1; }
                    if (xb) *(v4u*)(xb + (size_t)row * D + col) = pack8(v0, v1);
                    sq += (v0[0] * v0[0] + v0[1] * v0[1]) + (v0[2] * v0[2] + v0[3] * v0[3]) + (v1[0] * v1[0] + v1[1] * v1[1]) + (v1[2] * v1[2] + v1[3] * v1[3]); } }
            sq += swap16(sq); sq += swap_half(sq);
            if (ok && fq == 0) atomicAdd(ssq + row, sq); }
    }
};
struct EpiScaleBf16 { static constexpr bool MIDK = false;
    const float* ssq; float scale; bf16* O;
    __device__ __forceinline__ void operator()(const f32x4 (&acc)[2][2][4][2], const pg8::Unit& u, int wr, int wc, int fr_, int fq_) const { int fr = fr_, fq = fq_; asm volatile("" : "+v"(fr), "+v"(fq));
        EPI_LOOP_BEGIN
            if (row < MALL) { const float rs = scale / sqrtf(ssq[row] * (1.f / D) + EPS); v0 = v0 * rs; v1 = v1 * rs; *(v4u*)(O + (size_t)row * D + col) = pack8(v0, v1); }
        EPI_LOOP_END
    }
};
struct EpiGateUp { static constexpr bool MIDK = false;
    const float* ssq; bf16 *GBp, *UBp; float* out;
    __device__ __forceinline__ void operator()(const f32x4 (&acc)[2][2][4][2], const pg8::Unit& u, int wr, int wc, int fr_, int fq_) const { int fr = fr_, fq = fq_; asm volatile("" : "+v"(fr), "+v"(fq));
        const bool up = u.pn >= 11;
        EPI_LOOP_BEGIN
            if (row < MALL) { const float rs = 1.f / sqrtf(ssq[row] * (1.f / D) + EPS); v0 = v0 * rs; v1 = v1 * rs;
                if (up) *(v4u*)(UBp + (size_t)row * FF + (col - FF)) = pack8(v0, v1);
                else { *(v4u*)(GBp + (size_t)row * FF + col) = pack8(v0, v1);
                    if (row >= MPR) { float* o = out + O_CVS + ((size_t)(row - MPR) * 2 + 1) * FF + col; *(f32x4*)o = v0; *(f32x4*)(o + 4) = v1; }
                    else { const int t = row & 4095; if (t >= T - 2) { float* o = out + O_CVP + ((size_t)(row >> 12) * 2 + (t - (T - 2))) * FF + col; *(f32x4*)o = v0; *(f32x4*)(o + 4) = v1; } } } }
        EPI_LOOP_END
    }
};
struct SsmOrder {
    int G, c; size_t bstride;
    __device__ bool next(int i, pg8::Unit& u) const { const int L = i * G + c; if (L >= NG * NB) return false; u.pn = L >> 2; u.pm = L & 3; return true; }
    __device__ __forceinline__ size_t aoff(const pg8::Unit& u) const { return ((size_t)u.pm * NCH * NG * XHP + (size_t)u.pn * XHP) * 2; }
    __device__ __forceinline__ size_t boff(const pg8::Unit& u) const { return (size_t)u.pn * bstride; }
};
template <class Epi>
__device__ __forceinline__ void skinny_gemm(Frame& F, const bf16* A, int lda, const bf16* Bt, int ldb, int N, int K, const Epi& E, int u0, int ustride, int ustep = 32, int nb1off = 16) {
    const int lane = F.lane, wid = F.wave; const int kw = K >> 3, nks = kw >> 5;
    LAS float* red = (LAS float*)(F.lds + RING_OFF);
    for (int u = u0; u < 2 * (N / ustep); u += ustride) {
        const int uc = u >> 1, rh = u & 1;
        f32x4 acc[2][4];
#pragma unroll
        for (int nb = 0; nb < 2; ++nb)
#pragma unroll
            for (int mb = 0; mb < 4; ++mb) acc[nb][mb] = (f32x4){0.f, 0.f, 0.f, 0.f};
        const bf16* wp = Bt + (size_t)(uc * ustep + (lane & 15)) * ldb + wid * kw + 8 * (lane >> 4);
        const bf16* ap = A + (size_t)(rh * 64 + (lane & 15)) * lda + wid * kw + 8 * (lane >> 4);
#pragma unroll 1
        for (int ks0 = 0; ks0 < nks; ks0 += 4) {
            bf16x8 wf[4][2], af[4][4];
#pragma unroll
            for (int j = 0; j < 4; ++j) { const int ks = (ks0 + j < nks) ? ks0 + j : nks - 1;
                wf[j][0] = *(const bf16x8*)(wp + ks * 32); wf[j][1] = *(const bf16x8*)(wp + (size_t)nb1off * ldb + ks * 32);
#pragma unroll
                for (int mb = 0; mb < 4; ++mb) af[j][mb] = *(const bf16x8*)(ap + (size_t)mb * 16 * lda + ks * 32); }
#pragma unroll
            for (int j = 0; j < 4; ++j) if (ks0 + j < nks) {
#pragma unroll
                for (int nb = 0; nb < 2; ++nb)
#pragma unroll
                    for (int mb = 0; mb < 4; ++mb) acc[nb][mb] = __builtin_amdgcn_mfma_f32_16x16x32_bf16(wf[j][nb], af[j][mb], acc[nb][mb], 0, 0, 0); }
        }
        __syncthreads();
#pragma unroll
        for (int nb = 0; nb < 2; ++nb)
#pragma unroll
            for (int mb = 0; mb < 4; ++mb) *(LAS f32x4*)(red + ((wid * 8 + nb * 4 + mb) * 64 + lane) * 4) = acc[nb][mb];
        __syncthreads();
        if constexpr (!Epi::PAIR) { const int blk = F.tid >> 6, l = F.tid & 63;
            f32x4 s = {0.f, 0.f, 0.f, 0.f}, s2 = {0.f, 0.f, 0.f, 0.f};
#pragma unroll
            for (int w = 0; w < 4; ++w) s = s + *(const LAS f32x4*)(red + ((w * 8 + blk) * 64 + l) * 4);
#pragma unroll
            for (int w = 4; w < 8; ++w) s2 = s2 + *(const LAS f32x4*)(red + ((w * 8 + blk) * 64 + l) * 4);
            const int em = rh * 64 + 16 * (blk & 3) + (l & 15), en = uc * 32 + 16 * (blk >> 2) + 4 * (l >> 4);
            if constexpr (Epi::STATS) {
                float sq; if constexpr (Epi::SPLIT2) sq = E(em, en, s, s2); else sq = E(em, en, s + s2);
                sq += swap16(sq); sq += swap_half(sq);
                LAS float* r2 = red + 8 * 8 * 64 * 4;
                if ((l >> 4) == 0) r2[blk * 16 + (l & 15)] = sq;
                __syncthreads();
                if (F.tid < 64) atomicAdd(E.ssq + MPR + rh * 64 + F.tid, r2[(F.tid >> 4) * 16 + (F.tid & 15)] + r2[(4 + (F.tid >> 4)) * 16 + (F.tid & 15)]);
            } else {
                if constexpr (Epi::SPLIT2) E(em, en, s, s2);
                else E(em, en, s + s2); } }
        else if (F.tid < 256) { const int mb = F.tid >> 6, l = F.tid & 63;
            f32x4 s0 = {0.f, 0.f, 0.f, 0.f}, s1 = {0.f, 0.f, 0.f, 0.f};
#pragma unroll
            for (int w = 0; w < 8; ++w) { s0 = s0 + *(const LAS f32x4*)(red + ((w * 8 + mb) * 64 + l) * 4); s1 = s1 + *(const LAS f32x4*)(red + ((w * 8 + 4 + mb) * 64 + l) * 4); }
            E(rh * 64 + 16 * mb + (l & 15), uc * 16 + 4 * (l >> 4), s0, s1); }
    }
    __syncthreads();
}
__device__ __forceinline__ v2u pack4(f32x4 a) { v2u w; w.x = cvtpk(a[0], a[1]); w.y = cvtpk(a[2], a[3]); return w; }
struct SkInProj { static constexpr bool STATS = false; static constexpr bool SPLIT2 = false; static constexpr bool PAIR = false;
    const float* rstd; bf16* QBp; float *QSp, *USp, *out;
    __device__ __forceinline__ void operator()(int m, int n, f32x4 v) const {
        v = v * rstd[MPR + m]; const int sect = n >> 9, c = n & 511;
        if (sect == 0) { v = v * C2; *(f32x4*)(QSp + (size_t)m * SBW + c) = v; }
        else if (sect == 1) *(f32x4*)(out + O_KS + (size_t)m * SBW + c) = v;
        else if (sect == 2) *(f32x4*)(out + O_VS + (size_t)m * SBW + c) = v;
        else *(f32x4*)(USp + (size_t)m * SBW + c) = v;
    }
};
struct SkGlu { static constexpr bool STATS = true; static constexpr bool SPLIT2 = false; static constexpr bool PAIR = false;
    const bf16* YG; const float* bglu; bf16* MIXU; float* ssq;
    __device__ __forceinline__ float operator()(int m, int n, f32x4 v) const {
        const v2u yw = *(const v2u*)(YG + (size_t)(MPR + m) * SBW + n); const f32x4 b = *(const f32x4*)(bglu + n);
        const float y[4] = {bflo(yw.x), bfhi(yw.x), bflo(yw.y), bfhi(yw.y)};
#pragma unroll
        for (int e = 0; e < 4; ++e) v[e] = y[e] * __builtin_amdgcn_rcpf(1.f + __builtin_amdgcn_exp2f(-(v[e] + b[e]) * LOG2E));
        *(v2u*)(MIXU + (size_t)(MPR + m) * D + SBW + n) = pack4(v);
        return (v[0] * v[0] + v[1] * v[1]) + (v[2] * v[2] + v[3] * v[3]);
    }
};
struct SkResid { static constexpr bool STATS = true; static constexpr bool SPLIT2 = false; static constexpr bool PAIR = false;
    const float* base; float* xo; bf16* xb; float* ssq;
    __device__ __forceinline__ float operator()(int m, int n, f32x4 v) const {
        v = v + *(const f32x4*)(base + (size_t)m * D + n); const size_t o = (size_t)(MPR + m) * D + n;
        if (xo) *(f32x4*)(xo + o) = v; if (xb) *(v2u*)(xb + o) = pack4(v);
        return (v[0] * v[0] + v[1] * v[1]) + (v[2] * v[2] + v[3] * v[3]);
    }
};
struct SkScale { static constexpr bool STATS = false; static constexpr bool SPLIT2 = false; static constexpr bool PAIR = false;
    const float* ssq; float scale; bf16* O;
    __device__ __forceinline__ void operator()(int m, int n, f32x4 v) const {
        const float rs = scale / sqrtf(ssq[MPR + m] * (1.f / D) + EPS); v = v * rs; *(v2u*)(O + (size_t)(MPR + m) * D + n) = pack4(v);
    }
};
struct SkGateUp { static constexpr bool STATS = false; static constexpr bool SPLIT2 = false; static constexpr bool PAIR = false;
    const float* ssq; bf16 *GBp, *UBp; float* out;
    __device__ __forceinline__ void operator()(int m, int n, f32x4 v) const {
        const float rs = 1.f / sqrtf(ssq[MPR + m] * (1.f / D) + EPS); v = v * rs;
        if (n >= FF) *(v2u*)(UBp + (size_t)(MPR + m) * FF + (n - FF)) = pack4(v);
        else { *(v2u*)(GBp + (size_t)(MPR + m) * FF + n) = pack4(v); *(f32x4*)(out + O_CVS + ((size_t)m * 2 + 1) * FF + n) = v; }
    }
};

constexpr int HALO_OFF = RING_BYTES + 1024;
__device__ __forceinline__ float dpp_ror1(float x) { return __builtin_bit_cast(float, __builtin_amdgcn_update_dpp(0, __builtin_bit_cast(int, x), 0x121, 0xf, 0xf, true)); }
__device__ __forceinline__ float dpp_ror2(float x) { return __builtin_bit_cast(float, __builtin_amdgcn_update_dpp(0, __builtin_bit_cast(int, x), 0x122, 0xf, 0xf, true)); }
struct EpiGateUpConv { static constexpr bool MIDK = false;
    const float* ssq; bf16* ACT; float* out; const float* cw; const float* cb; LAS float* halo;
    __device__ __forceinline__ void operator()(const f32x4 (&acc)[2][2][4][2], const pg8::Unit& u, int wr, int wc, int fr_, int fq_) const {
        int fr = fr_, fq = fq_; asm volatile("" : "+v"(fr), "+v"(fq));
        const int cl = wc * 32 + 8 * fq, col = u.pn * 128 + cl, prow0 = u.pm * 254;
        float rs[2][4];
#pragma unroll
        for (int ai = 0; ai < 2; ++ai)
#pragma unroll
            for (int m = 0; m < 4; ++m) { const int row = prow0 + ai * 128 + wr * 64 + m * 16 + fr; rs[ai][m] = (row < MPR) ? 1.f / sqrtf(ssq[row < MPR ? row : 0] * (1.f / D) + EPS) : 0.f; }
        if (fr >= 14) {
#pragma unroll
            for (int ai = 0; ai < 2; ++ai) { LAS float* hp = halo + (((2 * ai + wr) * 2 + (fr - 14)) * 128 + cl); *(LAS f32x4*)hp = acc[ai][0][3][0] * rs[ai][3]; *(LAS f32x4*)(hp + 4) = acc[ai][0][3][1] * rs[ai][3]; }
        }
        asm volatile("s_waitcnt lgkmcnt(0)\n\ts_barrier" ::: "memory");
        f32x4 w0[2], w1[2], w2[2], bb[2];
#pragma unroll
        for (int n = 0; n < 2; ++n) { w0[n] = *(const f32x4*)(cw + col + 4 * n); w1[n] = *(const f32x4*)(cw + FF + col + 4 * n); w2[n] = *(const f32x4*)(cw + 2 * FF + col + 4 * n); bb[n] = *(const f32x4*)(cb + col + 4 * n); }
#pragma unroll
        for (int ai = 0; ai < 2; ++ai) {
            const int blk = 2 * ai + wr;
            f32x4 r1p[2], r2p[2];
            if (blk == 0) { r1p[0] = r1p[1] = r2p[0] = r2p[1] = (f32x4){0.f, 0.f, 0.f, 0.f}; }
            else { const LAS float* hb = halo + ((blk - 1) * 2) * 128 + cl;
                const f32x4 a0 = *(const LAS f32x4*)hb, a1 = *(const LAS f32x4*)(hb + 4), b0 = *(const LAS f32x4*)(hb + 128), b1 = *(const LAS f32x4*)(hb + 132);
                r1p[0] = b0; r1p[1] = b1; r2p[0] = (fr == 0) ? a0 : b0; r2p[1] = (fr == 0) ? a1 : b1; }
#pragma unroll
            for (int m = 0; m < 4; ++m) {
                const int lr = ai * 128 + wr * 64 + m * 16 + fr, row = prow0 + lr, t = row & (T - 1); const float rsv = rs[ai][m];
                f32x4 g[2], up[2], R1[2], R2[2];
#pragma unroll
                for (int n = 0; n < 2; ++n) { g[n] = acc[ai][0][m][n] * rsv; up[n] = acc[ai][1][m][n] * rsv;
#pragma unroll
                    for (int e = 0; e < 4; ++e) { R1[n][e] = dpp_ror1(g[n][e]); R2[n][e] = dpp_ror2(g[n][e]); } }
                const bool valid = (row < MPR) && (lr >= 2 || u.pm == 0);
                f32x4 av[2];
#pragma unroll
                for (int n = 0; n < 2; ++n) { f32x4 g1 = (fr == 0) ? r1p[n] : R1[n], g2 = (fr < 2) ? r2p[n] : R2[n];
                    if (t < 1) g1 = (f32x4){0.f, 0.f, 0.f, 0.f}; if (t < 2) g2 = (f32x4){0.f, 0.f, 0.f, 0.f};
                    const f32x4 cv = bb[n] + w0[n] * g2 + w1[n] * g1 + w2[n] * g[n];
#pragma unroll
                    for (int e = 0; e < 4; ++e) av[n][e] = gelu_tanh_f(cv[e]) * up[n][e]; }
                if (valid) { *(v4u*)(ACT + (size_t)row * FF + col) = pack8(av[0], av[1]);
                    if (t >= T - 2) { float* o = out + O_CVP + ((size_t)(row >> 12) * 2 + (t - (T - 2))) * FF + col; *(f32x4*)o = g[0]; *(f32x4*)(o + 4) = g[1]; } }
                r1p[0] = R1[0]; r1p[1] = R1[1]; r2p[0] = R2[0]; r2p[1] = R2[1];
            }
        }
    }
};
struct PanelOrder254 {
    pg8::GridOrder Gd;
    __device__ bool next(int i, pg8::Unit& u) const { return Gd.next(i, u); }
    __device__ __forceinline__ size_t aoff(const pg8::Unit& u) const { return (size_t)u.pm * 254 * D * 2; }
    __device__ __forceinline__ size_t boff(const pg8::Unit& u) const { return (size_t)u.pn * 128 * D * 2; }
};
struct SkGateUpConv { static constexpr bool STATS = false; static constexpr bool SPLIT2 = false; static constexpr bool PAIR = true;
    const float* ssq; bf16* ACT; float* out; const float* cw; const float* cb; const float* sc;
    __device__ __forceinline__ void operator()(int m, int n, f32x4 g, f32x4 up) const {
        const float rs = 1.f / sqrtf(ssq[MPR + m] * (1.f / D) + EPS); g = g * rs; up = up * rs;
        const f32x4 s0 = *(const f32x4*)(sc + ((size_t)m * 2 + 0) * FF + n), s1 = *(const f32x4*)(sc + ((size_t)m * 2 + 1) * FF + n);
        *(f32x4*)(out + O_CVS + ((size_t)m * 2 + 0) * FF + n) = s1; *(f32x4*)(out + O_CVS + ((size_t)m * 2 + 1) * FF + n) = g;
        const f32x4 cv = *(const f32x4*)(cb + n) + *(const f32x4*)(cw + n) * s0 + *(const f32x4*)(cw + FF + n) * s1 + *(const f32x4*)(cw + 2 * FF + n) * g;
        f32x4 a;
#pragma unroll
        for (int e = 0; e < 4; ++e) a[e] = gelu_tanh_f(cv[e]) * up[e];
        *(v2u*)(ACT + (size_t)(MPR + m) * FF + n) = pack4(a);
    }
};

struct EpiResidB { static constexpr bool MIDK = false;
    const bf16* base; float* xo; bf16* xb; float* ssq; LAS float* rowpart;
    __device__ __forceinline__ void operator()(const f32x4 (&acc)[2][2][4][2], const pg8::Unit& u, int wr, int wc, int fr_, int fq_) const { int fr = fr_, fq = fq_; asm volatile("" : "+v"(fr), "+v"(fq));
        _Pragma("unroll") for (int ai = 0; ai < 2; ++ai) _Pragma("unroll") for (int m = 0; m < 4; ++m) { const int row = u.pm * 256 + ai * 128 + wr * 64 + m * 16 + fr; float sq = 0.f;
            _Pragma("unroll") for (int bj = 0; bj < 2; ++bj) { const int col = u.pn * 256 + bj * 128 + wc * 32 + 8 * fq; f32x4 v0 = acc[ai][bj][m][0], v1 = acc[ai][bj][m][1];
                const v4u bw = *(const v4u*)(base + (size_t)row * D + col);
                v0 = v0 + (f32x4){bflo(bw.x), bfhi(bw.x), bflo(bw.y), bfhi(bw.y)}; v1 = v1 + (f32x4){bflo(bw.z), bfhi(bw.z), bflo(bw.w), bfhi(bw.w)};
                if (xo) { float* o = xo + (size_t)row * D + col; *(f32x4*)o = v0; *(f32x4*)(o + 4) = v1; }
                if (xb) *(v4u*)(xb + (size_t)row * D + col) = pack8(v0, v1);
                sq += (v0[0] * v0[0] + v0[1] * v0[1]) + (v0[2] * v0[2] + v0[3] * v0[3]) + (v1[0] * v1[0] + v1[1] * v1[1]) + (v1[2] * v1[2] + v1[3] * v1[3]); }
            sq += swap16(sq); sq += swap_half(sq);
            if (fq == 0) rowpart[(ai * 128 + wr * 64 + m * 16 + fr) * 4 + wc] = sq; }
        asm volatile("s_waitcnt lgkmcnt(0)\n\ts_barrier" ::: "memory");
        if (threadIdx.x < 256) { const f32x4 pp = *(const LAS f32x4*)(rowpart + threadIdx.x * 4); atomicAdd(ssq + u.pm * 256 + threadIdx.x, (pp[0] + pp[1]) + (pp[2] + pp[3])); }
    }
};
struct EpiResidFinal { static constexpr bool MIDK = false;
    const bf16* base; float* ssq; LAS float* rowpart; unsigned* pcnt; unsigned* bar; const float* gain; float* y; const bf16* xs;
    __device__ __forceinline__ void operator()(const f32x4 (&acc)[2][2][4][2], const pg8::Unit& u, int wr, int wc, int fr_, int fq_) const { int fr = fr_, fq = fq_; asm volatile("" : "+v"(fr), "+v"(fq));
        _Pragma("unroll") for (int ai = 0; ai < 2; ++ai) _Pragma("unroll") for (int m = 0; m < 4; ++m) { const int row = u.pm * 256 + ai * 128 + wr * 64 + m * 16 + fr; float sq = 0.f;
            _Pragma("unroll") for (int bj = 0; bj < 2; ++bj) { const int col = u.pn * 256 + bj * 128 + wc * 32 + 8 * fq; f32x4 v0 = acc[ai][bj][m][0], v1 = acc[ai][bj][m][1];
                const v4u bw = *(const v4u*)(base + (size_t)row * D + col);
                v0 = v0 + (f32x4){bflo(bw.x), bfhi(bw.x), bflo(bw.y), bfhi(bw.y)}; v1 = v1 + (f32x4){bflo(bw.z), bfhi(bw.z), bflo(bw.w), bfhi(bw.w)};
                sq += (v0[0] * v0[0] + v0[1] * v0[1]) + (v0[2] * v0[2] + v0[3] * v0[3]) + (v1[0] * v1[0] + v1[1] * v1[1]) + (v1[2] * v1[2] + v1[3] * v1[3]); }
            sq += swap16(sq); sq += swap_half(sq);
            if (fq == 0) rowpart[(ai * 128 + wr * 64 + m * 16 + fr) * 4 + wc] = sq; }
        asm volatile("s_waitcnt lgkmcnt(0)\n\ts_barrier" ::: "memory");
        if (threadIdx.x < 256) { const f32x4 pp = *(const LAS f32x4*)(rowpart + threadIdx.x * 4); atomicAdd(ssq + u.pm * 256 + threadIdx.x, (pp[0] + pp[1]) + (pp[2] + pp[3])); }
        asm volatile("s_waitcnt vmcnt(0)" ::: "memory");
        __syncthreads();
        if (threadIdx.x == 0) {
            unsigned* pc = pcnt + u.pm * 16;
            (void)xb_add(pc, 1u);
        }
        if ((threadIdx.x >> 6) == 1 && (int)blockIdx.x < MS) { const int row = MPR + (int)blockIdx.x, lane = threadIdx.x & 63;
            const float rs = 1.f / sqrtf(ssq[row] * (1.f / D) + EPS); float* yr = y + (size_t)row * D; const bf16* x3 = xs + (size_t)row * D;
            _Pragma("unroll") for (int j = 0; j < 2; ++j) { const int c = 8 * lane + 512 * j; const v4u w = *(const v4u*)(x3 + c); const f32x4 g0 = *(const f32x4*)(gain + c), g1 = *(const f32x4*)(gain + c + 4);
                *(f32x4*)(yr + c) = (f32x4){bflo(w.x), bfhi(w.x), bflo(w.y), bfhi(w.y)} * rs * g0; *(f32x4*)(yr + c + 4) = (f32x4){bflo(w.z), bfhi(w.z), bflo(w.w), bfhi(w.w)} * rs * g1; } }
        if (threadIdx.x == 0) {
            unsigned* pc = pcnt + u.pm * 16;
            XB_SPIN(xb_ld(pc) < 4u, bar);
            __builtin_amdgcn_fence(__ATOMIC_ACQUIRE, "agent");
        }
        __syncthreads();
        if (threadIdx.x < 256) { const unsigned tb = __hip_atomic_load((const unsigned*)ssq + u.pm * 256 + threadIdx.x, __ATOMIC_RELAXED, __HIP_MEMORY_SCOPE_AGENT);
            rowpart[threadIdx.x * 4] = 1.f / sqrtf(__builtin_bit_cast(float, tb) * (1.f / D) + EPS); }
        asm volatile("s_waitcnt lgkmcnt(0)\n\ts_barrier" ::: "memory");
        int fr2 = fr_, fq2 = fq_; asm volatile("" : "+v"(fr2), "+v"(fq2));
        _Pragma("unroll") for (int ai = 0; ai < 2; ++ai) _Pragma("unroll") for (int m = 0; m < 4; ++m) { const int rl = ai * 128 + wr * 64 + m * 16 + fr2; const int row = u.pm * 256 + rl; const float rs = rowpart[rl * 4];
            _Pragma("unroll") for (int bj = 0; bj < 2; ++bj) { const int col = u.pn * 256 + bj * 128 + wc * 32 + 8 * fq2; f32x4 v0 = acc[ai][bj][m][0], v1 = acc[ai][bj][m][1];
                const v4u bw = *(const v4u*)(base + (size_t)row * D + col); const f32x4 g0 = *(const f32x4*)(gain + col), g1 = *(const f32x4*)(gain + col + 4);
                v0 = (v0 + (f32x4){bflo(bw.x), bfhi(bw.x), bflo(bw.y), bfhi(bw.y)}) * rs * g0; v1 = (v1 + (f32x4){bflo(bw.z), bfhi(bw.z), bflo(bw.w), bfhi(bw.w)}) * rs * g1;
                float* o = y + (size_t)row * D + col; *(f32x4*)o = v0; *(f32x4*)(o + 4) = v1; } }
    }
};
struct SkResidB { static constexpr bool STATS = true; static constexpr bool SPLIT2 = false; static constexpr bool PAIR = false;
    const bf16* base; float* xo; bf16* xb; float* ssq;
    __device__ __forceinline__ float operator()(int m, int n, f32x4 v) const {
        const size_t o = (size_t)(MPR + m) * D + n; const v2u bw = *(const v2u*)(base + o);
        v = v + (f32x4){bflo(bw.x), bfhi(bw.x), bflo(bw.y), bfhi(bw.y)};
        if (xo) *(f32x4*)(xo + o) = v; if (xb) *(v2u*)(xb + o) = pack4(v);
        return (v[0] * v[0] + v[1] * v[1]) + (v[2] * v[2] + v[3] * v[3]);
    }
};

struct InProjOrder {
    int c;
    __device__ __forceinline__ bool next(int i, pg8::Unit& u) const { if (i >= 2 || c >= 256) return false;
        const int wgid = (c % pg8::NXCD) * (256 / pg8::NXCD) + c / pg8::NXCD, j = wgid & 3; u.pm = wgid >> 2; u.pn = (i == 0) ? 2 + j : (j < 2 ? j : 4 + j); return true; }
    __device__ __forceinline__ size_t aoff(const pg8::Unit& u) const { return (size_t)u.pm * ((size_t)pg8::BM * D * 2); }
    __device__ __forceinline__ size_t boff(const pg8::Unit& u) const { return (size_t)u.pn * ((size_t)pg8::BM * D * 2); }
};
struct SsmOne {
    int b, g; size_t bstride; int cnt;
    __device__ bool next(int i, pg8::Unit& u) const { if (i >= cnt) return false; u.pm = b; u.pn = g; return true; }
    __device__ __forceinline__ size_t aoff(const pg8::Unit& u) const { return ((size_t)u.pm * NCH * NG * XHP + (size_t)u.pn * XHP) * 2; }
    __device__ __forceinline__ size_t boff(const pg8::Unit& u) const { return (size_t)u.pn * bstride; }
};

struct EpiResidMix { static constexpr bool MIDK = true;
    const bf16* base; bf16* xb; float* ssq; const float* ssqA; const float* ssqB; LAS float* rowpart;
    __device__ __forceinline__ void mid(f32x4 (&acc)[2][2][4][2], const pg8::Unit& u, int wr, int wc, int fr_, int fq_) const { int fr = fr_; asm volatile("" : "+v"(fr));
        _Pragma("unroll") for (int ai = 0; ai < 2; ++ai) _Pragma("unroll") for (int m = 0; m < 4; ++m) { const int row = u.pm * 256 + ai * 128 + wr * 64 + m * 16 + fr;
            const float ratio = sqrtf((ssqB[row] * (1.f / SBW) + EPS) / (ssqA[row] * (1.f / SBW) + EPS));
            _Pragma("unroll") for (int bj = 0; bj < 2; ++bj) _Pragma("unroll") for (int n = 0; n < 2; ++n) acc[ai][bj][m][n] = acc[ai][bj][m][n] * ratio; }
    }
    __device__ __forceinline__ void operator()(const f32x4 (&acc)[2][2][4][2], const pg8::Unit& u, int wr, int wc, int fr_, int fq_) const { int fr = fr_, fq = fq_; asm volatile("" : "+v"(fr), "+v"(fq));
        _Pragma("unroll") for (int ai = 0; ai < 2; ++ai) _Pragma("unroll") for (int m = 0; m < 4; ++m) { const int row = u.pm * 256 + ai * 128 + wr * 64 + m * 16 + fr; float sq = 0.f;
            const float rsB = 1.f / sqrtf(ssqB[row] * (1.f / SBW) + EPS);
            _Pragma("unroll") for (int bj = 0; bj < 2; ++bj) { const int col = u.pn * 256 + bj * 128 + wc * 32 + 8 * fq; f32x4 v0 = acc[ai][bj][m][0] * rsB, v1 = acc[ai][bj][m][1] * rsB;
                const v4u bw = *(const v4u*)(base + (size_t)row * D + col);
                v0 = v0 + (f32x4){bflo(bw.x), bfhi(bw.x), bflo(bw.y), bfhi(bw.y)}; v1 = v1 + (f32x4){bflo(bw.z), bfhi(bw.z), bflo(bw.w), bfhi(bw.w)};
                *(v4u*)(xb + (size_t)row * D + col) = pack8(v0, v1);
                sq += (v0[0] * v0[0] + v0[1] * v0[1]) + (v0[2] * v0[2] + v0[3] * v0[3]) + (v1[0] * v1[0] + v1[1] * v1[1]) + (v1[2] * v1[2] + v1[3] * v1[3]); }
            sq += swap16(sq); sq += swap_half(sq);
            if (fq == 0) rowpart[(ai * 128 + wr * 64 + m * 16 + fr) * 4 + wc] = sq; }
        asm volatile("s_waitcnt lgkmcnt(0)\n\ts_barrier" ::: "memory");
        if (threadIdx.x < 256) { const f32x4 pp = *(const LAS f32x4*)(rowpart + threadIdx.x * 4); atomicAdd(ssq + u.pm * 256 + threadIdx.x, (pp[0] + pp[1]) + (pp[2] + pp[3])); }
    }
};
struct SkResidMix { static constexpr bool STATS = true; static constexpr bool SPLIT2 = true; static constexpr bool PAIR = false;
    const bf16* base; bf16* xb; float* ssq; const float* ssqA; const float* ssqB;
    __device__ __forceinline__ float operator()(int m, int n, f32x4 sA, f32x4 sB) const {
        const float rsA = 1.f / sqrtf(ssqA[MPR + m] * (1.f / SBW) + EPS), rsB = 1.f / sqrtf(ssqB[MPR + m] * (1.f / SBW) + EPS);
        const size_t o = (size_t)(MPR + m) * D + n; const v2u bw = *(const v2u*)(base + o);
        const f32x4 v = sA * rsA + sB * rsB + (f32x4){bflo(bw.x), bfhi(bw.x), bflo(bw.y), bfhi(bw.y)};
        *(v2u*)(xb + o) = pack4(v);
        return (v[0] * v[0] + v[1] * v[1]) + (v[2] * v[2] + v[3] * v[3]);
    }
};
__device__ __forceinline__ int crow(int r, int hi) { return (r & 3) + 8 * (r >> 2) + 4 * hi; }
__device__ __forceinline__ void glds16(const void* gsrc, unsigned lds_dst) { unsigned keep;
    asm volatile("s_mov_b32 %0, m0\n\ts_mov_b32 m0, %2\n\ts_nop 0\n\tglobal_load_lds_dwordx4 %1, off\n\ts_mov_b32 m0, %0" : "=&s"(keep) : "v"(gsrc), "s"(lds_dst) : "memory"); }
#define WAIT_BAR(N) asm volatile("s_waitcnt vmcnt(" #N ") lgkmcnt(0)\n\ts_barrier" ::: "memory")
typedef LAS const char* lds_cptr;
typedef short v4i16_t __attribute__((ext_vector_type(4)));
__device__ __forceinline__ s16x4 vtr(lds_cptr p) { return __builtin_bit_cast(s16x4, __builtin_amdgcn_ds_read_tr16_b64_v4i16((LAS v4i16_t*)p)); }
__device__ __forceinline__ bf16x8 ldsq(lds_cptr p) { return *(const LAS bf16x8*)p; }
#define MFMA32(a, b, c) __builtin_amdgcn_mfma_f32_32x32x16_bf16((a), (b), (c), 0, 0, 0)
typedef float f32x2_t __attribute__((ext_vector_type(2))); typedef __bf16 bf16x2_t __attribute__((ext_vector_type(2)));
__device__ __forceinline__ unsigned cvtpk_s(float lo, float hi) { f32x2_t v = {lo, hi}; bf16x2_t b = __builtin_convertvector(v, bf16x2_t); return __builtin_bit_cast(unsigned, b); }
__device__ __forceinline__ bf16x8 pack_bf8(const f32x16& p, int base) {
    v4u w; w.x = cvtpk_s(p[base], p[base + 1]); w.y = cvtpk_s(p[base + 2], p[base + 3]); w.z = cvtpk_s(p[base + 4], p[base + 5]); w.w = cvtpk_s(p[base + 6], p[base + 7]); return __builtin_bit_cast(bf16x8, w);
}
template <int CTRL> __device__ __forceinline__ float dppf(float x) { return __builtin_bit_cast(float, __builtin_amdgcn_update_dpp(0, __builtin_bit_cast(int, x), CTRL, 0xf, 0xf, true)); }

constexpr int SBA_K = 0, SBA_V = 24576, SBA_OST = 49152;
__device__ __forceinline__ void sb_attn_unit(Frame& F, int b, int h, int qb, float b2) {
    int lane = F.lane; asm volatile("" : "+v"(lane));
    const int r32 = lane & 31, hi = lane >> 5, wid = F.wave;
    const bf16* QBp = WSP(bf16, WS_QB); const bf16* KBp = WSP(bf16, WS_KB); const bf16* VBp = WSP(bf16, WS_VB); bf16* MIXU = WSP(bf16, WS_MIX); float* SSQA = (float*)(F.ctl + CW_SSQA);
    const long rowbase = (long)b * T; const int q0 = qb * 256;
    const bf16* Qw = QBp + (rowbase + q0 + wid * 32) * SBW + h * HD;
    const bf16* Kh = KBp + rowbase * SBW + h * HD; const bf16* Vh = VBp + rowbase * SBW + h * HD;
    const unsigned lds0 = (unsigned)(uintptr_t)(F.lds + RING_OFF);
    const bf16* ksrc = Kh + (long)lane * SBW + wid * 8;
    const bf16* vsrc = Vh + (long)(16 * (wid & 3) + (lane >> 2)) * SBW + (wid >> 2) * 32 + (lane & 3) * 8;
    const unsigned kdst = lds0 + SBA_K + wid * 1024, vdst = lds0 + SBA_V + wid * 1024;
    const lds_cptr base3 = (lds_cptr)(F.lds + RING_OFF);
    const lds_cptr kp0 = base3 + SBA_K + hi * 1024 + r32 * 16;
    const lds_cptr vp0 = base3 + SBA_V + ((lane >> 4) & 1) * 32 + (lane & 3) * 8 + (4 * hi + ((lane & 15) >> 2)) * 64;
    const int NT = (q0 + 256) / 64;
#define DMA_KV(t, slot) do { glds16(ksrc + (long)(t) * 64 * SBW, (unsigned)__builtin_amdgcn_readfirstlane(kdst + (slot) * 8192)); glds16(vsrc + (long)(t) * 64 * SBW, (unsigned)__builtin_amdgcn_readfirstlane(vdst + (slot) * 8192)); } while (0)
    DMA_KV(NT - 1, 0); DMA_KV(NT - 2, 1);
    bf16x8 qr[4];
#pragma unroll
    for (int d0 = 0; d0 < 4; ++d0) qr[d0] = *reinterpret_cast<const bf16x8*>(&Qw[(long)r32 * SBW + d0 * 16 + hi * 8]);
    asm volatile("" : "+v"(qr[0]), "+v"(qr[1]), "+v"(qr[2]), "+v"(qr[3]));
    bf16x8 A0, A1, AN;
#pragma unroll
    for (int j = 0; j < 8; ++j) { const int kv = crow(j, hi); A0[j] = (short)((kv >= r32) ? 0xBF80 : 0); A1[j] = (short)((kv + 16 >= r32) ? 0xBF80 : 0); AN[j] = (short)0xBF80; }
    f32x16 o0 = {}, o1 = {}, racc, bt;
#pragma unroll
    for (int r = 0; r < 16; ++r) { bt[r] = b2; racc[r] = b2; }
    const int qrel = wid * 32 + r32;
    for (int it = 0; it < NT; ++it) {
        const int t = NT - 1 - it, cur = it % 3;
        if (it + 1 < NT) { WAIT_BAR(2); } else { WAIT_BAR(0); }
        if (it + 2 < NT) DMA_KV(t - 2, (it + 2) % 3);
        const int jb = t - (NT - 4);
        if (jb <= (wid >> 1)) {
            int so = cur * 8192; asm volatile("" : "+s"(so));
            const lds_cptr kp = kp0 + so; const lds_cptr vp = vp0 + so;
            f32x16 p0 = bt, p1 = bt, d0 = racc, d1 = racc;
#pragma unroll
            for (int dd = 0; dd < 4; ++dd) { const bf16x8 k0 = ldsq(kp + dd * 2048), k1 = ldsq(kp + dd * 2048 + 512);
                p0 = MFMA32(k0, qr[dd], p0); p1 = MFMA32(k1, qr[dd], p1); d0 = MFMA32(k0, qr[dd], d0); d1 = MFMA32(k1, qr[dd], d1); }
            const bool diag = (jb == (wid >> 1));
            if (diag) {
                const float NEG = -INFINITY; const int kb = 64 * jb + 4 * hi;
#pragma unroll
                for (int r = 0; r < 16; ++r) { const int kv = kb + (r & 3) + 8 * (r >> 2); if (kv >= qrel) p0[r] = NEG; if (kv + 32 >= qrel) p1[r] = NEG; }
            }
            f32x16 s0, s1;
#pragma unroll
            for (int r = 0; r < 16; ++r) { s0[r] = __builtin_amdgcn_logf(1.f + __builtin_amdgcn_exp2f(p0[r])); s1[r] = __builtin_amdgcn_logf(1.f + __builtin_amdgcn_exp2f(p1[r])); }
            const bf16x8 sb0 = pack_bf8(s0, 0), sb1 = pack_bf8(s0, 8), sb2 = pack_bf8(s1, 0), sb3 = pack_bf8(s1, 8);
            d1 = MFMA32(A0, sb2, d1); d1 = MFMA32(A1, sb3, d1);
            d0 = MFMA32(A0, sb0, d0); d0 = MFMA32(A1, sb1, d0); d0 = MFMA32(AN, sb2, d0); d0 = MFMA32(AN, sb3, d0);
            racc = MFMA32(AN, sb0, racc); racc = MFMA32(AN, sb1, racc); racc = MFMA32(AN, sb2, racc); racc = MFMA32(AN, sb3, racc);
            if (diag) { const float NEG = -INFINITY; const int kb = 64 * jb + 4 * hi;
#pragma unroll
                for (int r = 0; r < 16; ++r) { const int kv = kb + (r & 3) + 8 * (r >> 2); if (kv >= qrel) d0[r] = NEG; if (kv + 32 >= qrel) d1[r] = NEG; } }
#pragma unroll
            for (int r = 0; r < 16; ++r) { p0[r] = __builtin_amdgcn_exp2f(d0[r]); p1[r] = __builtin_amdgcn_exp2f(d1[r]); }
            const bf16x8 pa0 = pack_bf8(p0, 0), pa1 = pack_bf8(p0, 8), pa2 = pack_bf8(p1, 0), pa3 = pack_bf8(p1, 8);
#pragma unroll
            for (int dh = 0; dh < 2; ++dh) {
                f32x16& o = dh ? o1 : o0;
#pragma unroll
                for (int rg = 0; rg < 4; ++rg) { const s16x4 lo = vtr(vp + dh * 4096 + rg * 1024), hh = vtr(vp + dh * 4096 + rg * 1024 + 512);
                    const bf16x8 vf = (bf16x8){lo[0], lo[1], lo[2], lo[3], hh[0], hh[1], hh[2], hh[3]};
                    o = MFMA32(rg == 0 ? pa0 : rg == 1 ? pa1 : rg == 2 ? pa2 : pa3, vf, o); }
            }
        }
    }
#undef DMA_KV
    { int l2 = lane; asm volatile("" : "+v"(l2)); const int e32 = l2 & 31, ehi = l2 >> 5;
      LAS bf16* stg = (LAS bf16*)(F.lds + RING_OFF + SBA_OST) + wid * 2048; LAS bf16* sb = stg + (4 * ehi) * 64 + e32;
#pragma unroll
      for (int r = 0; r < 16; ++r) { sb[((r & 3) + 8 * (r >> 2)) * 64] = (bf16)f2bf(o0[r]); sb[((r & 3) + 8 * (r >> 2)) * 64 + 32] = (bf16)f2bf(o1[r]); }
      LDS_WAIT();
      const long orow = rowbase + q0 + wid * 32 + (l2 >> 3);
      bf16* Ow = MIXU + orow * D + h * HD + (l2 & 7) * 8; const LAS bf16* sr = stg + (l2 >> 3) * 64 + (l2 & 7) * 8;
#pragma unroll
      for (int i = 0; i < 4; ++i) { const v4u v = *(const LAS v4u*)(sr + i * 512); *(v4u*)(Ow + (long)i * 8 * D) = v;
          float sq = (bflo(v.x) * bflo(v.x) + bfhi(v.x) * bfhi(v.x)) + (bflo(v.y) * bflo(v.y) + bfhi(v.y) * bfhi(v.y)) + (bflo(v.z) * bflo(v.z) + bfhi(v.z) * bfhi(v.z)) + (bflo(v.w) * bflo(v.w) + bfhi(v.w) * bfhi(v.w));
          sq += dppf<0xB1>(sq); sq += dppf<0x4E>(sq); sq += dppf<0x141>(sq);
          if ((l2 & 7) == 0) atomicAdd(SSQA + orow + i * 8, sq); } }
    asm volatile("s_waitcnt vmcnt(0) lgkmcnt(0)\n\ts_barrier" ::: "memory");
}

__device__ __forceinline__ float dpp_sum16(float x) {
    x += __builtin_bit_cast(float, __builtin_amdgcn_update_dpp(0, __builtin_bit_cast(int, x), 0xB1, 0xf, 0xf, true));
    x += __builtin_bit_cast(float, __builtin_amdgcn_update_dpp(0, __builtin_bit_cast(int, x), 0x4E, 0xf, 0xf, true));
    x += __builtin_bit_cast(float, __builtin_amdgcn_update_dpp(0, __builtin_bit_cast(int, x), 0x141, 0xf, 0xf, true));
    x += __builtin_bit_cast(float, __builtin_amdgcn_update_dpp(0, __builtin_bit_cast(int, x), 0x140, 0xf, 0xf, true));
    return x;
}
__device__ __forceinline__ float wave_sum_fast(float x) { x = dpp_sum16(x); x += swap16(x); x += swap_half(x); return x; }
__device__ __forceinline__ float swz_xor4(float x) { return __builtin_bit_cast(float, __builtin_amdgcn_ds_swizzle(__builtin_bit_cast(int, x), 0x101F)); }
__device__ __forceinline__ void sb_sample_unit(Frame& F, int b, int pg) {
    int lane = F.lane; asm volatile("" : "+v"(lane));
    const int h = F.wave, ts = lane >> 4, d4 = lane & 15;
    const float* QS = WSP(float, WS_QS); const float* ck = INF(2); const float* cv = INF(3); const int* pt = (const int*)F.in[4];
    const float bl2 = INF(13)[h] * LOG2E;
    const f32x4 q4 = *(const f32x4*)(QS + (size_t)b * SBW + h * HD + 4 * d4);
    const int page = pt[b * NPG + pg];
    const float* kb = ck + ((size_t)page * PAGE + ts) * (NH * HD) + h * HD + 4 * d4;
    const float* vb = cv + ((size_t)page * PAGE + ts) * (NH * HD) + h * HD + 4 * d4;
    float p[32];
    { f32x4 kk[32];
#pragma unroll
      for (int i = 0; i < 32; ++i) kk[i] = __builtin_nontemporal_load((const f32x4*)(kb + (size_t)i * 4 * NH * HD));
#pragma unroll
      for (int i = 0; i < 32; ++i) p[i] = (q4[0] * kk[i][0] + q4[1] * kk[i][1]) + (q4[2] * kk[i][2] + q4[3] * kk[i][3]); }
    f32x4 vv[32];
#pragma unroll
    for (int i = 0; i < 32; ++i) vv[i] = __builtin_nontemporal_load((const f32x4*)(vb + (size_t)i * 4 * NH * HD));
    const bool c0 = d4 & 1, c1 = d4 & 2, c2 = d4 & 4, c3 = d4 & 8;
    float v1[16], v2[8], v3[4], zz[2];
#pragma unroll
    for (int k = 0; k < 16; ++k) { const float keep = c0 ? p[2 * k + 1] : p[2 * k], send = c0 ? p[2 * k] : p[2 * k + 1]; v1[k] = keep + dppf<0xB1>(send); }
#pragma unroll
    for (int k = 0; k < 8; ++k) { const float keep = c1 ? v1[2 * k + 1] : v1[2 * k], send = c1 ? v1[2 * k] : v1[2 * k + 1]; v2[k] = keep + dppf<0x4E>(send); }
#pragma unroll
    for (int k = 0; k < 4; ++k) { const float keep = c2 ? v2[2 * k + 1] : v2[2 * k], send = c2 ? v2[2 * k] : v2[2 * k + 1]; v3[k] = keep + swz_xor4(send); }
#pragma unroll
    for (int k = 0; k < 2; ++k) { const float keep = c3 ? v3[2 * k + 1] : v3[2 * k], send = c3 ? v3[2 * k] : v3[2 * k + 1]; zz[k] = keep + dppf<0x128>(send) + bl2; }
    float sp[2], aft[2], G[2], sfx[2];
#pragma unroll
    for (int k = 0; k < 2; ++k) {
        sp[k] = __builtin_amdgcn_logf(1.f + __builtin_amdgcn_exp2f(zz[k]));
        const float nb = swap16(sp[k]), w1 = sp[k] + nb, po = swap_half(w1);
        aft[k] = ((ts & 1) ? 0.f : nb) + ((ts & 2) ? 0.f : po); G[k] = w1 + po;
        float s2 = G[k]; s2 += dppf<0x101>(s2); s2 += dppf<0x102>(s2); s2 += dppf<0x104>(s2); s2 += dppf<0x108>(s2); sfx[k] = s2;
    }
    const float tot1 = __builtin_bit_cast(float, __builtin_amdgcn_readlane(__builtin_bit_cast(int, sfx[1]), 0)), tot0 = __builtin_bit_cast(float, __builtin_amdgcn_readlane(__builtin_bit_cast(int, sfx[0]), 0));
    const float a1 = __builtin_amdgcn_exp2f(zz[1] - sp[1] - (aft[1] + (sfx[1] - G[1])));
    const float a0 = __builtin_amdgcn_exp2f(zz[0] - sp[0] - (aft[0] + (sfx[0] - G[0]) + tot1));
    LAS float* aw = (LAS float*)(F.lds + RING_OFF) + h * 128 + ts * 32;
    aw[d4] = a0; aw[d4 + 16] = a1;
    LDS_WAIT(); asm volatile("" ::: "memory");
    f32x4 acc = {0.f, 0.f, 0.f, 0.f};
#pragma unroll
    for (int i4 = 0; i4 < 8; ++i4) { const f32x4 a4 = *(const LAS f32x4*)(aw + 4 * i4);
#pragma unroll
        for (int e2 = 0; e2 < 4; ++e2) acc = acc + vv[4 * i4 + e2] * a4[e2]; }
    LDS_WAIT(); asm volatile("" ::: "memory");
#pragma unroll
    for (int e2 = 0; e2 < 4; ++e2) { acc[e2] += swap16(acc[e2]); acc[e2] += swap_half(acc[e2]); }
    if (ts == 0) *(f32x4*)(WSP(float, WS_SBPO) + (((size_t)b * NPG + pg) * NH + h) * HD + 4 * d4) = acc;
    if (lane == 0) WSP(float, WS_SBPL)[((size_t)b * NPG + pg) * NH + h] = -(tot0 + tot1);
}
__device__ __forceinline__ void sb_sample_combine(Frame& F, int b, int h) {
    const float* PO = WSP(float, WS_SBPO); const float* PL = WSP(float, WS_SBPL); float o = 0.f, run = 0.f;
#pragma unroll
    for (int pg = NPG - 1; pg >= 0; --pg) { o += __builtin_amdgcn_exp2f(run) * PO[(((size_t)b * NPG + pg) * NH + h) * HD + F.lane]; run += PL[((size_t)b * NPG + pg) * NH + h]; }
    const unsigned ob = f2bf(o); const float orr = bf2f((unsigned short)ob);
    WSP(bf16, WS_MIX)[(size_t)(MPR + b) * D + h * HD + F.lane] = (bf16)ob;
    const float sq = wave_sum_fast(orr * orr);
    if (F.lane == 0) atomicAdd((float*)(F.ctl + CW_SSQA) + MPR + b, sq);
}
__device__ __forceinline__ void ssm_sample_unit(Frame& F, int b, int g) {
    const int n = F.lane;
    const float lr = INF(14)[g * NST + n], li = INF(15)[g * NST + n], ldt = INF(16)[g];
    float lbr, lbi, cr, ci; lam_pow(lr, li, ldt, 1, lbr, lbi); lam_coef(lr, li, ldt, cr, ci);
    const float* u = WSP(float, WS_US) + (size_t)b * SBW + g * GP;
    float br = 0.f, bi = 0.f;
#pragma unroll
    for (int p = 0; p < 16; ++p) { const float bre = INF(17)[(g * NST + n) * GP + p], bim = INF(18)[(g * NST + n) * GP + p]; const float uv = u[p]; br += (cr * bre - ci * bim) * uv; bi += (cr * bim + ci * bre) * uv; }
    const float h0r = INF(5)[(b * NG + g) * NST + n], h0i = INF(6)[(b * NG + g) * NST + n];
    const float hr = lbr * h0r - lbi * h0i + br, hi = lbr * h0i + lbi * h0r + bi;
    F.out[O_RES + (size_t)(b * NG + g) * NST + n] = hr; F.out[O_IMS + (size_t)(b * NG + g) * NST + n] = hi;
    float y = 0.f;
#pragma unroll
    for (int p = 0; p < 16; ++p) { const float v = wave_sum(INF(19)[(g * GP + p) * NST + n] * hr - INF(20)[(g * GP + p) * NST + n] * hi); if (n == p) y = v; }
    if (n < 16) { y += INF(21)[g * GP + n] * u[n]; WSP(bf16, WS_YG)[(size_t)(MPR + b) * SBW + g * GP + n] = (bf16)f2bf(gelu_tanh_f(y)); }
}
__device__ __forceinline__ void ssm_scan_bg(Frame& F, int b, int g) {
    const int n = F.tid & 63, seg = F.tid >> 6;
    LAS float* tot = (LAS float*)(F.lds + RING_OFF);
    const float lr = INF(14)[g * NST + n], li = INF(15)[g * NST + n], ldt = INF(16)[g];
    float Lr, Li, Sr, Si; lam_pow(lr, li, ldt, LC, Lr, Li); lam_pow(lr, li, ldt, LC * 32, Sr, Si);
    const float* SST = WSP(float, WS_SST); bf16* XH = WSP(bf16, WS_XH);
    f32x2 s[32];
#pragma unroll
    for (int k = 0; k < 32; ++k) s[k] = *(const f32x2*)(SST + ((size_t)(b * NCH + seg * 32 + k) * NG + g) * 128 + 2 * n);
    float pr = 0.f, pi = 0.f;
#pragma unroll
    for (int k = 0; k < 32; ++k) { const float nr = Lr * pr - Li * pi + s[k].x, ni = Lr * pi + Li * pr + s[k].y; pr = nr; pi = ni; s[k].x = pr; s[k].y = pi; }
    tot[(seg * 64 + n) * 2] = pr; tot[(seg * 64 + n) * 2 + 1] = pi;
    __syncthreads();
    float cr = 0.f, ci = 0.f;
    for (int s2 = 0; s2 < seg; ++s2) { const float tr = tot[(s2 * 64 + n) * 2], ti = tot[(s2 * 64 + n) * 2 + 1]; const float nr = Sr * cr - Si * ci + tr, ni = Sr * ci + Si * cr + ti; cr = nr; ci = ni; }
    if (seg == 0) *(GAS unsigned*)(XH + ((size_t)(b * NCH) * NG + g) * XHP + 256 + 2 * n) = 0u;
    float wr_ = Lr, wi_ = Li;
#pragma unroll
    for (int k = 0; k < 32; ++k) {
        const float hr = wr_ * cr - wi_ * ci + s[k].x, hi = wr_ * ci + wi_ * cr + s[k].y;
        const int c = seg * 32 + k;
        if (c + 1 < NCH) *(GAS unsigned*)(XH + ((size_t)(b * NCH + c + 1) * NG + g) * XHP + 256 + 2 * n) = pk2(hr, hi);
        else { F.out[O_REP + (size_t)(b * NG + g) * NST + n] = hr; F.out[O_IMP + (size_t)(b * NG + g) * NST + n] = hi; }
        const float nr = wr_ * Lr - wi_ * Li, ni = wr_ * Li + wi_ * Lr; wr_ = nr; wi_ = ni;
    }
}
__device__ __forceinline__ void xattn_prompt_kload(Frame& F, int b, int h) {
    const int lane = F.lane, wid = F.wave; const bf16* MKB = WSP(bf16, WS_MKB);
    const unsigned lds0 = (unsigned)(uintptr_t)(F.lds + RING_OFF);
#pragma unroll
    for (int t = 0; t < 4; ++t)
#pragma unroll
        for (int j = 0; j < 4; ++j) { const int c = wid + 8 * j;
            glds16(MKB + ((long)b * MT + t * 64 + lane) * D + h * MHD + c * 8, (unsigned)__builtin_amdgcn_readfirstlane(lds0 + t * 32768 + c * 1024)); }
}
__device__ __forceinline__ void xattn_prompt_unit(Frame& F, int b, int h, int qb, bool have_k) {
    const int lane = F.lane, r32 = lane & 31, hi = lane >> 5, wid = F.wave;
    const bf16* QM = WSP(bf16, WS_QM); const bf16* MVB = WSP(bf16, WS_MVB); bf16* OM = WSP(bf16, WS_OMEM);
    const unsigned lds0 = (unsigned)(uintptr_t)(F.lds + RING_OFF); const lds_cptr base3 = (lds_cptr)(F.lds + RING_OFF);
    const long qrow0 = (long)b * T + qb * 256 + wid * 32;
    if (!have_k) xattn_prompt_kload(F, b, h);
    bf16x8 qr[16];
#pragma unroll
    for (int ks = 0; ks < 16; ++ks) qr[ks] = *reinterpret_cast<const bf16x8*>(QM + (qrow0 + r32) * D + h * MHD + ks * 16 + hi * 8);
    WAIT_BAR(0);
    f32x16 S[8];
#pragma unroll
    for (int t = 0; t < 4; ++t)
#pragma unroll
        for (int blk = 0; blk < 2; ++blk) { f32x16 p = {};
#pragma unroll
            for (int ks = 0; ks < 16; ++ks) p = MFMA32(ldsq(base3 + t * 32768 + (2 * ks + hi) * 1024 + (32 * blk + r32) * 16), qr[ks], p);
            S[t * 2 + blk] = p; }
    WAIT_BAR(0);
#pragma unroll
    for (int t = 0; t < 4; ++t)
#pragma unroll
        for (int j = 0; j < 4; ++j) { const int p = wid + 8 * j, dblk = p >> 2, rg = p & 3;
            glds16(MVB + ((long)b * MT + t * 64 + 16 * rg + (lane >> 2)) * D + h * MHD + dblk * 32 + (lane & 3) * 8, (unsigned)__builtin_amdgcn_readfirstlane(lds0 + t * 32768 + p * 1024)); }
    float mx = -INFINITY;
#pragma unroll
    for (int i = 0; i < 8; ++i)
#pragma unroll
        for (int r = 0; r < 16; ++r) mx = fmaxf(mx, S[i][r]);
    mx = fmaxf(mx, swap_half(mx));
    float l = 0.f;
#pragma unroll
    for (int i = 0; i < 8; ++i)
#pragma unroll
        for (int r = 0; r < 16; ++r) { S[i][r] = __builtin_amdgcn_exp2f(S[i][r] - mx); l += S[i][r]; }
    l += swap_half(l);
    bf16x8 pa[16];
#pragma unroll
    for (int i = 0; i < 8; ++i) { pa[2 * i] = pack_bf8(S[i], 0); pa[2 * i + 1] = pack_bf8(S[i], 8); }
    WAIT_BAR(0);
    f32x16 o[8];
#pragma unroll
    for (int dblk = 0; dblk < 8; ++dblk) o[dblk] = (f32x16){};
    const lds_cptr vp0 = base3 + ((lane >> 4) & 1) * 32 + (lane & 3) * 8 + (4 * hi + ((lane & 15) >> 2)) * 64;
#pragma unroll
    for (int t = 0; t < 4; ++t)
#pragma unroll
        for (int dblk = 0; dblk < 8; ++dblk)
#pragma unroll
            for (int rg = 0; rg < 4; ++rg) { const s16x4 lo = vtr(vp0 + t * 32768 + dblk * 4096 + rg * 1024), hh = vtr(vp0 + t * 32768 + dblk * 4096 + rg * 1024 + 512);
                const bf16x8 vf = (bf16x8){lo[0], lo[1], lo[2], lo[3], hh[0], hh[1], hh[2], hh[3]};
                o[dblk] = MFMA32(pa[t * 4 + rg], vf, o[dblk]); }
    WAIT_BAR(0);
    int l2 = lane; asm volatile("" : "+v"(l2));
    const int e32 = l2 & 31, ehi = l2 >> 5;
    LAS bf16* stg = (LAS bf16*)(F.lds + RING_OFF) + wid * 8192;
    LAS float* lsw = (LAS float*)stg;
    if (ehi == 0) lsw[e32] = l;
    LDS_WAIT();
    float rli[16];
    { const LAS float* lb = lsw + 4 * ehi;
#pragma unroll
      for (int r = 0; r < 16; ++r) rli[r] = __builtin_amdgcn_rcpf(lb[(r & 3) + 8 * (r >> 2)]); }
    LDS_WAIT(); asm volatile("" ::: "memory");
    { LAS bf16* sb = stg + (4 * ehi) * 256 + e32;
#pragma unroll
      for (int dblk = 0; dblk < 8; ++dblk)
#pragma unroll
        for (int r = 0; r < 16; ++r) sb[((r & 3) + 8 * (r >> 2)) * 256 + dblk * 32] = (bf16)f2bf(o[dblk][r] * rli[r]); }
    LDS_WAIT();
    { bf16* Ow = OM + (qrow0 + (l2 >> 5)) * D + h * MHD + (l2 & 31) * 8; const LAS bf16* sr = stg + (l2 >> 5) * 256 + (l2 & 31) * 8;
#pragma unroll
      for (int i = 0; i < 16; ++i) { const v4u v = *(const LAS v4u*)(sr + i * 512); *(v4u*)(Ow + (long)i * 2 * D) = v; } }
    asm volatile("s_waitcnt vmcnt(0) lgkmcnt(0)\n\ts_barrier" ::: "memory");
}
__device__ __forceinline__ void xattn_sample_unit(Frame& F, int b, int h) {
    const int lane = F.lane, wid = F.wave;
    const bf16* QM = WSP(bf16, WS_QM); const float* ck = INF(8); const float* cv = INF(9);
    LAS float* xm = (LAS float*)(F.lds + HALO_OFF);
    const v2u qw = *(const v2u*)(QM + (size_t)(MPR + b) * D + h * MHD + 4 * lane);
    const f32x4 q4 = {bflo(qw.x), bfhi(qw.x), bflo(qw.y), bfhi(qw.y)};
    const float* kb = ck + (((size_t)b * MT + wid * 32) * MH + h) * MHD + 4 * lane;
    const float* vb = cv + (((size_t)b * MT + wid * 32) * MH + h) * MHD + 4 * lane;
    float s[32];
    f32x4 kk[32], vv[32];
#pragma unroll
    for (int i = 0; i < 32; ++i) kk[i] = __builtin_nontemporal_load((const f32x4*)(kb + (size_t)i * MH * MHD));
#pragma unroll
    for (int i0 = 0; i0 < 32; i0 += 16) {
#pragma unroll
        for (int i = 0; i < 16; ++i) s[i0 + i] = wave_sum_fast((q4[0] * kk[i0 + i][0] + q4[1] * kk[i0 + i][1]) + (q4[2] * kk[i0 + i][2] + q4[3] * kk[i0 + i][3]));
#pragma unroll
        for (int i = 0; i < 16; ++i) vv[i0 + i] = __builtin_nontemporal_load((const f32x4*)(vb + (size_t)(i0 + i) * MH * MHD));
        __builtin_amdgcn_sched_barrier(0);
    }
    float mx = s[0];
#pragma unroll
    for (int i = 1; i < 32; ++i) mx = fmaxf(mx, s[i]);
    float l = 0.f;
#pragma unroll
    for (int i = 0; i < 32; ++i) { s[i] = __builtin_amdgcn_exp2f(s[i] - mx); l += s[i]; }
    f32x4 acc = {0.f, 0.f, 0.f, 0.f};
#pragma unroll
    for (int i = 0; i < 32; ++i) acc = acc + vv[i] * s[i];
    WAIT_BAR(0);
    if (lane == 0) { xm[wid] = mx; xm[8 + wid] = l; }
    *(LAS f32x4*)(xm + 64 + wid * 256 + 4 * lane) = acc;
    WAIT_BAR(0);
    if (F.tid < 256) { float gm = xm[0];
#pragma unroll
        for (int w = 1; w < 8; ++w) gm = fmaxf(gm, xm[w]);
        float lt = 0.f, ov = 0.f;
#pragma unroll
        for (int w = 0; w < 8; ++w) { const float f = __builtin_amdgcn_exp2f(xm[w] - gm); lt += xm[8 + w] * f; ov += xm[64 + w * 256 + F.tid] * f; }
        WSP(bf16, WS_OMEM)[(size_t)(MPR + b) * D + h * MHD + F.tid] = (bf16)f2bf(ov / lt); }
}
__device__ __forceinline__ void mix_row(Frame& F, int row) {
    const int lane = F.lane;
#pragma unroll
    for (int half = 0; half < 2; ++half) {
        const bf16* src = (half ? WSP(bf16, WS_OSSM) : WSP(bf16, WS_OSB)) + (size_t)row * SBW + 8 * lane;
        const v4u w = *(const v4u*)src; float v[8] = {bflo(w.x), bfhi(w.x), bflo(w.y), bfhi(w.y), bflo(w.z), bfhi(w.z), bflo(w.w), bfhi(w.w)};
        float s = 0.f;
#pragma unroll
        for (int e = 0; e < 8; ++e) s += v[e] * v[e];
        s = wave_sum(s); const float rs = 1.f / sqrtf(s * (1.f / SBW) + EPS);
        v4u o; o.x = pk2(v[0] * rs, v[1] * rs); o.y = pk2(v[2] * rs, v[3] * rs); o.z = pk2(v[4] * rs, v[5] * rs); o.w = pk2(v[6] * rs, v[7] * rs);
        *(v4u*)(WSP(bf16, WS_MIX) + (size_t)row * D + half * SBW + 8 * lane) = o;
    }
}
__device__ __forceinline__ void conv_act_item(Frame& F, long item) {
    const int row = (int)(item / (FF / 8)), j = (int)(item % (FF / 8)) * 8;
    const bf16* GB = WSP(bf16, WS_GB); bf16* UB = WSP(bf16, WS_UB);
    const float* cw = INF(36); const float* cb = INF(37); const float* sc = INF(7);
    float g0[8], g1[8], g2[8], uu[8];
    { const v4u w = *(const v4u*)(GB + (size_t)row * FF + j); g0[0] = bflo(w.x); g0[1] = bfhi(w.x); g0[2] = bflo(w.y); g0[3] = bfhi(w.y); g0[4] = bflo(w.z); g0[5] = bfhi(w.z); g0[6] = bflo(w.w); g0[7] = bfhi(w.w); }
    { const v4u w = *(const v4u*)(UB + (size_t)row * FF + j); uu[0] = bflo(w.x); uu[1] = bfhi(w.x); uu[2] = bflo(w.y); uu[3] = bfhi(w.y); uu[4] = bflo(w.z); uu[5] = bfhi(w.z); uu[6] = bflo(w.w); uu[7] = bfhi(w.w); }
    if (row < MPR) { const int t = row & 4095;
        if (t >= 1) { const v4u w = *(const v4u*)(GB + (size_t)(row - 1) * FF + j); g1[0] = bflo(w.x); g1[1] = bfhi(w.x); g1[2] = bflo(w.y); g1[3] = bfhi(w.y); g1[4] = bflo(w.z); g1[5] = bfhi(w.z); g1[6] = bflo(w.w); g1[7] = bfhi(w.w); }
        else { _Pragma("unroll") for (int e = 0; e < 8; ++e) g1[e] = 0.f; }
        if (t >= 2) { const v4u w = *(const v4u*)(GB + (size_t)(row - 2) * FF + j); g2[0] = bflo(w.x); g2[1] = bfhi(w.x); g2[2] = bflo(w.y); g2[3] = bfhi(w.y); g2[4] = bflo(w.z); g2[5] = bfhi(w.z); g2[6] = bflo(w.w); g2[7] = bfhi(w.w); }
        else { _Pragma("unroll") for (int e = 0; e < 8; ++e) g2[e] = 0.f; }
    } else { const int b = row - MPR;
        _Pragma("unroll") for (int e = 0; e < 8; ++e) { g2[e] = sc[((size_t)b * 2 + 0) * FF + j + e]; g1[e] = sc[((size_t)b * 2 + 1) * FF + j + e]; F.out[O_CVS + ((size_t)b * 2 + 0) * FF + j + e] = g1[e]; } }
    float r[8];
#pragma unroll
    for (int e = 0; e < 8; ++e) { const float c = cb[j + e] + cw[j + e] * g2[e] + cw[FF + j + e] * g1[e] + cw[2 * FF + j + e] * g0[e]; r[e] = gelu_tanh_f(c) * uu[e]; }
    v4u o; o.x = pk2(r[0], r[1]); o.y = pk2(r[2], r[3]); o.z = pk2(r[4], r[5]); o.w = pk2(r[6], r[7]);
    *(v4u*)(UB + (size_t)row * FF + j) = o;
}
__device__ __forceinline__ void final_norm_row(Frame& F, int row) {
    const float rs = 1.f / sqrtf(((const float*)(F.ctl + CW_SSQ3))[row] * (1.f / D) + EPS);
    float* y = F.out + O_YP + (size_t)row * D; const float* g = INF(39); const bf16* x3 = WSP(bf16, WS_X1B) + (size_t)row * D;
#pragma unroll
    for (int j = 0; j < 2; ++j) { const int c = 8 * F.lane + 512 * j; const v4u w = *(const v4u*)(x3 + c); const f32x4 g0 = *(const f32x4*)(g + c), g1 = *(const f32x4*)(g + c + 4);
        const f32x4 v0 = (f32x4){bflo(w.x), bfhi(w.x), bflo(w.y), bfhi(w.y)} * rs * g0, v1 = (f32x4){bflo(w.z), bfhi(w.z), bflo(w.w), bfhi(w.w)} * rs * g1;
        *(f32x4*)(y + c) = v0; *(f32x4*)(y + c + 4) = v1; }
}
constexpr int N_PHASES = 15;
__global__ void __launch_bounds__(NTHR, 2) mk_fwd(Args args) {
    extern __shared__ __attribute__((aligned(16))) unsigned char lds[];
    Frame F;
    F.lds = (LAS unsigned char*)lds; F.MISC = (volatile LAS unsigned*)(F.lds + MISC_OFF);
    F.tid = threadIdx.x; F.lane = F.tid & 63; F.wave = __builtin_amdgcn_readfirstlane(F.tid >> 6);
    F.G = gridDim.x; { const int bx = blockIdx.x; F.vcu = (F.G % 8 == 0) ? (bx % 8) * (F.G / 8) + bx / 8 : bx; }
    F.ws = args.ws; F.out = args.out; F.in = args.in; F.ctl = (unsigned*)(args.ws + WS_CTL);
    for (int u = F.tid; u < (LDS_BYTES - LDSCTL_OFF) / 4; u += NTHR) ((LAS unsigned*)(F.lds + LDSCTL_OFF))[u] = 0u;
    __syncthreads();
    XcdBarrier bar; bar.bar = F.ctl + CW_BAR; bar.x = 0; bar.st = nullptr;
    if (args.use_bar) bar = xcd_barrier_post(F.ctl + CW_BAR, F.MISC + 8);
    const int lo = args.ph_lo, hi = args.ph_hi;
#define IN(k) (lo <= (k) && (k) < hi)
#if MK_PROBE >= 200
    unsigned long long tp0 = 0, tpd = 0;
#define TP_BEGIN(k) do { if ((k) == MK_PROBE - 200) tp0 = __builtin_amdgcn_s_memrealtime(); } while (0)
#define TP_END(k) do { if ((k) == MK_PROBE - 200) tpd = __builtin_amdgcn_s_memrealtime() - tp0; } while (0)
#else
#define TP_BEGIN(k) do {} while (0)
#define TP_END(k) do {} while (0)
#endif
#define SEAM(k) do { if (IN(k) && IN((k) + 1)) xcd_barrier(bar); TP_END(k); TP_BEGIN((k) + 1); TP_BEGIN((k) + 2); TP_BEGIN((k) + 3); } while (0)
    const int gw = F.vcu * NWAVES + F.wave, NGW = F.G * NWAVES;
    LAS unsigned char* ring = F.lds + RING_OFF;

    TP_BEGIN(0);
    if (IN(0)) { p0_prologue(F);
#if MK_PROBE == 100
        __syncthreads(); p0_prologue(F);
#endif
    } SEAM(0);
    if (IN(1)) {
        { pg8::Gemm g{WSP(bf16, WS_XB), WSP(bf16, WS_WIN), D, D, D}; InProjOrder S{(int)blockIdx.x};
          EpiInProj E{WSP(float, WS_RSTD0), WSP(bf16, WS_QB), WSP(bf16, WS_KB), WSP(bf16, WS_VB), WSP(bf16, WS_XH), WSP(float, WS_QS), WSP(float, WS_US), F.out};
          pg8::gemm_phase<EpiInProj, InProjOrder>(ring, g, S, E);
#if MK_PROBE == 1
          pg8::gemm_phase<EpiInProj, InProjOrder>(ring, g, S, E);
#endif
        }
        { SkInProj E{WSP(float, WS_RSTD0), WSP(bf16, WS_QB), WSP(float, WS_QS), WSP(float, WS_US), F.out};
          skinny_gemm(F, WSP(bf16, WS_XB) + (size_t)MPR * D, D, WSP(bf16, WS_WIN), D, INW, D, E, (int)blockIdx.x, F.G); }
    } SEAM(1);
    if (IN(2)) {
        if ((int)blockIdx.x < NG * NB) { const int u = (int)blockIdx.x; const int sb_ = u & 3, sg_ = u >> 2; int one = 1; asm volatile("" : "+s"(one));
          { pg8::Gemm g{WSP(bf16, WS_XH), WSP(bf16, WS_W1), NG * XHP, 256, 256}; SsmOne S{sb_, sg_, (size_t)128 * 256 * 2, one};
            EpiSsmA E{WSP(float, WS_SST)};
            pg8::gemm_phase<EpiSsmA, SsmOne>(ring, g, S, E); }
          VM_WAIT(); __syncthreads();
          ssm_scan_bg(F, sb_, sg_);
          VM_WAIT(); __syncthreads();
        }
        { pg8::Gemm g{WSP(bf16, WS_MB), WSP(bf16, WS_WMKV), D, D, D}; pg8::GridOrder S; S.init(4, 8, F.G, (int)blockIdx.x, 128, D, D);
          EpiMemKV E{WSP(float, WS_RSTDM), WSP(bf16, WS_MKB), WSP(bf16, WS_MVB), F.out};
          pg8::gemm_phase<EpiMemKV, pg8::GridOrder>(ring, g, S, E); }
        for (int u = gw; u < MS * NG; u += NGW) ssm_sample_unit(F, u >> 5, u & 31);
        weight_copies(F, NITEMS_EARLY, NITEMS_GLU);
        __syncthreads();
        { int mode = (MK_STREAM_DIV > 0 ? (F.vcu % MK_STREAM_DIV == MK_STREAM_DIV - 1) : (F.vcu % (-MK_STREAM_DIV) != 0)) ? 1 : 0; bool adone = false, mdone = false;
          while (!(adone && mdone)) {
              if (mode == 0 && adone) mode = 1; else if (mode == 1 && mdone) mode = 0;
              __syncthreads();
              if (F.tid == 0) F.MISC[16] = __hip_atomic_fetch_add(F.ctl + (mode ? CW_QM : CW_QA), 1u, __ATOMIC_RELAXED, __HIP_MEMORY_SCOPE_AGENT);
              __syncthreads();
              const int idx = (int)F.MISC[16];
              if (mode == 0) { if (idx >= 512) { adone = true; continue; }
                  const int qb = 15 - (idx >> 5), bh = idx & 31; sb_attn_unit(F, bh >> 3, bh & 7, qb, INF(13)[bh & 7] * LOG2E); }
              else { if (idx >= MS * NPG) { mdone = true; continue; }
                  sb_sample_unit(F, idx >> 4, idx & 15); }
          } }
#if MK_PROBE == 22
        if (args.use_bar) { xcd_barrier(bar); if (blockIdx.x == 0 && F.tid == 0) { __hip_atomic_store(F.ctl + CW_QA, 0u, __ATOMIC_RELAXED, __HIP_MEMORY_SCOPE_AGENT); __hip_atomic_store(F.ctl + CW_QM, 0u, __ATOMIC_RELAXED, __HIP_MEMORY_SCOPE_AGENT); } xcd_barrier(bar);
        { int mode = (MK_STREAM_DIV > 0 ? (F.vcu % MK_STREAM_DIV == MK_STREAM_DIV - 1) : (F.vcu % (-MK_STREAM_DIV) != 0)) ? 1 : 0; bool adone = false, mdone = false;
          while (!(adone && mdone)) {
              if (mode == 0 && adone) mode = 1; else if (mode == 1 && mdone) mode = 0;
              __syncthreads();
              if (F.tid == 0) F.MISC[16] = __hip_atomic_fetch_add(F.ctl + (mode ? CW_QM : CW_QA), 1u, __ATOMIC_RELAXED, __HIP_MEMORY_SCOPE_AGENT);
              __syncthreads();
              const int idx = (int)F.MISC[16];
              if (mode == 0) { if (idx >= 512) { adone = true; continue; }
                  const int qb = 15 - (idx >> 5), bh = idx & 31; sb_attn_unit(F, bh >> 3, bh & 7, qb, INF(13)[bh & 7] * LOG2E); }
              else { if (idx >= MS * NPG) { mdone = true; continue; }
                  sb_sample_unit(F, idx >> 4, idx & 15); }
          } }
        }
#endif
        __syncthreads();
        if ((int)blockIdx.x < NG * NB) { const int u = (int)blockIdx.x; const int sb_ = u & 3, sg_ = u >> 2; int one = 1; asm volatile("" : "+s"(one));
          { pg8::Gemm g{WSP(bf16, WS_XH), WSP(bf16, WS_BTC), NG * XHP, XHP, XHP}; SsmOne S{sb_, sg_, (size_t)256 * XHP * 2, one};
            EpiSsmC E{WSP(bf16, WS_YG)};
            pg8::gemm_phase<EpiSsmC, SsmOne>(ring, g, S, E); }
        }
        weight_copies(F, NITEMS_GLU, NITEMS_MID, NG * NB, F.G - NG * NB);
    } SEAM(2);
    if (IN(5)) {
        for (int u = gw; u < MS * NH; u += NGW) sb_sample_combine(F, u >> 3, u & 7);
        pg8::Gemm g{WSP(bf16, WS_YG), WSP(bf16, WS_WGLU), SBW, SBW, SBW}; pg8::GridOrder S; S.init(MPR / 256, 2, F.G, (int)blockIdx.x, 0, SBW, SBW);
        EpiGlu E{WSP(bf16, WS_YG), INF(23), WSP(bf16, WS_MIX), (float*)(F.ctl + CW_SSQB)};
        pg8::gemm_phase<EpiGlu, pg8::GridOrder>(ring, g, S, E);
        weight_copies(F, NITEMS_MID, NITEMS_ALL, 128, F.G - 128);
        __syncthreads();
        SkGlu E2{WSP(bf16, WS_YG), INF(23), WSP(bf16, WS_MIX), (float*)(F.ctl + CW_SSQB)};
        skinny_gemm(F, WSP(bf16, WS_YG) + (size_t)MPR * SBW, SBW, WSP(bf16, WS_WGLU), SBW, SBW, SBW, E2, ((int)blockIdx.x + F.G - 128) % F.G, F.G);
    } SEAM(5);
    if (IN(7)) {
        pg8::Gemm g{WSP(bf16, WS_MIX), WSP(bf16, WS_WOUT), D, D, D}; pg8::GridOrder S; S.init(MPR / 256, 4, F.G, (int)blockIdx.x, 0, D, D);
        EpiResidMix E{WSP(bf16, WS_XB), WSP(bf16, WS_X1B), (float*)(F.ctl + CW_SSQ1), (const float*)(F.ctl + CW_SSQA), (const float*)(F.ctl + CW_SSQB), (LAS float*)(F.lds + HALO_OFF_C)};
        pg8::gemm_phase<EpiResidMix, pg8::GridOrder>(ring, g, S, E);
        SkResidMix E2{WSP(bf16, WS_XB), WSP(bf16, WS_X1B), (float*)(F.ctl + CW_SSQ1), (const float*)(F.ctl + CW_SSQA), (const float*)(F.ctl + CW_SSQB)};
        skinny_gemm(F, WSP(bf16, WS_MIX) + (size_t)MPR * D, D, WSP(bf16, WS_WOUT), D, D, D, E2, (int)blockIdx.x, F.G);
    } SEAM(7);
    if (IN(8)) {
        pg8::Gemm g{WSP(bf16, WS_X1B), WSP(bf16, WS_WMQ), D, D, D}; pg8::GridOrder S; S.init(MPR / 256, 4, F.G, (int)blockIdx.x, 0, D, D);
        EpiScaleBf16 E{(const float*)(F.ctl + CW_SSQ1), CM, WSP(bf16, WS_QM)};
        pg8::gemm_phase<EpiScaleBf16, pg8::GridOrder>(ring, g, S, E);
#if MK_PROBE == 8
        pg8::gemm_phase<EpiScaleBf16, pg8::GridOrder>(ring, g, S, E);
#endif
        SkScale E2{(const float*)(F.ctl + CW_SSQ1), CM, WSP(bf16, WS_QM)};
        skinny_gemm(F, WSP(bf16, WS_X1B) + (size_t)MPR * D, D, WSP(bf16, WS_WMQ), D, D, D, E2, (int)blockIdx.x, F.G);
        if (IN(9) && F.vcu < 256) { __syncthreads(); xattn_prompt_kload(F, F.vcu >> 6, (F.vcu >> 4) & 3); }
    } SEAM(8);
    if (IN(9)) {
#if MK_XSTAG
        const bool sfirst = ((F.vcu >> 4) & 1) != 0;
#else
        const bool sfirst = false;
#endif
        if (sfirst) { for (int u = F.vcu; u < MS * MH; u += F.G) xattn_sample_unit(F, u >> 2, u & 3); __syncthreads(); }
        { bool have_k = IN(8); for (int u = F.vcu; u < 256; u += F.G) { xattn_prompt_unit(F, u >> 6, (u >> 4) & 3, u & 15, have_k); have_k = false; } }
        if (!sfirst) { for (int u = F.vcu; u < MS * MH; u += F.G) xattn_sample_unit(F, u >> 2, u & 3); }
    } SEAM(9);
    if (IN(10)) {
        pg8::Gemm g{WSP(bf16, WS_OMEM), WSP(bf16, WS_WMO), D, D, D}; pg8::GridOrder S; S.init(MPR / 256, 4, F.G, (int)blockIdx.x, 0, D, D);
        EpiResidB E{WSP(bf16, WS_X1B), nullptr, WSP(bf16, WS_X2B), (float*)(F.ctl + CW_SSQ2), (LAS float*)(F.lds + HALO_OFF_C)};
        pg8::gemm_phase<EpiResidB, pg8::GridOrder>(ring, g, S, E);
#if MK_PROBE == 10
        { EpiResidB Ed{WSP(bf16, WS_X1B), nullptr, WSP(bf16, WS_X2B), (float*)(F.ctl + CW_SSQD), (LAS float*)(F.lds + HALO_OFF_C)}; pg8::gemm_phase<EpiResidB, pg8::GridOrder>(ring, g, S, Ed); }
#endif
        SkResidB E2{WSP(bf16, WS_X1B), nullptr, WSP(bf16, WS_X2B), (float*)(F.ctl + CW_SSQ2)};
        skinny_gemm(F, WSP(bf16, WS_OMEM) + (size_t)MPR * D, D, WSP(bf16, WS_WMO), D, D, D, E2, (int)blockIdx.x, F.G);
    } SEAM(10);
    if (IN(11)) {
        pg8::Gemm g{WSP(bf16, WS_X2B), WSP(bf16, WS_WGU), D, D, D, FF}; PanelOrder254 S; S.Gd.init(65, 22, F.G, (int)blockIdx.x, 0, D, D);
        EpiGateUpConv E{(const float*)(F.ctl + CW_SSQ2), WSP(bf16, WS_UB), F.out, INF(36), INF(37), (LAS float*)(F.lds + HALO_OFF)};
        const int nheavy = 1430 - (1430 / F.G) * F.G; const bool heavy = (int)blockIdx.x < nheavy;
        SkGateUpConv E2{(const float*)(F.ctl + CW_SSQ2), WSP(bf16, WS_UB), F.out, INF(36), INF(37), INF(7)};
        const int su0 = ((int)blockIdx.x + F.G - nheavy) % F.G;
        if (heavy) { skinny_gemm(F, WSP(bf16, WS_X2B) + (size_t)MPR * D, D, WSP(bf16, WS_WGU), D, FF, D, E2, su0, F.G, 16, FF);
            asm volatile("s_waitcnt vmcnt(0)" ::: "memory"); __syncthreads();
            if (F.tid == 0) { __builtin_amdgcn_fence(__ATOMIC_RELEASE, "agent"); (void)xb_add(F.ctl + CW_SCNT, 1u); } }
        pg8::gemm_phase<EpiGateUpConv, PanelOrder254>(ring, g, S, E);
#if MK_PROBE == 11
        pg8::gemm_phase<EpiGateUpConv, PanelOrder254>(ring, g, S, E);
#endif
        if (!heavy) { skinny_gemm(F, WSP(bf16, WS_X2B) + (size_t)MPR * D, D, WSP(bf16, WS_WGU), D, FF, D, E2, su0, F.G, 16, FF);
            asm volatile("s_waitcnt vmcnt(0)" ::: "memory"); __syncthreads();
            if (F.tid == 0) { __builtin_amdgcn_fence(__ATOMIC_RELEASE, "agent"); (void)xb_add(F.ctl + CW_SCNT, 1u);
                XB_SPIN(xb_ld(F.ctl + CW_SCNT) < (unsigned)F.G, F.ctl + CW_BAR); __builtin_amdgcn_fence(__ATOMIC_ACQUIRE, "agent"); }
            __syncthreads();
            SkResidB E3{WSP(bf16, WS_X2B), nullptr, WSP(bf16, WS_X1B), (float*)(F.ctl + CW_SSQ3)};
            skinny_gemm(F, WSP(bf16, WS_UB) + (size_t)MPR * FF, FF, WSP(bf16, WS_WDN), FF, D, FF, E3, su0, F.G - nheavy); }
    } SEAM(11);
    if (IN(13)) {
        pg8::Gemm g{WSP(bf16, WS_UB), WSP(bf16, WS_WDN), FF, FF, FF}; pg8::GridOrder S; S.init(MPR / 256, 4, F.G, (int)blockIdx.x, 0, FF, FF);
        EpiResidFinal E{WSP(bf16, WS_X2B), (float*)(F.ctl + CW_SSQ3), (LAS float*)(F.lds + HALO_OFF_C), F.ctl + CW_PCNT, F.ctl + CW_BAR, INF(39), F.out + O_YP, WSP(bf16, WS_X1B)};
        pg8::gemm_phase<EpiResidFinal, pg8::GridOrder>(ring, g, S, E);
#if MK_PROBE == 13
        { EpiResidB Ed{WSP(bf16, WS_X2B), nullptr, WSP(bf16, WS_X1B), (float*)(F.ctl + CW_SSQD), (LAS float*)(F.lds + HALO_OFF_C)}; pg8::gemm_phase<EpiResidB, pg8::GridOrder>(ring, g, S, Ed); }
#endif
    }
#if MK_PROBE == 20
    if (args.use_bar) { for (int i = 0; i < 10; ++i) xcd_barrier(bar); }
#endif
#if MK_PROBE >= 200
    TP_END(14);
    if (blockIdx.x == 0) { const unsigned long long t1 = __builtin_amdgcn_s_memrealtime(); while (__builtin_amdgcn_s_memrealtime() - t1 < tpd) __builtin_amdgcn_s_sleep(8); }
#endif
#undef IN
#undef SEAM
}
#ifndef MK_DEBUG
#define MK_DEBUG 0
#endif
#ifndef MK_ONE_LAUNCH
#define MK_ONE_LAUNCH 1
#endif
#if MK_DEBUG
struct Chk { const void* fast; const float* ref; long rows, cols, ldf, ldr; int isbf; float scale; };
__global__ void k_compare(Chk c, double* acc) {
    __shared__ double se[256], sr[256];
    double e = 0.0, r = 0.0; const long n = c.rows * c.cols;
    for (long i = (long)blockIdx.x * 256 + threadIdx.x; i < n; i += (long)gridDim.x * 256) { const long rr = i / c.cols, cc = i % c.cols;
        const float f = (c.isbf ? bf2f(((const unsigned short*)c.fast)[rr * c.ldf + cc]) : ((const float*)c.fast)[rr * c.ldf + cc]) * c.scale; const float g = c.ref[rr * c.ldr + cc];
        const double d = (double)f - (double)g; e += d * d; r += (double)g * (double)g; }
    se[threadIdx.x] = e; sr[threadIdx.x] = r; __syncthreads();
    for (int k = 128; k > 0; k >>= 1) { if ((int)threadIdx.x < k) { se[threadIdx.x] += se[threadIdx.x + k]; sr[threadIdx.x] += sr[threadIdx.x + k]; } __syncthreads(); }
    if (threadIdx.x == 0) { atomicAdd(acc, se[0]); atomicAdd(acc + 1, sr[0]); }
}
__global__ void k_compare_xh(const unsigned short* XH, const float* proj, const float* hs, int part, double* acc) {
    __shared__ double se[256], sr[256];
    double e = 0.0, r = 0.0; const int w = part ? 128 : 256; const long n = (long)1024 * NG * w;
    for (long i = (long)blockIdx.x * 256 + threadIdx.x; i < n; i += (long)gridDim.x * 256) { const int j = (int)(i % w); const long bcg = i / w; const int g = (int)(bcg % NG); const long bc = bcg / NG; const int b = (int)(bc / NCH), c = (int)(bc % NCH);
        const float f = bf2f(XH[bcg * XHP + (part ? 256 : 0) + j]); float gref;
        if (!part) { const int s = j >> 4, q = j & 15; gref = proj[((size_t)b * T + c * LC + s) * INW + 1536 + g * GP + q]; }
        else { const int nn = j >> 1, ri = j & 1; gref = (c == 0) ? 0.f : hs[((((size_t)b * T + c * LC - 1) * NG + g) * NST + nn) * 2 + ri]; }
        const double d = (double)f - (double)gref; e += d * d; r += (double)gref * (double)gref; }
    se[threadIdx.x] = e; sr[threadIdx.x] = r; __syncthreads();
    for (int k = 128; k > 0; k >>= 1) { if ((int)threadIdx.x < k) { se[threadIdx.x] += se[threadIdx.x + k]; sr[threadIdx.x] += sr[threadIdx.x + k]; } __syncthreads(); }
    if (threadIdx.x == 0) { atomicAdd(acc, se[0]); atomicAdd(acc + 1, sr[0]); }
}
__global__ void k_judge(const double* acc, int n, float tol, float* out) {
    if (threadIdx.x != 0 || blockIdx.x != 0) return;
    for (int k = 0; k < n; ++k) { const double rv = acc[2 * k] / acc[2 * k + 1];
        if (!(rv < (double)tol)) { int m = 5; if (rv != rv) m = 0; else if (rv >= 1.0) m = 9; else if (rv >= 0.1) m = 8; else if (rv >= 0.01) m = 7; else if (rv >= 0.001) m = 6;
            const int grp = k / 9, kk = k % 9 + 1; float code = (float)(10 * kk + m) * 100.f; for (int i = 0; i < grp; ++i) code *= 100.f; out[0] = code; return; } }
}
#endif

extern "C" void kernel_launch(void* const* d_in, const int* in_sizes, int n_in, void* d_out, int out_size, void* d_ws, size_t ws_size, hipStream_t stream) {
    static int grid = 0;
    if (grid == 0) {
        if (n_in != 40 || (size_t)out_size != O_END || ws_size < WS_FAST_END) { fprintf(stderr, "kernel_launch: unexpected shapes: n_in %d out %d ws %zu\n", n_in, out_size, ws_size); grid = -1; return; }
        int dev = 0, cus = 0, per_cu = 0;
        if (hipGetDevice(&dev) != hipSuccess || hipDeviceGetAttribute(&cus, hipDeviceAttributeMultiprocessorCount, dev) != hipSuccess) { grid = -1; return; }
        if (hipFuncSetAttribute((const void*)mk_fwd, hipFuncAttributeMaxDynamicSharedMemorySize, LDS_BYTES) != hipSuccess) { fprintf(stderr, "kernel_launch: hipFuncSetAttribute failed\n"); grid = -1; return; }
        if (hipOccupancyMaxActiveBlocksPerMultiprocessor(&per_cu, (const void*)mk_fwd, NTHR, LDS_BYTES) != hipSuccess || per_cu < 1) { fprintf(stderr, "kernel_launch: occupancy query says %d\n", per_cu); }
        (void)hipGetLastError();
        grid = cus;
        if (grid < 256) { fprintf(stderr, "kernel_launch: this kernel needs at least 256 CUs (found %d): the down projection's 256 units meet on per-panel counters and must all be resident at once\n", grid); grid = -1; return; }
    }
    if (grid < 0) return;
    (void)hipMemsetAsync((char*)d_ws + WS_CTL, 0, CTL_ZERO_BYTES, stream);
    Args a{};
    for (int i = 0; i < 40; ++i) a.in[i] = d_in[i];
    a.out = (float*)d_out; a.ws = (unsigned char*)d_ws;
#if MK_DEBUG
    const size_t fo_off = (WS_FAST_END + 4095) & ~(size_t)4095, nv_off = fo_off + (((size_t)O_END * 4 + 4095) & ~(size_t)4095), chk_off = nv_off + (((size_t)nv::WS_FLOATS * 4 + 4095) & ~(size_t)4095);
    if (ws_size < chk_off + 4096) { fprintf(stderr, "debug build: workspace too small (%zu < %zu)\n", ws_size, chk_off + 4096); return; }
    float* fast_out = (float*)((char*)d_ws + fo_off); float* nvws = (float*)((char*)d_ws + nv_off); double* chk = (double*)((char*)d_ws + chk_off);
    nv::forward(d_in, (float*)d_out, nvws, stream);
    a.out = fast_out;
    (void)hipMemsetAsync(chk, 0, 4096, stream);
#endif
#if MK_ONE_LAUNCH
    a.ph_lo = 0; a.ph_hi = N_PHASES; a.use_bar = 1;
    hipLaunchKernelGGL(mk_fwd, dim3(grid), dim3(NTHR), LDS_BYTES, stream, a);
#else
    for (int p = 0; p < N_PHASES; ++p) { a.ph_lo = p; a.ph_hi = p + 1; a.use_bar = 0; hipLaunchKernelGGL(mk_fwd, dim3(grid), dim3(NTHR), LDS_BYTES, stream, a); }
#endif
#if MK_DEBUG
    {
        const nv::Bufs B = nv::carve(nvws); unsigned char* ws = (unsigned char*)d_ws; int k = 0; const float* no = (const float*)d_out;
        auto cmp = [&](const void* fast, int isbf, long ldf, const float* ref, long ldr, long rows, long cols, float scale) {
            Chk c; memset(&c, 0, sizeof(c)); c.fast = fast; c.ref = ref; c.rows = rows; c.cols = cols; c.ldf = ldf; c.ldr = ldr; c.isbf = isbf; c.scale = scale; hipLaunchKernelGGL(k_compare, dim3(1024), dim3(256), 0, stream, c, chk + 2 * k); ++k; };
        cmp(ws + WS_KB, 1, SBW, B.PROJ + 512, INW, MPR, SBW, 1.f);
        cmp(ws + WS_VB, 1, SBW, B.PROJ + 1024, INW, MPR, SBW, 1.f);
        cmp(ws + WS_QB, 1, SBW, B.PROJ, INW, MPR, SBW, 1.f / C2);
        hipLaunchKernelGGL(k_compare_xh, dim3(1024), dim3(256), 0, stream, (const unsigned short*)(ws + WS_XH), B.PROJ, B.HS, 0, chk + 2 * k); ++k;
        cmp(ws + WS_MKB, 1, D, no + O_MKP, D, NB * MT, D, 1.f);
        cmp(ws + WS_MVB, 1, D, no + O_MVP, D, NB * MT, D, 1.f);
        cmp(ws + WS_MIX, 1, D, B.OSB, SBW, MPR, SBW, 1.f);
        cmp(ws + WS_MIX + (size_t)MPR * D * 2, 1, D, B.OSB + (size_t)MPR * SBW, SBW, MS, SBW, 1.f);
        hipLaunchKernelGGL(k_compare_xh, dim3(1024), dim3(256), 0, stream, (const unsigned short*)(ws + WS_XH), B.PROJ, B.HS, 1, chk + 2 * k); ++k;
        cmp(ws + WS_YG, 1, SBW, B.YG, SBW, MPR, SBW, 1.f);
        cmp(ws + WS_YG + (size_t)MPR * SBW * 2, 1, SBW, B.YG + (size_t)MPR * SBW, SBW, MS, SBW, 1.f);
        cmp(ws + WS_MIX + SBW * 2, 1, D, B.OSSM, SBW, MALL, SBW, 1.f);
        cmp(ws + WS_X1B, 1, D, B.X3, D, MALL, D, 1.f);
        cmp(ws + WS_QM, 1, D, B.Q, D, MALL, D, 1.f / CM);
        cmp(ws + WS_OMEM, 1, D, B.OM, D, MPR, D, 1.f);
        cmp(ws + WS_OMEM + (size_t)MPR * D * 2, 1, D, B.OM + (size_t)MPR * D, D, MS, D, 1.f);
        cmp(ws + WS_X2B, 1, D, B.X2, D, MALL, D, 1.f);
        cmp(ws + WS_X2B, 1, D, B.X2, D, MALL, D, 1.f);
        cmp(ws + WS_UB, 1, FF, B.ACT, FF, MALL, FF, 1.f);
        const size_t offs[15] = {O_YP, O_YS, O_KP, O_VP, O_REP, O_IMP, O_CVP, O_MKP, O_MVP, O_KS, O_VS, O_RES, O_IMS, O_CVS, O_END};
        for (int i = 0; i < 14; ++i) cmp(fast_out + offs[i], 0, 1, no + offs[i], 1, (long)(offs[i + 1] - offs[i]), 1, 1.f);
        hipLaunchKernelGGL(k_judge, dim3(1), dim3(64), 0, stream, (const double*)chk, k, 2e-3f, (float*)d_out);
    }
#endif
}
```
